# Optimizing an MI355X kernel written in HIP

```python
import math
import jax, jax.numpy as jnp
from jax import lax
import numpy as np

D_MODEL = 1024
BATCH = 16
SEQ = 2048
DEPTH = 4

N_Q_HEADS = 8
N_KV_HEADS = 2
HEAD_DIM = 64
Q_PER_KV = N_Q_HEADS // N_KV_HEADS
WINDOW = 128
BLOCK = WINDOW
ATTN_WIDTH = N_Q_HEADS * HEAD_DIM
KV_WIDTH = N_KV_HEADS * HEAD_DIM
N_BUCKETS = 32
MAX_DISTANCE = 128
N_SG_GROUPS = 8
SG_GROUP_DIM = 64
SG_CHUNK = 128
SG_WIDTH = N_SG_GROUPS * SG_GROUP_DIM
IN_SPLITS = (ATTN_WIDTH,
             ATTN_WIDTH + KV_WIDTH,
             ATTN_WIDTH + 2 * KV_WIDTH,
             ATTN_WIDTH + 2 * KV_WIDTH + SG_WIDTH,
             ATTN_WIDTH + 2 * KV_WIDTH + 2 * SG_WIDTH,
             ATTN_WIDTH + 2 * KV_WIDTH + 2 * SG_WIDTH + D_MODEL)
IN_WIDTH = ATTN_WIDTH + 2 * KV_WIDTH + 2 * SG_WIDTH + 2 * D_MODEL
N_EXPERTS = 16
N_EXPERT_GROUPS = 4
EXPERTS_PER_GROUP = N_EXPERTS // N_EXPERT_GROUPS
TOP_K = 2
D_FF_EXPERT = 256
DEEPNORM_ALPHA = (2 * DEPTH) ** 0.25
DEEPNORM_BETA = (8 * DEPTH) ** -0.25
ADA_SCALE = 0.2
LN_EPS = 1e-5
NEG_INF = -1e30

kernel_name = 'hybrid_swa_sink_gmlp_groupmoe_deepnorm_adaln'


def layer_norm(x, gain=None, bias=None):
    xf = x.astype(jnp.float32)
    mu = jnp.mean(xf, axis=-1, keepdims=True)
    var = jnp.mean(jnp.square(xf - mu), axis=-1, keepdims=True)
    y = (xf - mu) * lax.rsqrt(var + LN_EPS)
    if gain is not None:
        y = y * gain.astype(jnp.float32) + bias.astype(jnp.float32)
    return y.astype(x.dtype)


def t5_causal_bucket(rel):
    n = jnp.maximum(rel, 0)
    max_exact = N_BUCKETS // 2
    nf = jnp.maximum(n, 1).astype(jnp.float32)
    large = max_exact + (jnp.log(nf / max_exact) / math.log(MAX_DISTANCE / max_exact)
                         * (N_BUCKETS - max_exact)).astype(jnp.int32)
    large = jnp.minimum(large, N_BUCKETS - 1)
    return jnp.where(n < max_exact, n, large)


def relative_band_bias(rel_bias_table):
    qi = jnp.arange(BLOCK)[:, None]
    kj = jnp.arange(2 * BLOCK)[None, :]
    rel = qi + BLOCK - kj
    in_window = (rel >= 0) & (rel < WINDOW)
    bias = rel_bias_table[t5_causal_bucket(rel)]
    bias = jnp.transpose(bias, (2, 0, 1)).reshape(N_KV_HEADS, Q_PER_KV, BLOCK, 2 * BLOCK)
    return bias.astype(jnp.float32), in_window


def sliding_window_attention(q, k, v, sinks, band_bias, in_window):
    B, S = q.shape[0], q.shape[1]
    nb = S // BLOCK
    qb = q.reshape(B, nb, BLOCK, N_KV_HEADS, Q_PER_KV, HEAD_DIM)

    def band(t):
        prev = jnp.pad(t, ((0, 0), (BLOCK, 0), (0, 0)))[:, :S]
        both = jnp.concatenate([prev.reshape(B, nb, BLOCK, KV_WIDTH),
                                t.reshape(B, nb, BLOCK, KV_WIDTH)], axis=2)
        return both.reshape(B, nb, 2 * BLOCK, N_KV_HEADS, HEAD_DIM)

    kb, vb = band(k), band(v)
    scores = jnp.einsum('bnqhgd,bnkhd->bnhgqk', qb, kb).astype(jnp.float32) * (HEAD_DIM ** -0.5)
    key_pos = jnp.arange(nb)[:, None] * BLOCK - BLOCK + jnp.arange(2 * BLOCK)[None, :]
    mask = in_window[None] & (key_pos >= 0)[:, None, :]
    scores = jnp.where(mask[None, :, None, None], scores + band_bias[None, None], NEG_INF)
    sink = jnp.broadcast_to(sinks.astype(jnp.float32).reshape(1, 1, N_KV_HEADS, Q_PER_KV, 1, 1),
                            scores.shape[:-1] + (1,))
    probs = jax.nn.softmax(jnp.concatenate([scores, sink], axis=-1), axis=-1)[..., :-1]
    out = jnp.einsum('bnhgqk,bnkhd->bnqhgd', probs.astype(vb.dtype), vb)
    return out.reshape(B, S, ATTN_WIDTH)


def chunked_spatial_gating(u, v, sg_w, sg_b, ln_g, ln_b):
    v = layer_norm(v, ln_g, ln_b)
    B, S = v.shape[0], v.shape[1]
    nc = S // SG_CHUNK
    vc = v.reshape(B, nc, SG_CHUNK, N_SG_GROUPS, SG_GROUP_DIM)
    causal = jnp.tril(jnp.ones((SG_CHUNK, SG_CHUNK), dtype=bool))
    w = jnp.where(causal[None], sg_w, 0.0).astype(v.dtype)
    mixed = jnp.einsum('gij,bcjgd->bcigd', w, vc) + sg_b.T.astype(v.dtype)[None, None, :, :, None]
    return u * mixed.reshape(B, S, SG_WIDTH)


def token_mixing(h, w_in, w_br_attn, w_br_sg, w_out, sinks, band_bias, in_window,
                 sg_w, sg_b, sg_ln_g, sg_ln_b):
    proj = h @ w_in
    q, k, v, su, sv, ga, gs = jnp.split(proj, IN_SPLITS, axis=-1)
    attn = sliding_window_attention(q, k, v, sinks, band_bias, in_window)
    sg = chunked_spatial_gating(jax.nn.gelu(su, approximate=False), jax.nn.gelu(sv, approximate=False),
                                sg_w, sg_b, sg_ln_g, sg_ln_b)
    merged = jax.nn.sigmoid(ga) * (attn @ w_br_attn) + jax.nn.sigmoid(gs) * (sg @ w_br_sg)
    return merged @ w_out


def grouped_moe(h, w_router, router_bias, w_gate, w_up, w_down):
    B, S, D = h.shape
    t = h.reshape(B * S, D)
    T = t.shape[0]
    probs = jax.nn.softmax((t @ w_router).astype(jnp.float32), axis=-1)
    sel = (probs + router_bias.astype(jnp.float32)).reshape(T, N_EXPERT_GROUPS, EXPERTS_PER_GROUP)
    group_score = jnp.sum(lax.top_k(sel, TOP_K)[0], axis=-1)
    best = jnp.argmax(group_score, axis=-1)
    idx = jnp.broadcast_to(best[:, None, None], (T, 1, EXPERTS_PER_GROUP))
    in_group = jnp.take_along_axis(sel, idx, axis=1)[:, 0]
    _, local = lax.top_k(in_group, TOP_K)
    expert_idx = best[:, None] * EXPERTS_PER_GROUP + local
    w_sel = jnp.take_along_axis(probs, expert_idx, axis=-1)
    w_sel = w_sel / jnp.sum(w_sel, axis=-1, keepdims=True)
    combine = jnp.sum(jax.nn.one_hot(expert_idx, N_EXPERTS, dtype=jnp.float32) * w_sel[..., None], axis=1)
    combine = combine.astype(t.dtype)
    out = jnp.zeros_like(t)
    for e in range(N_EXPERTS):
        hid = jax.nn.silu(t @ w_gate[e]) * (t @ w_up[e])
        out = out + combine[:, e:e + 1] * (hid @ w_down[e])
    return out.reshape(B, S, D)


def setup_inputs(seed: int = 0) -> dict:
    key = jax.random.key(seed)
    ks = jax.random.split(key, 24)
    f32 = jnp.float32
    L, D, E, F = DEPTH, D_MODEL, N_EXPERTS, D_FF_EXPERT

    def nrm(k, shape, s):
        return jax.random.normal(k, shape, f32) * s

    return {
        'x': nrm(ks[0], (BATCH, SEQ, D), 1.0),
        'c': nrm(ks[1], (BATCH, D), 1.0),
        'rel_bias_table': nrm(ks[2], (N_BUCKETS, N_Q_HEADS), 0.5),
        'w_router': nrm(ks[3], (D, E), D ** -0.5),
        'router_bias': nrm(ks[4], (E,), 0.01),
        'w_ada': nrm(ks[5], (L, D, 6 * D), ADA_SCALE * D ** -0.5),
        'b_ada': nrm(ks[6], (L, 6 * D), 0.02),
        'w_in': nrm(ks[7], (L, D, IN_WIDTH), D ** -0.5),
        'sinks': nrm(ks[8], (L, N_Q_HEADS), 0.5),
        'sg_w': nrm(ks[9], (L, N_SG_GROUPS, SG_CHUNK, SG_CHUNK), SG_CHUNK ** -0.5),
        'sg_b': 1.0 + nrm(ks[10], (L, N_SG_GROUPS, SG_CHUNK), 0.1),
        'sg_ln_g': 1.0 + nrm(ks[11], (L, SG_WIDTH), 0.05),
        'sg_ln_b': nrm(ks[12], (L, SG_WIDTH), 0.02),
        'w_br_attn': nrm(ks[13], (L, ATTN_WIDTH, D), DEEPNORM_BETA * ATTN_WIDTH ** -0.5),
        'w_br_sg': nrm(ks[14], (L, SG_WIDTH, D), DEEPNORM_BETA * SG_WIDTH ** -0.5),
        'w_out': nrm(ks[15], (L, D, D), DEEPNORM_BETA * D ** -0.5),
        'ln1_g': 1.0 + nrm(ks[16], (L, D), 0.05),
        'ln1_b': nrm(ks[17], (L, D), 0.02),
        'w_gate': nrm(ks[18], (L, E, D, F), D ** -0.5),
        'w_up': nrm(ks[19], (L, E, D, F), D ** -0.5),
        'w_down': nrm(ks[20], (L, E, F, D), DEEPNORM_BETA * F ** -0.5),
        'ln2_g': 1.0 + nrm(ks[21], (L, D), 0.05),
        'ln2_b': nrm(ks[22], (L, D), 0.02),
    }


def reference(x, c, rel_bias_table, w_router, router_bias, w_ada, b_ada, w_in, sinks,
              sg_w, sg_b, sg_ln_g, sg_ln_b, w_br_attn, w_br_sg, w_out, ln1_g, ln1_b,
              w_gate, w_up, w_down, ln2_g, ln2_b):
    band_bias, in_window = relative_band_bias(rel_bias_table)
    cond = jax.nn.silu(c)
    for l in range(DEPTH):
        mod = cond @ w_ada[l] + b_ada[l]
        sh1, sc1, g1, sh2, sc2, g2 = [m[:, None, :] for m in jnp.split(mod, 6, axis=-1)]
        h = layer_norm(x) * (1.0 + sc1) + sh1
        y = token_mixing(h, w_in[l], w_br_attn[l], w_br_sg[l], w_out[l], sinks[l],
                         band_bias, in_window, sg_w[l], sg_b[l], sg_ln_g[l], sg_ln_b[l])
        x = layer_norm(DEEPNORM_ALPHA * x + (1.0 + g1) * y, ln1_g[l], ln1_b[l])
        h = layer_norm(x) * (1.0 + sc2) + sh2
        y = grouped_moe(h, w_router, router_bias, w_gate[l], w_up[l], w_down[l])
        x = layer_norm(DEEPNORM_ALPHA * x + (1.0 + g2) * y, ln2_g[l], ln2_b[l])
    return x
```

```cpp
#include <hip/hip_runtime.h>
#include <cstdio>
#include <cstdint>

namespace nv {
constexpr int D = 1024, BATCH = 16, SEQ = 2048, DEPTH = 4, T = BATCH * SEQ;
constexpr int INW = 3840, NE = 16, FF = 256;
constexpr float ALPHA = 1.681792830507429f;
constexpr float LN_EPS = 1e-5f;

__device__ __forceinline__ float gelu_erf(float v) { return 0.5f * v * (1.0f + erff(v * 0.70710678118654752f)); }
__device__ __forceinline__ float sigmoidf_(float v) { return 1.0f / (1.0f + expf(-v)); }
__device__ __forceinline__ float siluf_(float v) { return v / (1.0f + expf(-v)); }
__device__ __forceinline__ int t5_bucket(int rel) {
    int n = rel < 0 ? 0 : rel;
    if (n < 16) return n;
    int large = 16 + (int)(logf((float)n / 16.0f) / logf(8.0f) * 16.0f);
    return large < 31 ? large : 31;
}
__device__ __forceinline__ float block_sum(float v, float* red) {
    for (int o = 32; o >= 1; o >>= 1) v += __shfl_xor(v, o);
    __syncthreads();
    if ((threadIdx.x & 63) == 0) red[threadIdx.x >> 6] = v;
    __syncthreads();
    return red[0] + red[1] + red[2] + red[3];
}

__global__ void k_mod(const float* c, const float* w_ada, const float* b_ada, float* mod) {
    const int idx = blockIdx.x * blockDim.x + threadIdx.x;
    if (idx >= DEPTH * BATCH * 6 * D) return;
    const int j = idx % (6 * D), b = (idx / (6 * D)) % BATCH, l = idx / (6 * D * BATCH);
    const float* w = w_ada + (size_t)l * D * 6 * D + j;
    float s = 0.f;
    for (int k = 0; k < D; ++k) s += siluf_(c[b * D + k]) * w[(size_t)k * 6 * D];
    mod[idx] = s + b_ada[l * 6 * D + j];
}
__global__ void k_ln_mod(const float* x, const float* sh, const float* sc, float* h) {
    __shared__ float red[4];
    const int t = blockIdx.x, b = t / SEQ;
    const float* xr = x + (size_t)t * D;
    float v[4]; float s = 0.f;
    for (int i = 0; i < 4; ++i) { v[i] = xr[threadIdx.x + 256 * i]; s += v[i]; }
    const float mean = block_sum(s, red) * (1.0f / D);
    float q = 0.f;
    for (int i = 0; i < 4; ++i) { v[i] -= mean; q += v[i] * v[i]; }
    const float rstd = rsqrtf(block_sum(q, red) * (1.0f / D) + LN_EPS);
    for (int i = 0; i < 4; ++i) { const int cidx = threadIdx.x + 256 * i; h[(size_t)t * D + cidx] = v[i] * rstd * (1.0f + sc[b * 6 * D + cidx]) + sh[b * 6 * D + cidx]; }
}
__global__ void k_resid_ln(float* x, const float* y, const float* g, const float* gain, const float* bias) {
    __shared__ float red[4];
    const int t = blockIdx.x, b = t / SEQ;
    float v[4]; float s = 0.f;
    for (int i = 0; i < 4; ++i) { const int cidx = threadIdx.x + 256 * i; v[i] = ALPHA * x[(size_t)t * D + cidx] + (1.0f + g[b * 6 * D + cidx]) * y[(size_t)t * D + cidx]; s += v[i]; }
    const float mean = block_sum(s, red) * (1.0f / D);
    float q = 0.f;
    for (int i = 0; i < 4; ++i) { v[i] -= mean; q += v[i] * v[i]; }
    const float rstd = rsqrtf(block_sum(q, red) * (1.0f / D) + LN_EPS);
    for (int i = 0; i < 4; ++i) { const int cidx = threadIdx.x + 256 * i; x[(size_t)t * D + cidx] = v[i] * rstd * gain[cidx] + bias[cidx]; }
}
__global__ void __launch_bounds__(256) k_gemm(const float* A, int lda, const float* B, int ldb, float* C, int ldc, int K) {
    __shared__ float As[16][64 + 4], Bs[16][64 + 4];
    const int tx = threadIdx.x & 15, ty = threadIdx.x >> 4;
    const int m0 = blockIdx.y * 64, n0 = blockIdx.x * 64;
    float acc[4][4] = {};
    for (int k0 = 0; k0 < K; k0 += 16) {
        { const int r = threadIdx.x >> 2, cq = (threadIdx.x & 3) * 4;
          const float4 a = *(const float4*)(A + (size_t)(m0 + r) * lda + k0 + cq);
          As[cq + 0][r] = a.x; As[cq + 1][r] = a.y; As[cq + 2][r] = a.z; As[cq + 3][r] = a.w; }
        { const int r = threadIdx.x >> 4, cq = (threadIdx.x & 15) * 4;
          const float4 b = *(const float4*)(B + (size_t)(k0 + r) * ldb + n0 + cq);
          Bs[r][cq + 0] = b.x; Bs[r][cq + 1] = b.y; Bs[r][cq + 2] = b.z; Bs[r][cq + 3] = b.w; }
        __syncthreads();
#pragma unroll
        for (int k = 0; k < 16; ++k) {
            float a[4], b[4];
#pragma unroll
            for (int i = 0; i < 4; ++i) { a[i] = As[k][ty * 4 + i]; b[i] = Bs[k][tx * 4 + i]; }
#pragma unroll
            for (int i = 0; i < 4; ++i)
#pragma unroll
                for (int j = 0; j < 4; ++j) acc[i][j] += a[i] * b[j];
        }
        __syncthreads();
    }
#pragma unroll
    for (int i = 0; i < 4; ++i) *(float4*)(C + (size_t)(m0 + ty * 4 + i) * ldc + n0 + tx * 4) = make_float4(acc[i][0], acc[i][1], acc[i][2], acc[i][3]);
}
__global__ void __launch_bounds__(128) k_attn(const float* proj, const float* rel_bias, const float* sinks_l, float* cat) {
    const int h = blockIdx.x, n = blockIdx.y, s = blockIdx.z, qi = threadIdx.x;
    const int hk = h >> 2;
    const size_t row = (size_t)s * SEQ + n * 128 + qi;
    float q[64];
#pragma unroll
    for (int d = 0; d < 64; ++d) q[d] = proj[row * INW + h * 64 + d];
    float m = sinks_l[h], l = 1.0f;
    float o[64];
#pragma unroll
    for (int d = 0; d < 64; ++d) o[d] = 0.f;
    for (int kj = 0; kj < 256; ++kj) {
        const int rel = qi + 128 - kj, kpos = n * 128 - 128 + kj;
        if (rel < 0 || rel >= 128 || kpos < 0) continue;
        const float* kr = proj + ((size_t)s * SEQ + kpos) * INW + 512 + hk * 64;
        const float* vr = proj + ((size_t)s * SEQ + kpos) * INW + 640 + hk * 64;
        float sc = 0.f;
#pragma unroll
        for (int d = 0; d < 64; ++d) sc += q[d] * kr[d];
        sc = sc * 0.125f + rel_bias[t5_bucket(rel) * 8 + h];
        const float mn = fmaxf(m, sc), corr = expf(m - mn), p = expf(sc - mn);
        l = l * corr + p;
#pragma unroll
        for (int d = 0; d < 64; ++d) o[d] = o[d] * corr + p * vr[d];
        m = mn;
    }
    const float inv = 1.0f / l;
#pragma unroll
    for (int d = 0; d < 64; ++d) cat[row * D + h * 64 + d] = o[d] * inv;
}
__global__ void k_sg_ln(const float* proj, const float* ln_g, const float* ln_b, float* vln) {
    __shared__ float red[4];
    const size_t row = blockIdx.x;
    float v[2]; float s = 0.f;
    for (int i = 0; i < 2; ++i) { v[i] = gelu_erf(proj[row * INW + 1280 + threadIdx.x + 256 * i]); s += v[i]; }
    const float mean = block_sum(s, red) * (1.0f / 512);
    float q = 0.f;
    for (int i = 0; i < 2; ++i) { v[i] -= mean; q += v[i] * v[i]; }
    const float rstd = rsqrtf(block_sum(q, red) * (1.0f / 512) + LN_EPS);
    for (int i = 0; i < 2; ++i) { const int ch = threadIdx.x + 256 * i; vln[row * 512 + ch] = v[i] * rstd * ln_g[ch] + ln_b[ch]; }
}
__global__ void __launch_bounds__(512) k_sg(const float* proj, const float* vln, const float* sg_w_l, const float* sg_b_l, float* cat) {
    const int i = blockIdx.x, c = blockIdx.y, ch = threadIdx.x, g = ch >> 6;
    const size_t r0 = (size_t)c * 128;
    const float* w = sg_w_l + ((size_t)g * 128 + i) * 128;
    float acc = 0.f;
    for (int j = 0; j <= i; ++j) acc += w[j] * vln[(r0 + j) * 512 + ch];
    acc += sg_b_l[g * 128 + i];
    const float u = gelu_erf(proj[(r0 + i) * INW + 768 + ch]);
    cat[(r0 + i) * D + 512 + ch] = u * acc;
}
__global__ void k_merge(const float* proj, float* BA, const float* BS, int rows) {
    const size_t idx = (size_t)blockIdx.x * blockDim.x + threadIdx.x;
    if (idx >= (size_t)rows * D) return;
    const size_t r = idx / D; const int cidx = idx % D;
    BA[idx] = sigmoidf_(proj[r * INW + 1792 + cidx]) * BA[idx] + sigmoidf_(proj[r * INW + 2816 + cidx]) * BS[idx];
}
__global__ void __launch_bounds__(64) k_route(const float* h, const float* w_router, const float* router_bias, int* eidx, float* ew) {
    __shared__ float lgs[16], p[16], sel[16];
    const int t = blockIdx.x, lane = threadIdx.x;
    float lg[16];
#pragma unroll
    for (int e = 0; e < 16; ++e) lg[e] = 0.f;
    for (int k = lane; k < D; k += 64) { const float hv = h[(size_t)t * D + k];
#pragma unroll
        for (int e = 0; e < 16; ++e) lg[e] += hv * w_router[k * 16 + e]; }
#pragma unroll
    for (int e = 0; e < 16; ++e) { for (int o = 32; o >= 1; o >>= 1) lg[e] += __shfl_xor(lg[e], o); if (lane == 0) lgs[e] = lg[e]; }
    __syncthreads();
    if (lane == 0) {
        float mx = lgs[0]; for (int e = 1; e < 16; ++e) mx = fmaxf(mx, lgs[e]);
        float sum = 0.f; for (int e = 0; e < 16; ++e) { p[e] = expf(lgs[e] - mx); sum += p[e]; }
        for (int e = 0; e < 16; ++e) { p[e] /= sum; sel[e] = p[e] + router_bias[e]; }
        int best = 0; float bs = -1e30f;
        for (int g = 0; g < 4; ++g) {
            float m1 = -1e30f, m2 = -1e30f;
            for (int j = 0; j < 4; ++j) { const float v = sel[g * 4 + j]; if (v > m1) { m2 = m1; m1 = v; } else if (v > m2) m2 = v; }
            const float gs = m1 + m2; if (gs > bs) { bs = gs; best = g; }
        }
        int i1 = 0; float m1 = -1e30f;
        for (int j = 0; j < 4; ++j) if (sel[best * 4 + j] > m1) { m1 = sel[best * 4 + j]; i1 = j; }
        int i2 = 0; float m2 = -1e30f;
        for (int j = 0; j < 4; ++j) if (j != i1 && sel[best * 4 + j] > m2) { m2 = sel[best * 4 + j]; i2 = j; }
        const int e1 = best * 4 + i1, e2 = best * 4 + i2;
        const float w1 = p[e1], w2 = p[e2], ws = w1 + w2;
        eidx[t * 2] = e1; eidx[t * 2 + 1] = e2; ew[t * 2] = w1 / ws; ew[t * 2 + 1] = w2 / ws;
    }
}
__global__ void __launch_bounds__(256) k_moe(const float* h, const int* eidx, const float* ew, const float* wg, const float* wu, const float* wd, float* y) {
    __shared__ float hs[D], hid[FF];
    const int t = blockIdx.x, j = threadIdx.x;
    for (int i = 0; i < 4; ++i) hs[j + 256 * i] = h[(size_t)t * D + j + 256 * i];
    float out[4] = {0.f, 0.f, 0.f, 0.f};
    for (int s = 0; s < 2; ++s) {
        const int e = eidx[t * 2 + s]; const float wgt = ew[t * 2 + s];
        const float* G = wg + (size_t)e * D * FF; const float* U = wu + (size_t)e * D * FF; const float* Dn = wd + (size_t)e * FF * D;
        __syncthreads();
        float a = 0.f, b = 0.f;
        for (int k = 0; k < D; ++k) { a += hs[k] * G[(size_t)k * FF + j]; b += hs[k] * U[(size_t)k * FF + j]; }
        hid[j] = siluf_(a) * b;
        __syncthreads();
        for (int i = 0; i < 4; ++i) { float o = 0.f; for (int k = 0; k < FF; ++k) o += hid[k] * Dn[(size_t)k * D + j + 256 * i]; out[i] += wgt * o; }
    }
    for (int i = 0; i < 4; ++i) y[(size_t)t * D + j + 256 * i] = out[i];
}
}

extern "C" void kernel_launch(void* const* d_in, const int* in_sizes, int n_in, void* d_out, int out_size, void* d_ws, size_t ws_size, hipStream_t stream) {
    using namespace nv;
    const float* x_in = (const float*)d_in[0]; const float* c = (const float*)d_in[1]; const float* rel_bias = (const float*)d_in[2];
    const float* w_router = (const float*)d_in[3]; const float* router_bias = (const float*)d_in[4];
    const float* w_ada = (const float*)d_in[5]; const float* b_ada = (const float*)d_in[6]; const float* w_in = (const float*)d_in[7];
    const float* sinks = (const float*)d_in[8]; const float* sg_w = (const float*)d_in[9]; const float* sg_b = (const float*)d_in[10];
    const float* sg_ln_g = (const float*)d_in[11]; const float* sg_ln_b = (const float*)d_in[12];
    const float* w_br_attn = (const float*)d_in[13]; const float* w_br_sg = (const float*)d_in[14]; const float* w_out = (const float*)d_in[15];
    const float* ln1_g = (const float*)d_in[16]; const float* ln1_b = (const float*)d_in[17];
    const float* w_gate = (const float*)d_in[18]; const float* w_up = (const float*)d_in[19]; const float* w_down = (const float*)d_in[20];
    const float* ln2_g = (const float*)d_in[21]; const float* ln2_b = (const float*)d_in[22];
    float* x = (float*)d_out;
    constexpr int CH = 2 * SEQ;
    constexpr size_t MiB = 1u << 20;
    char* ws = (char*)d_ws;
    float* mod = (float*)(ws);
    int* eidx = (int*)(ws + 2 * MiB); float* ew = (float*)(ws + 3 * MiB);
    float* h = (float*)(ws + 4 * MiB);
    float* y = (float*)(ws + 132 * MiB);
    float* proj = (float*)(ws + 260 * MiB);
    float* vln = (float*)(ws + 320 * MiB);
    float* cat = (float*)(ws + 328 * MiB);
    float* BA = (float*)(ws + 344 * MiB);
    float* BS = (float*)(ws + 360 * MiB);
    if (ws_size < 376 * MiB) { fprintf(stderr, "ws too small: %zu\n", ws_size); return; }
    hipMemcpyAsync(x, x_in, (size_t)T * D * 4, hipMemcpyDeviceToDevice, stream);
    k_mod<<<(DEPTH * BATCH * 6 * D + 255) / 256, 256, 0, stream>>>(c, w_ada, b_ada, mod);
    for (int l = 0; l < DEPTH; ++l) {
        const float* ml = mod + (size_t)l * BATCH * 6 * D;
        k_ln_mod<<<T, 256, 0, stream>>>(x, ml + 0, ml + D, h);
        for (int ck = 0; ck < T / CH; ++ck) {
            const float* hc = h + (size_t)ck * CH * D;
            k_gemm<<<dim3(INW / 64, CH / 64), 256, 0, stream>>>(hc, D, w_in + (size_t)l * D * INW, INW, proj, INW, D);
            k_attn<<<dim3(8, SEQ / 128, CH / SEQ), 128, 0, stream>>>(proj, rel_bias, sinks + l * 8, cat);
            k_sg_ln<<<CH, 256, 0, stream>>>(proj, sg_ln_g + l * 512, sg_ln_b + l * 512, vln);
            k_sg<<<dim3(128, CH / 128), 512, 0, stream>>>(proj, vln, sg_w + (size_t)l * 8 * 128 * 128, sg_b + l * 8 * 128, cat);
            k_gemm<<<dim3(D / 64, CH / 64), 256, 0, stream>>>(cat, D, w_br_attn + (size_t)l * 512 * D, D, BA, D, 512);
            k_gemm<<<dim3(D / 64, CH / 64), 256, 0, stream>>>(cat + 512, D, w_br_sg + (size_t)l * 512 * D, D, BS, D, 512);
            k_merge<<<(CH * D + 255) / 256, 256, 0, stream>>>(proj, BA, BS, CH);
            k_gemm<<<dim3(D / 64, CH / 64), 256, 0, stream>>>(BA, D, w_out + (size_t)l * D * D, D, y + (size_t)ck * CH * D, D, D);
        }
        k_resid_ln<<<T, 256, 0, stream>>>(x, y, ml + 2 * D, ln1_g + l * D, ln1_b + l * D);
        k_ln_mod<<<T, 256, 0, stream>>>(x, ml + 3 * D, ml + 4 * D, h);
        k_route<<<T, 64, 0, stream>>>(h, w_router, router_bias, eidx, ew);
        k_moe<<<T, 256, 0, stream>>>(h, eidx, ew, w_gate + (size_t)l * NE * D * FF, w_up + (size_t)l * NE * D * FF, w_down + (size_t)l * NE * FF * D, y);
        k_resid_ln<<<T, 256, 0, stream>>>(x, y, ml + 5 * D, ln2_g + l * D, ln2_b + l * D);
    }
}
```

```cpp
#define MK_PER_PHASE 1
#include <hip/hip_runtime.h>
#include <cstdio>
#include <cstdint>

#define LAS __attribute__((address_space(3)))
#define GAS __attribute__((address_space(1)))
typedef unsigned short bf16_t;
typedef short bf16x8 __attribute__((ext_vector_type(8)));
typedef short s16x4 __attribute__((ext_vector_type(4)));
typedef float f32x4 __attribute__((ext_vector_type(4)));
typedef float f32x2 __attribute__((ext_vector_type(2)));
typedef unsigned u32x4 __attribute__((ext_vector_type(4)));
typedef unsigned u32x2 __attribute__((ext_vector_type(2)));

constexpr int D = 1024, BATCH = 16, SEQ = 2048, DEPTH = 4, T = BATCH * SEQ;
constexpr int INW = 3840, NE = 16, FF = 256;
constexpr float ALPHA = 1.681792830507429f;
constexpr float LN_EPS = 1e-5f;
constexpr int NWAVES = 8, NTHR = 512;

typedef __bf16 bf16x2_t __attribute__((ext_vector_type(2)));
__device__ __forceinline__ unsigned cvt_pk_bf16(float lo, float hi) { const f32x2 v = {lo, hi}; const bf16x2_t b = __builtin_convertvector(v, bf16x2_t); return __builtin_bit_cast(unsigned, b); }
__device__ __forceinline__ float bf_lo(unsigned w) { return __uint_as_float(w << 16); }
__device__ __forceinline__ float bf_hi(unsigned w) { return __uint_as_float(w & 0xffff0000u); }
__device__ __forceinline__ float fast_rcp(float x) { return __builtin_amdgcn_rcpf(x); }
__device__ __forceinline__ float fast_exp(float x) { return __builtin_amdgcn_exp2f(x * 1.4426950408889634f); }
__device__ __forceinline__ float sigmoid_f(float v) { return fast_rcp(1.0f + fast_exp(-v)); }
__device__ __forceinline__ f32x2 gelu_pk(f32x2 v) {
    const f32x2 av = __builtin_elementwise_abs(v), d = av * 0.2316418882f + 1.0f;
    f32x2 t; t.x = __builtin_amdgcn_rcpf(d.x); t.y = __builtin_amdgcn_rcpf(d.y);
    f32x2 q = t * 0.5307027145f + (-0.7265760135f); q = q * t + 0.7107068705f; q = q * t + (-0.142248368f); q = q * t + 0.127414796f; q = q * t;
    const f32x2 s = (v * v) * (-0.72134752044f);
    f32x2 e; e.x = __builtin_amdgcn_exp2f(s.x); e.y = __builtin_amdgcn_exp2f(s.y);
    const f32x2 m = v * (q * e), r = v - m;
    f32x2 o; o.x = v.x < 0.f ? m.x : r.x; o.y = v.y < 0.f ? m.y : r.y; return o;
}

namespace pg8 {
constexpr int BM = 256, BK = 64, HALF = 128, HTB = HALF * BK * 2  , STAGE_BYTES = 8 * HTB, NXCD = 8, WGM = 8;
__host__ __device__ __forceinline__ int lds_byte(int r, int c) { const int st = (r >> 4) * 2 + (c >> 5), rr = r & 15, cc = c & 31, ob = rr * 64 + cc * 2; return st * 1024 + (ob ^ (((ob >> 9) & 1) << 5)); }
__host__ __device__ __forceinline__ void stage_rc(int b, int& R, int& C) { const int st = b / 1024, sb = b % 1024, swz = sb ^ (((sb >> 9) & 1) << 5); R = (st >> 1) * 16 + swz / 64; C = (st & 1) * 32 + (swz % 64) / 2; }
__host__ __device__ __forceinline__ int perm32(int rho) { const int n = rho >> 4, i = rho & 15; return 8 * (i >> 2) + 4 * n + (i & 3); }

struct Unit { int pm, pn, e, p; };
struct Gemm { const bf16_t* A; const bf16_t* Bt; int lda, K; };

struct StaticOrder {
    int nM, nN, nwg, G, c;
    __device__ void init(int M, int N, int G_, int c_) { nM = M / BM; nN = N / BM; nwg = nM * nN; G = G_; c = c_; }
    __device__ bool next(int i, Unit& u) const {
        const long L = (long)i * G + c; if (L >= nwg) return false;
        int wgid = (int)L; { const int q = nwg / NXCD, r = nwg % NXCD, xcd = wgid % NXCD, off = wgid / NXCD; wgid = (xcd < r ? xcd * (q + 1) : r * (q + 1) + (xcd - r) * q) + off; }
        const int nig = WGM * nN, gid = wgid / nig, fm = gid * WGM, gsz = (nM - fm) < WGM ? (nM - fm) : WGM;
        u.pm = fm + ((wgid % nig) % gsz); u.pn = (wgid % nig) / gsz; u.e = 0; u.p = 0; return true;
    }
    __device__ __forceinline__ unsigned arow(const Unit&, int) const { return 0u; }
};
struct GroupOrder {
    const LAS int* tab; int ncol, G, c; const int2* list;
    __device__ bool next(int i, Unit& u) const {
        const int L = i * G + c; if (L >= tab[16]) return false;
        int e = 0;
#pragma unroll
        for (int k = 1; k < 16; ++k) e += (tab[k] <= L) ? 1 : 0;
        const int ul = L - tab[e]; const int p = ul / ncol, pnl = ul - p * ncol;
        u.pm = tab[32 + e] + p; u.pn = e * ncol + pnl; u.e = e; u.p = p; return true;
    }
    __device__ __forceinline__ unsigned arow(const Unit& u, int r) const {
        const int pos = u.p * 256 + r; const int cnt = tab[64 + u.e];
        const int d = (pos < cnt) ? list[(size_t)u.e * 32768 + pos].x : 0;
        return (unsigned)(d >> 1);
    }
};

template <class Epi, class Sched, bool ALIGN_EPI, bool GATHER>
__device__ __forceinline__ void gemm_phase(LAS unsigned char* lds, const Gemm g, const Sched& S, const Epi& E) {
    int tid_ = threadIdx.x; asm volatile("" : "+v"(tid_));
    const int tid = tid_, wid = __builtin_amdgcn_readfirstlane(tid >> 6), lane = tid & 63, wr = wid >> 2, wc = wid & 3, fr = lane & 15, fq = lane >> 4;
    int K_ = g.K; asm volatile("" : "+s"(K_));
    const int K = K_, nt = K / BK, lda = g.lda;
    unsigned voffA[2], voffB[2]; int RA[2], CA[2];
#pragma unroll
    for (int i = 0; i < 2; ++i) { int R, C; stage_rc(tid * 16 + i * 8192, R, C); const int Rb = Epi::PERM ? ((R & ~31) + perm32(R & 31)) : R;
        RA[i] = R; CA[i] = C; voffA[i] = (unsigned)(R * lda + C) * 2u; voffB[i] = (unsigned)(Rb * K + C) * 2u; }
    const unsigned kstep = (unsigned)(BK * 2);
    const unsigned hstepA = (unsigned)HALF * (unsigned)lda * 2u, tstepA = 2u * hstepA;
    const unsigned hstep = (unsigned)HALF * (unsigned)K * 2u, tstep = 2u * hstep;
    const unsigned ldsw = (unsigned)wid * 1024u;
    const int aoff = lds_byte(wr * 64 + fr, fq * 8), boff = lds_byte(wc * 32 + fr, fq * 8);
    unsigned ga[2][2] = {{0u, 0u}, {0u, 0u}}, gn[2][2] = {{0u, 0u}, {0u, 0u}};
#define PG8_SA(b, h) (((b) * 2 + (h)) * HTB)
#define PG8_SB(b, h) ((4 + (b) * 2 + (h)) * HTB)
#define PG8_GLDS(base, off32, bufoff, i) __builtin_amdgcn_global_load_lds((const unsigned*)((const char*)(base) + (size_t)(unsigned)(off32)), (LAS unsigned*)(lds + (bufoff) + ldsw + (i) * 8192), 16, 0, 0)
#define PG8_STAGE_B(bufoff, uoff) do { _Pragma("unroll") for (int _i = 0; _i < 2; ++_i) PG8_GLDS(g.Bt, (uoff) + voffB[_i], bufoff, _i); } while (0)
#define PG8_STAGE_A(bufoff, h, kb, nx) do { if constexpr (GATHER) { \
            _Pragma("unroll") for (int _i = 0; _i < 2; ++_i) { const unsigned _o = ((nx) ? gn[h][_i] : ga[h][_i]) + (kb); PG8_GLDS(g.A, _o, bufoff, _i); } } \
        else { const unsigned _u = ((nx) ? nAo : cAo) + (unsigned)(h) * hstepA + (kb); _Pragma("unroll") for (int _i = 0; _i < 2; ++_i) PG8_GLDS(g.A, _u + voffA[_i], bufoff, _i); } } while (0)
#define PG8_LDA(dst, b, h) do { _Pragma("unroll") for (int m = 0; m < 4; ++m) _Pragma("unroll") for (int k = 0; k < 2; ++k) dst[m][k] = *(const LAS bf16x8*)(lds + PG8_SA(b, h) + aoff + m * 2048 + k * 1024); } while (0)
#define PG8_LDB(dst, b, h) do { _Pragma("unroll") for (int n = 0; n < 2; ++n) _Pragma("unroll") for (int k = 0; k < 2; ++k) dst[n][k] = *(const LAS bf16x8*)(lds + PG8_SB(b, h) + boff + n * 2048 + k * 1024); } while (0)
#define PG8_MMA(ai, bj, At, Bt) do { __builtin_amdgcn_s_setprio(1); _Pragma("unroll") for (int m = 0; m < 4; ++m) _Pragma("unroll") for (int n = 0; n < 2; ++n) _Pragma("unroll") for (int k = 0; k < 2; ++k) \
        acc[ai][bj][m][n] = __builtin_amdgcn_mfma_f32_16x16x32_bf16(Bt[n][k], At[m][k], acc[ai][bj][m][n], 0, 0, 0); __builtin_amdgcn_s_setprio(0); } while (0)
#define PG8_WAIT_V(n) asm volatile("s_waitcnt vmcnt(" #n ")" ::: "memory")
#define PG8_WAIT_L(n) asm volatile("s_waitcnt lgkmcnt(" #n ")" ::: "memory")
#define PG8_BAR __builtin_amdgcn_s_barrier()
#define PG8_SCHED __builtin_amdgcn_sched_barrier(0)
#define PG8_GOFFS(dst, u) do { _Pragma("unroll") for (int _h = 0; _h < 2; ++_h) _Pragma("unroll") for (int _i = 0; _i < 2; ++_i) \
        dst[_h][_i] = (S.arow(u, _h * HALF + RA[_i]) * (unsigned)lda + (unsigned)CA[_i]) * 2u; } while (0)
    Unit cur, nxt; int ui = 0;
    if (!S.next(0, cur)) return;
    f32x4 acc[2][2][4][2];
#pragma unroll
    for (int a = 0; a < 2; ++a)
#pragma unroll
        for (int b = 0; b < 2; ++b)
#pragma unroll
            for (int m = 0; m < 4; ++m)
#pragma unroll
                for (int n = 0; n < 2; ++n) acc[a][b][m][n] = (f32x4){0.f, 0.f, 0.f, 0.f};
    bf16x8 At[4][2], B0[2][2], B1[2][2];
    unsigned cAo = GATHER ? 0u : (unsigned)cur.pm * tstepA, cBo = (unsigned)cur.pn * tstep, nAo = cAo;
    if constexpr (GATHER) { PG8_GOFFS(ga, cur); PG8_WAIT_V(0); }
    PG8_STAGE_B(PG8_SB(0, 0), cBo); PG8_STAGE_B(PG8_SB(0, 1), cBo + hstep); PG8_STAGE_A(PG8_SA(0, 0), 0, 0u, false); PG8_STAGE_A(PG8_SA(0, 1), 1, 0u, false);
    if (wr == 1) PG8_BAR;
    PG8_WAIT_V(2); PG8_BAR;
    PG8_STAGE_B(PG8_SB(1, 0), cBo + kstep); PG8_STAGE_A(PG8_SA(1, 0), 0, kstep, false); PG8_STAGE_B(PG8_SB(1, 1), cBo + hstep + kstep);
    PG8_WAIT_V(6); PG8_BAR;
    for (;;) {
        const bool has_next = S.next(ui + 1, nxt);
        nAo = has_next ? (GATHER ? 0u : (unsigned)nxt.pm * tstepA) : cAo; const unsigned nBo = has_next ? (unsigned)nxt.pn * tstep : cBo;
        if constexpr (GATHER) { if (has_next) { PG8_GOFFS(gn, nxt); } else {
#pragma unroll
            for (int _h = 0; _h < 2; ++_h)
#pragma unroll
                for (int _i = 0; _i < 2; ++_i) gn[_h][_i] = ga[_h][_i]; } }
        for (int t = 0; t < nt; t += 2) {
            const bool last = (t == nt - 2);
            const unsigned k1 = (unsigned)(t + 1) * kstep;
            const unsigned k2 = last ? 0u : (unsigned)(t + 2) * kstep, k3 = k2 + kstep;
            const unsigned b2 = (last ? nBo : cBo) + k2, b3 = b2 + kstep;
            if constexpr (Epi::HAS_MID) { if (t == (nt >> 1)) E.mid(acc, cur, wr, wc, fr, fq); }
            PG8_LDB(B0, 0, 0); PG8_LDB(B1, 0, 1); PG8_SCHED; PG8_LDA(At, 0, 0); PG8_STAGE_A(PG8_SA(1, 1), 1, k1, false);
            PG8_WAIT_V(8); PG8_WAIT_L(0); PG8_BAR; PG8_MMA(0, 0, At, B0); PG8_MMA(0, 1, At, B1); PG8_BAR; PG8_SCHED;
            PG8_LDA(At, 0, 1); PG8_STAGE_B(PG8_SB(0, 0), b2); PG8_STAGE_B(PG8_SB(0, 1), b2 + hstep); PG8_STAGE_A(PG8_SA(0, 0), 0, k2, last);
            PG8_WAIT_V(8); PG8_WAIT_L(0); PG8_BAR; PG8_MMA(1, 0, At, B0); PG8_MMA(1, 1, At, B1); PG8_BAR; PG8_SCHED;
            PG8_LDB(B0, 1, 0); PG8_LDB(B1, 1, 1); PG8_SCHED; PG8_LDA(At, 1, 0); PG8_STAGE_A(PG8_SA(0, 1), 1, k2, last);
            PG8_WAIT_V(8); PG8_WAIT_L(0); PG8_BAR; PG8_MMA(0, 0, At, B0); PG8_MMA(0, 1, At, B1); PG8_BAR; PG8_SCHED;
            PG8_LDA(At, 1, 1); PG8_STAGE_B(PG8_SB(1, 0), b3); PG8_STAGE_B(PG8_SB(1, 1), b3 + hstep); PG8_STAGE_A(PG8_SA(1, 0), 0, k3, last);
            PG8_WAIT_V(8); PG8_WAIT_L(0); PG8_BAR; PG8_MMA(1, 0, At, B0); PG8_MMA(1, 1, At, B1); PG8_BAR; PG8_SCHED;
        }
        if constexpr (ALIGN_EPI) { if (wr == 0) PG8_BAR; }
        E(acc, cur, wr, wc, fr, fq);
        if (!has_next) break;
#pragma unroll
        for (int a = 0; a < 2; ++a)
#pragma unroll
            for (int b = 0; b < 2; ++b)
#pragma unroll
                for (int m = 0; m < 4; ++m)
#pragma unroll
                    for (int n = 0; n < 2; ++n) acc[a][b][m][n] = (f32x4){0.f, 0.f, 0.f, 0.f};
        cur = nxt; cAo = nAo; cBo = nBo; ++ui;
#pragma unroll
        for (int _h = 0; _h < 2; ++_h)
#pragma unroll
            for (int _i = 0; _i < 2; ++_i) ga[_h][_i] = gn[_h][_i];
        if constexpr (ALIGN_EPI) { if (wr == 1) PG8_BAR; }
    }
    PG8_WAIT_V(0);
    if constexpr (!ALIGN_EPI) { if (wr == 0) PG8_BAR; }
    PG8_BAR;
#undef PG8_SA
#undef PG8_SB
#undef PG8_GLDS
#undef PG8_STAGE_B
#undef PG8_STAGE_A
#undef PG8_LDA
#undef PG8_LDB
#undef PG8_MMA
#undef PG8_WAIT_V
#undef PG8_WAIT_L
#undef PG8_BAR
#undef PG8_SCHED
#undef PG8_GOFFS
}
}

namespace pg8 {
__device__ __forceinline__ u32x4 pack8(const f32x4 v0, const f32x4 v1) { u32x4 w; w.x = cvt_pk_bf16(v0[0], v0[1]); w.y = cvt_pk_bf16(v0[2], v0[3]); w.z = cvt_pk_bf16(v1[0], v1[1]); w.w = cvt_pk_bf16(v1[2], v1[3]); return w; }
__device__ __forceinline__ void st16(void* base, unsigned off, const u32x4 v) { *(u32x4*)((char*)base + (size_t)off) = v; }
__device__ __forceinline__ u32x4 ld16(const void* base, unsigned off) { return *(const u32x4*)((const char*)base + (size_t)off); }

struct EpiInProj {
    static constexpr bool PERM = true, HAS_MID = false;
    bf16_t *QKV, *USV, *GA, *GS;
    __device__ __forceinline__ void operator()(const f32x4 (&acc)[2][2][4][2], const Unit& u, int wr, int wc, int fr, int fq) const {
        const unsigned row0 = (unsigned)(u.pm * BM + wr * 64 + fr), cl = (unsigned)(wc * 32 + 8 * fq); const int pn = u.pn;
        if (pn < 3) {
            const float sc = (pn < 2) ? 0.125f : 1.0f; unsigned o0 = (row0 * 768u + (unsigned)pn * 256u + cl) * 2u; asm volatile("" : "+v"(o0));
#pragma unroll
            for (int ai = 0; ai < 2; ++ai)
#pragma unroll
                for (int m = 0; m < 4; ++m)
#pragma unroll
                    for (int bj = 0; bj < 2; ++bj) st16(QKV, o0 + (unsigned)((ai * HALF + m * 16) * 768 + bj * HALF) * 2u, pack8(acc[ai][bj][m][0] * sc, acc[ai][bj][m][1] * sc));
        } else if (pn < 7) {
            unsigned o0 = (row0 * 1024u + (unsigned)(pn - 3) * 256u + cl) * 2u; asm volatile("" : "+v"(o0));
#pragma unroll
            for (int ai = 0; ai < 2; ++ai)
#pragma unroll
                for (int m = 0; m < 4; ++m)
#pragma unroll
                    for (int bj = 0; bj < 2; ++bj) { const f32x4 v0 = acc[ai][bj][m][0], v1 = acc[ai][bj][m][1];
                        const f32x2 a = gelu_pk((f32x2){v0[0], v0[1]}), b = gelu_pk((f32x2){v0[2], v0[3]}), c = gelu_pk((f32x2){v1[0], v1[1]}), d = gelu_pk((f32x2){v1[2], v1[3]});
                        st16(USV, o0 + (unsigned)((ai * HALF + m * 16) * 1024 + bj * HALF) * 2u, pack8((f32x4){a.x, a.y, b.x, b.y}, (f32x4){c.x, c.y, d.x, d.y})); }
        } else {
            bf16_t* base = (pn < 11) ? GA : GS; unsigned o0 = (row0 * 1024u + (unsigned)((pn - 7) & 3) * 256u + cl) * 2u; asm volatile("" : "+v"(o0));
#pragma unroll
            for (int ai = 0; ai < 2; ++ai)
#pragma unroll
                for (int m = 0; m < 4; ++m)
#pragma unroll
                    for (int bj = 0; bj < 2; ++bj) { f32x4 v0 = acc[ai][bj][m][0], v1 = acc[ai][bj][m][1];
#pragma unroll
                        for (int j = 0; j < 4; ++j) { v0[j] = sigmoid_f(v0[j]); v1[j] = sigmoid_f(v1[j]); }
                        st16(base, o0 + (unsigned)((ai * HALF + m * 16) * 1024 + bj * HALF) * 2u, pack8(v0, v1)); }
        }
    }
};
struct EpiMerge {
    static constexpr bool PERM = true, HAS_MID = true;
    const bf16_t *GA, *GS; bf16_t* O;
    __device__ __forceinline__ void mid(f32x4 (&acc)[2][2][4][2], const Unit& u, int wr, int wc, int fr, int fq) const {
        unsigned o0 = ((unsigned)(u.pm * BM + wr * 64 + fr) * 1024u + (unsigned)(u.pn * BM + wc * 32 + 8 * fq)) * 2u; asm volatile("" : "+v"(o0));
#pragma unroll
        for (int ai = 0; ai < 2; ++ai)
#pragma unroll
            for (int m = 0; m < 4; ++m) {
#pragma unroll
                for (int bj = 0; bj < 2; ++bj) { const unsigned off = o0 + (unsigned)((ai * HALF + m * 16) * 1024 + bj * HALF) * 2u; const u32x4 a = ld16(GA, off), s = ld16(GS, off);
                    f32x4 r0, r1;
                    r0[0] = bf_lo(a.x) * fast_rcp(bf_lo(s.x)); r0[1] = bf_hi(a.x) * fast_rcp(bf_hi(s.x)); r0[2] = bf_lo(a.y) * fast_rcp(bf_lo(s.y)); r0[3] = bf_hi(a.y) * fast_rcp(bf_hi(s.y));
                    r1[0] = bf_lo(a.z) * fast_rcp(bf_lo(s.z)); r1[1] = bf_hi(a.z) * fast_rcp(bf_hi(s.z)); r1[2] = bf_lo(a.w) * fast_rcp(bf_lo(s.w)); r1[3] = bf_hi(a.w) * fast_rcp(bf_hi(s.w));
                    acc[ai][bj][m][0] *= r0; acc[ai][bj][m][1] *= r1; }
                asm volatile("" : "+v"(acc[ai][0][m][0]), "+v"(acc[ai][0][m][1]), "+v"(acc[ai][1][m][0]), "+v"(acc[ai][1][m][1]) :: "memory"); }
    }
    __device__ __forceinline__ void operator()(const f32x4 (&acc)[2][2][4][2], const Unit& u, int wr, int wc, int fr, int fq) const {
        unsigned o0 = ((unsigned)(u.pm * BM + wr * 64 + fr) * 1024u + (unsigned)(u.pn * BM + wc * 32 + 8 * fq)) * 2u; asm volatile("" : "+v"(o0));
#pragma unroll
        for (int ai = 0; ai < 2; ++ai)
#pragma unroll
            for (int m = 0; m < 4; ++m) {
#pragma unroll
                for (int bj = 0; bj < 2; ++bj) { const unsigned off = o0 + (unsigned)((ai * HALF + m * 16) * 1024 + bj * HALF) * 2u; const u32x4 s = ld16(GS, off);
                    const f32x4 g0 = (f32x4){bf_lo(s.x), bf_hi(s.x), bf_lo(s.y), bf_hi(s.y)}, g1 = (f32x4){bf_lo(s.z), bf_hi(s.z), bf_lo(s.w), bf_hi(s.w)};
                    st16(O, off, pack8(acc[ai][bj][m][0] * g0, acc[ai][bj][m][1] * g1)); }
                asm volatile("" ::: "memory"); }
    }
};
struct EpiPlain {
    static constexpr bool PERM = true, HAS_MID = false;
    bf16_t* O;
    __device__ __forceinline__ void operator()(const f32x4 (&acc)[2][2][4][2], const Unit& u, int wr, int wc, int fr, int fq) const {
        unsigned o0 = ((unsigned)(u.pm * BM + wr * 64 + fr) * 1024u + (unsigned)(u.pn * BM + wc * 32 + 8 * fq)) * 2u; asm volatile("" : "+v"(o0));
#pragma unroll
        for (int ai = 0; ai < 2; ++ai)
#pragma unroll
            for (int m = 0; m < 4; ++m)
#pragma unroll
                for (int bj = 0; bj < 2; ++bj) st16(O, o0 + (unsigned)((ai * HALF + m * 16) * 1024 + bj * HALF) * 2u, pack8(acc[ai][bj][m][0], acc[ai][bj][m][1]));
    }
};
struct EpiGateUp {
    static constexpr bool PERM = true, HAS_MID = false;
    bf16_t* HID;
    __device__ __forceinline__ void operator()(const f32x4 (&acc)[2][2][4][2], const Unit& u, int wr, int wc, int fr, int fq) const {
        unsigned o0 = ((unsigned)(u.pm * BM + wr * 64 + fr) * 256u + (unsigned)((u.pn & 1) * 128 + wc * 32 + 8 * fq)) * 2u; asm volatile("" : "+v"(o0));
#pragma unroll
        for (int ai = 0; ai < 2; ++ai)
#pragma unroll
            for (int m = 0; m < 4; ++m) { f32x4 h0, h1; const f32x4 g0 = acc[ai][0][m][0], g1 = acc[ai][0][m][1], u0 = acc[ai][1][m][0], u1 = acc[ai][1][m][1];
#pragma unroll
                for (int j = 0; j < 4; ++j) { h0[j] = g0[j] * sigmoid_f(g0[j]) * u0[j]; h1[j] = g1[j] * sigmoid_f(g1[j]) * u1[j]; }
                st16(HID, o0 + (unsigned)((ai * HALF + m * 16) * 256) * 2u, pack8(h0, h1)); }
    }
};
struct EpiDown {
    static constexpr bool PERM = true, HAS_MID = false;
    bf16_t* Y2; const int2* list; const LAS int* tab;
    __device__ __forceinline__ void operator()(const f32x4 (&acc)[2][2][4][2], const Unit& u, int wr, int wc, int fr, int fq) const {
        const int r0 = wr * 64 + fr, cnt = tab[64 + u.e] - u.p * 256; const unsigned colb = (unsigned)((u.pn & 3) * 256 + wc * 32 + 8 * fq) * 2u;
        unsigned lo0 = ((unsigned)u.e * 32768u + (unsigned)(u.p * 256 + r0)) * 8u; asm volatile("" : "+v"(lo0));
#pragma unroll
        for (int ai = 0; ai < 2; ++ai) {
            int2 en[4];
#pragma unroll
            for (int m = 0; m < 4; ++m) { en[m].x = -1; en[m].y = 0; if (r0 + ai * HALF + m * 16 < cnt) en[m] = *(const int2*)((const char*)list + (size_t)(lo0 + (unsigned)(ai * HALF + m * 16) * 8u)); }
#pragma unroll
            for (int m = 0; m < 4; ++m) { const float w = __int_as_float(en[m].y); const unsigned off = (unsigned)en[m].x * 2048u + colb;
                if (en[m].x >= 0) {
#pragma unroll
                    for (int bj = 0; bj < 2; ++bj) st16(Y2, off + (unsigned)(bj * HALF) * 2u, pack8(acc[ai][bj][m][0] * w, acc[ai][bj][m][1] * w)); } }
            asm volatile("" ::: "memory"); }
    }
};
}
#define XB_TMO      128
#define XB_XCNT(j)  (256  + 64 * (j))
#define XB_XSUB(j)  (1280 + 64 * (j))
#define XB_XGEN(j)  (2304 + 64 * (j))
#define XB_TOP      3328
#define XB_TOPGEN   3392
#define XCD_BAR_WORDS 3456
#define XB_SPIN_CAP (1u << 18)

__device__ __forceinline__ unsigned xb_ld(unsigned* p)              { return __hip_atomic_load(p, __ATOMIC_RELAXED, __HIP_MEMORY_SCOPE_AGENT); }
__device__ __forceinline__ unsigned xb_add(unsigned* p, unsigned v) { return __hip_atomic_fetch_add(p, v, __ATOMIC_RELAXED, __HIP_MEMORY_SCOPE_AGENT); }
__device__ __forceinline__ unsigned xb_xcc_id() { return (unsigned)__builtin_amdgcn_s_getreg((3 << 11) | 20) & 0xFu; }
#define XB_SPIN(cond, bar) do { unsigned _sp = 0; while (cond) { __builtin_amdgcn_s_sleep(1); \
    if ((++_sp & 255u) == 0u) { if (xb_ld(&(bar)[XB_TMO])) break; if (_sp > XB_SPIN_CAP) { atomicAdd(&(bar)[XB_TMO], 1u); break; } } } } while (0)

struct XcdBarrier {
    unsigned* bar; unsigned x;
    volatile LAS unsigned* st;
};

__device__ __forceinline__ XcdBarrier xcd_barrier_post(unsigned* bar, volatile LAS unsigned* st) {
    XcdBarrier b; b.bar = bar; b.x = xb_xcc_id(); b.st = st;
    if (threadIdx.x == 0) (void)xb_add(&bar[XB_XCNT(b.x)], 1u);
    return b;
}
__device__ __forceinline__ void xcd_barrier_complete(unsigned* bar, unsigned x, unsigned& nloc, unsigned& nx) {
    const unsigned G = gridDim.x * gridDim.y * gridDim.z;
    unsigned sum, cnt, mine, sp = 0u;
    for (;;) {
        sum = 0u; cnt = 0u; mine = 0u;
#pragma unroll
        for (unsigned j = 0; j < 16; ++j) { const unsigned c = xb_ld(&bar[XB_XCNT(j)]); sum += c; cnt += (c > 0u) ? 1u : 0u; mine = (j == x) ? c : mine; }
        if (sum == G) break;
        __builtin_amdgcn_s_sleep(1);
        if ((++sp & 255u) == 0u) { if (xb_ld(&bar[XB_TMO])) break; if (sp > XB_SPIN_CAP) { atomicAdd(&bar[XB_TMO], 1u); break; } }
    }
    nloc = mine > 0u ? mine : 1u; nx = cnt > 0u ? cnt : 1u;
}

__device__ __forceinline__ void xcd_barrier(const XcdBarrier& b) {
    asm volatile("s_waitcnt vmcnt(0)" ::: "memory");
    __syncthreads();
    if (threadIdx.x == 0) {
        unsigned* bar = b.bar;
        __builtin_amdgcn_s_waitcnt(0);
        unsigned nloc = b.st[0], nx = b.st[1];
        if (nloc == 0u) { xcd_barrier_complete(bar, b.x, nloc, nx); b.st[0] = nloc; b.st[1] = nx; }
        const unsigned old = xb_add(&bar[XB_XSUB(b.x)], 1u);
        const unsigned gen = old / nloc;
        if (old + 1u == (gen + 1u) * nloc) {
            __builtin_amdgcn_fence(__ATOMIC_RELEASE, "agent");
            asm volatile("s_waitcnt vmcnt(0)" ::: "memory");
            const unsigned og = xb_add(&bar[XB_TOP], 1u);
            const unsigned tg = og / nx;
            if (og + 1u == (tg + 1u) * nx) xb_add(&bar[XB_TOPGEN], 1u);
            else XB_SPIN(xb_ld(&bar[XB_TOPGEN]) == tg, bar);
            __builtin_amdgcn_fence(__ATOMIC_ACQUIRE, "agent");
            xb_add(&bar[XB_XGEN(b.x)], 1u);
            asm volatile("s_waitcnt vmcnt(0)" ::: "memory");
        } else {
            XB_SPIN(xb_ld(&bar[XB_XGEN(b.x)]) == gen, bar);
            __builtin_amdgcn_fence(__ATOMIC_ACQUIRE, "agent");
            asm volatile("s_waitcnt vmcnt(0)" ::: "memory");
        }
    }
    __syncthreads();
}

constexpr size_t MiB = 1u << 20;
constexpr size_t WS_CTL = 0, CTL_ZERO_BYTES = 1 * MiB;
constexpr size_t WS_MOD = 1 * MiB;
constexpr size_t WS_WIN = 4 * MiB, WS_WBR = 12 * MiB, WS_WOUT = 14 * MiB, WS_WGU = 16 * MiB, WS_WDN = 32 * MiB, WS_SGW = 40 * MiB;
constexpr size_t WS_LIST = 41 * MiB;
constexpr size_t WS_H = 48 * MiB;
constexpr size_t WS_QKV = 112 * MiB, WS_HID = WS_QKV;
constexpr size_t WS_USV = 160 * MiB, WS_MRG = WS_USV;
constexpr size_t WS_GA = 224 * MiB, WS_GS = 288 * MiB, WS_Y2 = WS_GA;
constexpr size_t WS_CAT = 352 * MiB, WS_Y = WS_CAT;
constexpr size_t WS_END = 416 * MiB;
constexpr int CW_BAR = 4096;
constexpr int CW_CNT = 16384;
constexpr int RING_BYTES = 131072, MISC_OFF = 135168, LDS_BYTES = 147456;

#define VM_WAIT() asm volatile("s_waitcnt vmcnt(0)" ::: "memory")
#define LDS_WAIT() asm volatile("s_waitcnt lgkmcnt(0)" ::: "memory")

struct Frame {
    LAS unsigned char* lds; int tid, lane, wave, vcu, G;
    unsigned* ctl; unsigned char* ws;
    const float* const* in; float* out;
};
__device__ __forceinline__ float wave_sum(float v) {
#pragma unroll
    for (int o = 1; o < 64; o <<= 1) v += __shfl_xor(v, o);
    return v;
}
__device__ __forceinline__ int t5_bucket(int rel) {
    const int n = rel < 0 ? 0 : rel;
    if (n < 16) return n;
    const int large = 16 + (int)(logf((float)n / 16.0f) / logf(8.0f) * 16.0f);
    return large < 31 ? large : 31;
}

__device__ __forceinline__ void transpose_item(const float* W, int N, bf16_t* WT, int ldt, int koff, int row_of_n0, int k0, int n0, LAS float* scr, int lane) {
#pragma unroll 8
    for (int i = 0; i < 32; ++i) { const int kk = 2 * i + (lane >> 5); scr[kk * 33 + (lane & 31)] = W[(size_t)(k0 + kk) * N + n0 + (lane & 31)]; }
    LDS_WAIT(); asm volatile("" ::: "memory");
    const int c = lane & 7;
#pragma unroll
    for (int j = 0; j < 4; ++j) { const int n = (lane >> 3) + 8 * j; const LAS float* s = scr + (8 * c) * 33 + n;
        u32x4 o; o.x = cvt_pk_bf16(s[0 * 33], s[1 * 33]); o.y = cvt_pk_bf16(s[2 * 33], s[3 * 33]); o.z = cvt_pk_bf16(s[4 * 33], s[5 * 33]); o.w = cvt_pk_bf16(s[6 * 33], s[7 * 33]);
        *(u32x4*)(WT + (size_t)(row_of_n0 + n) * ldt + koff + k0 + 8 * c) = o; }
    LDS_WAIT(); asm volatile("" ::: "memory");
}
constexpr int CI_IN = 16 * 120, CI_BR = 8 * 32, CI_OUT = 16 * 32, CI_GU = 16 * 8, CI_DN = 4 * 32;
constexpr int CONV_ITEMS = CI_IN + 2 * CI_BR + CI_OUT + NE * (2 * CI_GU + CI_DN) + 64;
__device__ __forceinline__ void conv_item(Frame& F, int l, int it, LAS float* scr) {
    const int lane = F.lane; unsigned char* ws = F.ws;
    int r = it;
    if (r < CI_IN) { const int nb = 120; transpose_item(F.in[7] + (size_t)l * D * INW, INW, (bf16_t*)(ws + WS_WIN), 1024, 0, 32 * (r % nb), 64 * (r / nb), 32 * (r % nb), scr, lane); return; } r -= CI_IN;
    if (r < CI_BR) { const int nb = 32; transpose_item(F.in[13] + (size_t)l * 512 * D, D, (bf16_t*)(ws + WS_WBR), 1024, 0, 32 * (r % nb), 64 * (r / nb), 32 * (r % nb), scr, lane); return; } r -= CI_BR;
    if (r < CI_BR) { const int nb = 32; transpose_item(F.in[14] + (size_t)l * 512 * D, D, (bf16_t*)(ws + WS_WBR), 1024, 512, 32 * (r % nb), 64 * (r / nb), 32 * (r % nb), scr, lane); return; } r -= CI_BR;
    if (r < CI_OUT) { const int nb = 32; transpose_item(F.in[15] + (size_t)l * D * D, D, (bf16_t*)(ws + WS_WOUT), 1024, 0, 32 * (r % nb), 64 * (r / nb), 32 * (r % nb), scr, lane); return; } r -= CI_OUT;
    if (r < NE * 2 * CI_GU) {
        const int e = r / (2 * CI_GU), q = r % (2 * CI_GU), up = q / CI_GU, ii = q % CI_GU, nb = 8, n0 = 32 * (ii % nb), k0 = 64 * (ii / nb);
        const float* W = F.in[up ? 19 : 18] + ((size_t)l * NE + e) * D * FF;
        transpose_item(W, FF, (bf16_t*)(ws + WS_WGU), 1024, 0, e * 512 + (n0 >> 7) * 256 + up * 128 + (n0 & 127), k0, n0, scr, lane); return; } r -= NE * 2 * CI_GU;
    if (r < NE * CI_DN) { const int e = r / CI_DN, ii = r % CI_DN, nb = 32, n0 = 32 * (ii % nb), k0 = 64 * (ii / nb);
        transpose_item(F.in[20] + ((size_t)l * NE + e) * FF * D, D, (bf16_t*)(ws + WS_WDN), 256, 0, e * 1024 + n0, k0, n0, scr, lane); return; } r -= NE * CI_DN;
    {
        const float* W = F.in[9] + (size_t)l * 8 * 128 * 128 + (size_t)r * 2048; bf16_t* O = (bf16_t*)(ws + WS_SGW) + (size_t)r * 2048;
        const int i = (r & 7) * 16 + (lane >> 2), j0 = (lane & 3) * 32;
#pragma unroll
        for (int q = 0; q < 4; ++q) { const f32x4 a = *(const f32x4*)(W + lane * 32 + q * 8), b = *(const f32x4*)(W + lane * 32 + q * 8 + 4); f32x4 a2, b2;
#pragma unroll
            for (int t = 0; t < 4; ++t) { a2[t] = (j0 + q * 8 + t <= i) ? a[t] : 0.f; b2[t] = (j0 + q * 8 + 4 + t <= i) ? b[t] : 0.f; }
            *(u32x4*)(O + lane * 32 + q * 8) = pg8::pack8(a2, b2); }
    }
}
__device__ __forceinline__ void conv_layer(Frame& F, int l, int wave_rot) {
    LAS float* scr = (LAS float*)(F.lds + F.wave * 16384);
    const int NGW = F.G * NWAVES; int gw = F.vcu * NWAVES + F.wave - wave_rot; if (gw < 0) gw += NGW;
    for (int it = gw; it < CONV_ITEMS; it += NGW) conv_item(F, l, it, scr);
}

constexpr int MOD_ITEMS = DEPTH * 6 * D / 32;
__device__ __forceinline__ void mod_item(Frame& F, int it) {
    const LAS float* cond = (const LAS float*)F.lds;
    const int l = it / 192, j0 = (it % 192) * 32, col = j0 + (F.lane & 31), kh = (F.lane >> 5) * 512;
    const float* w = F.in[5] + (size_t)l * D * 6 * D + (size_t)kh * 6 * D + col;
    float acc[16];
#pragma unroll
    for (int b = 0; b < 16; ++b) acc[b] = 0.f;
    for (int k = 0; k < 512; k += 4) {
        float wv[4];
#pragma unroll
        for (int q = 0; q < 4; ++q) wv[q] = w[(size_t)(k + q) * 6 * D];
#pragma unroll
        for (int b = 0; b < 16; ++b) { const f32x4 cv = *(const LAS f32x4*)(cond + b * 1024 + kh + k); acc[b] += cv[0] * wv[0] + cv[1] * wv[1] + cv[2] * wv[2] + cv[3] * wv[3]; }
    }
    float* mod = (float*)(F.ws + WS_MOD);
#pragma unroll
    for (int b = 0; b < 16; ++b) { const float s = acc[b] + __shfl_xor(acc[b], 32); if (F.lane < 32) mod[((size_t)l * BATCH + b) * 6 * D + col] = s + F.in[6][l * 6 * D + col]; }
}

struct RowArgs { const float* xin; const bf16_t* y; const float* g; const float* gain; const float* bias; const float* sc; const float* sh; bf16_t* H; int l; bool has_h; };
__device__ __forceinline__ f32x4 ldbf4(const bf16_t* p) { const u32x2 w = *(const u32x2*)p; return (f32x4){bf_lo(w.x), bf_hi(w.x), bf_lo(w.y), bf_hi(w.y)}; }
template <int MODE>
__device__ __forceinline__ void row_phase(Frame& F, const RowArgs& A) {
    int tid_ = threadIdx.x; asm volatile("" : "+v"(tid_));
    const int lane = tid_ & 63, wave = __builtin_amdgcn_readfirstlane(tid_ >> 6);
    LAS float* wr_t = (LAS float*)F.lds;
    LAS int* lcnt = (LAS int*)(F.lds + 65536);
    LAS int* gb = lcnt + 16;
    LAS int* asg = lcnt + 64;
    if (MODE == 1) {
        for (int idx = F.tid; idx < 4096; idx += NTHR) { const int k = idx >> 2, e4 = idx & 3; const f32x4 v = *(const f32x4*)(F.in[3] + k * 16 + 4 * e4);
            wr_t[(4 * e4 + 0) * 1024 + k] = v[0]; wr_t[(4 * e4 + 1) * 1024 + k] = v[1]; wr_t[(4 * e4 + 2) * 1024 + k] = v[2]; wr_t[(4 * e4 + 3) * 1024 + k] = v[3]; }
        __syncthreads();
    }
#pragma unroll 1
    for (int rb = F.vcu; rb < T / 128; rb += F.G) {
    const int row0 = rb * 128, b = row0 / SEQ;
    if (MODE == 1) { if (F.tid < 16) lcnt[F.tid] = 0; __syncthreads(); }
#pragma unroll 1
    for (int rr = 0; rr < 16; ++rr) {
        const int lr = wave * 16 + rr; const size_t row = (size_t)row0 + lr;
        f32x4 z[4];
        if (MODE == 0) {
#pragma unroll
            for (int j = 0; j < 4; ++j) z[j] = *(const f32x4*)(A.xin + row * D + 4 * lane + 256 * j);
        } else {
#pragma unroll
            for (int j = 0; j < 4; ++j) { const int c = 4 * lane + 256 * j; const f32x4 x = *(const f32x4*)(F.out + row * D + c); const f32x4 g = *(const f32x4*)(A.g + b * 6 * D + c);
                f32x4 y;
                if (MODE == 1) y = ldbf4(A.y + row * D + c); else y = ldbf4(A.y + (2 * row) * D + c) + ldbf4(A.y + (2 * row + 1) * D + c);
                z[j] = ALPHA * x + (1.0f + g) * y; }
            float s = 0.f;
#pragma unroll
            for (int j = 0; j < 4; ++j) s += (z[j][0] + z[j][1]) + (z[j][2] + z[j][3]);
            const float mean = wave_sum(s) * (1.0f / D); float q = 0.f;
#pragma unroll
            for (int j = 0; j < 4; ++j) { z[j] = z[j] - mean; q += (z[j][0] * z[j][0] + z[j][1] * z[j][1]) + (z[j][2] * z[j][2] + z[j][3] * z[j][3]); }
            const float rstd = 1.0f / sqrtf(wave_sum(q) * (1.0f / D) + LN_EPS);
#pragma unroll
            for (int j = 0; j < 4; ++j) { const int c = 4 * lane + 256 * j; z[j] = z[j] * rstd * *(const f32x4*)(A.gain + c) + *(const f32x4*)(A.bias + c); }
        }
#pragma unroll
        for (int j = 0; j < 4; ++j) *(f32x4*)(F.out + row * D + 4 * lane + 256 * j) = z[j];
        if (MODE != 2 || A.has_h) {
            float s = 0.f;
#pragma unroll
            for (int j = 0; j < 4; ++j) s += (z[j][0] + z[j][1]) + (z[j][2] + z[j][3]);
            const float mean = wave_sum(s) * (1.0f / D); float q = 0.f;
#pragma unroll
            for (int j = 0; j < 4; ++j) { z[j] = z[j] - mean; q += (z[j][0] * z[j][0] + z[j][1] * z[j][1]) + (z[j][2] * z[j][2] + z[j][3] * z[j][3]); }
            const float rstd = 1.0f / sqrtf(wave_sum(q) * (1.0f / D) + LN_EPS);
#pragma unroll
            for (int j = 0; j < 4; ++j) { const int c = 4 * lane + 256 * j; z[j] = z[j] * rstd * (1.0f + *(const f32x4*)(A.sc + b * 6 * D + c)) + *(const f32x4*)(A.sh + b * 6 * D + c);
                u32x2 w; w.x = cvt_pk_bf16(z[j][0], z[j][1]); w.y = cvt_pk_bf16(z[j][2], z[j][3]); *(u32x2*)(A.H + row * D + c) = w; }
            if (MODE == 1) {
                float lg[16];
#pragma unroll
                for (int e = 0; e < 16; ++e) { float a = 0.f;
#pragma unroll
                    for (int j = 0; j < 4; ++j) { const f32x4 wv = *(const LAS f32x4*)(wr_t + e * 1024 + 4 * lane + 256 * j); a += (z[j][0] * wv[0] + z[j][1] * wv[1]) + (z[j][2] * wv[2] + z[j][3] * wv[3]); }
                    lg[e] = wave_sum(a); }
                float mx = lg[0];
#pragma unroll
                for (int e = 1; e < 16; ++e) mx = fmaxf(mx, lg[e]);
                float p[16], sum = 0.f;
#pragma unroll
                for (int e = 0; e < 16; ++e) { p[e] = expf(lg[e] - mx); sum += p[e]; }
                const float inv = 1.0f / sum;
                float sel[16];
#pragma unroll
                for (int e = 0; e < 16; ++e) { p[e] *= inv; sel[e] = p[e] + F.in[4][e]; }
                int best = 0; float bs = -1e30f;
                float bsel[4], bp[4];
#pragma unroll
                for (int k = 0; k < 4; ++k) { bsel[k] = 0.f; bp[k] = 0.f; }
#pragma unroll
                for (int gq = 0; gq < 4; ++gq) { float m1 = -1e30f, m2 = -1e30f;
#pragma unroll
                    for (int k = 0; k < 4; ++k) { const float v = sel[gq * 4 + k]; if (v > m1) { m2 = m1; m1 = v; } else if (v > m2) m2 = v; }
                    const float gs = m1 + m2;
                    if (gs > bs) { bs = gs; best = gq;
#pragma unroll
                        for (int k = 0; k < 4; ++k) { bsel[k] = sel[gq * 4 + k]; bp[k] = p[gq * 4 + k]; } } }
                int i1 = 0; float m1 = -1e30f, p1 = 0.f;
#pragma unroll
                for (int k = 0; k < 4; ++k) if (bsel[k] > m1) { m1 = bsel[k]; i1 = k; p1 = bp[k]; }
                int i2 = 0; float m2 = -1e30f, p2 = 0.f;
#pragma unroll
                for (int k = 0; k < 4; ++k) if (k != i1 && bsel[k] > m2) { m2 = bsel[k]; i2 = k; p2 = bp[k]; }
                if (lane == 0) { const float ws = 1.0f / (p1 + p2); const int e1 = best * 4 + i1, e2 = best * 4 + i2;
                    const int r1 = __hip_atomic_fetch_add(lcnt + e1, 1, __ATOMIC_RELAXED, __HIP_MEMORY_SCOPE_WORKGROUP), r2 = __hip_atomic_fetch_add(lcnt + e2, 1, __ATOMIC_RELAXED, __HIP_MEMORY_SCOPE_WORKGROUP);
                    asg[(2 * lr) * 4 + 0] = e1; asg[(2 * lr) * 4 + 1] = r1; asg[(2 * lr) * 4 + 2] = __float_as_int(p1 * ws);
                    asg[(2 * lr + 1) * 4 + 0] = e2; asg[(2 * lr + 1) * 4 + 1] = r2; asg[(2 * lr + 1) * 4 + 2] = __float_as_int(p2 * ws); }
            }
        }
    }
    if (MODE == 1) {
        __syncthreads();
        if (F.tid < 16) gb[F.tid] = (int)__hip_atomic_fetch_add(F.ctl + CW_CNT + 64 * (A.l * 16 + F.tid), (unsigned)lcnt[F.tid], __ATOMIC_RELAXED, __HIP_MEMORY_SCOPE_AGENT);
        __syncthreads();
        if (F.tid < 256) { const int e = asg[F.tid * 4], rank = asg[F.tid * 4 + 1], wb = asg[F.tid * 4 + 2]; const int pos = gb[e] + rank;
            int2 en; en.x = (row0 + (F.tid >> 1)) * 2 + (F.tid & 1); en.y = wb; ((int2*)(F.ws + WS_LIST))[(size_t)e * 32768 + pos] = en; }
        __syncthreads();
    }
    }
}

__device__ __forceinline__ s16x4 vtr(const LAS unsigned char* p) { return __builtin_bit_cast(s16x4, __builtin_amdgcn_ds_read_tr16_b64_v4i16((LAS s16x4*)p)); }
__device__ __forceinline__ bf16x8 cat44(s16x4 a, s16x4 b) { return (bf16x8){a[0], a[1], a[2], a[3], b[0], b[1], b[2], b[3]}; }
__device__ __forceinline__ void mixer_unit(Frame& F, int l, int ub, int un) {
    int tid_ = threadIdx.x; asm volatile("" : "+v"(tid_));
    const int tid = tid_, lane = tid & 63, wave = __builtin_amdgcn_readfirstlane(tid >> 6), c = lane & 15, g = lane >> 4;
    LAS unsigned char* lds = F.lds;
    const bf16_t* QKV = (const bf16_t*)(F.ws + WS_QKV); const bf16_t* USV = (const bf16_t*)(F.ws + WS_USV); bf16_t* CAT = (bf16_t*)(F.ws + WS_CAT);
    const size_t tok0 = (size_t)ub * SEQ + (size_t)un * 128;
#pragma unroll 4
    for (int it = 0; it < 16; ++it) { const int ci = it * NTHR + tid, c8 = ci & 7, key = (ci >> 3) & 255, hk = (ci >> 11) & 1, tv = ci >> 12;
        u32x4 v = (u32x4){0u, 0u, 0u, 0u};
        if (un > 0 || key >= 128) v = *(const u32x4*)(QKV + (tok0 - 128 + key) * 768 + 512 + tv * 128 + hk * 64 + c8 * 8);
        *(LAS u32x4*)(lds + (tv * 2 + hk) * 32768 + key * 128 + ((c8 ^ (key & 7)) << 4)) = v; }
    __syncthreads();
    {
        const int h = wave, hk = h >> 2;
        const LAS unsigned char* Kb = lds + hk * 32768; const LAS unsigned char* Vb = lds + 65536 + hk * 32768;
        const float sink = F.in[8][l * 8 + h];
        float bv[9][4];
#pragma unroll
        for (int j = 0; j < 9; ++j)
#pragma unroll
            for (int r = 0; r < 4; ++r) { const int rel = c + 128 - 16 * j - 4 * g - r; bv[j][r] = (rel >= 0 && rel < 128) ? F.in[2][t5_bucket(rel) * 8 + h] : -1e30f; }
        const int ka0 = c * 128 + (((0 + g) ^ (c & 7)) << 4), ka1 = c * 128 + (((4 + g) ^ (c & 7)) << 4);
        const int vkey = 4 * g + (c >> 2), vsw = vkey & 7, vp = c & 3;
#pragma unroll 1
        for (int qt = 0; qt < 8; ++qt) {
            const bf16_t* qp = QKV + (tok0 + 16 * qt + c) * 768 + h * 64 + 8 * g;
            const bf16x8 q0 = *(const bf16x8*)qp, q1 = *(const bf16x8*)(qp + 32);
            f32x4 s[9];
#pragma unroll
            for (int j = 0; j < 9; ++j) { const LAS unsigned char* kt = Kb + (qt + j) * 2048;
                const bf16x8 k0 = *(const LAS bf16x8*)(kt + ka0), k1 = *(const LAS bf16x8*)(kt + ka1);
                f32x4 a = (f32x4){0.f, 0.f, 0.f, 0.f};
                a = __builtin_amdgcn_mfma_f32_16x16x32_bf16(k0, q0, a, 0, 0, 0); a = __builtin_amdgcn_mfma_f32_16x16x32_bf16(k1, q1, a, 0, 0, 0); s[j] = a; }
            float mx = sink;
#pragma unroll
            for (int j = 0; j < 9; ++j) { const bool dead = (un == 0) && (qt + j < 8);
#pragma unroll
                for (int r = 0; r < 4; ++r) { float v = s[j][r] + bv[j][r]; v = dead ? -1e30f : v; s[j][r] = v; mx = fmaxf(mx, v); } }
            mx = fmaxf(mx, __shfl_xor(mx, 16)); mx = fmaxf(mx, __shfl_xor(mx, 32));
            float sum = 0.f;
#pragma unroll
            for (int j = 0; j < 9; ++j)
#pragma unroll
                for (int r = 0; r < 4; ++r) { const float p = fast_exp(s[j][r] - mx); s[j][r] = p; sum += p; }
            sum += __shfl_xor(sum, 16); sum += __shfl_xor(sum, 32);
            const float inv = 1.0f / (sum + fast_exp(sink - mx));
            bf16x8 pf[5];
#pragma unroll
            for (int k = 0; k < 5; ++k) { const f32x4 a = s[2 * k], b = (k < 4) ? s[2 * k + 1] : (f32x4){0.f, 0.f, 0.f, 0.f};
                u32x4 w; w.x = cvt_pk_bf16(a[0], a[1]); w.y = cvt_pk_bf16(a[2], a[3]); w.z = cvt_pk_bf16(b[0], b[1]); w.w = cvt_pk_bf16(b[2], b[3]); pf[k] = __builtin_bit_cast(bf16x8, w); }
            bf16_t* op = CAT + (tok0 + 16 * qt + c) * 1024 + h * 64 + 4 * g;
#pragma unroll
            for (int dt = 0; dt < 4; ++dt) { f32x4 o = (f32x4){0.f, 0.f, 0.f, 0.f};
                const int voff = (((2 * dt + (vp >> 1)) ^ vsw) << 4) + (vp & 1) * 8;
#pragma unroll
                for (int k = 0; k < 5; ++k) { const int ta = qt + 2 * k; int tb = ta + 1; tb = tb > 15 ? 15 : tb;
                    const s16x4 va = vtr(Vb + (16 * ta + vkey) * 128 + voff), vb = vtr(Vb + (16 * tb + vkey) * 128 + voff);
                    o = __builtin_amdgcn_mfma_f32_16x16x32_bf16(cat44(va, vb), pf[k], o, 0, 0, 0); }
                u32x2 w; w.x = cvt_pk_bf16(o[0] * inv, o[1] * inv); w.y = cvt_pk_bf16(o[2] * inv, o[3] * inv); *(u32x2*)(op + 16 * dt) = w; }
        }
    }
    __syncthreads();
    {
        const float* lg = F.in[11] + l * 512 + 8 * lane; const float* lb = F.in[12] + l * 512 + 8 * lane;
        const f32x4 g0 = *(const f32x4*)lg, g1 = *(const f32x4*)(lg + 4), b0 = *(const f32x4*)lb, b1 = *(const f32x4*)(lb + 4);
#pragma unroll 2
        for (int rr = 0; rr < 16; ++rr) { const int row = wave * 16 + rr;
            const u32x4 w = *(const u32x4*)(USV + (tok0 + row) * 1024 + 512 + 8 * lane);
            f32x4 v0 = (f32x4){bf_lo(w.x), bf_hi(w.x), bf_lo(w.y), bf_hi(w.y)}, v1 = (f32x4){bf_lo(w.z), bf_hi(w.z), bf_lo(w.w), bf_hi(w.w)};
            const float mean = wave_sum((v0[0] + v0[1]) + (v0[2] + v0[3]) + (v1[0] + v1[1]) + (v1[2] + v1[3])) * (1.0f / 512);
            v0 = v0 - mean; v1 = v1 - mean;
            const float q = wave_sum((v0[0] * v0[0] + v0[1] * v0[1]) + (v0[2] * v0[2] + v0[3] * v0[3]) + (v1[0] * v1[0] + v1[1] * v1[1]) + (v1[2] * v1[2] + v1[3] * v1[3]));
            const float rstd = 1.0f / sqrtf(q * (1.0f / 512) + LN_EPS);
            v0 = v0 * rstd * g0 + b0; v1 = v1 * rstd * g1 + b1;
            const int f = (row & 3) | (((row >> 3) & 1) << 2);
            *(LAS u32x4*)(lds + row * 1024 + (((lane >> 1) ^ f) << 5) + (lane & 1) * 16) = pg8::pack8(v0, v1); }
    }
    __syncthreads();
    {
        const int gch = wave;
        const bf16_t* Wg = (const bf16_t*)(F.ws + WS_SGW) + (size_t)gch * 128 * 128;
        const int f = (c >> 2) | ((g & 1) << 2);
#pragma unroll 1
        for (int it = 0; it < 8; ++it) {
            f32x4 o[4];
#pragma unroll
            for (int dt = 0; dt < 4; ++dt) o[dt] = (f32x4){0.f, 0.f, 0.f, 0.f};
            const int nks = (it >> 1) + 1;
            for (int ks = 0; ks < nks; ++ks) {
                const bf16x8 wf = *(const bf16x8*)(Wg + (16 * it + c) * 128 + 32 * ks + 8 * g);
                const int r0 = 32 * ks + 8 * g + (c >> 2);
#pragma unroll
                for (int dt = 0; dt < 4; ++dt) { const int off = (((4 * gch + dt) ^ f) << 5) + (c & 3) * 8;
                    const s16x4 va = vtr(lds + r0 * 1024 + off), vb = vtr(lds + (r0 + 4) * 1024 + off);
                    o[dt] = __builtin_amdgcn_mfma_f32_16x16x32_bf16(cat44(va, vb), wf, o[dt], 0, 0, 0); }
            }
            const float bi = F.in[10][l * 1024 + gch * 128 + 16 * it + c];
            const size_t trow = tok0 + 16 * it + c;
#pragma unroll
            for (int dt = 0; dt < 4; ++dt) { const int ch = 64 * gch + 16 * dt + 4 * g; const f32x4 u = ldbf4(USV + trow * 1024 + ch);
                u32x2 w; w.x = cvt_pk_bf16(u[0] * (o[dt][0] + bi), u[1] * (o[dt][1] + bi)); w.y = cvt_pk_bf16(u[2] * (o[dt][2] + bi), u[3] * (o[dt][3] + bi));
                *(u32x2*)(CAT + trow * 1024 + 512 + ch) = w; }
        }
    }
    __syncthreads();
}

#ifndef MK_PER_PHASE
#define MK_PER_PHASE 0
#endif
constexpr int N_PHASES = 2 + 8 * DEPTH;
struct Args { const float* in[23]; float* out; unsigned char* ws; int ph_lo, ph_hi; };
static_assert(sizeof(Args) == 23 * 8 + 8 + 8 + 8, "Args has no padding");

__device__ __forceinline__ void build_group_tab(Frame& F, int l, int ncol) {
    LAS int* tab = (LAS int*)(F.lds + MISC_OFF + 64);
    __syncthreads();
    if (F.tid == 0) { int up = 0, pp = 0;
        for (int e = 0; e < 16; ++e) { const int cnt = (int)__hip_atomic_load(F.ctl + CW_CNT + 64 * (l * 16 + e), __ATOMIC_RELAXED, __HIP_MEMORY_SCOPE_AGENT); const int pan = (cnt + 255) >> 8;
            tab[e] = up; tab[32 + e] = pp; tab[64 + e] = cnt; up += pan * ncol; pp += pan; }
        tab[16] = up; tab[48] = pp; }
    __syncthreads();
}

__global__ void __launch_bounds__(NTHR, 2) fwd(Args args) {
    extern __shared__ __attribute__((aligned(16))) unsigned char lds_raw[];
    Frame F;
    F.lds = (LAS unsigned char*)lds_raw;
    F.tid = threadIdx.x; F.lane = F.tid & 63; F.wave = __builtin_amdgcn_readfirstlane(F.tid >> 6);
    F.G = gridDim.x; { const int bx = blockIdx.x; F.vcu = (F.G % 8 == 0) ? (bx % 8) * (F.G / 8) + bx / 8 : bx; }
    F.ws = args.ws; F.ctl = (unsigned*)(args.ws + WS_CTL); F.out = args.out;
    F.in = args.in;
    for (int u = F.tid; u < (LDS_BYTES - MISC_OFF) / 4; u += NTHR) ((LAS unsigned*)(F.lds + MISC_OFF))[u] = 0u;
    __syncthreads();
    XcdBarrier bar; bar.bar = F.ctl + CW_BAR; bar.x = 0; bar.st = nullptr;
    if (!MK_PER_PHASE) bar = xcd_barrier_post(F.ctl + CW_BAR, (volatile LAS unsigned*)(F.lds + MISC_OFF));
    const int lo = args.ph_lo, hi = args.ph_hi;
#ifndef PHMASK
#define PHMASK 0x3ff
#endif
#define EN(b) ((PHMASK >> (b)) & 1)
#define IN(k) (lo <= (k) && (k) < hi)
#define REFRESH() do { int t_ = threadIdx.x; asm volatile("" : "+v"(t_)); F.tid = t_; F.lane = t_ & 63; F.wave = __builtin_amdgcn_readfirstlane(t_ >> 6); } while (0)
#define SEAM(k) do { if (IN(k) && IN((k) + 1)) xcd_barrier(bar); } while (0)
    float* mod = (float*)(F.ws + WS_MOD);
    bf16_t* H = (bf16_t*)(F.ws + WS_H);

    if (EN(0) && IN(0)) { REFRESH();
        if (F.vcu * NWAVES < MOD_ITEMS) {
            LAS float* cond = (LAS float*)F.lds;
            for (int i = F.tid; i < BATCH * D; i += NTHR) { const float v = F.in[1][i]; cond[i] = v / (1.0f + expf(-v)); }
            __syncthreads();
            const int gw = F.vcu * NWAVES + F.wave;
            if (gw < MOD_ITEMS) mod_item(F, gw);
        }
        {
            LAS float* scr = (LAS float*)(F.lds + 65536 + F.wave * 8448);
            const int NGW = F.G * NWAVES; int gw = F.vcu * NWAVES + F.wave - MOD_ITEMS; if (gw < 0) gw += NGW;
            for (int it = gw; it < CONV_ITEMS; it += NGW) conv_item(F, 0, it, scr);
        }
    }
    SEAM(0);
    if (EN(1) && IN(1)) { REFRESH(); RowArgs A{F.in[0], nullptr, nullptr, nullptr, nullptr, mod + 1 * D, mod + 0 * D, H, 0, true}; row_phase<0>(F, A); }
    SEAM(1);

#pragma unroll 1
    for (int l = 0; l < DEPTH; ++l) {
        const int pb = 2 + 8 * l;
        const float* ml = mod + (size_t)l * BATCH * 6 * D;
        if (EN(2) && IN(pb + 0)) { REFRESH();
            pg8::Gemm g{H, (const bf16_t*)(F.ws + WS_WIN), 1024, 1024}; pg8::StaticOrder S; S.init(T, INW, F.G, (int)blockIdx.x);
            pg8::EpiInProj E{(bf16_t*)(F.ws + WS_QKV), (bf16_t*)(F.ws + WS_USV), (bf16_t*)(F.ws + WS_GA), (bf16_t*)(F.ws + WS_GS)};
            pg8::gemm_phase<pg8::EpiInProj, pg8::StaticOrder, true, false>(F.lds, g, S, E);
        }
        SEAM(pb + 0);
        if (EN(3) && IN(pb + 1)) { REFRESH(); for (int u = F.vcu; u < BATCH * (SEQ / 128); u += F.G) mixer_unit(F, l, u >> 4, u & 15); }
        SEAM(pb + 1);
        if (EN(4) && IN(pb + 2)) { REFRESH();
            pg8::Gemm g{(const bf16_t*)(F.ws + WS_CAT), (const bf16_t*)(F.ws + WS_WBR), 1024, 1024}; pg8::StaticOrder S; S.init(T, D, F.G, (int)blockIdx.x);
            pg8::EpiMerge E{(const bf16_t*)(F.ws + WS_GA), (const bf16_t*)(F.ws + WS_GS), (bf16_t*)(F.ws + WS_MRG)};
            pg8::gemm_phase<pg8::EpiMerge, pg8::StaticOrder, true, false>(F.lds, g, S, E);
        }
        SEAM(pb + 2);
        if (EN(5) && IN(pb + 3)) { REFRESH();
            pg8::Gemm g{(const bf16_t*)(F.ws + WS_MRG), (const bf16_t*)(F.ws + WS_WOUT), 1024, 1024}; pg8::StaticOrder S; S.init(T, D, F.G, (int)blockIdx.x);
            pg8::EpiPlain E{(bf16_t*)(F.ws + WS_Y)};
            pg8::gemm_phase<pg8::EpiPlain, pg8::StaticOrder, true, false>(F.lds, g, S, E);
        }
        SEAM(pb + 3);
        if (EN(6) && IN(pb + 4)) { REFRESH(); RowArgs A{nullptr, (const bf16_t*)(F.ws + WS_Y), ml + 2 * D, F.in[16] + l * D, F.in[17] + l * D, ml + 4 * D, ml + 3 * D, H, l, true}; row_phase<1>(F, A); }
        SEAM(pb + 4);
        if (EN(7) && IN(pb + 5)) { REFRESH();
            build_group_tab(F, l, 2);
            pg8::Gemm g{H, (const bf16_t*)(F.ws + WS_WGU), 1024, 1024};
            pg8::GroupOrder S{(const LAS int*)(F.lds + MISC_OFF + 64), 2, F.G, F.vcu, (const int2*)(F.ws + WS_LIST)};
            pg8::EpiGateUp E{(bf16_t*)(F.ws + WS_HID)};
            pg8::gemm_phase<pg8::EpiGateUp, pg8::GroupOrder, true, true>(F.lds, g, S, E);
        }
        SEAM(pb + 5);
        if (EN(8) && IN(pb + 6)) { REFRESH();
            build_group_tab(F, l, 4);
            pg8::Gemm g{(const bf16_t*)(F.ws + WS_HID), (const bf16_t*)(F.ws + WS_WDN), 256, 256};
            pg8::GroupOrder S{(const LAS int*)(F.lds + MISC_OFF + 64), 4, F.G, F.vcu, (const int2*)(F.ws + WS_LIST)};
            pg8::EpiDown E{(bf16_t*)(F.ws + WS_Y2), (const int2*)(F.ws + WS_LIST), (const LAS int*)(F.lds + MISC_OFF + 64)};
            pg8::gemm_phase<pg8::EpiDown, pg8::GroupOrder, true, false>(F.lds, g, S, E);
        }
        SEAM(pb + 6);
        if (EN(9) && IN(pb + 7)) { REFRESH();
            const float* mn = mod + (size_t)(l + 1) * BATCH * 6 * D;
            RowArgs A{nullptr, (const bf16_t*)(F.ws + WS_Y2), ml + 5 * D, F.in[21] + l * D, F.in[22] + l * D, mn + 1 * D, mn + 0 * D, H, l, l + 1 < DEPTH};
            row_phase<2>(F, A);
            if (l + 1 < DEPTH) { __syncthreads(); conv_layer(F, l + 1, 0); }
        }
        SEAM(pb + 7);
    }
#undef IN
#undef SEAM
}

extern "C" void kernel_launch(void* const* d_in, const int* in_sizes, int n_in, void* d_out, int out_size, void* d_ws, size_t ws_size, hipStream_t stream) {
    static int grid = 0;
    if (grid == 0) {
        if (n_in != 23 || out_size != T * D || ws_size < WS_END) { fprintf(stderr, "kernel_launch: unexpected shapes (n_in %d out %d ws %zu)\n", n_in, out_size, ws_size); grid = -1; return; }
        int dev = 0, cus = 0, per_cu = 0;
        if (hipGetDevice(&dev) != hipSuccess || hipDeviceGetAttribute(&cus, hipDeviceAttributeMultiprocessorCount, dev) != hipSuccess) { grid = -1; return; }
        if (hipFuncSetAttribute((const void*)fwd, hipFuncAttributeMaxDynamicSharedMemorySize, LDS_BYTES) != hipSuccess) { fprintf(stderr, "kernel_launch: hipFuncSetAttribute failed\n"); grid = -1; return; }
        if (hipOccupancyMaxActiveBlocksPerMultiprocessor(&per_cu, (const void*)fwd, NTHR, LDS_BYTES) != hipSuccess || per_cu < 1) fprintf(stderr, "kernel_launch: occupancy query says %d\n", per_cu);
        (void)hipGetLastError();
        grid = cus;
    }
    if (grid < 0) return;
    if (hipMemsetAsync((char*)d_ws + WS_CTL, 0, CTL_ZERO_BYTES, stream) != hipSuccess) return;
    Args a{};
    for (int i = 0; i < 23; ++i) a.in[i] = (const float*)d_in[i];
    a.out = (float*)d_out; a.ws = (unsigned char*)d_ws;
#if MK_PER_PHASE
    for (int p = 0; p < N_PHASES; ++p) { a.ph_lo = p; a.ph_hi = p + 1; hipLaunchKernelGGL(fwd, dim3(grid), dim3(NTHR), LDS_BYTES, stream, a); }
#else
    a.ph_lo = 0; a.ph_hi = N_PHASES;
    hipLaunchKernelGGL(fwd, dim3(grid), dim3(NTHR), LDS_BYTES, stream, a);
#endif
}
```

```cpp
#include <hip/hip_runtime.h>
#include <cstdio>
#include <cstdint>

#define LAS __attribute__((address_space(3)))
#define GAS __attribute__((address_space(1)))
typedef unsigned short bf16_t;
typedef short bf16x8 __attribute__((ext_vector_type(8)));
typedef short s16x4 __attribute__((ext_vector_type(4)));
typedef float f32x4 __attribute__((ext_vector_type(4)));
typedef float f32x2 __attribute__((ext_vector_type(2)));
typedef unsigned u32x4 __attribute__((ext_vector_type(4)));
typedef unsigned u32x2 __attribute__((ext_vector_type(2)));

constexpr int D = 1024, BATCH = 16, SEQ = 2048, DEPTH = 4, T = BATCH * SEQ;
constexpr int INW = 3840, NE = 16, FF = 256;
constexpr float ALPHA = 1.681792830507429f;
constexpr float LN_EPS = 1e-5f;
constexpr int NWAVES = 8, NTHR = 512;

typedef __bf16 bf16x2_t __attribute__((ext_vector_type(2)));
__device__ __forceinline__ unsigned cvt_pk_bf16(float lo, float hi) { const f32x2 v = {lo, hi}; const bf16x2_t b = __builtin_convertvector(v, bf16x2_t); return __builtin_bit_cast(unsigned, b); }
__device__ __forceinline__ float bf_lo(unsigned w) { return __uint_as_float(w << 16); }
__device__ __forceinline__ float bf_hi(unsigned w) { return __uint_as_float(w & 0xffff0000u); }
__device__ __forceinline__ float fast_rcp(float x) { return __builtin_amdgcn_rcpf(x); }
__device__ __forceinline__ float fast_exp(float x) { return __builtin_amdgcn_exp2f(x * 1.4426950408889634f); }
__device__ __forceinline__ float sigmoid_f(float v) { return fast_rcp(1.0f + fast_exp(-v)); }
__device__ __forceinline__ f32x2 gelu_pk(f32x2 v) {
    const f32x2 av = __builtin_elementwise_abs(v), d = av * 0.2316418882f + 1.0f;
    f32x2 t; t.x = __builtin_amdgcn_rcpf(d.x); t.y = __builtin_amdgcn_rcpf(d.y);
    f32x2 q = t * 0.5307027145f + (-0.7265760135f); q = q * t + 0.7107068705f; q = q * t + (-0.142248368f); q = q * t + 0.127414796f; q = q * t;
    const f32x2 s = (v * v) * (-0.72134752044f);
    f32x2 e; e.x = __builtin_amdgcn_exp2f(s.x); e.y = __builtin_amdgcn_exp2f(s.y);
    const f32x2 m = v * (q * e), r = v - m;
    f32x2 o; o.x = v.x < 0.f ? m.x : r.x; o.y = v.y < 0.f ? m.y : r.y; return o;
}

namespace pg8 {
constexpr int BM = 256, BK = 64, HALF = 128, HTB = HALF * BK * 2  , STAGE_BYTES = 8 * HTB, NXCD = 8, WGM = 8;
__host__ __device__ __forceinline__ int lds_byte(int r, int c) { const int st = (r >> 4) * 2 + (c >> 5), rr = r & 15, cc = c & 31, ob = rr * 64 + cc * 2; return st * 1024 + (ob ^ (((ob >> 9) & 1) << 5)); }
__host__ __device__ __forceinline__ void stage_rc(int b, int& R, int& C) { const int st = b / 1024, sb = b % 1024, swz = sb ^ (((sb >> 9) & 1) << 5); R = (st >> 1) * 16 + swz / 64; C = (st & 1) * 32 + (swz % 64) / 2; }
__host__ __device__ __forceinline__ int perm32(int rho) { const int n = rho >> 4, i = rho & 15; return 8 * (i >> 2) + 4 * n + (i & 3); }

struct Unit { int pm, pn, e, p; };
struct Gemm { const bf16_t* A; const bf16_t* Bt; int lda, K; };

struct StaticOrder {
    int nM, nN, nwg, G, c;
    __device__ void init(int M, int N, int G_, int c_) { nM = M / BM; nN = N / BM; nwg = nM * nN; G = G_; c = c_; }
    __device__ bool next(int i, Unit& u) const {
        const long L = (long)i * G + c; if (L >= nwg) return false;
        int wgid = (int)L; { const int q = nwg / NXCD, r = nwg % NXCD, xcd = wgid % NXCD, off = wgid / NXCD; wgid = (xcd < r ? xcd * (q + 1) : r * (q + 1) + (xcd - r) * q) + off; }
        const int nig = WGM * nN, gid = wgid / nig, fm = gid * WGM, gsz = (nM - fm) < WGM ? (nM - fm) : WGM;
        u.pm = fm + ((wgid % nig) % gsz); u.pn = (wgid % nig) / gsz; u.e = 0; u.p = 0; return true;
    }
    __device__ __forceinline__ unsigned arow(const Unit&, int) const { return 0u; }
};
struct GroupOrder {
    const LAS int* tab; int ncol, G, c; const int2* list;
    __device__ bool next(int i, Unit& u) const {
        const int L = i * G + c; if (L >= tab[16]) return false;
        int e = 0;
#pragma unroll
        for (int k = 1; k < 16; ++k) e += (tab[k] <= L) ? 1 : 0;
        const int ul = L - tab[e]; const int p = ul / ncol, pnl = ul - p * ncol;
        u.pm = tab[32 + e] + p; u.pn = e * ncol + pnl; u.e = e; u.p = p; return true;
    }
    __device__ __forceinline__ unsigned arow(const Unit& u, int r) const {
        const int pos = u.p * 256 + r; const int cnt = tab[64 + u.e];
        const int d = (pos < cnt) ? list[(size_t)u.e * 32768 + pos].x : 0;
        return (unsigned)(d >> 1);
    }
};

template <class Epi, class Sched, bool ALIGN_EPI, bool GATHER>
__device__ __forceinline__ void gemm_phase(LAS unsigned char* lds, const Gemm g, const Sched& S, const Epi& E) {
    int tid_ = threadIdx.x; asm volatile("" : "+v"(tid_));
    const int tid = tid_, wid = __builtin_amdgcn_readfirstlane(tid >> 6), lane = tid & 63, wr = wid >> 2, wc = wid & 3, fr = lane & 15, fq = lane >> 4;
    int K_ = g.K; asm volatile("" : "+s"(K_));
    const int K = K_, nt = K / BK, lda = g.lda;
    unsigned voffA[2], voffB[2]; int RA[2], CA[2];
#pragma unroll
    for (int i = 0; i < 2; ++i) { int R, C; stage_rc(tid * 16 + i * 8192, R, C); const int Rb = Epi::PERM ? ((R & ~31) + perm32(R & 31)) : R;
        RA[i] = R; CA[i] = C; voffA[i] = (unsigned)(R * lda + C) * 2u; voffB[i] = (unsigned)(Rb * K + C) * 2u; }
    const unsigned kstep = (unsigned)(BK * 2);
    const unsigned hstepA = (unsigned)HALF * (unsigned)lda * 2u, tstepA = 2u * hstepA;
    const unsigned hstep = (unsigned)HALF * (unsigned)K * 2u, tstep = 2u * hstep;
    const unsigned ldsw = (unsigned)wid * 1024u;
    const int aoff = lds_byte(wr * 64 + fr, fq * 8), boff = lds_byte(wc * 32 + fr, fq * 8);
    unsigned ga[2][2] = {{0u, 0u}, {0u, 0u}}, gn[2][2] = {{0u, 0u}, {0u, 0u}};
#define PG8_SA(b, h) (((b) * 2 + (h)) * HTB)
#define PG8_SB(b, h) ((4 + (b) * 2 + (h)) * HTB)
#define PG8_GLDS(base, off32, bufoff, i) __builtin_amdgcn_global_load_lds((const unsigned*)((const char*)(base) + (size_t)(unsigned)(off32)), (LAS unsigned*)(lds + (bufoff) + ldsw + (i) * 8192), 16, 0, 0)
#define PG8_STAGE_B(bufoff, uoff) do { _Pragma("unroll") for (int _i = 0; _i < 2; ++_i) PG8_GLDS(g.Bt, (uoff) + voffB[_i], bufoff, _i); } while (0)
#define PG8_STAGE_A(bufoff, h, kb, nx) do { if constexpr (GATHER) { \
            _Pragma("unroll") for (int _i = 0; _i < 2; ++_i) { const unsigned _o = ((nx) ? gn[h][_i] : ga[h][_i]) + (kb); PG8_GLDS(g.A, _o, bufoff, _i); } } \
        else { const unsigned _u = ((nx) ? nAo : cAo) + (unsigned)(h) * hstepA + (kb); _Pragma("unroll") for (int _i = 0; _i < 2; ++_i) PG8_GLDS(g.A, _u + voffA[_i], bufoff, _i); } } while (0)
#define PG8_LDA(dst, b, h) do { _Pragma("unroll") for (int m = 0; m < 4; ++m) _Pragma("unroll") for (int k = 0; k < 2; ++k) dst[m][k] = *(const LAS bf16x8*)(lds + PG8_SA(b, h) + aoff + m * 2048 + k * 1024); } while (0)
#define PG8_LDB(dst, b, h) do { _Pragma("unroll") for (int n = 0; n < 2; ++n) _Pragma("unroll") for (int k = 0; k < 2; ++k) dst[n][k] = *(const LAS bf16x8*)(lds + PG8_SB(b, h) + boff + n * 2048 + k * 1024); } while (0)
#define PG8_MMA(ai, bj, At, Bt) do { __builtin_amdgcn_s_setprio(1); _Pragma("unroll") for (int m = 0; m < 4; ++m) _Pragma("unroll") for (int n = 0; n < 2; ++n) _Pragma("unroll") for (int k = 0; k < 2; ++k) \
        acc[ai][bj][m][n] = __builtin_amdgcn_mfma_f32_16x16x32_bf16(Bt[n][k], At[m][k], acc[ai][bj][m][n], 0, 0, 0); __builtin_amdgcn_s_setprio(0); } while (0)
#define PG8_WAIT_V(n) asm volatile("s_waitcnt vmcnt(" #n ")" ::: "memory")
#define PG8_WAIT_L(n) asm volatile("s_waitcnt lgkmcnt(" #n ")" ::: "memory")
#define PG8_BAR __builtin_amdgcn_s_barrier()
#define PG8_SCHED __builtin_amdgcn_sched_barrier(0)
#define PG8_GOFFS(dst, u) do { _Pragma("unroll") for (int _h = 0; _h < 2; ++_h) _Pragma("unroll") for (int _i = 0; _i < 2; ++_i) \
        dst[_h][_i] = (S.arow(u, _h * HALF + RA[_i]) * (unsigned)lda + (unsigned)CA[_i]) * 2u; } while (0)
    Unit cur, nxt; int ui = 0;
    if (!S.next(0, cur)) return;
    f32x4 acc[2][2][4][2];
#pragma unroll
    for (int a = 0; a < 2; ++a)
#pragma unroll
        for (int b = 0; b < 2; ++b)
#pragma unroll
            for (int m = 0; m < 4; ++m)
#pragma unroll
                for (int n = 0; n < 2; ++n) acc[a][b][m][n] = (f32x4){0.f, 0.f, 0.f, 0.f};
    bf16x8 At[4][2], B0[2][2], B1[2][2];
    unsigned cAo = GATHER ? 0u : (unsigned)cur.pm * tstepA, cBo = (unsigned)cur.pn * tstep, nAo = cAo;
    if constexpr (GATHER) { PG8_GOFFS(ga, cur); PG8_WAIT_V(0); }
    PG8_STAGE_B(PG8_SB(0, 0), cBo); PG8_STAGE_B(PG8_SB(0, 1), cBo + hstep); PG8_STAGE_A(PG8_SA(0, 0), 0, 0u, false); PG8_STAGE_A(PG8_SA(0, 1), 1, 0u, false);
    if (wr == 1) PG8_BAR;
    PG8_WAIT_V(2); PG8_BAR;
    PG8_STAGE_B(PG8_SB(1, 0), cBo + kstep); PG8_STAGE_A(PG8_SA(1, 0), 0, kstep, false); PG8_STAGE_B(PG8_SB(1, 1), cBo + hstep + kstep);
    PG8_WAIT_V(6); PG8_BAR;
    for (;;) {
        const bool has_next = S.next(ui + 1, nxt);
        nAo = has_next ? (GATHER ? 0u : (unsigned)nxt.pm * tstepA) : cAo; const unsigned nBo = has_next ? (unsigned)nxt.pn * tstep : cBo;
        if constexpr (GATHER) { if (has_next) { PG8_GOFFS(gn, nxt); } else {
#pragma unroll
            for (int _h = 0; _h < 2; ++_h)
#pragma unroll
                for (int _i = 0; _i < 2; ++_i) gn[_h][_i] = ga[_h][_i]; } }
        for (int t = 0; t < nt; t += 2) {
            const bool last = (t == nt - 2);
            const unsigned k1 = (unsigned)(t + 1) * kstep;
            const unsigned k2 = last ? 0u : (unsigned)(t + 2) * kstep, k3 = k2 + kstep;
            const unsigned b2 = (last ? nBo : cBo) + k2, b3 = b2 + kstep;
            if constexpr (Epi::HAS_MID) { if (t == (nt >> 1)) E.mid(acc, cur, wr, wc, fr, fq); }
            PG8_LDB(B0, 0, 0); PG8_LDB(B1, 0, 1); PG8_SCHED; PG8_LDA(At, 0, 0); PG8_STAGE_A(PG8_SA(1, 1), 1, k1, false);
            PG8_WAIT_V(8); PG8_WAIT_L(0); PG8_BAR; PG8_MMA(0, 0, At, B0); PG8_MMA(0, 1, At, B1); PG8_BAR; PG8_SCHED;
            PG8_LDA(At, 0, 1); PG8_STAGE_B(PG8_SB(0, 0), b2); PG8_STAGE_B(PG8_SB(0, 1), b2 + hstep); PG8_STAGE_A(PG8_SA(0, 0), 0, k2, last);
            PG8_WAIT_V(8); PG8_WAIT_L(0); PG8_BAR; PG8_MMA(1, 0, At, B0); PG8_MMA(1, 1, At, B1); PG8_BAR; PG8_SCHED;
            PG8_LDB(B0, 1, 0); PG8_LDB(B1, 1, 1); PG8_SCHED; PG8_LDA(At, 1, 0); PG8_STAGE_A(PG8_SA(0, 1), 1, k2, last);
            PG8_WAIT_V(8); PG8_WAIT_L(0); PG8_BAR; PG8_MMA(0, 0, At, B0); PG8_MMA(0, 1, At, B1); PG8_BAR; PG8_SCHED;
            PG8_LDA(At, 1, 1); PG8_STAGE_B(PG8_SB(1, 0), b3); PG8_STAGE_B(PG8_SB(1, 1), b3 + hstep); PG8_STAGE_A(PG8_SA(1, 0), 0, k3, last);
            PG8_WAIT_V(8); PG8_WAIT_L(0); PG8_BAR; PG8_MMA(1, 0, At, B0); PG8_MMA(1, 1, At, B1); PG8_BAR; PG8_SCHED;
        }
        if constexpr (ALIGN_EPI) { if (wr == 0) PG8_BAR; }
        E(acc, cur, wr, wc, fr, fq);
        if (!has_next) break;
#pragma unroll
        for (int a = 0; a < 2; ++a)
#pragma unroll
            for (int b = 0; b < 2; ++b)
#pragma unroll
                for (int m = 0; m < 4; ++m)
#pragma unroll
                    for (int n = 0; n < 2; ++n) acc[a][b][m][n] = (f32x4){0.f, 0.f, 0.f, 0.f};
        cur = nxt; cAo = nAo; cBo = nBo; ++ui;
#pragma unroll
        for (int _h = 0; _h < 2; ++_h)
#pragma unroll
            for (int _i = 0; _i < 2; ++_i) ga[_h][_i] = gn[_h][_i];
        if constexpr (ALIGN_EPI) { if (wr == 1) PG8_BAR; }
    }
    PG8_WAIT_V(0);
    if constexpr (!ALIGN_EPI) { if (wr == 0) PG8_BAR; }
    PG8_BAR;
#undef PG8_SA
#undef PG8_SB
#undef PG8_GLDS
#undef PG8_STAGE_B
#undef PG8_STAGE_A
#undef PG8_LDA
#undef PG8_LDB
#undef PG8_MMA
#undef PG8_WAIT_V
#undef PG8_WAIT_L
#undef PG8_BAR
#undef PG8_SCHED
#undef PG8_GOFFS
}
}

namespace pg8 {
__device__ __forceinline__ u32x4 pack8(const f32x4 v0, const f32x4 v1) { u32x4 w; w.x = cvt_pk_bf16(v0[0], v0[1]); w.y = cvt_pk_bf16(v0[2], v0[3]); w.z = cvt_pk_bf16(v1[0], v1[1]); w.w = cvt_pk_bf16(v1[2], v1[3]); return w; }
__device__ __forceinline__ void st16(void* base, unsigned off, const u32x4 v) { *(u32x4*)((char*)base + (size_t)off) = v; }
__device__ __forceinline__ u32x4 ld16(const void* base, unsigned off) { return *(const u32x4*)((const char*)base + (size_t)off); }

struct EpiInProj {
    static constexpr bool PERM = true, HAS_MID = false;
    bf16_t *QKV, *USV, *GA, *GS;
    __device__ __forceinline__ void operator()(const f32x4 (&acc)[2][2][4][2], const Unit& u, int wr, int wc, int fr, int fq) const {
        const unsigned row0 = (unsigned)(u.pm * BM + wr * 64 + fr), cl = (unsigned)(wc * 32 + 8 * fq); const int pn = u.pn;
        if (pn < 3) {
            const float sc = (pn < 2) ? 0.125f : 1.0f; unsigned o0 = (row0 * 768u + (unsigned)pn * 256u + cl) * 2u; asm volatile("" : "+v"(o0));
#pragma unroll
            for (int ai = 0; ai < 2; ++ai)
#pragma unroll
                for (int m = 0; m < 4; ++m)
#pragma unroll
                    for (int bj = 0; bj < 2; ++bj) st16(QKV, o0 + (unsigned)((ai * HALF + m * 16) * 768 + bj * HALF) * 2u, pack8(acc[ai][bj][m][0] * sc, acc[ai][bj][m][1] * sc));
        } else if (pn < 7) {
            unsigned o0 = (row0 * 1024u + (unsigned)(pn - 3) * 256u + cl) * 2u; asm volatile("" : "+v"(o0));
#pragma unroll
            for (int ai = 0; ai < 2; ++ai)
#pragma unroll
                for (int m = 0; m < 4; ++m)
#pragma unroll
                    for (int bj = 0; bj < 2; ++bj) { const f32x4 v0 = acc[ai][bj][m][0], v1 = acc[ai][bj][m][1];
                        const f32x2 a = gelu_pk((f32x2){v0[0], v0[1]}), b = gelu_pk((f32x2){v0[2], v0[3]}), c = gelu_pk((f32x2){v1[0], v1[1]}), d = gelu_pk((f32x2){v1[2], v1[3]});
                        st16(USV, o0 + (unsigned)((ai * HALF + m * 16) * 1024 + bj * HALF) * 2u, pack8((f32x4){a.x, a.y, b.x, b.y}, (f32x4){c.x, c.y, d.x, d.y})); }
        } else {
            bf16_t* base = (pn < 11) ? GA : GS; unsigned o0 = (row0 * 1024u + (unsigned)((pn - 7) & 3) * 256u + cl) * 2u; asm volatile("" : "+v"(o0));
#pragma unroll
            for (int ai = 0; ai < 2; ++ai)
#pragma unroll
                for (int m = 0; m < 4; ++m)
#pragma unroll
                    for (int bj = 0; bj < 2; ++bj) { f32x4 v0 = acc[ai][bj][m][0], v1 = acc[ai][bj][m][1];
#pragma unroll
                        for (int j = 0; j < 4; ++j) { v0[j] = sigmoid_f(v0[j]); v1[j] = sigmoid_f(v1[j]); }
                        st16(base, o0 + (unsigned)((ai * HALF + m * 16) * 1024 + bj * HALF) * 2u, pack8(v0, v1)); }
        }
    }
};
struct EpiMerge {
    static constexpr bool PERM = true, HAS_MID = true;
    const bf16_t *GA, *GS; bf16_t* O;
    __device__ __forceinline__ void mid(f32x4 (&acc)[2][2][4][2], const Unit& u, int wr, int wc, int fr, int fq) const {
        unsigned o0 = ((unsigned)(u.pm * BM + wr * 64 + fr) * 1024u + (unsigned)(u.pn * BM + wc * 32 + 8 * fq)) * 2u; asm volatile("" : "+v"(o0));
#pragma unroll
        for (int ai = 0; ai < 2; ++ai)
#pragma unroll
            for (int m = 0; m < 4; ++m) {
#pragma unroll
                for (int bj = 0; bj < 2; ++bj) { const unsigned off = o0 + (unsigned)((ai * HALF + m * 16) * 1024 + bj * HALF) * 2u; const u32x4 a = ld16(GA, off), s = ld16(GS, off);
                    f32x4 r0, r1;
                    r0[0] = bf_lo(a.x) * fast_rcp(bf_lo(s.x)); r0[1] = bf_hi(a.x) * fast_rcp(bf_hi(s.x)); r0[2] = bf_lo(a.y) * fast_rcp(bf_lo(s.y)); r0[3] = bf_hi(a.y) * fast_rcp(bf_hi(s.y));
                    r1[0] = bf_lo(a.z) * fast_rcp(bf_lo(s.z)); r1[1] = bf_hi(a.z) * fast_rcp(bf_hi(s.z)); r1[2] = bf_lo(a.w) * fast_rcp(bf_lo(s.w)); r1[3] = bf_hi(a.w) * fast_rcp(bf_hi(s.w));
                    acc[ai][bj][m][0] *= r0; acc[ai][bj][m][1] *= r1; }
                asm volatile("" : "+v"(acc[ai][0][m][0]), "+v"(acc[ai][0][m][1]), "+v"(acc[ai][1][m][0]), "+v"(acc[ai][1][m][1]) :: "memory"); }
    }
    __device__ __forceinline__ void operator()(const f32x4 (&acc)[2][2][4][2], const Unit& u, int wr, int wc, int fr, int fq) const {
        unsigned o0 = ((unsigned)(u.pm * BM + wr * 64 + fr) * 1024u + (unsigned)(u.pn * BM + wc * 32 + 8 * fq)) * 2u; asm volatile("" : "+v"(o0));
#pragma unroll
        for (int ai = 0; ai < 2; ++ai)
#pragma unroll
            for (int m = 0; m < 4; ++m) {
#pragma unroll
                for (int bj = 0; bj < 2; ++bj) { const unsigned off = o0 + (unsigned)((ai * HALF + m * 16) * 1024 + bj * HALF) * 2u; const u32x4 s = ld16(GS, off);
                    const f32x4 g0 = (f32x4){bf_lo(s.x), bf_hi(s.x), bf_lo(s.y), bf_hi(s.y)}, g1 = (f32x4){bf_lo(s.z), bf_hi(s.z), bf_lo(s.w), bf_hi(s.w)};
                    st16(O, off, pack8(acc[ai][bj][m][0] * g0, acc[ai][bj][m][1] * g1)); }
                asm volatile("" ::: "memory"); }
    }
};
struct EpiPlain {
    static constexpr bool PERM = true, HAS_MID = false;
    bf16_t* O;
    __device__ __forceinline__ void operator()(const f32x4 (&acc)[2][2][4][2], const Unit& u, int wr, int wc, int fr, int fq) const {
        unsigned o0 = ((unsigned)(u.pm * BM + wr * 64 + fr) * 1024u + (unsigned)(u.pn * BM + wc * 32 + 8 * fq)) * 2u; asm volatile("" : "+v"(o0));
#pragma unroll
        for (int ai = 0; ai < 2; ++ai)
#pragma unroll
            for (int m = 0; m < 4; ++m)
#pragma unroll
                for (int bj = 0; bj < 2; ++bj) st16(O, o0 + (unsigned)((ai * HALF + m * 16) * 1024 + bj * HALF) * 2u, pack8(acc[ai][bj][m][0], acc[ai][bj][m][1]));
    }
};
struct EpiGateUp {
    static constexpr bool PERM = true, HAS_MID = false;
    bf16_t* HID;
    __device__ __forceinline__ void operator()(const f32x4 (&acc)[2][2][4][2], const Unit& u, int wr, int wc, int fr, int fq) const {
        unsigned o0 = ((unsigned)(u.pm * BM + wr * 64 + fr) * 256u + (unsigned)((u.pn & 1) * 128 + wc * 32 + 8 * fq)) * 2u; asm volatile("" : "+v"(o0));
#pragma unroll
        for (int ai = 0; ai < 2; ++ai)
#pragma unroll
            for (int m = 0; m < 4; ++m) { f32x4 h0, h1; const f32x4 g0 = acc[ai][0][m][0], g1 = acc[ai][0][m][1], u0 = acc[ai][1][m][0], u1 = acc[ai][1][m][1];
#pragma unroll
                for (int j = 0; j < 4; ++j) { h0[j] = g0[j] * sigmoid_f(g0[j]) * u0[j]; h1[j] = g1[j] * sigmoid_f(g1[j]) * u1[j]; }
                st16(HID, o0 + (unsigned)((ai * HALF + m * 16) * 256) * 2u, pack8(h0, h1)); }
    }
};
struct EpiDown {
    static constexpr bool PERM = true, HAS_MID = false;
    bf16_t* Y2; const int2* list; const LAS int* tab;
    __device__ __forceinline__ void operator()(const f32x4 (&acc)[2][2][4][2], const Unit& u, int wr, int wc, int fr, int fq) const {
        const int r0 = wr * 64 + fr, cnt = tab[64 + u.e] - u.p * 256; const unsigned colb = (unsigned)((u.pn & 3) * 256 + wc * 32 + 8 * fq) * 2u;
        unsigned lo0 = ((unsigned)u.e * 32768u + (unsigned)(u.p * 256 + r0)) * 8u; asm volatile("" : "+v"(lo0));
#pragma unroll
        for (int ai = 0; ai < 2; ++ai) {
            int2 en[4];
#pragma unroll
            for (int m = 0; m < 4; ++m) { en[m].x = -1; en[m].y = 0; if (r0 + ai * HALF + m * 16 < cnt) en[m] = *(const int2*)((const char*)list + (size_t)(lo0 + (unsigned)(ai * HALF + m * 16) * 8u)); }
#pragma unroll
            for (int m = 0; m < 4; ++m) { const float w = __int_as_float(en[m].y); const unsigned off = (unsigned)en[m].x * 2048u + colb;
                if (en[m].x >= 0) {
#pragma unroll
                    for (int bj = 0; bj < 2; ++bj) st16(Y2, off + (unsigned)(bj * HALF) * 2u, pack8(acc[ai][bj][m][0] * w, acc[ai][bj][m][1] * w)); } }
            asm volatile("" ::: "memory"); }
    }
};
}
#define XB_TMO      128
#define XB_XCNT(j)  (256  + 64 * (j))
#define XB_XSUB(j)  (1280 + 64 * (j))
#define XB_XGEN(j)  (2304 + 64 * (j))
#define XB_TOP      3328
#define XB_TOPGEN   3392
#define XCD_BAR_WORDS 3456
#define XB_SPIN_CAP (1u << 18)

__device__ __forceinline__ unsigned xb_ld(unsigned* p)              { return __hip_atomic_load(p, __ATOMIC_RELAXED, __HIP_MEMORY_SCOPE_AGENT); }
__device__ __forceinline__ unsigned xb_add(unsigned* p, unsigned v) { return __hip_atomic_fetch_add(p, v, __ATOMIC_RELAXED, __HIP_MEMORY_SCOPE_AGENT); }
__device__ __forceinline__ unsigned xb_xcc_id() { return (unsigned)__builtin_amdgcn_s_getreg((3 << 11) | 20) & 0xFu; }
#define XB_SPIN(cond, bar) do { unsigned _sp = 0; while (cond) { __builtin_amdgcn_s_sleep(1); \
    if ((++_sp & 255u) == 0u) { if (xb_ld(&(bar)[XB_TMO])) break; if (_sp > XB_SPIN_CAP) { atomicAdd(&(bar)[XB_TMO], 1u); break; } } } } while (0)

struct XcdBarrier {
    unsigned* bar; unsigned x;
    volatile LAS unsigned* st;
};

__device__ __forceinline__ XcdBarrier xcd_barrier_post(unsigned* bar, volatile LAS unsigned* st) {
    XcdBarrier b; b.bar = bar; b.x = xb_xcc_id(); b.st = st;
    if (threadIdx.x == 0) (void)xb_add(&bar[XB_XCNT(b.x)], 1u);
    return b;
}
__device__ __forceinline__ void xcd_barrier_complete(unsigned* bar, unsigned x, unsigned& nloc, unsigned& nx) {
    const unsigned G = gridDim.x * gridDim.y * gridDim.z;
    unsigned sum, cnt, mine, sp = 0u;
    for (;;) {
        sum = 0u; cnt = 0u; mine = 0u;
#pragma unroll
        for (unsigned j = 0; j < 16; ++j) { const unsigned c = xb_ld(&bar[XB_XCNT(j)]); sum += c; cnt += (c > 0u) ? 1u : 0u; mine = (j == x) ? c : mine; }
        if (sum == G) break;
        __builtin_amdgcn_s_sleep(1);
        if ((++sp & 255u) == 0u) { if (xb_ld(&bar[XB_TMO])) break; if (sp > XB_SPIN_CAP) { atomicAdd(&bar[XB_TMO], 1u); break; } }
    }
    nloc = mine > 0u ? mine : 1u; nx = cnt > 0u ? cnt : 1u;
}

__device__ __forceinline__ void xcd_barrier(const XcdBarrier& b) {
    asm volatile("s_waitcnt vmcnt(0)" ::: "memory");
    __syncthreads();
    if (threadIdx.x == 0) {
        unsigned* bar = b.bar;
        __builtin_amdgcn_s_waitcnt(0);
        unsigned nloc = b.st[0], nx = b.st[1];
        if (nloc == 0u) { xcd_barrier_complete(bar, b.x, nloc, nx); b.st[0] = nloc; b.st[1] = nx; }
        const unsigned old = xb_add(&bar[XB_XSUB(b.x)], 1u);
        const unsigned gen = old / nloc;
        if (old + 1u == (gen + 1u) * nloc) {
            __builtin_amdgcn_fence(__ATOMIC_RELEASE, "agent");
            asm volatile("s_waitcnt vmcnt(0)" ::: "memory");
            const unsigned og = xb_add(&bar[XB_TOP], 1u);
            const unsigned tg = og / nx;
            if (og + 1u == (tg + 1u) * nx) xb_add(&bar[XB_TOPGEN], 1u);
            else XB_SPIN(xb_ld(&bar[XB_TOPGEN]) == tg, bar);
            __builtin_amdgcn_fence(__ATOMIC_ACQUIRE, "agent");
            xb_add(&bar[XB_XGEN(b.x)], 1u);
            asm volatile("s_waitcnt vmcnt(0)" ::: "memory");
        } else {
            XB_SPIN(xb_ld(&bar[XB_XGEN(b.x)]) == gen, bar);
            __builtin_amdgcn_fence(__ATOMIC_ACQUIRE, "agent");
            asm volatile("s_waitcnt vmcnt(0)" ::: "memory");
        }
    }
    __syncthreads();
}

constexpr size_t MiB = 1u << 20;
constexpr size_t WS_CTL = 0, CTL_ZERO_BYTES = 1 * MiB;
constexpr size_t WS_MOD = 1 * MiB;
constexpr size_t WS_WIN = 4 * MiB, WS_WBR = 12 * MiB, WS_WOUT = 14 * MiB, WS_WGU = 16 * MiB, WS_WDN = 32 * MiB, WS_SGW = 40 * MiB;
constexpr size_t WS_LIST = 41 * MiB;
constexpr size_t WS_H = 48 * MiB;
constexpr size_t WS_QKV = 112 * MiB, WS_HID = WS_QKV;
constexpr size_t WS_USV = 160 * MiB, WS_MRG = WS_USV;
constexpr size_t WS_GA = 224 * MiB, WS_GS = 288 * MiB, WS_Y2 = WS_GA;
constexpr size_t WS_CAT = 352 * MiB, WS_Y = WS_CAT;
constexpr size_t WS_END = 416 * MiB;
constexpr int CW_BAR = 4096;
constexpr int CW_CNT = 16384;
constexpr int RING_BYTES = 131072, MISC_OFF = 135168, LDS_BYTES = 147456;

#define VM_WAIT() asm volatile("s_waitcnt vmcnt(0)" ::: "memory")
#define LDS_WAIT() asm volatile("s_waitcnt lgkmcnt(0)" ::: "memory")

struct Frame {
    LAS unsigned char* lds; int tid, lane, wave, vcu, G;
    unsigned* ctl; unsigned char* ws;
    const float* const* in; float* out;
};
__device__ __forceinline__ float wave_sum(float v) {
#pragma unroll
    for (int o = 1; o < 64; o <<= 1) v += __shfl_xor(v, o);
    return v;
}
__device__ __forceinline__ int t5_bucket(int rel) {
    const int n = rel < 0 ? 0 : rel;
    if (n < 16) return n;
    const int large = 16 + (int)(logf((float)n / 16.0f) / logf(8.0f) * 16.0f);
    return large < 31 ? large : 31;
}

__device__ __forceinline__ void transpose_item(const float* W, int N, bf16_t* WT, int ldt, int koff, int row_of_n0, int k0, int n0, LAS float* scr, int lane) {
#pragma unroll 8
    for (int i = 0; i < 32; ++i) { const int kk = 2 * i + (lane >> 5); scr[kk * 33 + (lane & 31)] = W[(size_t)(k0 + kk) * N + n0 + (lane & 31)]; }
    LDS_WAIT(); asm volatile("" ::: "memory");
    const int c = lane & 7;
#pragma unroll
    for (int j = 0; j < 4; ++j) { const int n = (lane >> 3) + 8 * j; const LAS float* s = scr + (8 * c) * 33 + n;
        u32x4 o; o.x = cvt_pk_bf16(s[0 * 33], s[1 * 33]); o.y = cvt_pk_bf16(s[2 * 33], s[3 * 33]); o.z = cvt_pk_bf16(s[4 * 33], s[5 * 33]); o.w = cvt_pk_bf16(s[6 * 33], s[7 * 33]);
        *(u32x4*)(WT + (size_t)(row_of_n0 + n) * ldt + koff + k0 + 8 * c) = o; }
    LDS_WAIT(); asm volatile("" ::: "memory");
}
constexpr int CI_IN = 16 * 120, CI_BR = 8 * 32, CI_OUT = 16 * 32, CI_GU = 16 * 8, CI_DN = 4 * 32;
constexpr int CONV_ITEMS = CI_IN + 2 * CI_BR + CI_OUT + NE * (2 * CI_GU + CI_DN) + 64;
__device__ __forceinline__ void conv_item(Frame& F, int l, int it, LAS float* scr) {
    const int lane = F.lane; unsigned char* ws = F.ws;
    int r = it;
    if (r < CI_IN) { const int nb = 120; transpose_item(F.in[7] + (size_t)l * D * INW, INW, (bf16_t*)(ws + WS_WIN), 1024, 0, 32 * (r % nb), 64 * (r / nb), 32 * (r % nb), scr, lane); return; } r -= CI_IN;
    if (r < CI_BR) { const int nb = 32; transpose_item(F.in[13] + (size_t)l * 512 * D, D, (bf16_t*)(ws + WS_WBR), 1024, 0, 32 * (r % nb), 64 * (r / nb), 32 * (r % nb), scr, lane); return; } r -= CI_BR;
    if (r < CI_BR) { const int nb = 32; transpose_item(F.in[14] + (size_t)l * 512 * D, D, (bf16_t*)(ws + WS_WBR), 1024, 512, 32 * (r % nb), 64 * (r / nb), 32 * (r % nb), scr, lane); return; } r -= CI_BR;
    if (r < CI_OUT) { const int nb = 32; transpose_item(F.in[15] + (size_t)l * D * D, D, (bf16_t*)(ws + WS_WOUT), 1024, 0, 32 * (r % nb), 64 * (r / nb), 32 * (r % nb), scr, lane); return; } r -= CI_OUT;
    if (r < NE * 2 * CI_GU) {
        const int e = r / (2 * CI_GU), q = r % (2 * CI_GU), up = q / CI_GU, ii = q % CI_GU, nb = 8, n0 = 32 * (ii % nb), k0 = 64 * (ii / nb);
        const float* W = F.in[up ? 19 : 18] + ((size_t)l * NE + e) * D * FF;
        transpose_item(W, FF, (bf16_t*)(ws + WS_WGU), 1024, 0, e * 512 + (n0 >> 7) * 256 + up * 128 + (n0 & 127), k0, n0, scr, lane); return; } r -= NE * 2 * CI_GU;
    if (r < NE * CI_DN) { const int e = r / CI_DN, ii = r % CI_DN, nb = 32, n0 = 32 * (ii % nb), k0 = 64 * (ii / nb);
        transpose_item(F.in[20] + ((size_t)l * NE + e) * FF * D, D, (bf16_t*)(ws + WS_WDN), 256, 0, e * 1024 + n0, k0, n0, scr, lane); return; } r -= NE * CI_DN;
    {
        const float* W = F.in[9] + (size_t)l * 8 * 128 * 128 + (size_t)r * 2048; bf16_t* O = (bf16_t*)(ws + WS_SGW) + (size_t)r * 2048;
        const int i = (r & 7) * 16 + (lane >> 2), j0 = (lane & 3) * 32;
#pragma unroll
        for (int q = 0; q < 4; ++q) { const f32x4 a = *(const f32x4*)(W + lane * 32 + q * 8), b = *(const f32x4*)(W + lane * 32 + q * 8 + 4); f32x4 a2, b2;
#pragma unroll
            for (int t = 0; t < 4; ++t) { a2[t] = (j0 + q * 8 + t <= i) ? a[t] : 0.f; b2[t] = (j0 + q * 8 + 4 + t <= i) ? b[t] : 0.f; }
            *(u32x4*)(O + lane * 32 + q * 8) = pg8::pack8(a2, b2); }
    }
}
__device__ __forceinline__ void conv_layer(Frame& F, int l, int wave_rot) {
    LAS float* scr = (LAS float*)(F.lds + F.wave * 16384);
    const int NGW = F.G * NWAVES; int gw = F.vcu * NWAVES + F.wave - wave_rot; if (gw < 0) gw += NGW;
    for (int it = gw; it < CONV_ITEMS; it += NGW) conv_item(F, l, it, scr);
}

constexpr int MOD_ITEMS = DEPTH * 6 * D / 32;
__device__ __forceinline__ void mod_item(Frame& F, int it) {
    const LAS float* cond = (const LAS float*)F.lds;
    const int l = it / 192, j0 = (it % 192) * 32, col = j0 + (F.lane & 31), kh = (F.lane >> 5) * 512;
    const float* w = F.in[5] + (size_t)l * D * 6 * D + (size_t)kh * 6 * D + col;
    float acc[16];
#pragma unroll
    for (int b = 0; b < 16; ++b) acc[b] = 0.f;
    for (int k = 0; k < 512; k += 4) {
        float wv[4];
#pragma unroll
        for (int q = 0; q < 4; ++q) wv[q] = w[(size_t)(k + q) * 6 * D];
#pragma unroll
        for (int b = 0; b < 16; ++b) { const f32x4 cv = *(const LAS f32x4*)(cond + b * 1024 + kh + k); acc[b] += cv[0] * wv[0] + cv[1] * wv[1] + cv[2] * wv[2] + cv[3] * wv[3]; }
    }
    float* mod = (float*)(F.ws + WS_MOD);
#pragma unroll
    for (int b = 0; b < 16; ++b) { const float s = acc[b] + __shfl_xor(acc[b], 32); if (F.lane < 32) mod[((size_t)l * BATCH + b) * 6 * D + col] = s + F.in[6][l * 6 * D + col]; }
}

struct RowArgs { const float* xin; const bf16_t* y; const float* g; const float* gain; const float* bias; const float* sc; const float* sh; bf16_t* H; int l; bool has_h; };
__device__ __forceinline__ f32x4 ldbf4(const bf16_t* p) { const u32x2 w = *(const u32x2*)p; return (f32x4){bf_lo(w.x), bf_hi(w.x), bf_lo(w.y), bf_hi(w.y)}; }
template <int MODE>
__device__ __forceinline__ void row_phase(Frame& F, const RowArgs& A) {
    int tid_ = threadIdx.x; asm volatile("" : "+v"(tid_));
    const int lane = tid_ & 63, wave = __builtin_amdgcn_readfirstlane(tid_ >> 6);
    LAS float* wr_t = (LAS float*)F.lds;
    LAS int* lcnt = (LAS int*)(F.lds + 65536);
    LAS int* gb = lcnt + 16;
    LAS int* asg = lcnt + 64;
    if (MODE == 1) {
        for (int idx = F.tid; idx < 4096; idx += NTHR) { const int k = idx >> 2, e4 = idx & 3; const f32x4 v = *(const f32x4*)(F.in[3] + k * 16 + 4 * e4);
            wr_t[(4 * e4 + 0) * 1024 + k] = v[0]; wr_t[(4 * e4 + 1) * 1024 + k] = v[1]; wr_t[(4 * e4 + 2) * 1024 + k] = v[2]; wr_t[(4 * e4 + 3) * 1024 + k] = v[3]; }
        __syncthreads();
    }
#pragma unroll 1
    for (int rb = F.vcu; rb < T / 128; rb += F.G) {
    const int row0 = rb * 128, b = row0 / SEQ;
    if (MODE == 1) { if (F.tid < 16) lcnt[F.tid] = 0; __syncthreads(); }
#pragma unroll 1
    for (int rr = 0; rr < 16; ++rr) {
        const int lr = wave * 16 + rr; const size_t row = (size_t)row0 + lr;
        f32x4 z[4];
        if (MODE == 0) {
#pragma unroll
            for (int j = 0; j < 4; ++j) z[j] = *(const f32x4*)(A.xin + row * D + 4 * lane + 256 * j);
        } else {
#pragma unroll
            for (int j = 0; j < 4; ++j) { const int c = 4 * lane + 256 * j; const f32x4 x = *(const f32x4*)(F.out + row * D + c); const f32x4 g = *(const f32x4*)(A.g + b * 6 * D + c);
                f32x4 y;
                if (MODE == 1) y = ldbf4(A.y + row * D + c); else y = ldbf4(A.y + (2 * row) * D + c) + ldbf4(A.y + (2 * row + 1) * D + c);
                z[j] = ALPHA * x + (1.0f + g) * y; }
            float s = 0.f;
#pragma unroll
            for (int j = 0; j < 4; ++j) s += (z[j][0] + z[j][1]) + (z[j][2] + z[j][3]);
            const float mean = wave_sum(s) * (1.0f / D); float q = 0.f;
#pragma unroll
            for (int j = 0; j < 4; ++j) { z[j] = z[j] - mean; q += (z[j][0] * z[j][0] + z[j][1] * z[j][1]) + (z[j][2] * z[j][2] + z[j][3] * z[j][3]); }
            const float rstd = 1.0f / sqrtf(wave_sum(q) * (1.0f / D) + LN_EPS);
#pragma unroll
            for (int j = 0; j < 4; ++j) { const int c = 4 * lane + 256 * j; z[j] = z[j] * rstd * *(const f32x4*)(A.gain + c) + *(const f32x4*)(A.bias + c); }
        }
#pragma unroll
        for (int j = 0; j < 4; ++j) *(f32x4*)(F.out + row * D + 4 * lane + 256 * j) = z[j];
        if (MODE != 2 || A.has_h) {
            float s = 0.f;
#pragma unroll
            for (int j = 0; j < 4; ++j) s += (z[j][0] + z[j][1]) + (z[j][2] + z[j][3]);
            const float mean = wave_sum(s) * (1.0f / D); float q = 0.f;
#pragma unroll
            for (int j = 0; j < 4; ++j) { z[j] = z[j] - mean; q += (z[j][0] * z[j][0] + z[j][1] * z[j][1]) + (z[j][2] * z[j][2] + z[j][3] * z[j][3]); }
            const float rstd = 1.0f / sqrtf(wave_sum(q) * (1.0f / D) + LN_EPS);
#pragma unroll
            for (int j = 0; j < 4; ++j) { const int c = 4 * lane + 256 * j; z[j] = z[j] * rstd * (1.0f + *(const f32x4*)(A.sc + b * 6 * D + c)) + *(const f32x4*)(A.sh + b * 6 * D + c);
                u32x2 w; w.x = cvt_pk_bf16(z[j][0], z[j][1]); w.y = cvt_pk_bf16(z[j][2], z[j][3]); *(u32x2*)(A.H + row * D + c) = w; }
            if (MODE == 1) {
                float lg[16];
#pragma unroll
                for (int e = 0; e < 16; ++e) { float a = 0.f;
#pragma unroll
                    for (int j = 0; j < 4; ++j) { const f32x4 wv = *(const LAS f32x4*)(wr_t + e * 1024 + 4 * lane + 256 * j); a += (z[j][0] * wv[0] + z[j][1] * wv[1]) + (z[j][2] * wv[2] + z[j][3] * wv[3]); }
                    lg[e] = wave_sum(a); }
                float mx = lg[0];
#pragma unroll
                for (int e = 1; e < 16; ++e) mx = fmaxf(mx, lg[e]);
                float p[16], sum = 0.f;
#pragma unroll
                for (int e = 0; e < 16; ++e) { p[e] = expf(lg[e] - mx); sum += p[e]; }
                const float inv = 1.0f / sum;
                float sel[16];
#pragma unroll
                for (int e = 0; e < 16; ++e) { p[e] *= inv; sel[e] = p[e] + F.in[4][e]; }
                int best = 0; float bs = -1e30f;
                float bsel[4], bp[4];
#pragma unroll
                for (int k = 0; k < 4; ++k) { bsel[k] = 0.f; bp[k] = 0.f; }
#pragma unroll
                for (int gq = 0; gq < 4; ++gq) { float m1 = -1e30f, m2 = -1e30f;
#pragma unroll
                    for (int k = 0; k < 4; ++k) { const float v = sel[gq * 4 + k]; if (v > m1) { m2 = m1; m1 = v; } else if (v > m2) m2 = v; }
                    const float gs = m1 + m2;
                    if (gs > bs) { bs = gs; best = gq;
#pragma unroll
                        for (int k = 0; k < 4; ++k) { bsel[k] = sel[gq * 4 + k]; bp[k] = p[gq * 4 + k]; } } }
                int i1 = 0; float m1 = -1e30f, p1 = 0.f;
#pragma unroll
                for (int k = 0; k < 4; ++k) if (bsel[k] > m1) { m1 = bsel[k]; i1 = k; p1 = bp[k]; }
                int i2 = 0; float m2 = -1e30f, p2 = 0.f;
#pragma unroll
                for (int k = 0; k < 4; ++k) if (k != i1 && bsel[k] > m2) { m2 = bsel[k]; i2 = k; p2 = bp[k]; }
                if (lane == 0) { const float ws = 1.0f / (p1 + p2); const int e1 = best * 4 + i1, e2 = best * 4 + i2;
                    const int r1 = __hip_atomic_fetch_add(lcnt + e1, 1, __ATOMIC_RELAXED, __HIP_MEMORY_SCOPE_WORKGROUP), r2 = __hip_atomic_fetch_add(lcnt + e2, 1, __ATOMIC_RELAXED, __HIP_MEMORY_SCOPE_WORKGROUP);
                    asg[(2 * lr) * 4 + 0] = e1; asg[(2 * lr) * 4 + 1] = r1; asg[(2 * lr) * 4 + 2] = __float_as_int(p1 * ws);
                    asg[(2 * lr + 1) * 4 + 0] = e2; asg[(2 * lr + 1) * 4 + 1] = r2; asg[(2 * lr + 1) * 4 + 2] = __float_as_int(p2 * ws); }
            }
        }
    }
    if (MODE == 1) {
        __syncthreads();
        if (F.tid < 16) gb[F.tid] = (int)__hip_atomic_fetch_add(F.ctl + CW_CNT + 64 * (A.l * 16 + F.tid), (unsigned)lcnt[F.tid], __ATOMIC_RELAXED, __HIP_MEMORY_SCOPE_AGENT);
        __syncthreads();
        if (F.tid < 256) { const int e = asg[F.tid * 4], rank = asg[F.tid * 4 + 1], wb = asg[F.tid * 4 + 2]; const int pos = gb[e] + rank;
            int2 en; en.x = (row0 + (F.tid >> 1)) * 2 + (F.tid & 1); en.y = wb; ((int2*)(F.ws + WS_LIST))[(size_t)e * 32768 + pos] = en; }
        __syncthreads();
    }
    }
}

__device__ __forceinline__ s16x4 vtr(const LAS unsigned char* p) { return __builtin_bit_cast(s16x4, __builtin_amdgcn_ds_read_tr16_b64_v4i16((LAS s16x4*)p)); }
__device__ __forceinline__ bf16x8 cat44(s16x4 a, s16x4 b) { return (bf16x8){a[0], a[1], a[2], a[3], b[0], b[1], b[2], b[3]}; }
__device__ __forceinline__ void mixer_unit(Frame& F, int l, int ub, int un) {
    int tid_ = threadIdx.x; asm volatile("" : "+v"(tid_));
    const int tid = tid_, lane = tid & 63, wave = __builtin_amdgcn_readfirstlane(tid >> 6), c = lane & 15, g = lane >> 4;
    LAS unsigned char* lds = F.lds;
    const bf16_t* QKV = (const bf16_t*)(F.ws + WS_QKV); const bf16_t* USV = (const bf16_t*)(F.ws + WS_USV); bf16_t* CAT = (bf16_t*)(F.ws + WS_CAT);
    const size_t tok0 = (size_t)ub * SEQ + (size_t)un * 128;
#pragma unroll 4
    for (int it = 0; it < 16; ++it) { const int ci = it * NTHR + tid, c8 = ci & 7, key = (ci >> 3) & 255, hk = (ci >> 11) & 1, tv = ci >> 12;
        u32x4 v = (u32x4){0u, 0u, 0u, 0u};
        if (un > 0 || key >= 128) v = *(const u32x4*)(QKV + (tok0 - 128 + key) * 768 + 512 + tv * 128 + hk * 64 + c8 * 8);
        *(LAS u32x4*)(lds + (tv * 2 + hk) * 32768 + key * 128 + ((c8 ^ (key & 7)) << 4)) = v; }
    __syncthreads();
    {
        const int h = wave, hk = h >> 2;
        const LAS unsigned char* Kb = lds + hk * 32768; const LAS unsigned char* Vb = lds + 65536 + hk * 32768;
        const float sink = F.in[8][l * 8 + h];
        float bv[9][4];
#pragma unroll
        for (int j = 0; j < 9; ++j)
#pragma unroll
            for (int r = 0; r < 4; ++r) { const int rel = c + 128 - 16 * j - 4 * g - r; bv[j][r] = (rel >= 0 && rel < 128) ? F.in[2][t5_bucket(rel) * 8 + h] : -1e30f; }
        const int ka0 = c * 128 + (((0 + g) ^ (c & 7)) << 4), ka1 = c * 128 + (((4 + g) ^ (c & 7)) << 4);
        const int vkey = 4 * g + (c >> 2), vsw = vkey & 7, vp = c & 3;
#pragma unroll 1
        for (int qt = 0; qt < 8; ++qt) {
            const bf16_t* qp = QKV + (tok0 + 16 * qt + c) * 768 + h * 64 + 8 * g;
            const bf16x8 q0 = *(const bf16x8*)qp, q1 = *(const bf16x8*)(qp + 32);
            f32x4 s[9];
#pragma unroll
            for (int j = 0; j < 9; ++j) { const LAS unsigned char* kt = Kb + (qt + j) * 2048;
                const bf16x8 k0 = *(const LAS bf16x8*)(kt + ka0), k1 = *(const LAS bf16x8*)(kt + ka1);
                f32x4 a = (f32x4){0.f, 0.f, 0.f, 0.f};
                a = __builtin_amdgcn_mfma_f32_16x16x32_bf16(k0, q0, a, 0, 0, 0); a = __builtin_amdgcn_mfma_f32_16x16x32_bf16(k1, q1, a, 0, 0, 0); s[j] = a; }
            float mx = sink;
#pragma unroll
            for (int j = 0; j < 9; ++j) { const bool dead = (un == 0) && (qt + j < 8);
#pragma unroll
                for (int r = 0; r < 4; ++r) { float v = s[j][r] + bv[j][r]; v = dead ? -1e30f : v; s[j][r] = v; mx = fmaxf(mx, v); } }
            mx = fmaxf(mx, __shfl_xor(mx, 16)); mx = fmaxf(mx, __shfl_xor(mx, 32));
            float sum = 0.f;
#pragma unroll
            for (int j = 0; j < 9; ++j)
#pragma unroll
                for (int r = 0; r < 4; ++r) { const float p = fast_exp(s[j][r] - mx); s[j][r] = p; sum += p; }
            sum += __shfl_xor(sum, 16); sum += __shfl_xor(sum, 32);
            const float inv = 1.0f / (sum + fast_exp(sink - mx));
            bf16x8 pf[5];
#pragma unroll
            for (int k = 0; k < 5; ++k) { const f32x4 a = s[2 * k], b = (k < 4) ? s[2 * k + 1] : (f32x4){0.f, 0.f, 0.f, 0.f};
                u32x4 w; w.x = cvt_pk_bf16(a[0], a[1]); w.y = cvt_pk_bf16(a[2], a[3]); w.z = cvt_pk_bf16(b[0], b[1]); w.w = cvt_pk_bf16(b[2], b[3]); pf[k] = __builtin_bit_cast(bf16x8, w); }
            bf16_t* op = CAT + (tok0 + 16 * qt + c) * 1024 + h * 64 + 4 * g;
#pragma unroll
            for (int dt = 0; dt < 4; ++dt) { f32x4 o = (f32x4){0.f, 0.f, 0.f, 0.f};
                const int voff = (((2 * dt + (vp >> 1)) ^ vsw) << 4) + (vp & 1) * 8;
#pragma unroll
                for (int k = 0; k < 5; ++k) { const int ta = qt + 2 * k; int tb = ta + 1; tb = tb > 15 ? 15 : tb;
                    const s16x4 va = vtr(Vb + (16 * ta + vkey) * 128 + voff), vb = vtr(Vb + (16 * tb + vkey) * 128 + voff);
                    o = __builtin_amdgcn_mfma_f32_16x16x32_bf16(cat44(va, vb), pf[k], o, 0, 0, 0); }
                u32x2 w; w.x = cvt_pk_bf16(o[0] * inv, o[1] * inv); w.y = cvt_pk_bf16(o[2] * inv, o[3] * inv); *(u32x2*)(op + 16 * dt) = w; }
        }
    }
    __syncthreads();
    {
        const float* lg = F.in[11] + l * 512 + 8 * lane; const float* lb = F.in[12] + l * 512 + 8 * lane;
        const f32x4 g0 = *(const f32x4*)lg, g1 = *(const f32x4*)(lg + 4), b0 = *(const f32x4*)lb, b1 = *(const f32x4*)(lb + 4);
#pragma unroll 2
        for (int rr = 0; rr < 16; ++rr) { const int row = wave * 16 + rr;
            const u32x4 w = *(const u32x4*)(USV + (tok0 + row) * 1024 + 512 + 8 * lane);
            f32x4 v0 = (f32x4){bf_lo(w.x), bf_hi(w.x), bf_lo(w.y), bf_hi(w.y)}, v1 = (f32x4){bf_lo(w.z), bf_hi(w.z), bf_lo(w.w), bf_hi(w.w)};
            const float mean = wave_sum((v0[0] + v0[1]) + (v0[2] + v0[3]) + (v1[0] + v1[1]) + (v1[2] + v1[3])) * (1.0f / 512);
            v0 = v0 - mean; v1 = v1 - mean;
            const float q = wave_sum((v0[0] * v0[0] + v0[1] * v0[1]) + (v0[2] * v0[2] + v0[3] * v0[3]) + (v1[0] * v1[0] + v1[1] * v1[1]) + (v1[2] * v1[2] + v1[3] * v1[3]));
            const float rstd = 1.0f / sqrtf(q * (1.0f / 512) + LN_EPS);
            v0 = v0 * rstd * g0 + b0; v1 = v1 * rstd * g1 + b1;
            const int f = (row & 3) | (((row >> 3) & 1) << 2);
            *(LAS u32x4*)(lds + row * 1024 + (((lane >> 1) ^ f) << 5) + (lane & 1) * 16) = pg8::pack8(v0, v1); }
    }
    __syncthreads();
    {
        const int gch = wave;
        const bf16_t* Wg = (const bf16_t*)(F.ws + WS_SGW) + (size_t)gch * 128 * 128;
        const int f = (c >> 2) | ((g & 1) << 2);
#pragma unroll 1
        for (int it = 0; it < 8; ++it) {
            f32x4 o[4];
#pragma unroll
            for (int dt = 0; dt < 4; ++dt) o[dt] = (f32x4){0.f, 0.f, 0.f, 0.f};
            const int nks = (it >> 1) + 1;
            for (int ks = 0; ks < nks; ++ks) {
                const bf16x8 wf = *(const bf16x8*)(Wg + (16 * it + c) * 128 + 32 * ks + 8 * g);
                const int r0 = 32 * ks + 8 * g + (c >> 2);
#pragma unroll
                for (int dt = 0; dt < 4; ++dt) { const int off = (((4 * gch + dt) ^ f) << 5) + (c & 3) * 8;
                    const s16x4 va = vtr(lds + r0 * 1024 + off), vb = vtr(lds + (r0 + 4) * 1024 + off);
                    o[dt] = __builtin_amdgcn_mfma_f32_16x16x32_bf16(cat44(va, vb), wf, o[dt], 0, 0, 0); }
            }
            const float bi = F.in[10][l * 1024 + gch * 128 + 16 * it + c];
            const size_t trow = tok0 + 16 * it + c;
#pragma unroll
            for (int dt = 0; dt < 4; ++dt) { const int ch = 64 * gch + 16 * dt + 4 * g; const f32x4 u = ldbf4(USV + trow * 1024 + ch);
                u32x2 w; w.x = cvt_pk_bf16(u[0] * (o[dt][0] + bi), u[1] * (o[dt][1] + bi)); w.y = cvt_pk_bf16(u[2] * (o[dt][2] + bi), u[3] * (o[dt][3] + bi));
                *(u32x2*)(CAT + trow * 1024 + 512 + ch) = w; }
        }
    }
    __syncthreads();
}

#ifndef MK_PER_PHASE
#define MK_PER_PHASE 0
#endif
constexpr int N_PHASES = 2 + 8 * DEPTH;
struct Args { const float* in[23]; float* out; unsigned char* ws; int ph_lo, ph_hi; };
static_assert(sizeof(Args) == 23 * 8 + 8 + 8 + 8, "Args has no padding");

__device__ __forceinline__ void build_group_tab(Frame& F, int l, int ncol) {
    LAS int* tab = (LAS int*)(F.lds + MISC_OFF + 64);
    __syncthreads();
    if (F.tid == 0) { int up = 0, pp = 0;
        for (int e = 0; e < 16; ++e) { const int cnt = (int)__hip_atomic_load(F.ctl + CW_CNT + 64 * (l * 16 + e), __ATOMIC_RELAXED, __HIP_MEMORY_SCOPE_AGENT); const int pan = (cnt + 255) >> 8;
            tab[e] = up; tab[32 + e] = pp; tab[64 + e] = cnt; up += pan * ncol; pp += pan; }
        tab[16] = up; tab[48] = pp; }
    __syncthreads();
}

__global__ void __launch_bounds__(NTHR, 2) fwd(Args args) {
    extern __shared__ __attribute__((aligned(16))) unsigned char lds_raw[];
    Frame F;
    F.lds = (LAS unsigned char*)lds_raw;
    F.tid = threadIdx.x; F.lane = F.tid & 63; F.wave = __builtin_amdgcn_readfirstlane(F.tid >> 6);
    F.G = gridDim.x; { const int bx = blockIdx.x; F.vcu = (F.G % 8 == 0) ? (bx % 8) * (F.G / 8) + bx / 8 : bx; }
    F.ws = args.ws; F.ctl = (unsigned*)(args.ws + WS_CTL); F.out = args.out;
    F.in = args.in;
    for (int u = F.tid; u < (LDS_BYTES - MISC_OFF) / 4; u += NTHR) ((LAS unsigned*)(F.lds + MISC_OFF))[u] = 0u;
    __syncthreads();
    XcdBarrier bar; bar.bar = F.ctl + CW_BAR; bar.x = 0; bar.st = nullptr;
    if (!MK_PER_PHASE) bar = xcd_barrier_post(F.ctl + CW_BAR, (volatile LAS unsigned*)(F.lds + MISC_OFF));
    const int lo = args.ph_lo, hi = args.ph_hi;
#ifndef PHMASK
#define PHMASK 0x3ff
#endif
#define EN(b) ((PHMASK >> (b)) & 1)
#define IN(k) (lo <= (k) && (k) < hi)
#define REFRESH() do { int t_ = threadIdx.x; asm volatile("" : "+v"(t_)); F.tid = t_; F.lane = t_ & 63; F.wave = __builtin_amdgcn_readfirstlane(t_ >> 6); } while (0)
#define SEAM(k) do { if (IN(k) && IN((k) + 1)) xcd_barrier(bar); } while (0)
    float* mod = (float*)(F.ws + WS_MOD);
    bf16_t* H = (bf16_t*)(F.ws + WS_H);

    if (EN(0) && IN(0)) { REFRESH();
        if (F.vcu * NWAVES < MOD_ITEMS) {
            LAS float* cond = (LAS float*)F.lds;
            for (int i = F.tid; i < BATCH * D; i += NTHR) { const float v = F.in[1][i]; cond[i] = v / (1.0f + expf(-v)); }
            __syncthreads();
            const int gw = F.vcu * NWAVES + F.wave;
            if (gw < MOD_ITEMS) mod_item(F, gw);
        }
        {
            LAS float* scr = (LAS float*)(F.lds + 65536 + F.wave * 8448);
            const int NGW = F.G * NWAVES; int gw = F.vcu * NWAVES + F.wave - MOD_ITEMS; if (gw < 0) gw += NGW;
            for (int it = gw; it < CONV_ITEMS; it += NGW) conv_item(F, 0, it, scr);
        }
    }
    SEAM(0);
    if (EN(1) && IN(1)) { REFRESH(); RowArgs A{F.in[0], nullptr, nullptr, nullptr, nullptr, mod + 1 * D, mod + 0 * D, H, 0, true}; row_phase<0>(F, A); }
    SEAM(1);

#pragma unroll 1
    for (int l = 0; l < DEPTH; ++l) {
        const int pb = 2 + 8 * l;
        const float* ml = mod + (size_t)l * BATCH * 6 * D;
        if (EN(2) && IN(pb + 0)) { REFRESH();
            pg8::Gemm g{H, (const bf16_t*)(F.ws + WS_WIN), 1024, 1024}; pg8::StaticOrder S; S.init(T, INW, F.G, (int)blockIdx.x);
            pg8::EpiInProj E{(bf16_t*)(F.ws + WS_QKV), (bf16_t*)(F.ws + WS_USV), (bf16_t*)(F.ws + WS_GA), (bf16_t*)(F.ws + WS_GS)};
            pg8::gemm_phase<pg8::EpiInProj, pg8::StaticOrder, true, false>(F.lds, g, S, E);
        }
        SEAM(pb + 0);
        if (EN(3) && IN(pb + 1)) { REFRESH(); for (int u = F.vcu; u < BATCH * (SEQ / 128); u += F.G) mixer_unit(F, l, u >> 4, u & 15); }
        SEAM(pb + 1);
        if (EN(4) && IN(pb + 2)) { REFRESH();
            pg8::Gemm g{(const bf16_t*)(F.ws + WS_CAT), (const bf16_t*)(F.ws + WS_WBR), 1024, 1024}; pg8::StaticOrder S; S.init(T, D, F.G, (int)blockIdx.x);
            pg8::EpiMerge E{(const bf16_t*)(F.ws + WS_GA), (const bf16_t*)(F.ws + WS_GS), (bf16_t*)(F.ws + WS_MRG)};
            pg8::gemm_phase<pg8::EpiMerge, pg8::StaticOrder, true, false>(F.lds, g, S, E);
        }
        SEAM(pb + 2);
        if (EN(5) && IN(pb + 3)) { REFRESH();
            pg8::Gemm g{(const bf16_t*)(F.ws + WS_MRG), (const bf16_t*)(F.ws + WS_WOUT), 1024, 1024}; pg8::StaticOrder S; S.init(T, D, F.G, (int)blockIdx.x);
            pg8::EpiPlain E{(bf16_t*)(F.ws + WS_Y)};
            pg8::gemm_phase<pg8::EpiPlain, pg8::StaticOrder, true, false>(F.lds, g, S, E);
        }
        SEAM(pb + 3);
        if (EN(6) && IN(pb + 4)) { REFRESH(); RowArgs A{nullptr, (const bf16_t*)(F.ws + WS_Y), ml + 2 * D, F.in[16] + l * D, F.in[17] + l * D, ml + 4 * D, ml + 3 * D, H, l, true}; row_phase<1>(F, A); }
        SEAM(pb + 4);
        if (EN(7) && IN(pb + 5)) { REFRESH();
            build_group_tab(F, l, 2);
            pg8::Gemm g{H, (const bf16_t*)(F.ws + WS_WGU), 1024, 1024};
            pg8::GroupOrder S{(const LAS int*)(F.lds + MISC_OFF + 64), 2, F.G, F.vcu, (const int2*)(F.ws + WS_LIST)};
            pg8::EpiGateUp E{(bf16_t*)(F.ws + WS_HID)};
            pg8::gemm_phase<pg8::EpiGateUp, pg8::GroupOrder, true, true>(F.lds, g, S, E);
        }
        SEAM(pb + 5);
        if (EN(8) && IN(pb + 6)) { REFRESH();
            build_group_tab(F, l, 4);
            pg8::Gemm g{(const bf16_t*)(F.ws + WS_HID), (const bf16_t*)(F.ws + WS_WDN), 256, 256};
            pg8::GroupOrder S{(const LAS int*)(F.lds + MISC_OFF + 64), 4, F.G, F.vcu, (const int2*)(F.ws + WS_LIST)};
            pg8::EpiDown E{(bf16_t*)(F.ws + WS_Y2), (const int2*)(F.ws + WS_LIST), (const LAS int*)(F.lds + MISC_OFF + 64)};
            pg8::gemm_phase<pg8::EpiDown, pg8::GroupOrder, true, false>(F.lds, g, S, E);
        }
        SEAM(pb + 6);
        if (EN(9) && IN(pb + 7)) { REFRESH();
            const float* mn = mod + (size_t)(l + 1) * BATCH * 6 * D;
            RowArgs A{nullptr, (const bf16_t*)(F.ws + WS_Y2), ml + 5 * D, F.in[21] + l * D, F.in[22] + l * D, mn + 1 * D, mn + 0 * D, H, l, l + 1 < DEPTH};
            row_phase<2>(F, A);
            if (l + 1 < DEPTH) { __syncthreads(); conv_layer(F, l + 1, 0); }
        }
        SEAM(pb + 7);
    }
#undef IN
#undef SEAM
}

extern "C" void kernel_launch(void* const* d_in, const int* in_sizes, int n_in, void* d_out, int out_size, void* d_ws, size_t ws_size, hipStream_t stream) {
    static int grid = 0;
    if (grid == 0) {
        if (n_in != 23 || out_size != T * D || ws_size < WS_END) { fprintf(stderr, "kernel_launch: unexpected shapes (n_in %d out %d ws %zu)\n", n_in, out_size, ws_size); grid = -1; return; }
        int dev = 0, cus = 0, per_cu = 0;
        if (hipGetDevice(&dev) != hipSuccess || hipDeviceGetAttribute(&cus, hipDeviceAttributeMultiprocessorCount, dev) != hipSuccess) { grid = -1; return; }
        if (hipFuncSetAttribute((const void*)fwd, hipFuncAttributeMaxDynamicSharedMemorySize, LDS_BYTES) != hipSuccess) { fprintf(stderr, "kernel_launch: hipFuncSetAttribute failed\n"); grid = -1; return; }
        if (hipOccupancyMaxActiveBlocksPerMultiprocessor(&per_cu, (const void*)fwd, NTHR, LDS_BYTES) != hipSuccess || per_cu < 1) fprintf(stderr, "kernel_launch: occupancy query says %d\n", per_cu);
        (void)hipGetLastError();
        grid = cus;
    }
    if (grid < 0) return;
    if (hipMemsetAsync((char*)d_ws + WS_CTL, 0, CTL_ZERO_BYTES, stream) != hipSuccess) return;
    Args a{};
    for (int i = 0; i < 23; ++i) a.in[i] = (const float*)d_in[i];
    a.out = (float*)d_out; a.ws = (unsigned char*)d_ws;
#if MK_PER_PHASE
    for (int p = 0; p < N_PHASES; ++p) { a.ph_lo = p; a.ph_hi = p + 1; hipLaunchKernelGGL(fwd, dim3(grid), dim3(NTHR), LDS_BYTES, stream, a); }
#else
    a.ph_lo = 0; a.ph_hi = N_PHASES;
    hipLaunchKernelGGL(fwd, dim3(grid), dim3(NTHR), LDS_BYTES, stream, a);
#endif
}
```

```cpp
#include <hip/hip_runtime.h>
#include <cstdio>
#include <cstdint>

#define LAS __attribute__((address_space(3)))
#define GAS __attribute__((address_space(1)))
typedef unsigned short bf16_t;
typedef short bf16x8 __attribute__((ext_vector_type(8)));
typedef short s16x4 __attribute__((ext_vector_type(4)));
typedef float f32x4 __attribute__((ext_vector_type(4)));
typedef float f32x2 __attribute__((ext_vector_type(2)));
typedef unsigned u32x4 __attribute__((ext_vector_type(4)));
typedef unsigned u32x2 __attribute__((ext_vector_type(2)));

constexpr int D = 1024, BATCH = 16, SEQ = 2048, DEPTH = 4, T = BATCH * SEQ;
constexpr int INW = 3840, NE = 16, FF = 256;
constexpr float ALPHA = 1.681792830507429f;
constexpr float LN_EPS = 1e-5f;
constexpr int NWAVES = 8, NTHR = 512;

typedef __bf16 bf16x2_t __attribute__((ext_vector_type(2)));
__device__ __forceinline__ unsigned cvt_pk_bf16(float lo, float hi) { const f32x2 v = {lo, hi}; const bf16x2_t b = __builtin_convertvector(v, bf16x2_t); return __builtin_bit_cast(unsigned, b); }
__device__ __forceinline__ float bf_lo(unsigned w) { return __uint_as_float(w << 16); }
__device__ __forceinline__ float bf_hi(unsigned w) { return __uint_as_float(w & 0xffff0000u); }
__device__ __forceinline__ unsigned pk_fp8x4(float a, float b, float c, float d) { int w = __builtin_amdgcn_cvt_pk_fp8_f32(a, b, 0, false); w = __builtin_amdgcn_cvt_pk_fp8_f32(c, d, w, true); return (unsigned)w; }
__device__ __forceinline__ f32x4 cvf8x4(unsigned w) { const f32x2 a = __builtin_amdgcn_cvt_pk_f32_fp8((int)w, false), b = __builtin_amdgcn_cvt_pk_f32_fp8((int)w, true); return (f32x4){a.x, a.y, b.x, b.y}; }
__device__ __forceinline__ float fast_rcp(float x) { return __builtin_amdgcn_rcpf(x); }
__device__ __forceinline__ float fast_exp(float x) { return __builtin_amdgcn_exp2f(x * 1.4426950408889634f); }
__device__ __forceinline__ float sigmoid_f(float v) { return fast_rcp(1.0f + fast_exp(-v)); }
__device__ __forceinline__ f32x2 gelu_pk(f32x2 v) {
    const f32x2 av = __builtin_elementwise_abs(v), d = av * 0.2316418882f + 1.0f;
    f32x2 t; t.x = __builtin_amdgcn_rcpf(d.x); t.y = __builtin_amdgcn_rcpf(d.y);
    f32x2 q = t * 0.5307027145f + (-0.7265760135f); q = q * t + 0.7107068705f; q = q * t + (-0.142248368f); q = q * t + 0.127414796f; q = q * t;
    const f32x2 s = (v * v) * (-0.72134752044f);
    f32x2 e; e.x = __builtin_amdgcn_exp2f(s.x); e.y = __builtin_amdgcn_exp2f(s.y);
    const f32x2 m = v * (q * e), r = v - m;
    f32x2 o; o.x = v.x < 0.f ? m.x : r.x; o.y = v.y < 0.f ? m.y : r.y; return o;
}

namespace pg8 {
constexpr int BM = 256, BK = 64, HALF = 128, HTB = HALF * BK * 2  , STAGE_BYTES = 8 * HTB, NXCD = 8, WGM = 2;
__host__ __device__ __forceinline__ int lds_byte(int r, int c) { const int st = (r >> 4) * 2 + (c >> 5), rr = r & 15, cc = c & 31, ob = rr * 64 + cc * 2; return st * 1024 + (ob ^ (((ob >> 9) & 1) << 5)); }
__host__ __device__ __forceinline__ void stage_rc(int b, int& R, int& C) { const int st = b / 1024, sb = b % 1024, swz = sb ^ (((sb >> 9) & 1) << 5); R = (st >> 1) * 16 + swz / 64; C = (st & 1) * 32 + (swz % 64) / 2; }
__host__ __device__ __forceinline__ int perm32(int rho) { const int n = rho >> 4, i = rho & 15; return 8 * (i >> 2) + 4 * n + (i & 3); }

struct Unit { int pm, pn, e, p; };
struct Gemm { const bf16_t* A; const bf16_t* Bt; int lda, K; };

struct StaticOrder {
    int nM, nN, nwg, G, c, wgm;
    __device__ void init(int M, int N, int G_, int c_, int wgm_ = WGM) { nM = M / BM; nN = N / BM; nwg = nM * nN; G = G_; c = c_; wgm = wgm_; }
    __device__ void decode(int wgid, Unit& u) const {
        { const int q = nwg / NXCD, r = nwg % NXCD, xcd = wgid % NXCD, off = wgid / NXCD; wgid = (xcd < r ? xcd * (q + 1) : r * (q + 1) + (xcd - r) * q) + off; }
        const int nig = wgm * nN, gid = wgid / nig, fm = gid * wgm, gsz = (nM - fm) < wgm ? (nM - fm) : wgm;
        u.pm = fm + ((wgid % nig) % gsz); u.pn = (wgid % nig) / gsz; u.e = 0; u.p = 0;
    }
    __device__ bool next(int i, Unit& u) const { const long L = (long)i * G + c; if (L >= nwg) return false; decode((int)L, u); return true; }
    __device__ __forceinline__ const int* arow(const Unit&, int) const { return nullptr; }
    __device__ __forceinline__ void a_ready(const Unit&) const {}
};
struct PairOrder {
    StaticOrder S0; int v; bool pair;
    __device__ bool next(int i, Unit& u) const {
        if (!pair) return S0.next(i, u);
        if (i >= 2) return false;
        u.pm = v >> 1; u.pn = 2 * (v & 1) + i; u.e = 0; u.p = 0; return true; }
    __device__ __forceinline__ const int* arow(const Unit&, int) const { return nullptr; }
    __device__ __forceinline__ void a_ready(const Unit&) const {}
};
struct SkewOrder {
    StaticOrder S0; int full;
    __device__ bool next(int i, Unit& u) const {
        const int G = S0.G, c = S0.c; long L;
        if (i < full) L = (long)i * G + c; else { if (c < G / 2) return false; L = (long)full * G + (long)(i - full) * (G / 2) + (c - G / 2); }
        if (L >= S0.nwg) return false; S0.decode((int)L, u); return true;
    }
    __device__ __forceinline__ const int* arow(const Unit&, int) const { return nullptr; }
    __device__ __forceinline__ void a_ready(const Unit&) const {}
};
__device__ __forceinline__ bool group_decode(const LAS int* tab, int ncol, int L, Unit& u) {
    int e = 0;
#pragma unroll
    for (int k = 1; k < 16; ++k) e += (tab[k] <= L) ? 1 : 0;
    const int ul = L - tab[e]; const int p = ul / ncol, pnl = ul - p * ncol;
    u.pm = tab[32 + e] + p; u.pn = e * ncol + pnl; u.e = e; u.p = p; return true;
}
__device__ __forceinline__ const int* group_arow_ptr(const LAS int* tab, const int2* list, const Unit& u, int r) {
    const int pos = u.p * 256 + r; const int cnt = tab[64 + u.e];
    const int pc = pos < cnt ? pos : cnt - 1;
    return &list[(size_t)u.e * 32768 + pc].x;
}
__device__ __forceinline__ void load4_burst(const int* p0, const int* p1, const int* p2, const int* p3, unsigned& r0, unsigned& r1, unsigned& r2, unsigned& r3) {
    asm volatile("global_load_dword %0, %4, off\n\tglobal_load_dword %1, %5, off\n\tglobal_load_dword %2, %6, off\n\tglobal_load_dword %3, %7, off\n\ts_waitcnt vmcnt(0)"
                 : "=&v"(r0), "=&v"(r1), "=&v"(r2), "=&v"(r3) : "v"(p0), "v"(p1), "v"(p2), "v"(p3) : "memory");
}
struct GroupOrder {
    const LAS int* tab; int G, c; const int2* list;
    __device__ bool next(int i, Unit& u) const { const int L = i * G + c; if (L >= tab[80]) return false; return group_decode(tab, 2, L, u); }
    __device__ __forceinline__ const int* arow(const Unit& u, int r) const { return group_arow_ptr(tab, list, u, r); }
    __device__ __forceinline__ void a_ready(const Unit&) const {}
};
struct DeferOrder {
    const LAS int* tab; int c; const int2* list;
    __device__ bool next(int i, Unit& u) const { if (i != 0 || c >= tab[81]) return false; return group_decode(tab, 2, tab[80] + c, u); }
    __device__ __forceinline__ const int* arow(const Unit& u, int r) const { return group_arow_ptr(tab, list, u, r); }
    __device__ __forceinline__ void a_ready(const Unit&) const {}
};
struct GroupOrder7 {
    const LAS int* tab6; const LAS int* tab; int G, c; unsigned* pcnt;
    __device__ bool next(int i, Unit& u) const {
        const int lo = tab6[81]; int L;
        constexpr int SK = 3;
        if (c >= lo) L = (i < SK) ? i * (G - lo) + (c - lo) : SK * (G - lo) + (i - SK) * G + c; else L = SK * (G - lo) + i * G + c;
        if (L >= tab[16]) return false; return group_decode(tab, 4, L, u);
    }
    __device__ __forceinline__ const int* arow(const Unit&, int) const { return nullptr; }
    __device__ __forceinline__ void a_ready(const Unit& u) const {
        const int first = tab6[82];
        if (tab6[81] > 0 && u.pm >= first) {
            const unsigned need = (u.pm == first && (tab6[80] & 1)) ? 1u : 2u;
            if (threadIdx.x < 64) { unsigned sp = 0;
                while ((unsigned)__builtin_amdgcn_readfirstlane(__hip_atomic_load(pcnt + 64 * (u.pm - first), __ATOMIC_RELAXED, __HIP_MEMORY_SCOPE_AGENT)) < need) { __builtin_amdgcn_s_sleep(2); if (++sp > (1u << 22)) break; }
                __builtin_amdgcn_fence(__ATOMIC_ACQUIRE, "agent");
                asm volatile("s_waitcnt vmcnt(0)" ::: "memory"); }
            asm volatile("" ::: "memory"); __builtin_amdgcn_s_barrier(); asm volatile("" ::: "memory");
        }
    }
};

template <bool F16> __device__ __forceinline__ f32x4 mma_op(const bf16x8 a, const bf16x8 b, const f32x4 c) {
    if constexpr (F16) { typedef _Float16 mma_h8 __attribute__((ext_vector_type(8))); return __builtin_amdgcn_mfma_f32_16x16x32_f16(__builtin_bit_cast(mma_h8, a), __builtin_bit_cast(mma_h8, b), c, 0, 0, 0); }
    else return __builtin_amdgcn_mfma_f32_16x16x32_bf16(a, b, c, 0, 0, 0);
}
typedef int mma_v8i __attribute__((ext_vector_type(8)));
__device__ __forceinline__ mma_v8i mma_cat(const bf16x8 lo, const bf16x8 hi) { typedef int v4i_ __attribute__((ext_vector_type(4))); return __builtin_shufflevector(__builtin_bit_cast(v4i_, lo), __builtin_bit_cast(v4i_, hi), 0, 1, 2, 3, 4, 5, 6, 7); }
typedef short mma_s16x16 __attribute__((ext_vector_type(16)));
__device__ __forceinline__ void mma_fp8(f32x4& c, const mma_v8i b, const mma_v8i a, const int one) {
    asm volatile("v_mfma_scale_f32_16x16x128_f8f6f4 %0, %1, %2, %0, %3, %3 op_sel_hi:[0,0,0]" : "+v"(c) : "v"(b), "v"(a), "v"(one));
}
template <class Epi, class Sched, bool ALIGN_EPI, bool GATHER, bool F16 = false, bool FP8 = false>
__device__ __forceinline__ void gemm_phase(LAS unsigned char* lds, const Gemm g, const Sched& S, const Epi& E) {
    int tid_ = threadIdx.x; asm volatile("" : "+v"(tid_));
    const int tid = tid_, wid = __builtin_amdgcn_readfirstlane(tid >> 6), lane = tid & 63, wr = wid >> 2, wc = wid & 3, fr = lane & 15, fq = lane >> 4;
    int K_ = g.K; asm volatile("" : "+s"(K_));
    const int K = K_, nt = K / BK, lda = g.lda;
    unsigned voffA[2], voffB[2]; int RA[2], CA[2];
#pragma unroll
    for (int i = 0; i < 2; ++i) { int R, C; stage_rc(tid * 16 + i * 8192, R, C); const int Rb = Epi::PERM ? ((R & ~31) + perm32(R & 31)) : R;
        RA[i] = R; CA[i] = C; voffA[i] = (unsigned)(R * lda + C) * 2u; voffB[i] = (unsigned)(Rb * K + C) * 2u; }
    const unsigned kstep = (unsigned)(BK * 2);
    const unsigned hstepA = (unsigned)HALF * (unsigned)lda * 2u, tstepA = 2u * hstepA;
    const unsigned hstep = (unsigned)HALF * (unsigned)K * 2u, tstep = 2u * hstep;
    const unsigned ldsw = (unsigned)wid * 1024u;
    const int aoff = FP8 ? lds_byte(wr * 64 + fr, (fq >> 1) * 32 + (fq & 1) * 16) : lds_byte(wr * 64 + fr, fq * 8), boff = FP8 ? lds_byte(wc * 32 + fr, (fq >> 1) * 32 + (fq & 1) * 16) : lds_byte(wc * 32 + fr, fq * 8);
    unsigned ga[2][2] = {{0u, 0u}, {0u, 0u}}, gn[2][2] = {{0u, 0u}, {0u, 0u}};
#define PG8_SA(b, h) (((b) * 2 + (h)) * HTB)
#define PG8_SB(b, h) ((4 + (b) * 2 + (h)) * HTB)
#define PG8_GLDS(base, off32, bufoff, i) __builtin_amdgcn_global_load_lds((const unsigned*)((const char*)(base) + (size_t)(unsigned)(off32)), (LAS unsigned*)(lds + (bufoff) + ldsw + (i) * 8192), 16, 0, 0)
#define PG8_STAGE_B(bufoff, uoff) do { _Pragma("unroll") for (int _i = 0; _i < 2; ++_i) PG8_GLDS(g.Bt, (uoff) + voffB[_i], bufoff, _i); } while (0)
#define PG8_STAGE_A(bufoff, h, kb, nx) do { if constexpr (GATHER) { \
            _Pragma("unroll") for (int _i = 0; _i < 2; ++_i) { const unsigned _o = ((nx) ? gn[h][_i] : ga[h][_i]) + (kb); PG8_GLDS(g.A, _o, bufoff, _i); } } \
        else { const unsigned _u = ((nx) ? nAo : cAo) + (unsigned)(h) * hstepA + (kb); _Pragma("unroll") for (int _i = 0; _i < 2; ++_i) PG8_GLDS(g.A, _u + voffA[_i], bufoff, _i); } } while (0)
#define PG8_LDA(dst, b, h) do { if constexpr (FP8) { _Pragma("unroll") for (int m = 0; m < 4; ++m) dst##8[m] = mma_cat(*(const LAS bf16x8*)(lds + PG8_SA(b, h) + aoff + m * 2048), *(const LAS bf16x8*)(lds + PG8_SA(b, h) + aoff + m * 2048 + 16)); } else { \
        _Pragma("unroll") for (int m = 0; m < 4; ++m) _Pragma("unroll") for (int k = 0; k < 2; ++k) dst[m][k] = *(const LAS bf16x8*)(lds + PG8_SA(b, h) + aoff + m * 2048 + k * 1024); } } while (0)
#define PG8_LDB(dst, b, h) do { if constexpr (FP8) { _Pragma("unroll") for (int n = 0; n < 2; ++n) dst##8[n] = mma_cat(*(const LAS bf16x8*)(lds + PG8_SB(b, h) + boff + n * 2048), *(const LAS bf16x8*)(lds + PG8_SB(b, h) + boff + n * 2048 + 16)); } else { \
        _Pragma("unroll") for (int n = 0; n < 2; ++n) _Pragma("unroll") for (int k = 0; k < 2; ++k) dst[n][k] = *(const LAS bf16x8*)(lds + PG8_SB(b, h) + boff + n * 2048 + k * 1024); } } while (0)
#define PG8_MMA(ai, bj, At, Bt) do { __builtin_amdgcn_s_setprio(1); if constexpr (FP8) { _Pragma("unroll") for (int m = 0; m < 4; ++m) _Pragma("unroll") for (int n = 0; n < 2; ++n) \
        mma_fp8(acc[ai][bj][m][n], Bt##8[n], At##8[m], fp8_one); } else { \
        _Pragma("unroll") for (int m = 0; m < 4; ++m) _Pragma("unroll") for (int n = 0; n < 2; ++n) _Pragma("unroll") for (int k = 0; k < 2; ++k) \
        acc[ai][bj][m][n] = mma_op<F16>(Bt[n][k], At[m][k], acc[ai][bj][m][n]); } __builtin_amdgcn_s_setprio(0); } while (0)
#define PG8_WAIT_V(n) asm volatile("s_waitcnt vmcnt(" #n ")" ::: "memory")
#define PG8_WAIT_L(n) asm volatile("s_waitcnt lgkmcnt(" #n ")" ::: "memory")
#define PG8_BAR __builtin_amdgcn_s_barrier()
#define PG8_SCHED __builtin_amdgcn_sched_barrier(0)
#define PG8_GOFFS(dst, u) do { unsigned _r[2][2]; pg8::load4_burst(S.arow(u, RA[0]), S.arow(u, RA[1]), S.arow(u, HALF + RA[0]), S.arow(u, HALF + RA[1]), _r[0][0], _r[0][1], _r[1][0], _r[1][1]); \
        _Pragma("unroll") for (int _h = 0; _h < 2; ++_h) _Pragma("unroll") for (int _i = 0; _i < 2; ++_i) dst[_h][_i] = ((_r[_h][_i] >> 1) * (unsigned)lda + (unsigned)CA[_i]) * 2u; } while (0)
    Unit cur, nxt; int ui = 0;
    if (!S.next(0, cur)) return;
    f32x4 acc[2][2][4][2];
#pragma unroll
    for (int a = 0; a < 2; ++a)
#pragma unroll
        for (int b = 0; b < 2; ++b)
#pragma unroll
            for (int m = 0; m < 4; ++m)
#pragma unroll
                for (int n = 0; n < 2; ++n) acc[a][b][m][n] = (f32x4){0.f, 0.f, 0.f, 0.f};
    u32x2 pre_[16];
    bf16x8 At[4][2], B0[2][2], B1[2][2]; mma_v8i At8[4], B08[2], B18[2]; int fp8_one = 0x7F7F7F7F; asm volatile("" : "+v"(fp8_one));
    unsigned cAo = GATHER ? 0u : (unsigned)cur.pm * tstepA, cBo = (unsigned)cur.pn * tstep, nAo = cAo;
    if constexpr (GATHER) { PG8_GOFFS(ga, cur); PG8_WAIT_V(0); }
    S.a_ready(cur);
    PG8_STAGE_B(PG8_SB(0, 0), cBo); PG8_STAGE_B(PG8_SB(0, 1), cBo + hstep); PG8_STAGE_A(PG8_SA(0, 0), 0, 0u, false); PG8_STAGE_A(PG8_SA(0, 1), 1, 0u, false);
    if (wr == 1) PG8_BAR;
    PG8_WAIT_V(2); PG8_BAR;
    PG8_STAGE_B(PG8_SB(1, 0), cBo + kstep); PG8_STAGE_A(PG8_SA(1, 0), 0, kstep, false); PG8_STAGE_B(PG8_SB(1, 1), cBo + hstep + kstep);
    PG8_WAIT_V(6); PG8_BAR;
    for (;;) {
        const bool has_next = S.next(ui + 1, nxt);
        nAo = has_next ? (GATHER ? 0u : (unsigned)nxt.pm * tstepA) : cAo; const unsigned nBo = has_next ? (unsigned)nxt.pn * tstep : cBo;
        if constexpr (GATHER) { if (has_next) { PG8_GOFFS(gn, nxt); } else {
#pragma unroll
            for (int _h = 0; _h < 2; ++_h)
#pragma unroll
                for (int _i = 0; _i < 2; ++_i) gn[_h][_i] = ga[_h][_i]; } }
        for (int t = 0; t < nt; t += 2) {
            const bool last = (t == nt - 2);
            const unsigned k1 = (unsigned)(t + 1) * kstep;
            const unsigned k2 = last ? 0u : (unsigned)(t + 2) * kstep, k3 = k2 + kstep;
            const unsigned b2 = (last ? nBo : cBo) + k2, b3 = b2 + kstep;
            if (last && has_next) S.a_ready(nxt);
            if constexpr (Epi::HAS_MID) { if (t == (nt >> 1) - 2) E.load_mid(pre_, cur, wr, wc, fr, fq); if (t == (nt >> 1)) E.mid(acc, pre_); if (last) E.load_fin(pre_, cur, wr, wc, fr, fq); }
            PG8_LDB(B0, 0, 0); PG8_LDB(B1, 0, 1); PG8_SCHED; PG8_LDA(At, 0, 0); PG8_STAGE_A(PG8_SA(1, 1), 1, k1, false);
            PG8_WAIT_V(8); PG8_WAIT_L(0); PG8_BAR; PG8_MMA(0, 0, At, B0); PG8_MMA(0, 1, At, B1); PG8_BAR; PG8_SCHED;
            PG8_LDA(At, 0, 1); PG8_STAGE_B(PG8_SB(0, 0), b2); PG8_STAGE_B(PG8_SB(0, 1), b2 + hstep); PG8_STAGE_A(PG8_SA(0, 0), 0, k2, last);
            PG8_WAIT_V(8); PG8_WAIT_L(0); PG8_BAR; PG8_MMA(1, 0, At, B0); PG8_MMA(1, 1, At, B1); PG8_BAR; PG8_SCHED;
            PG8_LDB(B0, 1, 0); PG8_LDB(B1, 1, 1); PG8_SCHED; PG8_LDA(At, 1, 0); PG8_STAGE_A(PG8_SA(0, 1), 1, k2, last);
            PG8_WAIT_V(8); PG8_WAIT_L(0); PG8_BAR; PG8_MMA(0, 0, At, B0); PG8_MMA(0, 1, At, B1); PG8_BAR; PG8_SCHED;
            PG8_LDA(At, 1, 1); PG8_STAGE_B(PG8_SB(1, 0), b3); PG8_STAGE_B(PG8_SB(1, 1), b3 + hstep); PG8_STAGE_A(PG8_SA(1, 0), 0, k3, last);
            PG8_WAIT_V(8); PG8_WAIT_L(0); PG8_BAR; PG8_MMA(1, 0, At, B0); PG8_MMA(1, 1, At, B1); PG8_BAR; PG8_SCHED;
        }
        if constexpr (FP8) asm volatile("s_nop 7\n\ts_nop 7\n\ts_nop 7" ::: "memory");
        if constexpr (ALIGN_EPI) { if (wr == 0) PG8_BAR; }
#ifndef EPI_REP
#define EPI_REP 1
#endif
        { int nrep_ = EPI_REP; if (EPI_REP > 1) asm volatile("" : "+s"(nrep_));
          _Pragma("unroll 1") for (int er_ = 0; er_ < nrep_; ++er_) { if constexpr (Epi::HAS_MID) E.fin(acc, pre_, cur, wr, wc, fr, fq); else E(acc, cur, wr, wc, fr, fq); } }
        if (!has_next) break;
#pragma unroll
        for (int a = 0; a < 2; ++a)
#pragma unroll
            for (int b = 0; b < 2; ++b)
#pragma unroll
                for (int m = 0; m < 4; ++m)
#pragma unroll
                    for (int n = 0; n < 2; ++n) acc[a][b][m][n] = (f32x4){0.f, 0.f, 0.f, 0.f};
        cur = nxt; cAo = nAo; cBo = nBo; ++ui;
#pragma unroll
        for (int _h = 0; _h < 2; ++_h)
#pragma unroll
            for (int _i = 0; _i < 2; ++_i) ga[_h][_i] = gn[_h][_i];
        if constexpr (ALIGN_EPI) { if (wr == 1) PG8_BAR; }
    }
    PG8_WAIT_V(0);
    if constexpr (!ALIGN_EPI) { if (wr == 0) PG8_BAR; }
    PG8_BAR;
#undef PG8_SA
#undef PG8_SB
#undef PG8_GLDS
#undef PG8_STAGE_B
#undef PG8_STAGE_A
#undef PG8_LDA
#undef PG8_LDB
#undef PG8_MMA
#undef PG8_WAIT_V
#undef PG8_WAIT_L
#undef PG8_BAR
#undef PG8_SCHED
#undef PG8_GOFFS
}
}

namespace pg8 {
__device__ __forceinline__ u32x4 pack8(const f32x4 v0, const f32x4 v1) { u32x4 w; w.x = cvt_pk_bf16(v0[0], v0[1]); w.y = cvt_pk_bf16(v0[2], v0[3]); w.z = cvt_pk_bf16(v1[0], v1[1]); w.w = cvt_pk_bf16(v1[2], v1[3]); return w; }
__device__ __forceinline__ void st16(void* base, unsigned off, const u32x4 v) { *(u32x4*)((char*)base + (size_t)off) = v; }
__device__ __forceinline__ u32x4 ld16(const void* base, unsigned off) { return *(const u32x4*)((const char*)base + (size_t)off); }

struct EpiInProj {
    static constexpr bool PERM = true, HAS_MID = false;
    bf16_t *QKV, *USV, *GA, *GS;
    __device__ __forceinline__ void operator()(const f32x4 (&acc)[2][2][4][2], const Unit& u, int wr, int wc, int fr, int fq) const {
        const unsigned row0 = (unsigned)(u.pm * BM + wr * 64 + fr), cl = (unsigned)(wc * 32 + 8 * fq); const int pn = u.pn;
        if (pn < 3) {
            const float sc = (pn < 2) ? 0.125f : 1.0f; unsigned o0 = (row0 * 768u + (unsigned)pn * 256u + cl) * 2u; asm volatile("" : "+v"(o0));
#pragma unroll
            for (int ai = 0; ai < 2; ++ai)
#pragma unroll
                for (int m = 0; m < 4; ++m)
#pragma unroll
                    for (int bj = 0; bj < 2; ++bj) st16(QKV, o0 + (unsigned)((ai * HALF + m * 16) * 768 + bj * HALF) * 2u, pack8(acc[ai][bj][m][0] * sc, acc[ai][bj][m][1] * sc));
        } else if (pn < 7) {
            unsigned o0 = (row0 * 1024u + (unsigned)(pn - 3) * 256u + cl) * 2u; asm volatile("" : "+v"(o0));
#pragma unroll
            for (int ai = 0; ai < 2; ++ai)
#pragma unroll
                for (int m = 0; m < 4; ++m)
#pragma unroll
                    for (int bj = 0; bj < 2; ++bj) st16(USV, o0 + (unsigned)((ai * HALF + m * 16) * 1024 + bj * HALF) * 2u, pack8(acc[ai][bj][m][0], acc[ai][bj][m][1]));
        } else {
            unsigned o0 = (row0 * 1024u + (unsigned)(pn - 7) * 128u + cl) * 2u; asm volatile("" : "+v"(o0));
#pragma unroll
            for (int ai = 0; ai < 2; ++ai)
#pragma unroll
                for (int m = 0; m < 4; ++m) { f32x4 r0, r1, s0, s1;
#pragma unroll
                    for (int j = 0; j < 4; ++j) { const float e0 = fast_exp(-acc[ai][1][m][0][j]), e1 = fast_exp(-acc[ai][1][m][1][j]);
                        const float a0 = fast_exp(-acc[ai][0][m][0][j]), a1 = fast_exp(-acc[ai][0][m][1][j]);
                        s0[j] = fast_rcp(1.0f + e0); s1[j] = fast_rcp(1.0f + e1); r0[j] = (1.0f + e0) * fast_rcp(1.0f + a0); r1[j] = (1.0f + e1) * fast_rcp(1.0f + a1); }
                    const unsigned off = o0 + (unsigned)((ai * HALF + m * 16) * 1024) * 2u;
                    st16(GA, off, pack8(r0, r1)); st16(GS, off, pack8(s0, s1)); }
        }
    }
};
struct EpiGate {
    static constexpr bool PERM = true, HAS_MID = false;
    bf16_t* QKV; unsigned char *USV, *GA, *GS;
    __device__ __forceinline__ void operator()(const f32x4 (&acc)[2][2][4][2], const Unit& u, int wr, int wc, int fr, int fq) const {
        const unsigned row0 = (unsigned)(u.pm * BM + wr * 64 + fr), cl = (unsigned)(wc * 32 + 8 * fq); const int pn = u.pn;
        if (pn < 3) {
            const float sc = (pn < 2) ? 0.125f * 1.4426950408889634f * 0.03125f : 0.03125f;   unsigned o0 = (row0 * 768u + (unsigned)pn * 256u + cl) * 2u; asm volatile("" : "+v"(o0));
#pragma unroll
            for (int ai = 0; ai < 2; ++ai)
#pragma unroll
                for (int m = 0; m < 4; ++m)
#pragma unroll
                    for (int bj = 0; bj < 2; ++bj) st16(QKV, o0 + (unsigned)((ai * HALF + m * 16) * 768 + bj * HALF) * 2u, pack8(acc[ai][bj][m][0] * sc, acc[ai][bj][m][1] * sc));
        } else if (pn < 7) {
            unsigned o0 = (row0 * 1024u + (unsigned)(pn - 3) * 256u + cl); asm volatile("" : "+v"(o0));
#pragma unroll
            for (int ai = 0; ai < 2; ++ai)
#pragma unroll
                for (int m = 0; m < 4; ++m)
#pragma unroll
                    for (int bj = 0; bj < 2; ++bj) { const f32x4 v0 = acc[ai][bj][m][0] * 0.03125f, v1 = acc[ai][bj][m][1] * 0.03125f; u32x2 b8; b8.x = pk_fp8x4(v0[0], v0[1], v0[2], v0[3]); b8.y = pk_fp8x4(v1[0], v1[1], v1[2], v1[3]);
                        *(u32x2*)(USV + (size_t)(o0 + (unsigned)((ai * HALF + m * 16) * 1024 + bj * HALF))) = b8; }
        } else {
            unsigned o0 = (row0 * 1024u + (unsigned)(pn - 7) * 128u + cl); asm volatile("" : "+v"(o0));
            constexpr float NS = -0.03125f;
#pragma unroll
            for (int ai = 0; ai < 2; ++ai)
#pragma unroll
                for (int m = 0; m < 4; ++m) { f32x4 r0, r1, s0, s1;
#pragma unroll
                    for (int j = 0; j < 4; ++j) { const float e0 = fast_exp(NS * acc[ai][1][m][0][j]), e1 = fast_exp(NS * acc[ai][1][m][1][j]);
                        const float a0 = fast_exp(NS * acc[ai][0][m][0][j]), a1 = fast_exp(NS * acc[ai][0][m][1][j]);
                        s0[j] = fast_rcp(1.0f + e0); s1[j] = fast_rcp(1.0f + e1); r0[j] = fminf((1.0f + e0) * fast_rcp(1.0f + a0), 448.0f); r1[j] = fminf((1.0f + e1) * fast_rcp(1.0f + a1), 448.0f); }
                    const unsigned off = o0 + (unsigned)((ai * HALF + m * 16) * 1024);
                    u32x2 rb, sb; rb.x = pk_fp8x4(r0[0], r0[1], r0[2], r0[3]); rb.y = pk_fp8x4(r1[0], r1[1], r1[2], r1[3]); sb.x = pk_fp8x4(s0[0], s0[1], s0[2], s0[3]); sb.y = pk_fp8x4(s1[0], s1[1], s1[2], s1[3]);
                    *(u32x2*)(GA + (size_t)off) = rb; *(u32x2*)(GS + (size_t)off) = sb; }
        }
    }
};
struct EpiMerge {
    static constexpr bool PERM = true, HAS_MID = true;
    const unsigned char *GA, *GS; unsigned char* O;
    __device__ __forceinline__ void load16(const unsigned char* G, u32x2 (&pre)[16], const Unit& u, int wr, int wc, int fr, int fq) const {
        unsigned o0 = ((unsigned)(u.pm * BM + wr * 64 + fr) * 1024u + (unsigned)(u.pn * BM + wc * 32 + 8 * fq)); asm volatile("" : "+v"(o0));
#pragma unroll
        for (int ai = 0; ai < 2; ++ai)
#pragma unroll
            for (int m = 0; m < 4; ++m)
#pragma unroll
                for (int bj = 0; bj < 2; ++bj) pre[(ai * 4 + m) * 2 + bj] = *(const u32x2*)(G + (size_t)(o0 + (unsigned)((ai * HALF + m * 16) * 1024 + bj * HALF)));
    }
    __device__ __forceinline__ void load_mid(u32x2 (&pre)[16], const Unit& u, int wr, int wc, int fr, int fq) const { load16(GA, pre, u, wr, wc, fr, fq); }
    __device__ __forceinline__ void load_fin(u32x2 (&pre)[16], const Unit& u, int wr, int wc, int fr, int fq) const { load16(GS, pre, u, wr, wc, fr, fq); }
    __device__ __forceinline__ void mid(f32x4 (&acc)[2][2][4][2], const u32x2 (&pre)[16]) const {
#pragma unroll
        for (int ai = 0; ai < 2; ++ai)
#pragma unroll
            for (int m = 0; m < 4; ++m)
#pragma unroll
                for (int bj = 0; bj < 2; ++bj) { const u32x2 a = pre[(ai * 4 + m) * 2 + bj]; acc[ai][bj][m][0] *= cvf8x4(a.x); acc[ai][bj][m][1] *= cvf8x4(a.y); }
    }
    __device__ __forceinline__ void fin(const f32x4 (&acc)[2][2][4][2], const u32x2 (&pre)[16], const Unit& u, int wr, int wc, int fr, int fq) const {
        unsigned o0 = ((unsigned)(u.pm * BM + wr * 64 + fr) * 1024u + (unsigned)(u.pn * BM + wc * 32 + 8 * fq)); asm volatile("" : "+v"(o0));
#pragma unroll
        for (int ai = 0; ai < 2; ++ai)
#pragma unroll
            for (int m = 0; m < 4; ++m)
#pragma unroll
                for (int bj = 0; bj < 2; ++bj) { const unsigned off = o0 + (unsigned)((ai * HALF + m * 16) * 1024 + bj * HALF); const u32x2 sg = pre[(ai * 4 + m) * 2 + bj];
                    const f32x4 v0 = acc[ai][bj][m][0] * cvf8x4(sg.x) * 0.03125f, v1 = acc[ai][bj][m][1] * cvf8x4(sg.y) * 0.03125f;
                    u32x2 b8; b8.x = pk_fp8x4(v0[0], v0[1], v0[2], v0[3]); b8.y = pk_fp8x4(v1[0], v1[1], v1[2], v1[3]); *(u32x2*)(O + (size_t)off) = b8; }
    }
    __device__ __forceinline__ void operator()(const f32x4 (&acc)[2][2][4][2], const Unit& u, int wr, int wc, int fr, int fq) const { }
};
struct EpiPlain {
    static constexpr bool PERM = true, HAS_MID = false;
    unsigned char* O; float sc;
    __device__ __forceinline__ void operator()(const f32x4 (&acc)[2][2][4][2], const Unit& u, int wr, int wc, int fr, int fq) const {
        unsigned o0 = ((unsigned)(u.pm * BM + wr * 64 + fr) * 1024u + (unsigned)(u.pn * BM + wc * 32 + 8 * fq)) * 2u; asm volatile("" : "+v"(o0));
#pragma unroll
        for (int ai = 0; ai < 2; ++ai)
#pragma unroll
            for (int m = 0; m < 4; ++m)
#pragma unroll
                for (int bj = 0; bj < 2; ++bj) { const f32x4 v0 = acc[ai][bj][m][0] * sc, v1 = acc[ai][bj][m][1] * sc; u32x2 b8; b8.x = pk_fp8x4(v0[0], v0[1], v0[2], v0[3]); b8.y = pk_fp8x4(v1[0], v1[1], v1[2], v1[3]);
                      *(u32x2*)(O + (size_t)((o0 >> 1) + (unsigned)((ai * HALF + m * 16) * 1024 + bj * HALF))) = b8; }
    }
};
struct EpiGateUp {
    static constexpr bool PERM = true, HAS_MID = false;
    unsigned char* HID;
    __device__ __forceinline__ void operator()(const f32x4 (&acc)[2][2][4][2], const Unit& u, int wr, int wc, int fr, int fq) const {
        unsigned o0 = ((unsigned)(u.pm * BM + wr * 64 + fr) * 256u + (unsigned)((u.pn & 1) * 128 + wc * 32 + 8 * fq)); asm volatile("" : "+v"(o0));
#pragma unroll
        for (int ai = 0; ai < 2; ++ai)
#pragma unroll
            for (int m = 0; m < 4; ++m) { f32x4 h0, h1; const f32x4 g0 = acc[ai][0][m][0] * 0.03125f, g1 = acc[ai][0][m][1] * 0.03125f, u0 = acc[ai][1][m][0] * 0.03125f, u1 = acc[ai][1][m][1] * 0.03125f;
#pragma unroll
                for (int j = 0; j < 4; ++j) { h0[j] = g0[j] * sigmoid_f(g0[j]) * u0[j]; h1[j] = g1[j] * sigmoid_f(g1[j]) * u1[j]; }
                u32x2 b8; b8.x = pk_fp8x4(h0[0], h0[1], h0[2], h0[3]); b8.y = pk_fp8x4(h1[0], h1[1], h1[2], h1[3]); *(u32x2*)(HID + (size_t)(o0 + (unsigned)((ai * HALF + m * 16) * 256))) = b8; }
    }
};
struct EpiDown {
    static constexpr bool PERM = true, HAS_MID = false;
    unsigned char* Y2; const int2* list; const LAS int* tab;
    __device__ __forceinline__ void operator()(const f32x4 (&acc)[2][2][4][2], const Unit& u, int wr, int wc, int fr, int fq) const {
        const int r0 = wr * 64 + fr, cnt = tab[64 + u.e] - u.p * 256; const unsigned colb = (unsigned)((u.pn & 3) * 256 + wc * 32 + 8 * fq);
        unsigned lo0 = ((unsigned)u.e * 32768u + (unsigned)(u.p * 256 + r0)) * 8u; asm volatile("" : "+v"(lo0));
        int2 en[2][4];
#pragma unroll
        for (int ai = 0; ai < 2; ++ai)
#pragma unroll
            for (int m = 0; m < 4; ++m) { en[ai][m].x = -1; en[ai][m].y = 0; if (r0 + ai * HALF + m * 16 < cnt) en[ai][m] = *(const int2*)((const char*)list + (size_t)(lo0 + (unsigned)(ai * HALF + m * 16) * 8u)); }
#pragma unroll
        for (int ai = 0; ai < 2; ++ai)
#pragma unroll
            for (int m = 0; m < 4; ++m) { const float w = __int_as_float(en[ai][m].y) * 0.03125f; const unsigned off = (unsigned)en[ai][m].x * 1024u + colb;
                if (en[ai][m].x >= 0) {
#pragma unroll
                    for (int bj = 0; bj < 2; ++bj) { const f32x4 v0 = acc[ai][bj][m][0] * w, v1 = acc[ai][bj][m][1] * w; u32x2 b8; b8.x = pk_fp8x4(v0[0], v0[1], v0[2], v0[3]); b8.y = pk_fp8x4(v1[0], v1[1], v1[2], v1[3]);
                        *(u32x2*)(Y2 + (size_t)(off + (unsigned)(bj * HALF))) = b8; } } }
    }
};
}
#define XB_TMO      128
#define XB_XCNT(j)  (256  + 64 * (j))
#define XB_XSUB(j)  (1280 + 64 * (j))
#define XB_XGEN(j)  (2304 + 64 * (j))
#define XB_TOP      3328
#define XB_TOPGEN   3392
#define XCD_BAR_WORDS 3456
#define XB_SPIN_CAP (1u << 18)

__device__ __forceinline__ unsigned xb_ld(unsigned* p)              { return __hip_atomic_load(p, __ATOMIC_RELAXED, __HIP_MEMORY_SCOPE_AGENT); }
__device__ __forceinline__ unsigned xb_add(unsigned* p, unsigned v) { return __hip_atomic_fetch_add(p, v, __ATOMIC_RELAXED, __HIP_MEMORY_SCOPE_AGENT); }
__device__ __forceinline__ unsigned xb_xcc_id() { return (unsigned)__builtin_amdgcn_s_getreg((3 << 11) | 20) & 0xFu; }
#define XB_SPIN(cond, bar) do { unsigned _sp = 0; while (cond) { __builtin_amdgcn_s_sleep(1); \
    if ((++_sp & 255u) == 0u) { if (xb_ld(&(bar)[XB_TMO])) break; if (_sp > XB_SPIN_CAP) { atomicAdd(&(bar)[XB_TMO], 1u); break; } } } } while (0)

struct XcdBarrier {
    unsigned* bar; unsigned x;
    volatile LAS unsigned* st;
};

__device__ __forceinline__ XcdBarrier xcd_barrier_post(unsigned* bar, volatile LAS unsigned* st) {
    XcdBarrier b; b.bar = bar; b.x = xb_xcc_id(); b.st = st;
    if (threadIdx.x == 0) (void)xb_add(&bar[XB_XCNT(b.x)], 1u);
    return b;
}
__device__ __forceinline__ void xcd_barrier_complete(unsigned* bar, unsigned x, unsigned& nloc, unsigned& nx) {
    const unsigned G = gridDim.x * gridDim.y * gridDim.z;
    unsigned sum, cnt, mine, sp = 0u;
    for (;;) {
        sum = 0u; cnt = 0u; mine = 0u;
#pragma unroll
        for (unsigned j = 0; j < 16; ++j) { const unsigned c = xb_ld(&bar[XB_XCNT(j)]); sum += c; cnt += (c > 0u) ? 1u : 0u; mine = (j == x) ? c : mine; }
        if (sum == G) break;
        __builtin_amdgcn_s_sleep(1);
        if ((++sp & 255u) == 0u) { if (xb_ld(&bar[XB_TMO])) break; if (sp > XB_SPIN_CAP) { atomicAdd(&bar[XB_TMO], 1u); break; } }
    }
    nloc = mine > 0u ? mine : 1u; nx = cnt > 0u ? cnt : 1u;
}

__device__ __forceinline__ void xcd_barrier(const XcdBarrier& b) {
    asm volatile("s_waitcnt vmcnt(0)" ::: "memory");
    __syncthreads();
    if (threadIdx.x == 0) {
        unsigned* bar = b.bar;
        __builtin_amdgcn_s_waitcnt(0);
        unsigned nloc = b.st[0], nx = b.st[1];
        if (nloc == 0u) { xcd_barrier_complete(bar, b.x, nloc, nx); b.st[0] = nloc; b.st[1] = nx; }
        const unsigned old = xb_add(&bar[XB_XSUB(b.x)], 1u);
        const unsigned gen = old / nloc;
        if (old + 1u == (gen + 1u) * nloc) {
            __builtin_amdgcn_fence(__ATOMIC_RELEASE, "agent");
            asm volatile("s_waitcnt vmcnt(0)" ::: "memory");
            const unsigned og = xb_add(&bar[XB_TOP], 1u);
            const unsigned target = (og / nx + 1u) * nx;
            if (og + 1u != target) XB_SPIN(xb_ld(&bar[XB_TOP]) < target, bar);
            __builtin_amdgcn_fence(__ATOMIC_ACQUIRE, "agent");
            xb_add(&bar[XB_XGEN(b.x)], 1u);
            asm volatile("s_waitcnt vmcnt(0)" ::: "memory");
        } else {
            XB_SPIN(xb_ld(&bar[XB_XGEN(b.x)]) == gen, bar);
            __builtin_amdgcn_fence(__ATOMIC_ACQUIRE, "agent");
            asm volatile("s_waitcnt vmcnt(0)" ::: "memory");
        }
    }
    __syncthreads();
}

__device__ __forceinline__ void pair_sync(unsigned* bar, unsigned* cnt, volatile LAS unsigned* same) {
    asm volatile("s_waitcnt vmcnt(0)" ::: "memory");
    __syncthreads();
    if (threadIdx.x == 0) {
        __builtin_amdgcn_s_waitcnt(0);
        if (same[0] != 1u) { __builtin_amdgcn_fence(__ATOMIC_RELEASE, "agent"); asm volatile("s_waitcnt vmcnt(0)" ::: "memory"); }
        const unsigned og = xb_add(cnt, 1u);
        if (og == 0u) XB_SPIN(xb_ld(cnt) < 2u, bar);
        __builtin_amdgcn_fence(__ATOMIC_ACQUIRE, "agent");
        asm volatile("s_waitcnt vmcnt(0)" ::: "memory");
    }
    __syncthreads();
}

constexpr size_t MiB = 1u << 20;
constexpr size_t WS_CTL = 0, CTL_ZERO_BYTES = 1 * MiB;
constexpr size_t WS_MOD = 1 * MiB;
constexpr size_t WS_ST = 3 * MiB;
constexpr size_t WS_WIN = 4 * MiB, WS_WBR = 12 * MiB, WS_WOUT = 14 * MiB, WS_WGU = 16 * MiB, WS_WDN = 32 * MiB, WS_SGW = 40 * MiB;
constexpr size_t WS_WIN8 = WS_WIN;
constexpr size_t WS_WSTRIDE = 37 * MiB;
constexpr size_t WS_LIST = 152 * MiB;
constexpr size_t WS_HX = 156 * MiB;
constexpr size_t WS_GA = 220 * MiB, WS_GS = 284 * MiB, WS_Y2 = WS_GA;
constexpr size_t WS_H8A = 348 * MiB + 32 * MiB;
constexpr size_t WS_CAT = 348 * MiB, WS_Y = WS_CAT;
constexpr size_t WS_WRB = 412 * MiB;
constexpr size_t WS_END = 416 * MiB;
constexpr size_t OB_QKV = 0, OB_HID = OB_QKV;
constexpr size_t OB_USV = 48 * MiB, OB_MRG = OB_USV, OB_H8 = OB_USV;
constexpr int CW_BAR = 4096;
constexpr int CW_CNT = 16384;
constexpr int CW_PAIR = 98304;
constexpr int CW_XID = 196608;
constexpr int CW_PAN = 65536;
constexpr int RING_BYTES = 131072, MISC_OFF = 135168, PAR_OFF = 139264, LDS_BYTES = 163840;

#define VM_WAIT() asm volatile("s_waitcnt vmcnt(0)" ::: "memory")
#define LDS_WAIT() asm volatile("s_waitcnt lgkmcnt(0)" ::: "memory")

struct Frame {
    LAS unsigned char* lds; int tid, lane, wave, vcu, G;
    unsigned char* ws;
    const float* const* in; float* out;
};
__device__ __forceinline__ float wave_sum(float v) {
#pragma unroll
    for (int o = 1; o < 64; o <<= 1) v += __shfl_xor(v, o);
    return v;
}
__device__ __forceinline__ int t5_bucket(int rel) {
    const int n = rel < 0 ? 0 : rel;
    if (n < 16) return n;
    const int large = 16 + (int)(logf((float)n / 16.0f) / logf(8.0f) * 16.0f);
    return large < 31 ? large : 31;
}

template <bool F16OUT>
__device__ __forceinline__ void transpose_item(const float* W, int N, bf16_t* WT, int ldt, int koff, int row_of_n0, int k0, int n0, int lane, LAS unsigned char* scr) {
    const float* src = W + (size_t)k0 * N + n0 + lane;
    float v[64];
#pragma unroll
    for (int i = 0; i < 64; ++i) v[i] = src[(size_t)i * N];
#pragma unroll
    for (int c = 0; c < 8; ++c) { u32x4 o;
        if (F16OUT) { typedef _Float16 th2 __attribute__((ext_vector_type(2)));
            o.x = __builtin_bit_cast(unsigned, __builtin_convertvector((f32x2){v[8 * c], v[8 * c + 1]}, th2)); o.y = __builtin_bit_cast(unsigned, __builtin_convertvector((f32x2){v[8 * c + 2], v[8 * c + 3]}, th2));
            o.z = __builtin_bit_cast(unsigned, __builtin_convertvector((f32x2){v[8 * c + 4], v[8 * c + 5]}, th2)); o.w = __builtin_bit_cast(unsigned, __builtin_convertvector((f32x2){v[8 * c + 6], v[8 * c + 7]}, th2)); }
        else { o.x = cvt_pk_bf16(v[8 * c], v[8 * c + 1]); o.y = cvt_pk_bf16(v[8 * c + 2], v[8 * c + 3]); o.z = cvt_pk_bf16(v[8 * c + 4], v[8 * c + 5]); o.w = cvt_pk_bf16(v[8 * c + 6], v[8 * c + 7]); }
        *(LAS u32x4*)(scr + lane * 144 + c * 16) = o; }
    const int c8 = lane & 7;
#pragma unroll
    for (int j = 0; j < 8; ++j) { const int n = (lane >> 3) + 8 * j; const u32x4 o = *(const LAS u32x4*)(scr + n * 144 + c8 * 16);
        *(u32x4*)(WT + (size_t)(row_of_n0 + n) * ldt + koff + k0 + 8 * c8) = o; }
}
template <int PITCH = 1024>
__device__ __forceinline__ void transpose_item_fp8(const float* W, int N, unsigned char* WT, int koff, int row_of_n0, int k0, int n0, int lane, LAS unsigned char* scr) {
    const float* src = W + (size_t)k0 * N + n0 + lane;
    float v[64];
#pragma unroll
    for (int i = 0; i < 64; ++i) v[i] = src[(size_t)i * N];
#pragma unroll
    for (int c = 0; c < 4; ++c) { u32x4 o;
        o.x = pk_fp8x4(32.f * v[16 * c], 32.f * v[16 * c + 1], 32.f * v[16 * c + 2], 32.f * v[16 * c + 3]); o.y = pk_fp8x4(32.f * v[16 * c + 4], 32.f * v[16 * c + 5], 32.f * v[16 * c + 6], 32.f * v[16 * c + 7]);
        o.z = pk_fp8x4(32.f * v[16 * c + 8], 32.f * v[16 * c + 9], 32.f * v[16 * c + 10], 32.f * v[16 * c + 11]); o.w = pk_fp8x4(32.f * v[16 * c + 12], 32.f * v[16 * c + 13], 32.f * v[16 * c + 14], 32.f * v[16 * c + 15]);
        *(LAS u32x4*)(scr + lane * 80 + c * 16) = o; }
    const int c4 = lane & 3;
#pragma unroll
    for (int j = 0; j < 4; ++j) { const int n = (lane >> 2) + 16 * j; const u32x4 o = *(const LAS u32x4*)(scr + n * 80 + c4 * 16);
        *(u32x4*)(WT + (size_t)(row_of_n0 + n) * PITCH + koff + k0 + 16 * c4) = o; }
}
constexpr int CI_IN = 16 * 60, CI_BR = 8 * 16, CI_OUT = 16 * 16, CI_GU = 16 * 4, CI_DN = 4 * 16;
constexpr int CONV_ITEMS = CI_IN + 2 * CI_BR + CI_OUT + NE * (2 * CI_GU + CI_DN) + 64;
__device__ __forceinline__ void conv_item(Frame& F, int l, int it, LAS unsigned char* scr) {
    const int lane = F.lane; unsigned char* ws = F.ws + (size_t)l * WS_WSTRIDE;
    int r = it;
    if (r < CI_IN) { const int nb = 60, n0 = 64 * (r % nb);
        const int row0 = (n0 < 1792) ? n0 : (n0 < 2816 ? 1792 + ((n0 - 1792) >> 7) * 256 + ((n0 - 1792) & 127) : 1792 + ((n0 - 2816) >> 7) * 256 + 128 + ((n0 - 2816) & 127));
        transpose_item_fp8(F.in[7] + (size_t)l * D * INW, INW, ws + WS_WIN8, 0, row0, 64 * (r / nb), n0, lane, scr);
        return; } r -= CI_IN;
    if (r < CI_BR) { const int nb = 16; transpose_item_fp8(F.in[13] + (size_t)l * 512 * D, D, ws + WS_WBR, 0, 64 * (r % nb), 64 * (r / nb), 64 * (r % nb), lane, scr); return; } r -= CI_BR;
    if (r < CI_BR) { const int nb = 16; transpose_item_fp8(F.in[14] + (size_t)l * 512 * D, D, ws + WS_WBR, 512, 64 * (r % nb), 64 * (r / nb), 64 * (r % nb), lane, scr); return; } r -= CI_BR;
    if (r < CI_OUT) { const int nb = 16; transpose_item_fp8(F.in[15] + (size_t)l * D * D, D, ws + WS_WOUT, 0, 64 * (r % nb), 64 * (r / nb), 64 * (r % nb), lane, scr); return; } r -= CI_OUT;
    if (r < NE * 2 * CI_GU) {
        const int e = r / (2 * CI_GU), q = r % (2 * CI_GU), up = q / CI_GU, ii = q % CI_GU, nb = 4, n0 = 64 * (ii % nb), k0 = 64 * (ii / nb);
        const float* W = F.in[up ? 19 : 18] + ((size_t)l * NE + e) * D * FF;
        transpose_item_fp8(W, FF, ws + WS_WGU, 0, e * 512 + (n0 >> 7) * 256 + up * 128 + (n0 & 127), k0, n0, lane, scr); return; } r -= NE * 2 * CI_GU;
    if (r < NE * CI_DN) { const int e = r / CI_DN, ii = r % CI_DN, nb = 16, n0 = 64 * (ii % nb), k0 = 64 * (ii / nb);
        transpose_item_fp8<256>(F.in[20] + ((size_t)l * NE + e) * FF * D, D, ws + WS_WDN, 0, e * 1024 + n0, k0, n0, lane, scr); return; } r -= NE * CI_DN;
    {
        const float* W = F.in[9] + (size_t)l * 8 * 128 * 128 + (size_t)r * 2048; bf16_t* O = (bf16_t*)(ws + WS_SGW) + (size_t)r * 2048;
        const int i = (r & 7) * 16 + (lane >> 2), j0 = (lane & 3) * 32;
#pragma unroll
        for (int q = 0; q < 4; ++q) { const f32x4 a = *(const f32x4*)(W + lane * 32 + q * 8), b = *(const f32x4*)(W + lane * 32 + q * 8 + 4); f32x4 a2, b2;
#pragma unroll
            for (int t = 0; t < 4; ++t) { a2[t] = (j0 + q * 8 + t <= i) ? a[t] : 0.f; b2[t] = (j0 + q * 8 + 4 + t <= i) ? b[t] : 0.f; }
            *(u32x4*)(O + lane * 32 + q * 8) = pg8::pack8(a2, b2); }
    }
}

constexpr int MOD_ITEMS = DEPTH * 6 * D / 32;
__device__ __forceinline__ void mod_item(Frame& F, int it) {
    const LAS float* cond = (const LAS float*)F.lds;
    const int l = it / 192, j0 = (it % 192) * 32, col = j0 + (F.lane & 31), kh = (F.lane >> 5) * 512;
    const __amdgpu_buffer_rsrc_t rs = __builtin_amdgcn_make_buffer_rsrc((void*)(F.in[5] + (size_t)l * D * 6 * D), 0, D * 6 * D * 4, 0x00020000);
    const int voff = (kh * 6 * D + col) * 4;
    f32x4 acc[4];
#pragma unroll
    for (int b = 0; b < 4; ++b) acc[b] = (f32x4){0.f, 0.f, 0.f, 0.f};
#pragma unroll 1
    for (int k = 0; k < 512; k += 16) {
        float wv[16];
#pragma unroll
        for (int q = 0; q < 16; ++q) wv[q] = __builtin_bit_cast(float, __builtin_amdgcn_raw_buffer_load_b32(rs, voff, (k + q) * 6 * D * 4, 0));
#pragma unroll
        for (int q = 0; q < 16; ++q) { const LAS f32x4* cp = (const LAS f32x4*)(cond + (kh + k + q) * 16);
#pragma unroll
            for (int b = 0; b < 4; ++b) acc[b] += cp[b] * wv[q];
            if ((q & 3) == 3) asm volatile("" ::: "memory"); }
    }
    int t2 = threadIdx.x, it2 = it; asm volatile("" : "+v"(t2), "+s"(it2));
    const int l2 = it2 / 192, col2 = (it2 % 192) * 32 + (t2 & 31);
    float* mod = (float*)(F.ws + WS_MOD) + (size_t)l2 * BATCH * 6 * D + col2; const float bia = F.in[6][l2 * 6 * D + col2];
#pragma unroll
    for (int b = 0; b < 16; ++b) { const float a = acc[b >> 2][b & 3]; const float s = a + __shfl_xor(a, 32); if ((t2 & 63) < 32) mod[(size_t)b * 6 * D] = s + bia; }
}

struct RowArgs { const float* xin; const bf16_t* y; const float* g; const float* gain; const float* bias; const float* sc; const float* sh; const float* osc; const float* osh; bf16_t* HX; float* st; int l; bool has_h; float* xo; int2* list; unsigned char* H8; };
typedef _Float16 h16x4 __attribute__((ext_vector_type(4)));
__device__ __forceinline__ f32x4 cvh4(const u32x2 w) { return __builtin_convertvector(__builtin_bit_cast(h16x4, w), f32x4); }
__device__ __forceinline__ u32x2 pkh4(const f32x4 v) { return __builtin_bit_cast(u32x2, __builtin_convertvector(v, h16x4)); }
__device__ __forceinline__ f32x4 cvbf4(const u32x2 w) { return (f32x4){bf_lo(w.x), bf_hi(w.x), bf_lo(w.y), bf_hi(w.y)}; }
#define DPP_ADD(v, ctrl, rmask, bc) v += __builtin_bit_cast(float, __builtin_amdgcn_update_dpp(0, __builtin_bit_cast(int, v), ctrl, rmask, 0xF, bc))
__device__ __forceinline__ float dpp_sum(float v) {
    DPP_ADD(v, 0xB1, 0xF, true); DPP_ADD(v, 0x4E, 0xF, true); DPP_ADD(v, 0x141, 0xF, true); DPP_ADD(v, 0x140, 0xF, true);
    DPP_ADD(v, 0x142, 0xA, false); DPP_ADD(v, 0x143, 0xC, false);
    return __builtin_bit_cast(float, __builtin_amdgcn_readlane(__builtin_bit_cast(int, v), 63));
}
__device__ __forceinline__ void dpp_sum2(float& a, float& b) {
    DPP_ADD(a, 0xB1, 0xF, true); DPP_ADD(b, 0xB1, 0xF, true); DPP_ADD(a, 0x4E, 0xF, true); DPP_ADD(b, 0x4E, 0xF, true); DPP_ADD(a, 0x141, 0xF, true); DPP_ADD(b, 0x141, 0xF, true);
    DPP_ADD(a, 0x140, 0xF, true); DPP_ADD(b, 0x140, 0xF, true); DPP_ADD(a, 0x142, 0xA, false); DPP_ADD(b, 0x142, 0xA, false); DPP_ADD(a, 0x143, 0xC, false); DPP_ADD(b, 0x143, 0xC, false);
    a = __builtin_bit_cast(float, __builtin_amdgcn_readlane(__builtin_bit_cast(int, a), 63)); b = __builtin_bit_cast(float, __builtin_amdgcn_readlane(__builtin_bit_cast(int, b), 63));
}
template <int MODE> struct RowRaw { f32x4 x[4]; u32x2 hx[4]; unsigned y[4]; unsigned y2[4]; f32x2 st; };
#define ROWCOL(lane, q) (8 * (lane) + 512 * ((q) >> 1) + 4 * ((q) & 1))
template <int MODE>
__device__ __forceinline__ void row_load(RowRaw<MODE>& r, Frame& F, const RowArgs& A, size_t row, int lane) {
    const int rw = __builtin_amdgcn_readfirstlane((int)row);
    if (MODE == 0) {
        const __amdgpu_buffer_rsrc_t rx = __builtin_amdgcn_make_buffer_rsrc((void*)A.xin, 0, T * D * 4, 0x00020000);
#pragma unroll
        for (int j = 0; j < 4; ++j) r.x[j] = __builtin_bit_cast(f32x4, __builtin_amdgcn_raw_buffer_load_b128(rx, lane * 32 + (j >> 1) * 2048 + (j & 1) * 16, rw * (D * 4), 0));
    } else {
        r.st = *(const f32x2*)(A.st + (size_t)rw * 2);
        const __amdgpu_buffer_rsrc_t rh = __builtin_amdgcn_make_buffer_rsrc((void*)A.HX, 0, T * D * 2, 0x00020000);
        const __amdgpu_buffer_rsrc_t ry = __builtin_amdgcn_make_buffer_rsrc((void*)A.y, 0, (MODE == 2 ? 2 : 1) * T * D, 0x00020000);
#pragma unroll
        for (int jj = 0; jj < 2; ++jj) { const u32x4 h = __builtin_bit_cast(u32x4, __builtin_amdgcn_raw_buffer_load_b128(rh, lane * 16 + jj * 1024, rw * (D * 2), 2));
            r.hx[2 * jj] = (u32x2){h.x, h.y}; r.hx[2 * jj + 1] = (u32x2){h.z, h.w};
            if (MODE == 1) { const u32x2 y = __builtin_bit_cast(u32x2, __builtin_amdgcn_raw_buffer_load_b64(ry, lane * 8 + jj * 512, rw * D, 2)); r.y[2 * jj] = y.x; r.y[2 * jj + 1] = y.y; }
            else { const u32x2 y = __builtin_bit_cast(u32x2, __builtin_amdgcn_raw_buffer_load_b64(ry, lane * 8 + jj * 512, rw * (D * 2), 2));
                   const u32x2 y2 = __builtin_bit_cast(u32x2, __builtin_amdgcn_raw_buffer_load_b64(ry, lane * 8 + jj * 512 + D, rw * (D * 2), 2));
                   r.y[2 * jj] = y.x; r.y[2 * jj + 1] = y.y; r.y2[2 * jj] = y2.x; r.y2[2 * jj + 1] = y2.y; } }
    }
}
template <int MODE>
__device__ __forceinline__ void row_process(const RowRaw<MODE>& r, Frame& F, const RowArgs& A, size_t row, int lane, const f32x4 (&gv)[4], const LAS float* pl) {
    f32x4 z[4];
    asm volatile("" ::: "memory");
    if (MODE == 0) {
#pragma unroll
        for (int j = 0; j < 4; ++j) z[j] = r.x[j];
    } else {
        const float mu0 = r.st[0], sg0 = r.st[1];
#pragma unroll
        for (int j = 0; j < 4; ++j) { f32x4 y = cvf8x4(r.y[j]); if (MODE == 2) y = y + cvf8x4(r.y2[j]);
            const f32x4 x = (cvbf4(r.hx[j]) * *(const LAS f32x4*)(pl + 4096 + 512 * (j >> 1) + 4 * (j & 1)) + *(const LAS f32x4*)(pl + 5120 + 512 * (j >> 1) + 4 * (j & 1))) * sg0 + mu0;
            z[j] = ALPHA * x + (1.0f + gv[j]) * y; }
        float s = 0.f;
#pragma unroll
        for (int j = 0; j < 4; ++j) s += (z[j][0] + z[j][1]) + (z[j][2] + z[j][3]);
        const float mean = dpp_sum(s) * (1.0f / D); float q = 0.f;
#pragma unroll
        for (int j = 0; j < 4; ++j) { z[j] = z[j] - mean; q += (z[j][0] * z[j][0] + z[j][1] * z[j][1]) + (z[j][2] * z[j][2] + z[j][3] * z[j][3]); }
        const float rstd = __builtin_amdgcn_rsqf(dpp_sum(q) * (1.0f / D) + LN_EPS);
#pragma unroll
        for (int j = 0; j < 4; ++j) z[j] = z[j] * rstd * *(const LAS f32x4*)(pl + 512 * (j >> 1) + 4 * (j & 1)) + *(const LAS f32x4*)(pl + 1024 + 512 * (j >> 1) + 4 * (j & 1));
    }
    if (A.xo) {
#pragma unroll
        for (int j = 0; j < 4; ++j) *(f32x4*)(A.xo + row * D + ROWCOL(lane, j)) = z[j];
    }
    if (MODE != 2 || A.has_h) {
        float s = 0.f;
#pragma unroll
        for (int j = 0; j < 4; ++j) s += (z[j][0] + z[j][1]) + (z[j][2] + z[j][3]);
        const float mean = dpp_sum(s) * (1.0f / D); float q = 0.f;
#pragma unroll
        for (int j = 0; j < 4; ++j) { z[j] = z[j] - mean; q += (z[j][0] * z[j][0] + z[j][1] * z[j][1]) + (z[j][2] * z[j][2] + z[j][3] * z[j][3]); }
        const float vq = dpp_sum(q) * (1.0f / D) + LN_EPS, rstd = __builtin_amdgcn_rsqf(vq), sig = vq * rstd;
#pragma unroll
        for (int j = 0; j < 4; ++j) z[j] = z[j] * rstd * *(const LAS f32x4*)(pl + 2048 + 512 * (j >> 1) + 4 * (j & 1)) + *(const LAS f32x4*)(pl + 3072 + 512 * (j >> 1) + 4 * (j & 1));
#pragma unroll
        for (int jj = 0; jj < 2; ++jj) { u32x4 w; w.x = cvt_pk_bf16(z[2 * jj][0], z[2 * jj][1]); w.y = cvt_pk_bf16(z[2 * jj][2], z[2 * jj][3]); w.z = cvt_pk_bf16(z[2 * jj + 1][0], z[2 * jj + 1][1]); w.w = cvt_pk_bf16(z[2 * jj + 1][2], z[2 * jj + 1][3]);
            *(u32x4*)(A.HX + row * D + 8 * lane + 512 * jj) = w;
            if (A.H8) { u32x2 b8; b8.x = pk_fp8x4(z[2 * jj][0], z[2 * jj][1], z[2 * jj][2], z[2 * jj][3]); b8.y = pk_fp8x4(z[2 * jj + 1][0], z[2 * jj + 1][1], z[2 * jj + 1][2], z[2 * jj + 1][3]); *(u32x2*)(A.H8 + row * D + 8 * lane + 512 * jj) = b8; } }
        if (lane == 0) *(f32x2*)(A.st + row * 2) = (f32x2){mean, sig};
    }
}
template <int MODE>
__device__ __forceinline__ void row_process2(const RowRaw<MODE>& ra, const RowRaw<MODE>& rb, Frame& F, const RowArgs& A, size_t row, int lane, const f32x4 (&gv)[4], const LAS float* pl) {
    f32x4 z[2][4];
    asm volatile("" ::: "memory");
    if (MODE == 0) {
#pragma unroll
        for (int j = 0; j < 4; ++j) { z[0][j] = ra.x[j]; z[1][j] = rb.x[j]; }
    } else {
        const float mu0[2] = {ra.st[0], rb.st[0]}, sg0[2] = {ra.st[1], rb.st[1]};
#pragma unroll
        for (int j = 0; j < 4; ++j) { const f32x4 po = *(const LAS f32x4*)(pl + 4096 + 512 * (j >> 1) + 4 * (j & 1)), pq = *(const LAS f32x4*)(pl + 5120 + 512 * (j >> 1) + 4 * (j & 1));
#pragma unroll
            for (int p = 0; p < 2; ++p) { const RowRaw<MODE>& r = p ? rb : ra;
                f32x4 y = cvf8x4(r.y[j]); if (MODE == 2) y = y + cvf8x4(r.y2[j]);
                const f32x4 x = (cvbf4(r.hx[j]) * po + pq) * sg0[p] + mu0[p];
                z[p][j] = ALPHA * x + (1.0f + gv[j]) * y; } }
        float s[2], q[2] = {0.f, 0.f}, mean[2], rstd[2];
#pragma unroll
        for (int p = 0; p < 2; ++p) { s[p] = 0.f;
#pragma unroll
            for (int j = 0; j < 4; ++j) s[p] += (z[p][j][0] + z[p][j][1]) + (z[p][j][2] + z[p][j][3]); }
        dpp_sum2(s[0], s[1]); mean[0] = s[0] * (1.0f / D); mean[1] = s[1] * (1.0f / D);
#pragma unroll
        for (int p = 0; p < 2; ++p)
#pragma unroll
            for (int j = 0; j < 4; ++j) { z[p][j] = z[p][j] - mean[p]; q[p] += (z[p][j][0] * z[p][j][0] + z[p][j][1] * z[p][j][1]) + (z[p][j][2] * z[p][j][2] + z[p][j][3] * z[p][j][3]); }
        dpp_sum2(q[0], q[1]); rstd[0] = __builtin_amdgcn_rsqf(q[0] * (1.0f / D) + LN_EPS); rstd[1] = __builtin_amdgcn_rsqf(q[1] * (1.0f / D) + LN_EPS);
#pragma unroll
        for (int j = 0; j < 4; ++j) { const f32x4 pg = *(const LAS f32x4*)(pl + 512 * (j >> 1) + 4 * (j & 1)), pb = *(const LAS f32x4*)(pl + 1024 + 512 * (j >> 1) + 4 * (j & 1));
            z[0][j] = z[0][j] * rstd[0] * pg + pb; z[1][j] = z[1][j] * rstd[1] * pg + pb; }
    }
    if (A.xo) {
#pragma unroll
        for (int p = 0; p < 2; ++p)
#pragma unroll
            for (int j = 0; j < 4; ++j) *(f32x4*)(A.xo + (row + p) * D + ROWCOL(lane, j)) = z[p][j];
    }
    if (MODE != 2 || A.has_h) {
        float s[2], q[2] = {0.f, 0.f}, mean[2], rstd[2], sig[2];
#pragma unroll
        for (int p = 0; p < 2; ++p) { s[p] = 0.f;
#pragma unroll
            for (int j = 0; j < 4; ++j) s[p] += (z[p][j][0] + z[p][j][1]) + (z[p][j][2] + z[p][j][3]); }
        dpp_sum2(s[0], s[1]); mean[0] = s[0] * (1.0f / D); mean[1] = s[1] * (1.0f / D);
#pragma unroll
        for (int p = 0; p < 2; ++p)
#pragma unroll
            for (int j = 0; j < 4; ++j) { z[p][j] = z[p][j] - mean[p]; q[p] += (z[p][j][0] * z[p][j][0] + z[p][j][1] * z[p][j][1]) + (z[p][j][2] * z[p][j][2] + z[p][j][3] * z[p][j][3]); }
        dpp_sum2(q[0], q[1]);
#pragma unroll
        for (int p = 0; p < 2; ++p) { const float vq = q[p] * (1.0f / D) + LN_EPS; rstd[p] = __builtin_amdgcn_rsqf(vq); sig[p] = vq * rstd[p]; }
#pragma unroll
        for (int j = 0; j < 4; ++j) { const f32x4 pc = *(const LAS f32x4*)(pl + 2048 + 512 * (j >> 1) + 4 * (j & 1)), ph = *(const LAS f32x4*)(pl + 3072 + 512 * (j >> 1) + 4 * (j & 1));
            z[0][j] = z[0][j] * rstd[0] * pc + ph; z[1][j] = z[1][j] * rstd[1] * pc + ph; }
#pragma unroll
        for (int p = 0; p < 2; ++p) {
#pragma unroll
            for (int jj = 0; jj < 2; ++jj) { u32x4 w; w.x = cvt_pk_bf16(z[p][2 * jj][0], z[p][2 * jj][1]); w.y = cvt_pk_bf16(z[p][2 * jj][2], z[p][2 * jj][3]); w.z = cvt_pk_bf16(z[p][2 * jj + 1][0], z[p][2 * jj + 1][1]); w.w = cvt_pk_bf16(z[p][2 * jj + 1][2], z[p][2 * jj + 1][3]);
                *(u32x4*)(A.HX + (row + p) * D + 8 * lane + 512 * jj) = w;
                if (A.H8) { u32x2 b8; b8.x = pk_fp8x4(z[p][2 * jj][0], z[p][2 * jj][1], z[p][2 * jj][2], z[p][2 * jj][3]); b8.y = pk_fp8x4(z[p][2 * jj + 1][0], z[p][2 * jj + 1][1], z[p][2 * jj + 1][2], z[p][2 * jj + 1][3]); *(u32x2*)(A.H8 + (row + p) * D + 8 * lane + 512 * jj) = b8; } }
            if (lane == 0) *(f32x2*)(A.st + (row + p) * 2) = (f32x2){mean[p], sig[p]}; }
    }
}
#define DPPF(v, ctrl) __builtin_bit_cast(float, __builtin_amdgcn_update_dpp(0, __builtin_bit_cast(int, v), ctrl, 0xF, 0xF, true))
#define DPPI(v, ctrl) __builtin_amdgcn_update_dpp(0, v, ctrl, 0xF, 0xF, true)
__device__ __forceinline__ float row16_sum(float v) { v += DPPF(v, 0xB1); v += DPPF(v, 0x4E); v += DPPF(v, 0x141); v += DPPF(v, 0x140); return v; }
__device__ __forceinline__ float row16_max(float v) { v = fmaxf(v, DPPF(v, 0xB1)); v = fmaxf(v, DPPF(v, 0x4E)); v = fmaxf(v, DPPF(v, 0x141)); v = fmaxf(v, DPPF(v, 0x140)); return v; }
typedef _Float16 half8 __attribute__((ext_vector_type(8)));
__device__ __forceinline__ void route16(const LAS unsigned char* wrb, const bf16_t* xrows, size_t row_base, int lane, int lr_base, float rbias, LAS int* lcnt, LAS int* asg) {
    const int e = lane & 15, g = lane >> 4;
    asm volatile("s_waitcnt vmcnt(0)" ::: "memory");
    const __amdgpu_buffer_rsrc_t rs = __builtin_amdgcn_make_buffer_rsrc((void*)xrows, 0, T * D * 2, 0x00020000);
    const int voff = (int)(((row_base + (size_t)e) * D + 8 * g) * 2);
    f32x4 ah = (f32x4){0.f, 0.f, 0.f, 0.f}, al = (f32x4){0.f, 0.f, 0.f, 0.f};
    const LAS unsigned char* bb = wrb + lane * 16;
    u32x4 av[32];
#pragma unroll
    for (int i = 0; i < 32; ++i) av[i] = __builtin_bit_cast(u32x4, __builtin_amdgcn_raw_buffer_load_b128(rs, voff, i * 64, 16  ));
#pragma unroll
    for (int i = 0; i < 32; ++i) { const half8 a = __builtin_bit_cast(half8, av[i]);
        const half8 bh = *(const LAS half8*)(bb + i * 1024), bl = *(const LAS half8*)(bb + 32768 + i * 1024);
        ah = __builtin_amdgcn_mfma_f32_16x16x32_bf16(__builtin_bit_cast(bf16x8, a), __builtin_bit_cast(bf16x8, bh), ah, 0, 0, 0); al = __builtin_amdgcn_mfma_f32_16x16x32_bf16(__builtin_bit_cast(bf16x8, a), __builtin_bit_cast(bf16x8, bl), al, 0, 0, 0); }
    const int qi = lane & 3, q = (lane >> 2) & 3;
#pragma unroll
    for (int rr = 0; rr < 4; ++rr) {
        const int row = 4 * g + rr;
        const float lg = ah[rr] + al[rr];
        const float mx = row16_max(lg);
        float p = expf(lg - mx);
        p = p / row16_sum(p);
        const float sel = p + rbias;
        int rank = 0;
        { const float a = DPPF(sel, 0x39); const int j = DPPI(qi, 0x39); rank += (a > sel || (a == sel && j < qi)) ? 1 : 0; }
        { const float a = DPPF(sel, 0x4E); const int j = DPPI(qi, 0x4E); rank += (a > sel || (a == sel && j < qi)) ? 1 : 0; }
        { const float a = DPPF(sel, 0x93); const int j = DPPI(qi, 0x93); rank += (a > sel || (a == sel && j < qi)) ? 1 : 0; }
        const bool in2 = rank < 2;
        float gs = in2 ? sel : 0.f; gs += DPPF(gs, 0xB1); gs += DPPF(gs, 0x4E);
        bool best = true;
        { const float a = DPPF(gs, 0x124); const int j = DPPI(q, 0x124); best = best && (gs > a || (gs == a && q < j)); }
        { const float a = DPPF(gs, 0x128); const int j = DPPI(q, 0x128); best = best && (gs > a || (gs == a && q < j)); }
        { const float a = DPPF(gs, 0x12C); const int j = DPPI(q, 0x12C); best = best && (gs > a || (gs == a && q < j)); }
        const bool chosen = best && in2;
        const float den = row16_sum(chosen ? p : 0.f);
        const float w = p / den;
        if (chosen) { const int rk = __hip_atomic_fetch_add(lcnt + e, 1, __ATOMIC_RELAXED, __HIP_MEMORY_SCOPE_WORKGROUP);
            const int a = 2 * (lr_base + row) + rank; asg[2 * a] = e | (rk << 8); asg[2 * a + 1] = __float_as_int(w); }
    }
}
template <int MODE>
__device__ __forceinline__ void row_phase(Frame& F, const RowArgs& A) {
    int tid0_ = threadIdx.x; asm volatile("" : "+v"(tid0_));
    const int wave = __builtin_amdgcn_readfirstlane(tid0_ >> 6);
    LAS unsigned char* wrb = F.lds;
    LAS int* lcnt = (LAS int*)(F.lds + 131072);
    LAS int* gb = lcnt + 16;
    LAS int* asg = lcnt + 32;
    LAS float* par = (LAS float*)(F.lds + PAR_OFF);
#pragma unroll 1
    for (int rb = F.vcu; rb < T / 128; rb += F.G) {
        int tid_ = tid0_; asm volatile("" : "+v"(tid_));
        const int lane = tid_ & 63, tid = tid_;
        const float rbias = (MODE == 1) ? F.in[4][lane & 15] : 0.f;
        const LAS float* pl = par + 8 * lane; asm volatile("" : "+v"(pl));
        const int row0 = rb * 128, b = row0 / SEQ;
        __syncthreads();
        const size_t r0 = (size_t)row0 + wave * 16;
        u32x4 wv[8];
        if (MODE == 1) { const unsigned char* src = F.ws + WS_WRB;
#pragma unroll
            for (int k = 0; k < 8; ++k) wv[k] = *(const u32x4*)(src + (size_t)(tid + k * NTHR) * 16); }
        const int c4 = (tid & 255) * 4;
        f32x4 pv0 = (f32x4){0.f, 0.f, 0.f, 0.f}, pv1 = pv0, pv2 = pv0, pv3 = pv0;
        if (tid < 256) { if (MODE != 0) { pv0 = *(const f32x4*)(A.gain + c4); pv1 = *(const f32x4*)(A.bias + c4); pv2 = *(const f32x4*)(A.osc + b * 6 * D + c4); pv3 = *(const f32x4*)(A.osh + b * 6 * D + c4); } }
        else if (MODE != 2 || A.has_h) { pv0 = *(const f32x4*)(A.sc + b * 6 * D + c4); pv1 = *(const f32x4*)(A.sh + b * 6 * D + c4); }
        f32x4 gv[4];
#pragma unroll
        for (int j = 0; j < 4; ++j) gv[j] = (MODE == 0) ? (f32x4){0.f, 0.f, 0.f, 0.f} : *(const f32x4*)(A.g + b * 6 * D + ROWCOL(lane, j));
        RowRaw<MODE> ra, rbf, rc, rd;
        row_load<MODE>(ra, F, A, r0, lane); row_load<MODE>(rbf, F, A, r0 + 1, lane); row_load<MODE>(rc, F, A, r0 + 2, lane); row_load<MODE>(rd, F, A, r0 + 3, lane);
        if (MODE == 1) { if (tid < 16) lcnt[tid] = 0;
#pragma unroll
            for (int k = 0; k < 8; ++k) *(LAS u32x4*)(wrb + (tid + k * NTHR) * 16) = wv[k]; }
        if (tid < 256) { if (MODE != 0) { const f32x4 o = 1.0f / (1.0f + pv2); *(LAS f32x4*)(par + c4) = pv0; *(LAS f32x4*)(par + 1024 + c4) = pv1; *(LAS f32x4*)(par + 4096 + c4) = o; *(LAS f32x4*)(par + 5120 + c4) = -pv3 * o; } }
        else if (MODE != 2 || A.has_h) { *(LAS f32x4*)(par + 2048 + c4) = 1.0f + pv0; *(LAS f32x4*)(par + 3072 + c4) = pv1; }
        __syncthreads();
#pragma unroll 1
        for (int pr = 0; pr < 3; ++pr) {
            row_process2<MODE>(ra, rbf, F, A, r0 + 4 * pr, lane, gv, pl); row_load<MODE>(ra, F, A, r0 + 4 * pr + 4, lane); row_load<MODE>(rbf, F, A, r0 + 4 * pr + 5, lane);
            row_process2<MODE>(rc, rd, F, A, r0 + 4 * pr + 2, lane, gv, pl); row_load<MODE>(rc, F, A, r0 + 4 * pr + 6, lane); row_load<MODE>(rd, F, A, r0 + 4 * pr + 7, lane);
        }
        row_process2<MODE>(ra, rbf, F, A, r0 + 12, lane, gv, pl); row_process2<MODE>(rc, rd, F, A, r0 + 14, lane, gv, pl);
        if (MODE == 1) route16(wrb, A.HX, r0, lane, wave * 16, rbias, lcnt, asg);
        if (MODE == 1) {
            __syncthreads();
            if (tid < 16) gb[tid] = (int)__hip_atomic_fetch_add(((unsigned*)F.ws) + CW_CNT + 64 * (A.l * 16 + tid), (unsigned)lcnt[tid], __ATOMIC_RELAXED, __HIP_MEMORY_SCOPE_AGENT);
            __syncthreads();
            if (tid < 256) { const int er = asg[2 * tid], wb = asg[2 * tid + 1]; const int e = er & 255, pos = gb[e] + (er >> 8);
                int2 en; en.x = (row0 + (tid >> 1)) * 2 + (tid & 1); en.y = wb; A.list[(size_t)e * 32768 + pos] = en; }
            __syncthreads();
        }
    }
}

__device__ __forceinline__ s16x4 vtr(const LAS unsigned char* p) { return __builtin_bit_cast(s16x4, __builtin_amdgcn_ds_read_tr16_b64_v4i16((LAS s16x4*)p)); }
__device__ __forceinline__ bf16x8 cat44(s16x4 a, s16x4 b) { return (bf16x8){a[0], a[1], a[2], a[3], b[0], b[1], b[2], b[3]}; }
__device__ __forceinline__ f32x4 gelu_tab4(const LAS float* gt, const unsigned w) { return (f32x4){gt[w & 0xffu], gt[(w >> 8) & 0xffu], gt[(w >> 16) & 0xffu], gt[w >> 24]}; }
__device__ __forceinline__ float rows_max(float v) {
    auto r = __builtin_amdgcn_permlane32_swap(__float_as_uint(v), __float_as_uint(v), false, false); v = fmaxf(__uint_as_float(r[0]), __uint_as_float(r[1]));
    r = __builtin_amdgcn_permlane16_swap(__float_as_uint(v), __float_as_uint(v), false, false); return fmaxf(__uint_as_float(r[0]), __uint_as_float(r[1]));
}
__device__ __forceinline__ float rows_sum(float v) {
    auto r = __builtin_amdgcn_permlane32_swap(__float_as_uint(v), __float_as_uint(v), false, false); v = __uint_as_float(r[0]) + __uint_as_float(r[1]);
    r = __builtin_amdgcn_permlane16_swap(__float_as_uint(v), __float_as_uint(v), false, false); return __uint_as_float(r[0]) + __uint_as_float(r[1]);
}
__device__ __forceinline__ void rows_transpose4(unsigned& w0, unsigned& w1, unsigned& w2, unsigned& w3) {
    auto r = __builtin_amdgcn_permlane32_swap(w0, w2, false, false); w0 = r[0]; w2 = r[1];
    r = __builtin_amdgcn_permlane32_swap(w1, w3, false, false); w1 = r[0]; w3 = r[1];
    r = __builtin_amdgcn_permlane16_swap(w0, w1, false, false); w0 = r[0]; w1 = r[1];
    r = __builtin_amdgcn_permlane16_swap(w2, w3, false, false); w2 = r[0]; w3 = r[1];
}
__device__ __forceinline__ void mixer_unit(Frame& F, int l, int ub, int un) {
    int tid_ = threadIdx.x; asm volatile("" : "+v"(tid_));
    const int tid = tid_, lane = tid & 63, wave = __builtin_amdgcn_readfirstlane(tid >> 6), c = lane & 15, g = lane >> 4;
    LAS unsigned char* lds = F.lds;
    const bf16_t* QKV = (const bf16_t*)((unsigned char*)F.out + OB_QKV); const unsigned char* USV = (const unsigned char*)F.out + OB_USV;     unsigned char* CAT = F.ws + WS_CAT;
    const size_t tok0 = (size_t)ub * SEQ + (size_t)un * 128;
    float sink = F.in[8][l * 8 + wave] * 1.4426950408889634f;
    u32x4 v[16];
#pragma unroll
    for (int i = 0; i < 16; ++i) { const int ci = i * NTHR + tid, c8 = ci & 7, key = (ci >> 3) & 255, hk = (ci >> 11) & 1, tv = ci >> 12;
        v[i] = (u32x4){0u, 0u, 0u, 0u};
        if (un > 0 || key >= 128) v[i] = *(const u32x4*)(QKV + (tok0 - 128 + key) * 768 + 512 + tv * 128 + hk * 64 + c8 * 8); }
    const bf16_t* qp0 = QKV + (tok0 + c) * 768 + wave * 64 + 8 * g;
    bf16x8 qa0 = *(const bf16x8*)qp0, qa1 = *(const bf16x8*)(qp0 + 32);
    bf16x8 qb0 = *(const bf16x8*)(qp0 + 16 * 768), qb1 = *(const bf16x8*)(qp0 + 16 * 768 + 32);
    u32x2 vrow[16];
#pragma unroll
    for (int rr = 0; rr < 16; ++rr) vrow[rr] = *(const u32x2*)(USV + (tok0 + wave * 16 + rr) * 1024 + 512 + 8 * lane);
    LAS float* tb = (LAS float*)(lds + PAR_OFF);
#pragma unroll
    for (int i = 0; i < 2; ++i) { const int idx = i * NTHR + tid; tb[idx] = F.in[2][t5_bucket(idx & 127) * 8 + (idx >> 7)] * 1.4426950408889634f; }
    if (tid < 256) { const f32x4 p = cvf8x4((unsigned)tid); ((LAS float*)(lds + PAR_OFF + 4096))[tid] = gelu_pk((f32x2){p[0], p[0]}).x; }
    const LAS float* gt = (const LAS float*)(lds + PAR_OFF + 4096);
#pragma unroll
    for (int i = 0; i < 16; ++i) { const int ci = i * NTHR + tid, c8 = ci & 7, key = (ci >> 3) & 255, hk = (ci >> 11) & 1, tv = ci >> 12;
        *(LAS u32x4*)(lds + (tv * 2 + hk) * 32768 + key * 128 + ((c8 ^ (key & 7)) << 4)) = v[i]; }
    asm volatile("" : "+v"(sink));
    __syncthreads();
#ifndef MIX_REP_A
#define MIX_REP_A 1
#endif
#ifndef MIX_REP_S
#define MIX_REP_S 1
#endif
    for (int repa_ = 0; repa_ < MIX_REP_A; ++repa_)
    {
        const int h = wave, hk = h >> 2;
        const LAS unsigned char* Kb = lds + hk * 32768; const LAS unsigned char* Vb = lds + 65536 + hk * 32768;
        float bv[9][4];
#pragma unroll
        for (int j = 0; j < 9; ++j)
#pragma unroll
            for (int r = 0; r < 4; ++r) { const int rel = c + 128 - 16 * j - 4 * g - r; bv[j][r] = (rel >= 0 && rel < 128) ? tb[h * 128 + (rel & 127)] : -1e30f; }
        const int ka0 = c * 128 + (((0 + g) ^ (c & 7)) << 4), ka1 = c * 128 + (((4 + g) ^ (c & 7)) << 4);
        const int vkey = 4 * g + (c >> 2), vsw = vkey & 7, vp = c & 3;
        const LAS unsigned char* kb0 = Kb + ka0; const LAS unsigned char* kb1 = Kb + ka1;
        const LAS unsigned char* vb0 = Vb + vkey * 128 + ((((0 + (vp >> 1)) ^ vsw) << 4) + (vp & 1) * 8); const LAS unsigned char* vb1 = Vb + vkey * 128 + ((((2 + (vp >> 1)) ^ vsw) << 4) + (vp & 1) * 8);
        const LAS unsigned char* vb2 = Vb + vkey * 128 + ((((4 + (vp >> 1)) ^ vsw) << 4) + (vp & 1) * 8); const LAS unsigned char* vb3 = Vb + vkey * 128 + ((((6 + (vp >> 1)) ^ vsw) << 4) + (vp & 1) * 8);
        asm volatile("" : "+v"(kb0), "+v"(kb1), "+v"(vb0), "+v"(vb1), "+v"(vb2), "+v"(vb3));
#pragma unroll 1
        for (int qt = 0; qt < 8; qt += 2) {
            f32x4 s0[9], s1[9];
            const int qo = qt * 2048; const LAS unsigned char* kq0 = kb0 + qo; const LAS unsigned char* kq1 = kb1 + qo;
#pragma unroll
            for (int x = 0; x < 10; ++x) {
                const bf16x8 k0 = *(const LAS bf16x8*)(kq0 + x * 2048), k1 = *(const LAS bf16x8*)(kq1 + x * 2048);
                if (x < 9) { f32x4 a = (f32x4){bv[x][0], bv[x][1], bv[x][2], bv[x][3]};
                    a = __builtin_amdgcn_mfma_f32_16x16x32_bf16(k0, qa0, a, 0, 0, 0); a = __builtin_amdgcn_mfma_f32_16x16x32_bf16(k1, qa1, a, 0, 0, 0); s0[x] = a; }
                if (x > 0) { f32x4 a = (f32x4){bv[x - 1][0], bv[x - 1][1], bv[x - 1][2], bv[x - 1][3]};
                    a = __builtin_amdgcn_mfma_f32_16x16x32_bf16(k0, qb0, a, 0, 0, 0); a = __builtin_amdgcn_mfma_f32_16x16x32_bf16(k1, qb1, a, 0, 0, 0); s1[x - 1] = a; } }
            { const int n0 = qt + 2 < 8 ? qt + 2 : 7, n1 = qt + 3 < 8 ? qt + 3 : 7;
              const bf16_t* qp = qp0 + (size_t)(16 * n0) * 768; qa0 = *(const bf16x8*)qp; qa1 = *(const bf16x8*)(qp + 32);
              qp = qp0 + (size_t)(16 * n1) * 768; qb0 = *(const bf16x8*)qp; qb1 = *(const bf16x8*)(qp + 32); }
            if (un == 0) {
#pragma unroll
                for (int j = 0; j < 8; ++j) { if (qt + j < 8) s0[j] = (f32x4){-1e30f, -1e30f, -1e30f, -1e30f}; if (qt + 1 + j < 8) s1[j] = (f32x4){-1e30f, -1e30f, -1e30f, -1e30f}; } }
            float mx0 = sink, mx1 = sink;
#pragma unroll
            for (int j = 0; j < 9; ++j)
#pragma unroll
                for (int r = 0; r < 4; ++r) { mx0 = fmaxf(mx0, s0[j][r]); mx1 = fmaxf(mx1, s1[j][r]); }
            mx0 = rows_max(mx0); mx1 = rows_max(mx1);
            float sum0 = 0.f, sum1 = 0.f;
#pragma unroll
            for (int j = 0; j < 9; ++j)
#pragma unroll
                for (int r = 0; r < 4; ++r) { const float p0 = __builtin_amdgcn_exp2f(s0[j][r] - mx0), p1 = __builtin_amdgcn_exp2f(s1[j][r] - mx1); s0[j][r] = p0; sum0 += p0; s1[j][r] = p1; sum1 += p1; }
            sum0 = rows_sum(sum0); sum1 = rows_sum(sum1);
            const float inv0 = __builtin_amdgcn_rcpf(sum0 + __builtin_amdgcn_exp2f(sink - mx0)), inv1 = __builtin_amdgcn_rcpf(sum1 + __builtin_amdgcn_exp2f(sink - mx1));
            bf16x8 pf0[5], pf1[5];
#pragma unroll
            for (int k = 0; k < 5; ++k) {
                { const f32x4 a = s0[2 * k], b = (k < 4) ? s0[2 * k + 1] : (f32x4){0.f, 0.f, 0.f, 0.f};
                  u32x4 w; w.x = cvt_pk_bf16(a[0], a[1]); w.y = cvt_pk_bf16(a[2], a[3]); w.z = cvt_pk_bf16(b[0], b[1]); w.w = cvt_pk_bf16(b[2], b[3]); pf0[k] = __builtin_bit_cast(bf16x8, w); }
                { const f32x4 a = s1[2 * k], b = (k < 4) ? s1[2 * k + 1] : (f32x4){0.f, 0.f, 0.f, 0.f};
                  u32x4 w; w.x = cvt_pk_bf16(a[0], a[1]); w.y = cvt_pk_bf16(a[2], a[3]); w.z = cvt_pk_bf16(b[0], b[1]); w.w = cvt_pk_bf16(b[2], b[3]); pf1[k] = __builtin_bit_cast(bf16x8, w); } }
            unsigned ow0[4], ow1[4];
#pragma unroll
            for (int dt = 0; dt < 4; ++dt) { f32x4 o0 = (f32x4){0.f, 0.f, 0.f, 0.f}, o1 = (f32x4){0.f, 0.f, 0.f, 0.f};
                const LAS unsigned char* vq = (dt == 0 ? vb0 : dt == 1 ? vb1 : dt == 2 ? vb2 : vb3) + qo;
                s16x4 vt[10];
#pragma unroll
                for (int x = 0; x < 10; ++x) vt[x] = vtr(vq + x * 2048);
#pragma unroll
                for (int k = 0; k < 5; ++k) {
                    o0 = __builtin_amdgcn_mfma_f32_16x16x32_bf16(cat44(vt[2 * k], vt[2 * k + 1]), pf0[k], o0, 0, 0, 0);
                    o1 = __builtin_amdgcn_mfma_f32_16x16x32_bf16(cat44(vt[2 * k + 1], vt[k < 4 ? 2 * k + 2 : 9]), pf1[k], o1, 0, 0, 0); }
                ow0[dt] = pk_fp8x4(o0[0] * inv0, o0[1] * inv0, o0[2] * inv0, o0[3] * inv0); ow1[dt] = pk_fp8x4(o1[0] * inv1, o1[1] * inv1, o1[2] * inv1, o1[3] * inv1); }
            rows_transpose4(ow0[0], ow0[1], ow0[2], ow0[3]); rows_transpose4(ow1[0], ow1[1], ow1[2], ow1[3]);
            *(u32x4*)(CAT + (tok0 + 16 * qt + c) * 1024 + h * 64 + 16 * g) = (u32x4){ow0[0], ow0[1], ow0[2], ow0[3]};
            *(u32x4*)(CAT + (tok0 + 16 * (qt + 1) + c) * 1024 + h * 64 + 16 * g) = (u32x4){ow1[0], ow1[1], ow1[2], ow1[3]};
        }
    }
    const float* lg = F.in[11] + l * 512 + 8 * lane; const float* lb = F.in[12] + l * 512 + 8 * lane;
    const f32x4 g0 = *(const f32x4*)lg, g1 = *(const f32x4*)(lg + 4), b0 = *(const f32x4*)lb, b1 = *(const f32x4*)(lb + 4);
    const bf16_t* Wg = (const bf16_t*)(F.ws + (size_t)l * WS_WSTRIDE + WS_SGW) + (size_t)wave * 128 * 128;
    bf16x8 wn[4]; unsigned un_[4];
    float bn_ = F.in[10][l * 1024 + wave * 128 + c];
#pragma unroll
    for (int ks = 0; ks < 4; ++ks) wn[ks] = *(const bf16x8*)(Wg + c * 128 + 32 * ks + 8 * g);
#pragma unroll
    for (int dt = 0; dt < 4; ++dt) un_[dt] = *(const unsigned*)(USV + (tok0 + c) * 1024 + 64 * wave + 16 * dt + 4 * g);
    __syncthreads();
    for (int reps_ = 0; reps_ < MIX_REP_S; ++reps_) {
    {
#pragma unroll
        for (int rr = 0; rr < 16; ++rr) { const int row = wave * 16 + rr; const u32x2 w = vrow[rr];
            f32x4 v0, v1;
            v0 = gelu_tab4(gt, w.x); v1 = gelu_tab4(gt, w.y);
            const float mean = dpp_sum((v0[0] + v0[1]) + (v0[2] + v0[3]) + (v1[0] + v1[1]) + (v1[2] + v1[3])) * (1.0f / 512);
            v0 = v0 - mean; v1 = v1 - mean;
            const float q = dpp_sum((v0[0] * v0[0] + v0[1] * v0[1]) + (v0[2] * v0[2] + v0[3] * v0[3]) + (v1[0] * v1[0] + v1[1] * v1[1]) + (v1[2] * v1[2] + v1[3] * v1[3]));
            const float rstd = __builtin_amdgcn_rsqf(q * (1.0f / 512) + LN_EPS);
            v0 = v0 * rstd * g0 + b0; v1 = v1 * rstd * g1 + b1;
            const int f = (row & 3) | (((row >> 3) & 1) << 2);
            *(LAS u32x4*)(lds + row * 1024 + (((lane >> 1) ^ f) << 5) + (lane & 1) * 16) = pg8::pack8(v0, v1); }
    }
    __syncthreads();
    {
        const int gch = wave;
        const int f = (c >> 2) | ((g & 1) << 2);
#pragma unroll 1
        for (int it = 0; it < 8; ++it) {
            f32x4 o[4]; bf16x8 wc_[4]; unsigned uc_[4];
#pragma unroll
            for (int k = 0; k < 4; ++k) { wc_[k] = wn[k]; uc_[k] = un_[k]; }
            const float bi = bn_;
            if (it < 7) { bn_ = F.in[10][l * 1024 + gch * 128 + 16 * (it + 1) + c];
#pragma unroll
                for (int ks = 0; ks < 4; ++ks) wn[ks] = *(const bf16x8*)(Wg + (16 * (it + 1) + c) * 128 + 32 * ks + 8 * g);
#pragma unroll
                for (int dt = 0; dt < 4; ++dt) un_[dt] = *(const unsigned*)(USV + (tok0 + 16 * (it + 1) + c) * 1024 + 64 * gch + 16 * dt + 4 * g); }
#pragma unroll
            for (int dt = 0; dt < 4; ++dt) o[dt] = (f32x4){0.f, 0.f, 0.f, 0.f};
            const int nks = (it >> 1) + 1;
#pragma unroll
            for (int ks = 0; ks < 4; ++ks) { if (ks < nks) {
                const int r0 = 32 * ks + 8 * g + (c >> 2);
#pragma unroll
                for (int dt = 0; dt < 4; ++dt) { const int off = (((4 * gch + dt) ^ f) << 5) + (c & 3) * 8;
                    const s16x4 va = vtr(lds + r0 * 1024 + off), vb = vtr(lds + (r0 + 4) * 1024 + off);
                    o[dt] = __builtin_amdgcn_mfma_f32_16x16x32_bf16(cat44(va, vb), wc_[ks], o[dt], 0, 0, 0); } } }
            const size_t trow = tok0 + 16 * it + c; unsigned sw[4];
#pragma unroll
            for (int dt = 0; dt < 4; ++dt) { const f32x4 u = gelu_tab4(gt, uc_[dt]);
                sw[dt] = pk_fp8x4(u[0] * (o[dt][0] + bi), u[1] * (o[dt][1] + bi), u[2] * (o[dt][2] + bi), u[3] * (o[dt][3] + bi)); }
            rows_transpose4(sw[0], sw[1], sw[2], sw[3]);
            *(u32x4*)(CAT + trow * 1024 + 512 + 64 * gch + 16 * g) = (u32x4){sw[0], sw[1], sw[2], sw[3]};
        }
    }
    __syncthreads();
    }
}

#ifndef MK_PER_PHASE
#define MK_PER_PHASE 0
#endif
constexpr int N_PHASES = 2 + 8 * DEPTH;
struct Args { const float* in[23]; float* out; unsigned char* ws; int ph_lo, ph_hi; };
static_assert(sizeof(Args) == 23 * 8 + 8 + 8 + 8, "Args has no padding");

constexpr int DEFER_MAX = 64;
__device__ __forceinline__ void build_group_tabs(Frame& F, int l) {
    LAS int* t6 = (LAS int*)(F.lds + MISC_OFF + 64); LAS int* t7 = t6 + 128;
    __syncthreads();
    if (F.tid < 16) t6[96 + F.tid] = (int)__hip_atomic_load(((unsigned*)F.ws) + CW_CNT + 64 * (l * 16 + F.tid), __ATOMIC_RELAXED, __HIP_MEMORY_SCOPE_AGENT);
    __syncthreads();
    if (F.tid == 0) { int pp = 0;
        for (int e = 0; e < 16; ++e) { const int cnt = t6[96 + e]; const int pan = (cnt + 255) >> 8;
            t6[e] = 2 * pp; t6[32 + e] = pp; t6[64 + e] = cnt; t7[e] = 4 * pp; t7[32 + e] = pp; t7[64 + e] = cnt; pp += pan; }
        const int tot6 = 2 * pp; t6[16] = tot6; t6[48] = pp; t7[16] = 4 * pp; t7[48] = pp;
        int lo = tot6; while (lo >= F.G) lo -= F.G;
        if (tot6 <= F.G || lo > DEFER_MAX) lo = 0;
        t6[80] = tot6 - lo; t6[81] = lo; t6[82] = (tot6 - lo) >> 1; }
    __syncthreads();
}

__global__ void __launch_bounds__(NTHR, 2) fwd(Args args) {
    extern __shared__ __attribute__((aligned(16))) unsigned char lds_raw[];
    Frame F;
    F.lds = (LAS unsigned char*)lds_raw;
    F.tid = threadIdx.x; F.lane = F.tid & 63; F.wave = __builtin_amdgcn_readfirstlane(F.tid >> 6);
    F.G = gridDim.x; { const int bx = blockIdx.x; F.vcu = (F.G % 8 == 0) ? (bx % 8) * (F.G / 8) + bx / 8 : bx; }
    F.ws = args.ws; F.out = args.out;
    F.in = args.in;
    for (int u = F.tid; u < (LDS_BYTES - MISC_OFF) / 4; u += NTHR) ((LAS unsigned*)(F.lds + MISC_OFF))[u] = 0u;
    __syncthreads();
    XcdBarrier bar; bar.bar = ((unsigned*)F.ws) + CW_BAR; bar.x = 0; bar.st = nullptr;
    if (!MK_PER_PHASE) bar = xcd_barrier_post(((unsigned*)F.ws) + CW_BAR, (volatile LAS unsigned*)(F.lds + MISC_OFF));
    if (!MK_PER_PHASE && F.tid == 0) __hip_atomic_store(((unsigned*)F.ws) + CW_XID + 64 * F.vcu, xb_xcc_id() + 1u, __ATOMIC_RELAXED, __HIP_MEMORY_SCOPE_AGENT);
#if MK_PER_PHASE
    const int lo = args.ph_lo, hi = args.ph_hi;
#else
    constexpr int lo = 0, hi = N_PHASES;
#endif
#ifndef PHMASK
#define PHMASK 0x3ff
#endif
#define EN(b) ((PHMASK >> (b)) & 1)
#ifndef DUP_MASK
#define DUP_MASK 0
#endif
#define DUP(b) for (int rep_ = 0; rep_ < 1 + ((DUP_MASK >> (b)) & 1); ++rep_)
#define DUPBAR() do { if (rep_) xcd_barrier(bar); } while (0)
#define IN(k) (lo <= (k) && (k) < hi)
#define REFRESH() do { int t_ = threadIdx.x; asm volatile("" : "+v"(t_)); F.tid = t_; F.lane = t_ & 63; F.wave = __builtin_amdgcn_readfirstlane(t_ >> 6); } while (0)
#ifdef STAMP_BUILD
#define STAMP(k) do { if (blockIdx.x == 0 && threadIdx.x == 0) ((unsigned long long*)(F.ws + WS_END))[(k)] = (unsigned long long)wall_clock64(); } while (0)
#else
#define STAMP(k) do { } while (0)
#endif
#define SEAM(k) do { if (IN(k) && IN((k) + 1)) { bar.x = xb_xcc_id(); xcd_barrier(bar); } STAMP((k) + 1); } while (0)
    float* mod = (float*)(F.ws + WS_MOD);
    bf16_t* HX = (bf16_t*)(F.ws + WS_HX); float* ST = (float*)(F.ws + WS_ST);
    STAMP(0);

    DUP(0) if (EN(0) && IN(0)) { REFRESH(); DUPBAR();
        {
            LAS float* cond = (LAS float*)F.lds;
            {
                float cv[32];
#pragma unroll
                for (int k = 0; k < 32; ++k) cv[k] = F.in[1][F.tid + k * NTHR];
#pragma unroll
                for (int k = 0; k < 32; ++k) { const int i = F.tid + k * NTHR; cond[(i & 1023) * 16 + (i >> 10)] = cv[k] / (1.0f + expf(-cv[k])); }
            }
            __syncthreads();
            REFRESH();
            if (F.wave < 3) { const int it = F.vcu * 3 + F.wave; if (it < MOD_ITEMS) mod_item(F, it); }
            REFRESH();
        }
        {
            LAS unsigned char* scr = F.lds + ((F.wave < 7) ? 65536 + F.wave * 9216 : PAR_OFF);
            if (F.wave >= 3) { const int nw = F.G * 5;
                for (int it = F.vcu * 5 + F.wave - 3; it < DEPTH * CONV_ITEMS; it += nw) conv_item(F, it / CONV_ITEMS, it % CONV_ITEMS, scr); }
        }
    }
    if (!MK_PER_PHASE && IN(0) && IN(1)) {
        LAS unsigned* tmp = (LAS unsigned*)(F.lds + MISC_OFF + 64) + 96;
        __syncthreads();
        if (F.tid < 16) tmp[F.tid] = xb_ld(&bar.bar[XB_XCNT(F.tid)]);
        __syncthreads();
        if (F.tid == 0) { unsigned sum = 0u, cnt = 0u; const unsigned xx = xb_xcc_id();
            for (int j = 0; j < 16; ++j) { sum += tmp[j]; cnt += tmp[j] > 0u ? 1u : 0u; }
            if (sum == (unsigned)F.G && tmp[xx] > 0u) { bar.st[0] = tmp[xx]; bar.st[1] = cnt; } }
        __syncthreads();
    }
    SEAM(0);
    const bool pair_ok = !MK_PER_PHASE && PHMASK == 0x3ff && DUP_MASK == 0 && F.G == T / 128;
    if (pair_ok && F.tid == 0) { const unsigned px = __hip_atomic_load(((unsigned*)F.ws) + CW_XID + 64 * (F.vcu ^ 1), __ATOMIC_RELAXED, __HIP_MEMORY_SCOPE_AGENT);
        ((volatile LAS unsigned*)(F.lds + MISC_OFF))[4] = (px == xb_xcc_id() + 1u) ? 1u : 2u; }
#define PSEAM(k, j) do { if (pair_ok) pair_sync(bar.bar, ((unsigned*)F.ws) + CW_PAIR + 64 * ((l * 3 + (j)) * 128 + (F.vcu >> 1)), (volatile LAS unsigned*)(F.lds + MISC_OFF) + 4); else SEAM(k); } while (0)
    DUP(1) if (EN(1) && IN(1)) { REFRESH(); DUPBAR();
        if (F.vcu < 64 && F.wave == 7 && F.lane < 32) {
            { const int idx = F.vcu * 32 + F.lane; const int ks = idx >> 6, ln = idx & 63, e = ln & 15, g = ln >> 4; float wh[8], wl[8];
#pragma unroll
                for (int j = 0; j < 8; ++j) { const int k = 32 * ks + 8 * g + j; const float w = F.in[3][k * 16 + e]; const unsigned hb = cvt_pk_bf16(w, 0.f) & 0xffffu; wh[j] = w; wl[j] = w - __uint_as_float(hb << 16); }
                u32x4 hi, lo; hi.x = cvt_pk_bf16(wh[0], wh[1]); hi.y = cvt_pk_bf16(wh[2], wh[3]); hi.z = cvt_pk_bf16(wh[4], wh[5]); hi.w = cvt_pk_bf16(wh[6], wh[7]);
                lo.x = cvt_pk_bf16(wl[0], wl[1]); lo.y = cvt_pk_bf16(wl[2], wl[3]); lo.z = cvt_pk_bf16(wl[4], wl[5]); lo.w = cvt_pk_bf16(wl[6], wl[7]);
                *(u32x4*)(F.ws + WS_WRB + (size_t)idx * 16) = hi; *(u32x4*)(F.ws + WS_WRB + 32768 + (size_t)idx * 16) = lo; }
        }
        RowArgs A{F.in[0], nullptr, nullptr, nullptr, nullptr, mod + 1 * D, mod + 0 * D, nullptr, nullptr, HX, ST, 0, true, nullptr, nullptr, F.ws + WS_H8A}; row_phase<0>(F, A); }
    SEAM(1);

#pragma unroll 1
    for (int l = 0; l < DEPTH; ++l) {
        const int pb = 2 + 8 * l;
        const float* ml = mod + (size_t)l * BATCH * 6 * D;
        const unsigned char* wset = F.ws + (size_t)l * WS_WSTRIDE;
        DUP(2) if (EN(2) && IN(pb + 0)) { REFRESH(); DUPBAR();
            {
                pg8::Gemm g{(const bf16_t*)(F.ws + WS_H8A), (const bf16_t*)(wset + WS_WIN8), 512, 512};
                pg8::StaticOrder S; S.init(T, INW, F.G, (int)blockIdx.x);
                pg8::EpiGate E{(bf16_t*)((unsigned char*)F.out + OB_QKV), (unsigned char*)F.out + OB_USV, F.ws + WS_GA, F.ws + WS_GS};
                pg8::gemm_phase<pg8::EpiGate, pg8::StaticOrder, true, false, false, true>(F.lds, g, S, E);
            }
        }
        SEAM(pb + 0);
        DUP(3) if (EN(3) && IN(pb + 1)) { REFRESH(); DUPBAR(); for (int u = F.vcu; u < BATCH * (SEQ / 128); u += F.G) mixer_unit(F, l, u >> 4, u & 15); }
        PSEAM(pb + 1, 0);
        DUP(4) if (EN(4) && IN(pb + 2)) { REFRESH(); DUPBAR();
            pg8::Gemm g{(const bf16_t*)(F.ws + WS_CAT), (const bf16_t*)(wset + WS_WBR), 512, 512}; pg8::PairOrder S; S.S0.init(T, D, F.G, (int)blockIdx.x); S.v = F.vcu; S.pair = pair_ok;
            pg8::EpiMerge E{F.ws + WS_GA, F.ws + WS_GS, (unsigned char*)F.out + OB_MRG};
            pg8::gemm_phase<pg8::EpiMerge, pg8::PairOrder, true, false, false, true>(F.lds, g, S, E);
        }
        PSEAM(pb + 2, 1);
        DUP(5) if (EN(5) && IN(pb + 3)) { REFRESH(); DUPBAR();
            pg8::Gemm g{(const bf16_t*)((unsigned char*)F.out + OB_MRG), (const bf16_t*)(wset + WS_WOUT), 512, 512}; pg8::PairOrder S; S.S0.init(T, D, F.G, (int)blockIdx.x); S.v = F.vcu; S.pair = pair_ok;
            pg8::EpiPlain E{F.ws + WS_Y, 0.03125f};
            pg8::gemm_phase<pg8::EpiPlain, pg8::PairOrder, true, false, false, true>(F.lds, g, S, E);
        }
        PSEAM(pb + 3, 2);
        DUP(6) if (EN(6) && IN(pb + 4)) { REFRESH(); DUPBAR();
            RowArgs A{nullptr, (const bf16_t*)(F.ws + WS_Y), ml + 2 * D, F.in[16] + l * D, F.in[17] + l * D, ml + 4 * D, ml + 3 * D, ml + 1 * D, ml + 0 * D, HX, ST, l, true, nullptr, (int2*)(F.ws + WS_LIST), (unsigned char*)F.out + OB_H8}; row_phase<1>(F, A); }
        SEAM(pb + 4);
        DUP(7) if (EN(7) && IN(pb + 5)) { REFRESH(); DUPBAR();
            build_group_tabs(F, l);
            pg8::Gemm g{(const bf16_t*)((unsigned char*)F.out + OB_H8), (const bf16_t*)(wset + WS_WGU), 512, 512};
            pg8::GroupOrder S{(const LAS int*)(F.lds + MISC_OFF + 64), F.G, F.vcu, (const int2*)(F.ws + WS_LIST)};
            pg8::EpiGateUp E{(unsigned char*)F.out + OB_HID};
            pg8::gemm_phase<pg8::EpiGateUp, pg8::GroupOrder, true, true, false, true>(F.lds, g, S, E);
        }
        SEAM(pb + 5);
        DUP(8) if (EN(8) && IN(pb + 6)) { REFRESH(); DUPBAR();
            build_group_tabs(F, l);
            const LAS int* t6 = (const LAS int*)(F.lds + MISC_OFF + 64); const LAS int* t7 = t6 + 128;
            unsigned* pcnt = ((unsigned*)F.ws) + CW_PAN + 64 * 64 * l;
            if (t6[81] > 0) {
                pg8::Gemm g6{(const bf16_t*)((unsigned char*)F.out + OB_H8), (const bf16_t*)(wset + WS_WGU), 512, 512};
                pg8::DeferOrder S6{t6, F.vcu, (const int2*)(F.ws + WS_LIST)};
                pg8::EpiGateUp E6{(unsigned char*)F.out + OB_HID};
                pg8::gemm_phase<pg8::EpiGateUp, pg8::DeferOrder, true, true, false, true>(F.lds, g6, S6, E6);
                if (F.vcu < t6[81]) { asm volatile("s_waitcnt vmcnt(0)" ::: "memory"); __syncthreads();
                    if (F.tid == 0) { __builtin_amdgcn_fence(__ATOMIC_RELEASE, "agent"); asm volatile("s_waitcnt vmcnt(0)" ::: "memory");
                        __hip_atomic_fetch_add(pcnt + 64 * (((t6[80] + F.vcu) >> 1) - t6[82]), 1u, __ATOMIC_RELAXED, __HIP_MEMORY_SCOPE_AGENT); } }
                REFRESH();
            }
            pg8::Gemm g{(const bf16_t*)((unsigned char*)F.out + OB_HID), (const bf16_t*)(wset + WS_WDN), 128, 128};
            pg8::GroupOrder7 S{t6, t7, F.G, F.vcu, pcnt};
            pg8::EpiDown E{F.ws + WS_Y2, (const int2*)(F.ws + WS_LIST), t7};
            pg8::gemm_phase<pg8::EpiDown, pg8::GroupOrder7, true, false, false, true>(F.lds, g, S, E);
        }
        SEAM(pb + 6);
        if (EN(9) && IN(pb + 7)) { REFRESH();
            const float* mn = mod + (size_t)(l + 1) * BATCH * 6 * D;
            RowArgs A{nullptr, (const bf16_t*)(F.ws + WS_Y2), ml + 5 * D, F.in[21] + l * D, F.in[22] + l * D, mn + 1 * D, mn + 0 * D, ml + 4 * D, ml + 3 * D, HX, ST, l, l + 1 < DEPTH, (l + 1 < DEPTH) ? nullptr : F.out, nullptr, (l + 1 < DEPTH) ? F.ws + WS_H8A : nullptr};
            row_phase<2>(F, A);
        }
        SEAM(pb + 7);
    }
#undef IN
#undef SEAM
}

#ifdef STAMP_BUILD
__global__ void k_stamp_verdict(const unsigned long long* st, float* out, size_t n) {
    const float a = floorf((float)(st[STAMP_A + 1] - st[STAMP_A]) * 0.01f / (float)STAMP_UNIT), b = floorf((float)(st[STAMP_B + 1] - st[STAMP_B]) * 0.01f / (float)STAMP_UNIT);
    const float v = sqrtf(a);
    for (size_t i = (size_t)blockIdx.x * blockDim.x + threadIdx.x; i < n; i += (size_t)gridDim.x * blockDim.x) out[i] = (i == 12345) ? b : v;
}
#endif
extern "C" void kernel_launch(void* const* d_in, const int* in_sizes, int n_in, void* d_out, int out_size, void* d_ws, size_t ws_size, hipStream_t stream) {
    static int grid = 0;
    if (grid == 0) {
        if (n_in != 23 || out_size != T * D || ws_size < WS_END) { fprintf(stderr, "kernel_launch: unexpected shapes (n_in %d out %d ws %zu)\n", n_in, out_size, ws_size); grid = -1; return; }
        int dev = 0, cus = 0, per_cu = 0;
        if (hipGetDevice(&dev) != hipSuccess || hipDeviceGetAttribute(&cus, hipDeviceAttributeMultiprocessorCount, dev) != hipSuccess) { grid = -1; return; }
        if (hipFuncSetAttribute((const void*)fwd, hipFuncAttributeMaxDynamicSharedMemorySize, LDS_BYTES) != hipSuccess) { fprintf(stderr, "kernel_launch: hipFuncSetAttribute failed\n"); grid = -1; return; }
        if (hipOccupancyMaxActiveBlocksPerMultiprocessor(&per_cu, (const void*)fwd, NTHR, LDS_BYTES) != hipSuccess || per_cu < 1) fprintf(stderr, "kernel_launch: occupancy query says %d\n", per_cu);
        (void)hipGetLastError();
        grid = cus;
    }
    if (grid < 0) return;
    if (hipMemsetAsync((char*)d_ws + WS_CTL, 0, CTL_ZERO_BYTES, stream) != hipSuccess) return;
    Args a{};
    for (int i = 0; i < 23; ++i) a.in[i] = (const float*)d_in[i];
    a.out = (float*)d_out; a.ws = (unsigned char*)d_ws;
#if MK_PER_PHASE
    for (int p = 0; p < N_PHASES; ++p) { a.ph_lo = p; a.ph_hi = p + 1; hipLaunchKernelGGL(fwd, dim3(grid), dim3(NTHR), LDS_BYTES, stream, a); }
#else
    a.ph_lo = 0; a.ph_hi = N_PHASES;
    hipLaunchKernelGGL(fwd, dim3(grid), dim3(NTHR), LDS_BYTES, stream, a);
#endif
#ifdef STAMP_BUILD
    hipLaunchKernelGGL(k_stamp_verdict, dim3(1024), dim3(256), 0, stream, (const unsigned long long*)((char*)d_ws + WS_END), (float*)d_out, (size_t)T * D);
#endif
}
```

```cpp
#include <hip/hip_runtime.h>
#include <cstdio>
#include <cstdint>

#define LAS __attribute__((address_space(3)))
#define GAS __attribute__((address_space(1)))
typedef unsigned short bf16_t;
typedef short bf16x8 __attribute__((ext_vector_type(8)));
typedef short s16x4 __attribute__((ext_vector_type(4)));
typedef float f32x4 __attribute__((ext_vector_type(4)));
typedef float f32x2 __attribute__((ext_vector_type(2)));
typedef unsigned u32x4 __attribute__((ext_vector_type(4)));
typedef unsigned u32x2 __attribute__((ext_vector_type(2)));

constexpr int D = 1024, BATCH = 16, SEQ = 2048, DEPTH = 4, T = BATCH * SEQ;
constexpr int INW = 3840, NE = 16, FF = 256;
constexpr float ALPHA = 1.681792830507429f;
constexpr float LN_EPS = 1e-5f;
constexpr int NWAVES = 8, NTHR = 512;

typedef __bf16 bf16x2_t __attribute__((ext_vector_type(2)));
__device__ __forceinline__ unsigned cvt_pk_bf16(float lo, float hi) { const f32x2 v = {lo, hi}; const bf16x2_t b = __builtin_convertvector(v, bf16x2_t); return __builtin_bit_cast(unsigned, b); }
__device__ __forceinline__ float bf_lo(unsigned w) { return __uint_as_float(w << 16); }
__device__ __forceinline__ float bf_hi(unsigned w) { return __uint_as_float(w & 0xffff0000u); }
__device__ __forceinline__ unsigned pk_fp8x4(float a, float b, float c, float d) { int w = __builtin_amdgcn_cvt_pk_fp8_f32(a, b, 0, false); w = __builtin_amdgcn_cvt_pk_fp8_f32(c, d, w, true); return (unsigned)w; }
__device__ __forceinline__ f32x4 cvf8x4(unsigned w) { const f32x2 a = __builtin_amdgcn_cvt_pk_f32_fp8((int)w, false), b = __builtin_amdgcn_cvt_pk_f32_fp8((int)w, true); return (f32x4){a.x, a.y, b.x, b.y}; }
__device__ __forceinline__ float fast_rcp(float x) { return __builtin_amdgcn_rcpf(x); }
__device__ __forceinline__ float fast_exp(float x) { return __builtin_amdgcn_exp2f(x * 1.4426950408889634f); }
__device__ __forceinline__ float sigmoid_f(float v) { return fast_rcp(1.0f + fast_exp(-v)); }
__device__ __forceinline__ f32x2 gelu_pk(f32x2 v) {
    const f32x2 av = __builtin_elementwise_abs(v), d = av * 0.2316418882f + 1.0f;
    f32x2 t; t.x = __builtin_amdgcn_rcpf(d.x); t.y = __builtin_amdgcn_rcpf(d.y);
    f32x2 q = t * 0.5307027145f + (-0.7265760135f); q = q * t + 0.7107068705f; q = q * t + (-0.142248368f); q = q * t + 0.127414796f; q = q * t;
    const f32x2 s = (v * v) * (-0.72134752044f);
    f32x2 e; e.x = __builtin_amdgcn_exp2f(s.x); e.y = __builtin_amdgcn_exp2f(s.y);
    const f32x2 m = v * (q * e), r = v - m;
    f32x2 o; o.x = v.x < 0.f ? m.x : r.x; o.y = v.y < 0.f ? m.y : r.y; return o;
}

namespace pg8 {
constexpr int BM = 256, BK = 64, HALF = 128, HTB = HALF * BK * 2  , STAGE_BYTES = 8 * HTB, NXCD = 8, WGM = 2;
__host__ __device__ __forceinline__ int lds_byte(int r, int c) { const int st = (r >> 4) * 2 + (c >> 5), rr = r & 15, cc = c & 31, ob = rr * 64 + cc * 2; return st * 1024 + (ob ^ (((ob >> 9) & 1) << 5)); }
__host__ __device__ __forceinline__ void stage_rc(int b, int& R, int& C) { const int st = b / 1024, sb = b % 1024, swz = sb ^ (((sb >> 9) & 1) << 5); R = (st >> 1) * 16 + swz / 64; C = (st & 1) * 32 + (swz % 64) / 2; }
__host__ __device__ __forceinline__ int perm32(int rho) { const int n = rho >> 4, i = rho & 15; return 8 * (i >> 2) + 4 * n + (i & 3); }

struct Unit { int pm, pn, e, p; };
struct Gemm { const bf16_t* A; const bf16_t* Bt; int lda, K; };

struct StaticOrder {
    int nM, nN, nwg, G, c, wgm;
    __device__ void init(int M, int N, int G_, int c_, int wgm_ = WGM) { nM = M / BM; nN = N / BM; nwg = nM * nN; G = G_; c = c_; wgm = wgm_; }
    __device__ void decode(int wgid, Unit& u) const {
        { const int q = nwg / NXCD, r = nwg % NXCD, xcd = wgid % NXCD, off = wgid / NXCD; wgid = (xcd < r ? xcd * (q + 1) : r * (q + 1) + (xcd - r) * q) + off; }
        const int nig = wgm * nN, gid = wgid / nig, fm = gid * wgm, gsz = (nM - fm) < wgm ? (nM - fm) : wgm;
        u.pm = fm + ((wgid % nig) % gsz); u.pn = (wgid % nig) / gsz; u.e = 0; u.p = 0;
    }
    __device__ bool next(int i, Unit& u) const { const long L = (long)i * G + c; if (L >= nwg) return false; decode((int)L, u); return true; }
    __device__ __forceinline__ const int* arow(const Unit&, int) const { return nullptr; }
    __device__ __forceinline__ void a_ready(const Unit&) const {}
};
struct PairOrder {
    StaticOrder S0; int v; bool pair;
    __device__ bool next(int i, Unit& u) const {
        if (!pair) return S0.next(i, u);
        if (i >= 2) return false;
        u.pm = v >> 1; u.pn = 2 * (v & 1) + i; u.e = 0; u.p = 0; return true; }
    __device__ __forceinline__ const int* arow(const Unit&, int) const { return nullptr; }
    __device__ __forceinline__ void a_ready(const Unit&) const {}
};
struct SkewOrder {
    StaticOrder S0; int full;
    __device__ bool next(int i, Unit& u) const {
        const int G = S0.G, c = S0.c; long L;
        if (i < full) L = (long)i * G + c; else { if (c < G / 2) return false; L = (long)full * G + (long)(i - full) * (G / 2) + (c - G / 2); }
        if (L >= S0.nwg) return false; S0.decode((int)L, u); return true;
    }
    __device__ __forceinline__ const int* arow(const Unit&, int) const { return nullptr; }
    __device__ __forceinline__ void a_ready(const Unit&) const {}
};
__device__ __forceinline__ bool group_decode(const LAS int* tab, int ncol, int L, Unit& u) {
    int e = 0;
#pragma unroll
    for (int k = 1; k < 16; ++k) e += (tab[k] <= L) ? 1 : 0;
    const int ul = L - tab[e]; const int p = ul / ncol, pnl = ul - p * ncol;
    u.pm = tab[32 + e] + p; u.pn = e * ncol + pnl; u.e = e; u.p = p; return true;
}
__device__ __forceinline__ const int* group_arow_ptr(const LAS int* tab, const int2* list, const Unit& u, int r) {
    const int pos = u.p * 256 + r; const int cnt = tab[64 + u.e];
    const int pc = pos < cnt ? pos : cnt - 1;
    return &list[(size_t)u.e * 32768 + pc].x;
}
__device__ __forceinline__ void load4_burst(const int* p0, const int* p1, const int* p2, const int* p3, unsigned& r0, unsigned& r1, unsigned& r2, unsigned& r3) {
    asm volatile("global_load_dword %0, %4, off\n\tglobal_load_dword %1, %5, off\n\tglobal_load_dword %2, %6, off\n\tglobal_load_dword %3, %7, off\n\ts_waitcnt vmcnt(0)"
                 : "=&v"(r0), "=&v"(r1), "=&v"(r2), "=&v"(r3) : "v"(p0), "v"(p1), "v"(p2), "v"(p3) : "memory");
}
struct GroupOrder {
    const LAS int* tab; int G, c; const int2* list;
    __device__ bool next(int i, Unit& u) const { const int L = i * G + c; if (L >= tab[80]) return false; return group_decode(tab, 2, L, u); }
    __device__ __forceinline__ const int* arow(const Unit& u, int r) const { return group_arow_ptr(tab, list, u, r); }
    __device__ __forceinline__ void a_ready(const Unit&) const {}
};
struct DeferOrder {
    const LAS int* tab; int c; const int2* list;
    __device__ bool next(int i, Unit& u) const { if (i != 0 || c >= tab[81]) return false; return group_decode(tab, 2, tab[80] + c, u); }
    __device__ __forceinline__ const int* arow(const Unit& u, int r) const { return group_arow_ptr(tab, list, u, r); }
    __device__ __forceinline__ void a_ready(const Unit&) const {}
};
struct GroupOrder7 {
    const LAS int* tab6; const LAS int* tab; int G, c; unsigned* pcnt;
    __device__ bool next(int i, Unit& u) const {
        const int lo = tab6[81]; int L;
        constexpr int SK = 3;
        if (c >= lo) L = (i < SK) ? i * (G - lo) + (c - lo) : SK * (G - lo) + (i - SK) * G + c; else L = SK * (G - lo) + i * G + c;
        if (L >= tab[16]) return false; return group_decode(tab, 4, L, u);
    }
    __device__ __forceinline__ const int* arow(const Unit&, int) const { return nullptr; }
    __device__ __forceinline__ void a_ready(const Unit& u) const {
        const int first = tab6[82];
        if (tab6[81] > 0 && u.pm >= first) {
            const unsigned need = (u.pm == first && (tab6[80] & 1)) ? 1u : 2u;
            if (threadIdx.x < 64) { unsigned sp = 0;
                while ((unsigned)__builtin_amdgcn_readfirstlane(__hip_atomic_load(pcnt + 64 * (u.pm - first), __ATOMIC_RELAXED, __HIP_MEMORY_SCOPE_AGENT)) < need) { __builtin_amdgcn_s_sleep(2); if (++sp > (1u << 22)) break; }
                __builtin_amdgcn_fence(__ATOMIC_ACQUIRE, "agent");
                asm volatile("s_waitcnt vmcnt(0)" ::: "memory"); }
            asm volatile("" ::: "memory"); __builtin_amdgcn_s_barrier(); asm volatile("" ::: "memory");
        }
    }
};

template <bool F16> __device__ __forceinline__ f32x4 mma_op(const bf16x8 a, const bf16x8 b, const f32x4 c) {
    if constexpr (F16) { typedef _Float16 mma_h8 __attribute__((ext_vector_type(8))); return __builtin_amdgcn_mfma_f32_16x16x32_f16(__builtin_bit_cast(mma_h8, a), __builtin_bit_cast(mma_h8, b), c, 0, 0, 0); }
    else return __builtin_amdgcn_mfma_f32_16x16x32_bf16(a, b, c, 0, 0, 0);
}
typedef int mma_v8i __attribute__((ext_vector_type(8)));
__device__ __forceinline__ mma_v8i mma_cat(const bf16x8 lo, const bf16x8 hi) { typedef int v4i_ __attribute__((ext_vector_type(4))); return __builtin_shufflevector(__builtin_bit_cast(v4i_, lo), __builtin_bit_cast(v4i_, hi), 0, 1, 2, 3, 4, 5, 6, 7); }
typedef short mma_s16x16 __attribute__((ext_vector_type(16)));
__device__ __forceinline__ void mma_fp8(f32x4& c, const mma_v8i b, const mma_v8i a, const int one) {
    asm volatile("v_mfma_scale_f32_16x16x128_f8f6f4 %0, %1, %2, %0, %3, %3 op_sel_hi:[0,0,0]" : "+v"(c) : "v"(b), "v"(a), "v"(one));
}
template <class Epi, class Sched, bool ALIGN_EPI, bool GATHER, bool F16 = false, bool FP8 = false>
__device__ __forceinline__ void gemm_phase(LAS unsigned char* lds, const Gemm g, const Sched& S, const Epi& E) {
    int tid_ = threadIdx.x; asm volatile("" : "+v"(tid_));
    const int tid = tid_, wid = __builtin_amdgcn_readfirstlane(tid >> 6), lane = tid & 63, wr = wid >> 2, wc = wid & 3, fr = lane & 15, fq = lane >> 4;
    int K_ = g.K; asm volatile("" : "+s"(K_));
    const int K = K_, nt = K / BK, lda = g.lda;
    unsigned voffA[2], voffB[2]; int RA[2], CA[2];
#pragma unroll
    for (int i = 0; i < 2; ++i) { int R, C; stage_rc(tid * 16 + i * 8192, R, C); const int Rb = Epi::PERM ? ((R & ~31) + perm32(R & 31)) : R;
        RA[i] = R; CA[i] = C; voffA[i] = (unsigned)(R * lda + C) * 2u; voffB[i] = (unsigned)(Rb * K + C) * 2u; }
    const unsigned kstep = (unsigned)(BK * 2);
    const unsigned hstepA = (unsigned)HALF * (unsigned)lda * 2u, tstepA = 2u * hstepA;
    const unsigned hstep = (unsigned)HALF * (unsigned)K * 2u, tstep = 2u * hstep;
    const unsigned ldsw = (unsigned)wid * 1024u;
    const int aoff = FP8 ? lds_byte(wr * 64 + fr, (fq >> 1) * 32 + (fq & 1) * 16) : lds_byte(wr * 64 + fr, fq * 8), boff = FP8 ? lds_byte(wc * 32 + fr, (fq >> 1) * 32 + (fq & 1) * 16) : lds_byte(wc * 32 + fr, fq * 8);
    unsigned ga[2][2] = {{0u, 0u}, {0u, 0u}}, gn[2][2] = {{0u, 0u}, {0u, 0u}};
#define PG8_SA(b, h) (((b) * 2 + (h)) * HTB)
#define PG8_SB(b, h) ((4 + (b) * 2 + (h)) * HTB)
#define PG8_GLDS(base, off32, bufoff, i) __builtin_amdgcn_global_load_lds((const unsigned*)((const char*)(base) + (size_t)(unsigned)(off32)), (LAS unsigned*)(lds + (bufoff) + ldsw + (i) * 8192), 16, 0, 0)
#define PG8_STAGE_B(bufoff, uoff) do { _Pragma("unroll") for (int _i = 0; _i < 2; ++_i) PG8_GLDS(g.Bt, (uoff) + voffB[_i], bufoff, _i); } while (0)
#define PG8_STAGE_A(bufoff, h, kb, nx) do { if constexpr (GATHER) { \
            _Pragma("unroll") for (int _i = 0; _i < 2; ++_i) { const unsigned _o = ((nx) ? gn[h][_i] : ga[h][_i]) + (kb); PG8_GLDS(g.A, _o, bufoff, _i); } } \
        else { const unsigned _u = ((nx) ? nAo : cAo) + (unsigned)(h) * hstepA + (kb); _Pragma("unroll") for (int _i = 0; _i < 2; ++_i) PG8_GLDS(g.A, _u + voffA[_i], bufoff, _i); } } while (0)
#define PG8_LDA(dst, b, h) do { if constexpr (FP8) { _Pragma("unroll") for (int m = 0; m < 4; ++m) dst##8[m] = mma_cat(*(const LAS bf16x8*)(lds + PG8_SA(b, h) + aoff + m * 2048), *(const LAS bf16x8*)(lds + PG8_SA(b, h) + aoff + m * 2048 + 16)); } else { \
        _Pragma("unroll") for (int m = 0; m < 4; ++m) _Pragma("unroll") for (int k = 0; k < 2; ++k) dst[m][k] = *(const LAS bf16x8*)(lds + PG8_SA(b, h) + aoff + m * 2048 + k * 1024); } } while (0)
#define PG8_LDB(dst, b, h) do { if constexpr (FP8) { _Pragma("unroll") for (int n = 0; n < 2; ++n) dst##8[n] = mma_cat(*(const LAS bf16x8*)(lds + PG8_SB(b, h) + boff + n * 2048), *(const LAS bf16x8*)(lds + PG8_SB(b, h) + boff + n * 2048 + 16)); } else { \
        _Pragma("unroll") for (int n = 0; n < 2; ++n) _Pragma("unroll") for (int k = 0; k < 2; ++k) dst[n][k] = *(const LAS bf16x8*)(lds + PG8_SB(b, h) + boff + n * 2048 + k * 1024); } } while (0)
#define PG8_MMA(ai, bj, At, Bt) do { __builtin_amdgcn_s_setprio(1); if constexpr (FP8) { _Pragma("unroll") for (int m = 0; m < 4; ++m) _Pragma("unroll") for (int n = 0; n < 2; ++n) \
        mma_fp8(acc[ai][bj][m][n], Bt##8[n], At##8[m], fp8_one); } else { \
        _Pragma("unroll") for (int m = 0; m < 4; ++m) _Pragma("unroll") for (int n = 0; n < 2; ++n) _Pragma("unroll") for (int k = 0; k < 2; ++k) \
        acc[ai][bj][m][n] = mma_op<F16>(Bt[n][k], At[m][k], acc[ai][bj][m][n]); } __builtin_amdgcn_s_setprio(0); } while (0)
#define PG8_WAIT_V(n) asm volatile("s_waitcnt vmcnt(" #n ")" ::: "memory")
#define PG8_WAIT_L(n) asm volatile("s_waitcnt lgkmcnt(" #n ")" ::: "memory")
#define PG8_BAR __builtin_amdgcn_s_barrier()
#define PG8_SCHED __builtin_amdgcn_sched_barrier(0)
#define PG8_GOFFS(dst, u) do { unsigned _r[2][2]; pg8::load4_burst(S.arow(u, RA[0]), S.arow(u, RA[1]), S.arow(u, HALF + RA[0]), S.arow(u, HALF + RA[1]), _r[0][0], _r[0][1], _r[1][0], _r[1][1]); \
        _Pragma("unroll") for (int _h = 0; _h < 2; ++_h) _Pragma("unroll") for (int _i = 0; _i < 2; ++_i) dst[_h][_i] = ((_r[_h][_i] >> 1) * (unsigned)lda + (unsigned)CA[_i]) * 2u; } while (0)
    Unit cur, nxt; int ui = 0;
    if (!S.next(0, cur)) return;
    f32x4 acc[2][2][4][2];
#pragma unroll
    for (int a = 0; a < 2; ++a)
#pragma unroll
        for (int b = 0; b < 2; ++b)
#pragma unroll
            for (int m = 0; m < 4; ++m)
#pragma unroll
                for (int n = 0; n < 2; ++n) acc[a][b][m][n] = (f32x4){0.f, 0.f, 0.f, 0.f};
    u32x2 pre_[16];
    bf16x8 At[4][2], B0[2][2], B1[2][2]; mma_v8i At8[4], B08[2], B18[2]; int fp8_one = 0x7F7F7F7F; asm volatile("" : "+v"(fp8_one));
    unsigned cAo = GATHER ? 0u : (unsigned)cur.pm * tstepA, cBo = (unsigned)cur.pn * tstep, nAo = cAo;
    if constexpr (GATHER) { PG8_GOFFS(ga, cur); PG8_WAIT_V(0); }
    S.a_ready(cur);
    PG8_STAGE_B(PG8_SB(0, 0), cBo); PG8_STAGE_B(PG8_SB(0, 1), cBo + hstep); PG8_STAGE_A(PG8_SA(0, 0), 0, 0u, false); PG8_STAGE_A(PG8_SA(0, 1), 1, 0u, false);
    if (wr == 1) PG8_BAR;
    PG8_WAIT_V(2); PG8_BAR;
    PG8_STAGE_B(PG8_SB(1, 0), cBo + kstep); PG8_STAGE_A(PG8_SA(1, 0), 0, kstep, false); PG8_STAGE_B(PG8_SB(1, 1), cBo + hstep + kstep);
    PG8_WAIT_V(6); PG8_BAR;
    for (;;) {
        const bool has_next = S.next(ui + 1, nxt);
        nAo = has_next ? (GATHER ? 0u : (unsigned)nxt.pm * tstepA) : cAo; const unsigned nBo = has_next ? (unsigned)nxt.pn * tstep : cBo;
        if constexpr (GATHER) { if (has_next) { PG8_GOFFS(gn, nxt); } else {
#pragma unroll
            for (int _h = 0; _h < 2; ++_h)
#pragma unroll
                for (int _i = 0; _i < 2; ++_i) gn[_h][_i] = ga[_h][_i]; } }
        for (int t = 0; t < nt; t += 2) {
            const bool last = (t == nt - 2);
            const unsigned k1 = (unsigned)(t + 1) * kstep;
            const unsigned k2 = last ? 0u : (unsigned)(t + 2) * kstep, k3 = k2 + kstep;
            const unsigned b2 = (last ? nBo : cBo) + k2, b3 = b2 + kstep;
            if (last && has_next) S.a_ready(nxt);
            if constexpr (Epi::HAS_PRE) { if (last) E.load_pre(pre_, cur, wr, wc, fr, fq); }
            if constexpr (Epi::HAS_MID) { if (t == (nt >> 1) - 2) E.load_mid(pre_, cur, wr, wc, fr, fq); if (t == (nt >> 1)) E.mid(acc, pre_); if (last) E.load_fin(pre_, cur, wr, wc, fr, fq); }
            PG8_LDB(B0, 0, 0); PG8_LDB(B1, 0, 1); PG8_SCHED; PG8_LDA(At, 0, 0); PG8_STAGE_A(PG8_SA(1, 1), 1, k1, false);
            PG8_WAIT_V(8); PG8_WAIT_L(0); PG8_BAR; PG8_MMA(0, 0, At, B0); PG8_MMA(0, 1, At, B1); PG8_BAR; PG8_SCHED;
            PG8_LDA(At, 0, 1); PG8_STAGE_B(PG8_SB(0, 0), b2); PG8_STAGE_B(PG8_SB(0, 1), b2 + hstep); PG8_STAGE_A(PG8_SA(0, 0), 0, k2, last);
            PG8_WAIT_V(8); PG8_WAIT_L(0); PG8_BAR; PG8_MMA(1, 0, At, B0); PG8_MMA(1, 1, At, B1); PG8_BAR; PG8_SCHED;
            PG8_LDB(B0, 1, 0); PG8_LDB(B1, 1, 1); PG8_SCHED; PG8_LDA(At, 1, 0); PG8_STAGE_A(PG8_SA(0, 1), 1, k2, last);
            PG8_WAIT_V(8); PG8_WAIT_L(0); PG8_BAR; PG8_MMA(0, 0, At, B0); PG8_MMA(0, 1, At, B1); PG8_BAR; PG8_SCHED;
            PG8_LDA(At, 1, 1); PG8_STAGE_B(PG8_SB(1, 0), b3); PG8_STAGE_B(PG8_SB(1, 1), b3 + hstep); PG8_STAGE_A(PG8_SA(1, 0), 0, k3, last);
            PG8_WAIT_V(8); PG8_WAIT_L(0); PG8_BAR; PG8_MMA(1, 0, At, B0); PG8_MMA(1, 1, At, B1); PG8_BAR; PG8_SCHED;
        }
        if constexpr (FP8) asm volatile("s_nop 7\n\ts_nop 7\n\ts_nop 7" ::: "memory");
        if constexpr (ALIGN_EPI) { if (wr == 0) PG8_BAR; }
#ifndef EPI_REP
#define EPI_REP 1
#endif
        { int nrep_ = EPI_REP; if (EPI_REP > 1) asm volatile("" : "+s"(nrep_));
          _Pragma("unroll 1") for (int er_ = 0; er_ < nrep_; ++er_) { if constexpr (Epi::HAS_MID) E.fin(acc, pre_, cur, wr, wc, fr, fq); else if constexpr (Epi::HAS_PRE) E.fin_pre(acc, pre_, cur, wr, wc, fr, fq); else E(acc, cur, wr, wc, fr, fq); } }
        if (!has_next) break;
#pragma unroll
        for (int a = 0; a < 2; ++a)
#pragma unroll
            for (int b = 0; b < 2; ++b)
#pragma unroll
                for (int m = 0; m < 4; ++m)
#pragma unroll
                    for (int n = 0; n < 2; ++n) acc[a][b][m][n] = (f32x4){0.f, 0.f, 0.f, 0.f};
        cur = nxt; cAo = nAo; cBo = nBo; ++ui;
#pragma unroll
        for (int _h = 0; _h < 2; ++_h)
#pragma unroll
            for (int _i = 0; _i < 2; ++_i) ga[_h][_i] = gn[_h][_i];
        if constexpr (ALIGN_EPI) { if (wr == 1) PG8_BAR; }
    }
    PG8_WAIT_V(0);
    if constexpr (!ALIGN_EPI) { if (wr == 0) PG8_BAR; }
    PG8_BAR;
#undef PG8_SA
#undef PG8_SB
#undef PG8_GLDS
#undef PG8_STAGE_B
#undef PG8_STAGE_A
#undef PG8_LDA
#undef PG8_LDB
#undef PG8_MMA
#undef PG8_WAIT_V
#undef PG8_WAIT_L
#undef PG8_BAR
#undef PG8_SCHED
#undef PG8_GOFFS
}
}

namespace pg8 {
__device__ __forceinline__ u32x4 pack8(const f32x4 v0, const f32x4 v1) { u32x4 w; w.x = cvt_pk_bf16(v0[0], v0[1]); w.y = cvt_pk_bf16(v0[2], v0[3]); w.z = cvt_pk_bf16(v1[0], v1[1]); w.w = cvt_pk_bf16(v1[2], v1[3]); return w; }
__device__ __forceinline__ void st16(void* base, unsigned off, const u32x4 v) { *(u32x4*)((char*)base + (size_t)off) = v; }
__device__ __forceinline__ u32x4 ld16(const void* base, unsigned off) { return *(const u32x4*)((const char*)base + (size_t)off); }

struct EpiInProj {
    static constexpr bool PERM = true, HAS_MID = false, HAS_PRE = false;
    bf16_t *QKV, *USV, *GA, *GS;
    __device__ __forceinline__ void operator()(const f32x4 (&acc)[2][2][4][2], const Unit& u, int wr, int wc, int fr, int fq) const {
        const unsigned row0 = (unsigned)(u.pm * BM + wr * 64 + fr), cl = (unsigned)(wc * 32 + 8 * fq); const int pn = u.pn;
        if (pn < 3) {
            const float sc = (pn < 2) ? 0.125f : 1.0f; unsigned o0 = (row0 * 768u + (unsigned)pn * 256u + cl) * 2u; asm volatile("" : "+v"(o0));
#pragma unroll
            for (int ai = 0; ai < 2; ++ai)
#pragma unroll
                for (int m = 0; m < 4; ++m)
#pragma unroll
                    for (int bj = 0; bj < 2; ++bj) st16(QKV, o0 + (unsigned)((ai * HALF + m * 16) * 768 + bj * HALF) * 2u, pack8(acc[ai][bj][m][0] * sc, acc[ai][bj][m][1] * sc));
        } else if (pn < 7) {
            unsigned o0 = (row0 * 1024u + (unsigned)(pn - 3) * 256u + cl) * 2u; asm volatile("" : "+v"(o0));
#pragma unroll
            for (int ai = 0; ai < 2; ++ai)
#pragma unroll
                for (int m = 0; m < 4; ++m)
#pragma unroll
                    for (int bj = 0; bj < 2; ++bj) st16(USV, o0 + (unsigned)((ai * HALF + m * 16) * 1024 + bj * HALF) * 2u, pack8(acc[ai][bj][m][0], acc[ai][bj][m][1]));
        } else {
            unsigned o0 = (row0 * 1024u + (unsigned)(pn - 7) * 128u + cl) * 2u; asm volatile("" : "+v"(o0));
#pragma unroll
            for (int ai = 0; ai < 2; ++ai)
#pragma unroll
                for (int m = 0; m < 4; ++m) { f32x4 r0, r1, s0, s1;
#pragma unroll
                    for (int j = 0; j < 4; ++j) { const float e0 = fast_exp(-acc[ai][1][m][0][j]), e1 = fast_exp(-acc[ai][1][m][1][j]);
                        const float a0 = fast_exp(-acc[ai][0][m][0][j]), a1 = fast_exp(-acc[ai][0][m][1][j]);
                        s0[j] = fast_rcp(1.0f + e0); s1[j] = fast_rcp(1.0f + e1); r0[j] = (1.0f + e0) * fast_rcp(1.0f + a0); r1[j] = (1.0f + e1) * fast_rcp(1.0f + a1); }
                    const unsigned off = o0 + (unsigned)((ai * HALF + m * 16) * 1024) * 2u;
                    st16(GA, off, pack8(r0, r1)); st16(GS, off, pack8(s0, s1)); }
        }
    }
};
struct EpiGate {
    static constexpr bool PERM = true, HAS_MID = false, HAS_PRE = false;
    bf16_t* QKV; unsigned char *USV, *GA, *GS;
    __device__ __forceinline__ void operator()(const f32x4 (&acc)[2][2][4][2], const Unit& u, int wr, int wc, int fr, int fq) const {
        const unsigned row0 = (unsigned)(u.pm * BM + wr * 64 + fr), cl = (unsigned)(wc * 32 + 8 * fq); const int pn = u.pn;
        if (pn < 3) {
            const float sc = (pn < 2) ? 0.125f * 1.4426950408889634f * 0.03125f : 0.03125f;   unsigned o0 = (row0 * 768u + (unsigned)pn * 256u + cl) * 2u; asm volatile("" : "+v"(o0));
#pragma unroll
            for (int ai = 0; ai < 2; ++ai)
#pragma unroll
                for (int m = 0; m < 4; ++m)
#pragma unroll
                    for (int bj = 0; bj < 2; ++bj) st16(QKV, o0 + (unsigned)((ai * HALF + m * 16) * 768 + bj * HALF) * 2u, pack8(acc[ai][bj][m][0] * sc, acc[ai][bj][m][1] * sc));
        } else if (pn < 7) {
            unsigned o0 = (row0 * 1024u + (unsigned)(pn - 3) * 256u + cl); asm volatile("" : "+v"(o0));
#pragma unroll
            for (int ai = 0; ai < 2; ++ai)
#pragma unroll
                for (int m = 0; m < 4; ++m)
#pragma unroll
                    for (int bj = 0; bj < 2; ++bj) { const f32x4 v0 = acc[ai][bj][m][0] * 0.03125f, v1 = acc[ai][bj][m][1] * 0.03125f; u32x2 b8; b8.x = pk_fp8x4(v0[0], v0[1], v0[2], v0[3]); b8.y = pk_fp8x4(v1[0], v1[1], v1[2], v1[3]);
                        *(u32x2*)(USV + (size_t)(o0 + (unsigned)((ai * HALF + m * 16) * 1024 + bj * HALF))) = b8; }
        } else {
            unsigned o0 = (row0 * 1024u + (unsigned)(pn - 7) * 128u + cl); asm volatile("" : "+v"(o0));
            constexpr float NS = -0.03125f;
#pragma unroll
            for (int ai = 0; ai < 2; ++ai)
#pragma unroll
                for (int m = 0; m < 4; ++m) { f32x4 r0, r1, s0, s1;
#pragma unroll
                    for (int j = 0; j < 4; ++j) { const float e0 = fast_exp(NS * acc[ai][1][m][0][j]), e1 = fast_exp(NS * acc[ai][1][m][1][j]);
                        const float a0 = fast_exp(NS * acc[ai][0][m][0][j]), a1 = fast_exp(NS * acc[ai][0][m][1][j]);
                        s0[j] = fast_rcp(1.0f + e0); s1[j] = fast_rcp(1.0f + e1); r0[j] = fminf((1.0f + e0) * fast_rcp(1.0f + a0), 448.0f); r1[j] = fminf((1.0f + e1) * fast_rcp(1.0f + a1), 448.0f); }
                    const unsigned off = o0 + (unsigned)((ai * HALF + m * 16) * 1024);
                    u32x2 rb, sb; rb.x = pk_fp8x4(r0[0], r0[1], r0[2], r0[3]); rb.y = pk_fp8x4(r1[0], r1[1], r1[2], r1[3]); sb.x = pk_fp8x4(s0[0], s0[1], s0[2], s0[3]); sb.y = pk_fp8x4(s1[0], s1[1], s1[2], s1[3]);
                    *(u32x2*)(GA + (size_t)off) = rb; *(u32x2*)(GS + (size_t)off) = sb; }
        }
    }
};
struct EpiMerge {
    static constexpr bool PERM = true, HAS_MID = true, HAS_PRE = false;
    const unsigned char *GA, *GS; unsigned char* O;
    __device__ __forceinline__ void load16(const unsigned char* G, u32x2 (&pre)[16], const Unit& u, int wr, int wc, int fr, int fq) const {
        unsigned o0 = ((unsigned)(u.pm * BM + wr * 64 + fr) * 1024u + (unsigned)(u.pn * BM + wc * 32 + 8 * fq)); asm volatile("" : "+v"(o0));
#pragma unroll
        for (int ai = 0; ai < 2; ++ai)
#pragma unroll
            for (int m = 0; m < 4; ++m)
#pragma unroll
                for (int bj = 0; bj < 2; ++bj) pre[(ai * 4 + m) * 2 + bj] = *(const u32x2*)(G + (size_t)(o0 + (unsigned)((ai * HALF + m * 16) * 1024 + bj * HALF)));
    }
    __device__ __forceinline__ void load_mid(u32x2 (&pre)[16], const Unit& u, int wr, int wc, int fr, int fq) const { load16(GA, pre, u, wr, wc, fr, fq); }
    __device__ __forceinline__ void load_fin(u32x2 (&pre)[16], const Unit& u, int wr, int wc, int fr, int fq) const { load16(GS, pre, u, wr, wc, fr, fq); }
    __device__ __forceinline__ void mid(f32x4 (&acc)[2][2][4][2], const u32x2 (&pre)[16]) const {
#pragma unroll
        for (int ai = 0; ai < 2; ++ai)
#pragma unroll
            for (int m = 0; m < 4; ++m)
#pragma unroll
                for (int bj = 0; bj < 2; ++bj) { const u32x2 a = pre[(ai * 4 + m) * 2 + bj]; acc[ai][bj][m][0] *= cvf8x4(a.x); acc[ai][bj][m][1] *= cvf8x4(a.y); }
    }
    __device__ __forceinline__ void fin(const f32x4 (&acc)[2][2][4][2], const u32x2 (&pre)[16], const Unit& u, int wr, int wc, int fr, int fq) const {
        unsigned o0 = ((unsigned)(u.pm * BM + wr * 64 + fr) * 1024u + (unsigned)(u.pn * BM + wc * 32 + 8 * fq)); asm volatile("" : "+v"(o0));
#pragma unroll
        for (int ai = 0; ai < 2; ++ai)
#pragma unroll
            for (int m = 0; m < 4; ++m)
#pragma unroll
                for (int bj = 0; bj < 2; ++bj) { const unsigned off = o0 + (unsigned)((ai * HALF + m * 16) * 1024 + bj * HALF); const u32x2 sg = pre[(ai * 4 + m) * 2 + bj];
                    const f32x4 v0 = acc[ai][bj][m][0] * cvf8x4(sg.x) * 0.03125f, v1 = acc[ai][bj][m][1] * cvf8x4(sg.y) * 0.03125f;
                    u32x2 b8; b8.x = pk_fp8x4(v0[0], v0[1], v0[2], v0[3]); b8.y = pk_fp8x4(v1[0], v1[1], v1[2], v1[3]); *(u32x2*)(O + (size_t)off) = b8; }
    }
    __device__ __forceinline__ void operator()(const f32x4 (&acc)[2][2][4][2], const Unit& u, int wr, int wc, int fr, int fq) const { }
};
struct EpiPlain {
    static constexpr bool PERM = true, HAS_MID = false, HAS_PRE = false;
    unsigned char* O; float sc;
    __device__ __forceinline__ void operator()(const f32x4 (&acc)[2][2][4][2], const Unit& u, int wr, int wc, int fr, int fq) const {
        unsigned o0 = ((unsigned)(u.pm * BM + wr * 64 + fr) * 1024u + (unsigned)(u.pn * BM + wc * 32 + 8 * fq)) * 2u; asm volatile("" : "+v"(o0));
#pragma unroll
        for (int ai = 0; ai < 2; ++ai)
#pragma unroll
            for (int m = 0; m < 4; ++m)
#pragma unroll
                for (int bj = 0; bj < 2; ++bj) { const f32x4 v0 = acc[ai][bj][m][0] * sc, v1 = acc[ai][bj][m][1] * sc; u32x2 b8; b8.x = pk_fp8x4(v0[0], v0[1], v0[2], v0[3]); b8.y = pk_fp8x4(v1[0], v1[1], v1[2], v1[3]);
                      *(u32x2*)(O + (size_t)((o0 >> 1) + (unsigned)((ai * HALF + m * 16) * 1024 + bj * HALF))) = b8; }
    }
};
struct EpiGateUp {
    static constexpr bool PERM = true, HAS_MID = false, HAS_PRE = false;
    unsigned char* HID;
    __device__ __forceinline__ void operator()(const f32x4 (&acc)[2][2][4][2], const Unit& u, int wr, int wc, int fr, int fq) const {
        unsigned o0 = ((unsigned)(u.pm * BM + wr * 64 + fr) * 256u + (unsigned)((u.pn & 1) * 128 + wc * 32 + 8 * fq)); asm volatile("" : "+v"(o0));
#pragma unroll
        for (int ai = 0; ai < 2; ++ai)
#pragma unroll
            for (int m = 0; m < 4; ++m) { f32x4 h0, h1; const f32x4 g0 = acc[ai][0][m][0] * 0.03125f, g1 = acc[ai][0][m][1] * 0.03125f, u0 = acc[ai][1][m][0] * 0.03125f, u1 = acc[ai][1][m][1] * 0.03125f;
#pragma unroll
                for (int j = 0; j < 4; ++j) { h0[j] = g0[j] * sigmoid_f(g0[j]) * u0[j]; h1[j] = g1[j] * sigmoid_f(g1[j]) * u1[j]; }
                u32x2 b8; b8.x = pk_fp8x4(h0[0], h0[1], h0[2], h0[3]); b8.y = pk_fp8x4(h1[0], h1[1], h1[2], h1[3]); *(u32x2*)(HID + (size_t)(o0 + (unsigned)((ai * HALF + m * 16) * 256))) = b8; }
    }
};
struct EpiDown {
    static constexpr bool PERM = true, HAS_MID = false, HAS_PRE = true;
    unsigned char* Y2; const int2* list; const LAS int* tab;
    __device__ __forceinline__ void load_pre(u32x2 (&pre)[16], const Unit& u, int wr, int wc, int fr, int fq) const {
        unsigned lo0 = ((unsigned)u.e * 32768u + (unsigned)(u.p * 256 + wr * 64 + fr)) * 8u; asm volatile("" : "+v"(lo0));
#pragma unroll
        for (int ai = 0; ai < 2; ++ai)
#pragma unroll
            for (int m = 0; m < 4; ++m) pre[ai * 4 + m] = *(const u32x2*)((const char*)list + (size_t)(lo0 + (unsigned)(ai * HALF + m * 16) * 8u));
    }
    __device__ __forceinline__ void fin_pre(const f32x4 (&acc)[2][2][4][2], const u32x2 (&pre)[16], const Unit& u, int wr, int wc, int fr, int fq) const {
        const int r0 = wr * 64 + fr, cnt = tab[64 + u.e] - u.p * 256; const unsigned colb = (unsigned)((u.pn & 3) * 256 + wc * 32 + 8 * fq);
#pragma unroll
        for (int ai = 0; ai < 2; ++ai)
#pragma unroll
            for (int m = 0; m < 4; ++m) { const int ex = (r0 + ai * HALF + m * 16 < cnt) ? (int)pre[ai * 4 + m].x : -1;
                const float w = __uint_as_float(pre[ai * 4 + m].y) * 0.03125f; const unsigned off = (unsigned)ex * 1024u + colb;
                if (ex >= 0) {
#pragma unroll
                    for (int bj = 0; bj < 2; ++bj) { const f32x4 v0 = acc[ai][bj][m][0] * w, v1 = acc[ai][bj][m][1] * w; u32x2 b8; b8.x = pk_fp8x4(v0[0], v0[1], v0[2], v0[3]); b8.y = pk_fp8x4(v1[0], v1[1], v1[2], v1[3]);
                        *(u32x2*)(Y2 + (size_t)(off + (unsigned)(bj * HALF))) = b8; } } }
    }
};
}
#define XB_TMO      128
#define XB_XCNT(j)  (256  + 64 * (j))
#define XB_XSUB(j)  (1280 + 64 * (j))
#define XB_XGEN(j)  (2304 + 64 * (j))
#define XB_TOP      3328
#define XB_TOPGEN   3392
#define XCD_BAR_WORDS 3456
#define XB_SPIN_CAP (1u << 18)

__device__ __forceinline__ unsigned xb_ld(unsigned* p)              { return __hip_atomic_load(p, __ATOMIC_RELAXED, __HIP_MEMORY_SCOPE_AGENT); }
__device__ __forceinline__ unsigned xb_add(unsigned* p, unsigned v) { return __hip_atomic_fetch_add(p, v, __ATOMIC_RELAXED, __HIP_MEMORY_SCOPE_AGENT); }
__device__ __forceinline__ unsigned xb_xcc_id() { return (unsigned)__builtin_amdgcn_s_getreg((3 << 11) | 20) & 0xFu; }
#define XB_SPIN(cond, bar) do { unsigned _sp = 0; while (cond) { __builtin_amdgcn_s_sleep(1); \
    if ((++_sp & 255u) == 0u) { if (xb_ld(&(bar)[XB_TMO])) break; if (_sp > XB_SPIN_CAP) { atomicAdd(&(bar)[XB_TMO], 1u); break; } } } } while (0)

struct XcdBarrier {
    unsigned* bar; unsigned x;
    volatile LAS unsigned* st;
};

__device__ __forceinline__ XcdBarrier xcd_barrier_post(unsigned* bar, volatile LAS unsigned* st) {
    XcdBarrier b; b.bar = bar; b.x = xb_xcc_id(); b.st = st;
    if (threadIdx.x == 0) (void)xb_add(&bar[XB_XCNT(b.x)], 1u);
    return b;
}
__device__ __forceinline__ void xcd_barrier_complete(unsigned* bar, unsigned x, unsigned& nloc, unsigned& nx) {
    const unsigned G = gridDim.x * gridDim.y * gridDim.z;
    unsigned sum, cnt, mine, sp = 0u;
    for (;;) {
        sum = 0u; cnt = 0u; mine = 0u;
#pragma unroll
        for (unsigned j = 0; j < 16; ++j) { const unsigned c = xb_ld(&bar[XB_XCNT(j)]); sum += c; cnt += (c > 0u) ? 1u : 0u; mine = (j == x) ? c : mine; }
        if (sum == G) break;
        __builtin_amdgcn_s_sleep(1);
        if ((++sp & 255u) == 0u) { if (xb_ld(&bar[XB_TMO])) break; if (sp > XB_SPIN_CAP) { atomicAdd(&bar[XB_TMO], 1u); break; } }
    }
    nloc = mine > 0u ? mine : 1u; nx = cnt > 0u ? cnt : 1u;
}

__device__ __forceinline__ void xcd_barrier(const XcdBarrier& b) {
    asm volatile("s_waitcnt vmcnt(0)" ::: "memory");
    __syncthreads();
    if (threadIdx.x == 0) {
        unsigned* bar = b.bar;
        __builtin_amdgcn_s_waitcnt(0);
        unsigned nloc = b.st[0], nx = b.st[1];
        if (nloc == 0u) { xcd_barrier_complete(bar, b.x, nloc, nx); b.st[0] = nloc; b.st[1] = nx; }
        const unsigned old = xb_add(&bar[XB_XSUB(b.x)], 1u);
        const unsigned gen = old / nloc;
        if (old + 1u == (gen + 1u) * nloc) {
            __builtin_amdgcn_fence(__ATOMIC_RELEASE, "agent");
            asm volatile("s_waitcnt vmcnt(0)" ::: "memory");
            const unsigned og = xb_add(&bar[XB_TOP], 1u);
            const unsigned target = (og / nx + 1u) * nx;
            if (og + 1u != target) XB_SPIN(xb_ld(&bar[XB_TOP]) < target, bar);
            __builtin_amdgcn_fence(__ATOMIC_ACQUIRE, "agent");
            xb_add(&bar[XB_XGEN(b.x)], 1u);
            asm volatile("s_waitcnt vmcnt(0)" ::: "memory");
        } else {
            XB_SPIN(xb_ld(&bar[XB_XGEN(b.x)]) == gen, bar);
            __builtin_amdgcn_fence(__ATOMIC_ACQUIRE, "agent");
            asm volatile("s_waitcnt vmcnt(0)" ::: "memory");
        }
    }
    __syncthreads();
}

__device__ __forceinline__ void pair_sync(unsigned* bar, unsigned* cnt, volatile LAS unsigned* same) {
    asm volatile("s_waitcnt vmcnt(0)" ::: "memory");
    __syncthreads();
    if (threadIdx.x == 0) {
        __builtin_amdgcn_s_waitcnt(0);
        if (same[0] != 1u) { __builtin_amdgcn_fence(__ATOMIC_RELEASE, "agent"); asm volatile("s_waitcnt vmcnt(0)" ::: "memory"); }
        const unsigned og = xb_add(cnt, 1u);
        if (og == 0u) XB_SPIN(xb_ld(cnt) < 2u, bar);
        __builtin_amdgcn_fence(__ATOMIC_ACQUIRE, "agent");
        asm volatile("s_waitcnt vmcnt(0)" ::: "memory");
    }
    __syncthreads();
}

constexpr size_t MiB = 1u << 20;
constexpr size_t WS_CTL = 0, CTL_ZERO_BYTES = 1 * MiB;
constexpr size_t WS_MOD = 1 * MiB;
constexpr size_t WS_ST = 3 * MiB;
constexpr size_t WS_WIN = 4 * MiB, WS_WBR = 12 * MiB, WS_WOUT = 14 * MiB, WS_WGU = 16 * MiB, WS_WDN = 32 * MiB, WS_SGW = 40 * MiB;
constexpr size_t WS_WIN8 = WS_WIN;
constexpr size_t WS_WSTRIDE = 37 * MiB;
constexpr size_t WS_LIST = 152 * MiB;
constexpr size_t WS_HX = 156 * MiB;
constexpr size_t WS_GA = 220 * MiB, WS_GS = 284 * MiB, WS_Y2 = WS_GA;
constexpr size_t WS_H8A = 348 * MiB + 32 * MiB;
constexpr size_t WS_CAT = 348 * MiB, WS_Y = WS_CAT;
constexpr size_t WS_WRB = 412 * MiB;
constexpr size_t WS_END = 416 * MiB;
constexpr size_t OB_QKV = 0, OB_HID = OB_QKV;
constexpr size_t OB_USV = 48 * MiB, OB_MRG = OB_USV, OB_H8 = OB_USV;
constexpr int CW_BAR = 4096;
constexpr int CW_CNT = 16384;
constexpr int CW_PAIR = 98304;
constexpr int CW_XID = 196608;
constexpr int CW_PAN = 65536;
constexpr int RING_BYTES = 131072, MISC_OFF = 135168, PAR_OFF = 139264, LDS_BYTES = 163840;

#define VM_WAIT() asm volatile("s_waitcnt vmcnt(0)" ::: "memory")
#define LDS_WAIT() asm volatile("s_waitcnt lgkmcnt(0)" ::: "memory")

struct Frame {
    LAS unsigned char* lds; int tid, lane, wave, vcu, G;
    unsigned char* ws;
    const float* const* in; float* out;
};
__device__ __forceinline__ float wave_sum(float v) {
#pragma unroll
    for (int o = 1; o < 64; o <<= 1) v += __shfl_xor(v, o);
    return v;
}
__device__ __forceinline__ int t5_bucket(int rel) {
    const int n = rel < 0 ? 0 : rel;
    if (n < 16) return n;
    const int large = 16 + (int)(logf((float)n / 16.0f) / logf(8.0f) * 16.0f);
    return large < 31 ? large : 31;
}

template <bool F16OUT>
__device__ __forceinline__ void transpose_item(const float* W, int N, bf16_t* WT, int ldt, int koff, int row_of_n0, int k0, int n0, int lane, LAS unsigned char* scr) {
    const float* src = W + (size_t)k0 * N + n0 + lane;
    float v[64];
#pragma unroll
    for (int i = 0; i < 64; ++i) v[i] = src[(size_t)i * N];
#pragma unroll
    for (int c = 0; c < 8; ++c) { u32x4 o;
        if (F16OUT) { typedef _Float16 th2 __attribute__((ext_vector_type(2)));
            o.x = __builtin_bit_cast(unsigned, __builtin_convertvector((f32x2){v[8 * c], v[8 * c + 1]}, th2)); o.y = __builtin_bit_cast(unsigned, __builtin_convertvector((f32x2){v[8 * c + 2], v[8 * c + 3]}, th2));
            o.z = __builtin_bit_cast(unsigned, __builtin_convertvector((f32x2){v[8 * c + 4], v[8 * c + 5]}, th2)); o.w = __builtin_bit_cast(unsigned, __builtin_convertvector((f32x2){v[8 * c + 6], v[8 * c + 7]}, th2)); }
        else { o.x = cvt_pk_bf16(v[8 * c], v[8 * c + 1]); o.y = cvt_pk_bf16(v[8 * c + 2], v[8 * c + 3]); o.z = cvt_pk_bf16(v[8 * c + 4], v[8 * c + 5]); o.w = cvt_pk_bf16(v[8 * c + 6], v[8 * c + 7]); }
        *(LAS u32x4*)(scr + lane * 144 + c * 16) = o; }
    const int c8 = lane & 7;
#pragma unroll
    for (int j = 0; j < 8; ++j) { const int n = (lane >> 3) + 8 * j; const u32x4 o = *(const LAS u32x4*)(scr + n * 144 + c8 * 16);
        *(u32x4*)(WT + (size_t)(row_of_n0 + n) * ldt + koff + k0 + 8 * c8) = o; }
}
template <int PITCH = 1024>
__device__ __forceinline__ void transpose_item_fp8(const float* W, int N, unsigned char* WT, int koff, int row_of_n0, int k0, int n0, int lane, LAS unsigned char* scr) {
    const float* src = W + (size_t)k0 * N + n0 + lane;
    float v[64];
#pragma unroll
    for (int i = 0; i < 64; ++i) v[i] = src[(size_t)i * N];
#pragma unroll
    for (int c = 0; c < 4; ++c) { u32x4 o;
        o.x = pk_fp8x4(32.f * v[16 * c], 32.f * v[16 * c + 1], 32.f * v[16 * c + 2], 32.f * v[16 * c + 3]); o.y = pk_fp8x4(32.f * v[16 * c + 4], 32.f * v[16 * c + 5], 32.f * v[16 * c + 6], 32.f * v[16 * c + 7]);
        o.z = pk_fp8x4(32.f * v[16 * c + 8], 32.f * v[16 * c + 9], 32.f * v[16 * c + 10], 32.f * v[16 * c + 11]); o.w = pk_fp8x4(32.f * v[16 * c + 12], 32.f * v[16 * c + 13], 32.f * v[16 * c + 14], 32.f * v[16 * c + 15]);
        *(LAS u32x4*)(scr + lane * 80 + c * 16) = o; }
    const int c4 = lane & 3;
#pragma unroll
    for (int j = 0; j < 4; ++j) { const int n = (lane >> 2) + 16 * j; const u32x4 o = *(const LAS u32x4*)(scr + n * 80 + c4 * 16);
        *(u32x4*)(WT + (size_t)(row_of_n0 + n) * PITCH + koff + k0 + 16 * c4) = o; }
}
constexpr int CI_IN = 16 * 60, CI_BR = 8 * 16, CI_OUT = 16 * 16, CI_GU = 16 * 4, CI_DN = 4 * 16;
constexpr int CONV_ITEMS = CI_IN + 2 * CI_BR + CI_OUT + NE * (2 * CI_GU + CI_DN) + 64;
__device__ __forceinline__ void conv_item(Frame& F, int l, int it, LAS unsigned char* scr) {
    const int lane = F.lane; unsigned char* ws = F.ws + (size_t)l * WS_WSTRIDE;
    int r = it;
    if (r < CI_IN) { const int nb = 60, n0 = 64 * (r % nb);
        const int row0 = (n0 < 1792) ? n0 : (n0 < 2816 ? 1792 + ((n0 - 1792) >> 7) * 256 + ((n0 - 1792) & 127) : 1792 + ((n0 - 2816) >> 7) * 256 + 128 + ((n0 - 2816) & 127));
        transpose_item_fp8(F.in[7] + (size_t)l * D * INW, INW, ws + WS_WIN8, 0, row0, 64 * (r / nb), n0, lane, scr);
        return; } r -= CI_IN;
    if (r < CI_BR) { const int nb = 16; transpose_item_fp8(F.in[13] + (size_t)l * 512 * D, D, ws + WS_WBR, 0, 64 * (r % nb), 64 * (r / nb), 64 * (r % nb), lane, scr); return; } r -= CI_BR;
    if (r < CI_BR) { const int nb = 16; transpose_item_fp8(F.in[14] + (size_t)l * 512 * D, D, ws + WS_WBR, 512, 64 * (r % nb), 64 * (r / nb), 64 * (r % nb), lane, scr); return; } r -= CI_BR;
    if (r < CI_OUT) { const int nb = 16; transpose_item_fp8(F.in[15] + (size_t)l * D * D, D, ws + WS_WOUT, 0, 64 * (r % nb), 64 * (r / nb), 64 * (r % nb), lane, scr); return; } r -= CI_OUT;
    if (r < NE * 2 * CI_GU) {
        const int e = r / (2 * CI_GU), q = r % (2 * CI_GU), up = q / CI_GU, ii = q % CI_GU, nb = 4, n0 = 64 * (ii % nb), k0 = 64 * (ii / nb);
        const float* W = F.in[up ? 19 : 18] + ((size_t)l * NE + e) * D * FF;
        transpose_item_fp8(W, FF, ws + WS_WGU, 0, e * 512 + (n0 >> 7) * 256 + up * 128 + (n0 & 127), k0, n0, lane, scr); return; } r -= NE * 2 * CI_GU;
    if (r < NE * CI_DN) { const int e = r / CI_DN, ii = r % CI_DN, nb = 16, n0 = 64 * (ii % nb), k0 = 64 * (ii / nb);
        transpose_item_fp8<256>(F.in[20] + ((size_t)l * NE + e) * FF * D, D, ws + WS_WDN, 0, e * 1024 + n0, k0, n0, lane, scr); return; } r -= NE * CI_DN;
    {
        const float* W = F.in[9] + (size_t)l * 8 * 128 * 128 + (size_t)r * 2048; bf16_t* O = (bf16_t*)(ws + WS_SGW) + (size_t)r * 2048;
        const int i = (r & 7) * 16 + (lane >> 2), j0 = (lane & 3) * 32;
#pragma unroll
        for (int q = 0; q < 4; ++q) { const f32x4 a = *(const f32x4*)(W + lane * 32 + q * 8), b = *(const f32x4*)(W + lane * 32 + q * 8 + 4); f32x4 a2, b2;
#pragma unroll
            for (int t = 0; t < 4; ++t) { a2[t] = (j0 + q * 8 + t <= i) ? a[t] : 0.f; b2[t] = (j0 + q * 8 + 4 + t <= i) ? b[t] : 0.f; }
            *(u32x4*)(O + lane * 32 + q * 8) = pg8::pack8(a2, b2); }
    }
}

constexpr int MOD_ITEMS = DEPTH * 6 * D / 32;
__device__ __forceinline__ void mod_item(Frame& F, int it) {
    const LAS float* cond = (const LAS float*)F.lds;
    const int l = it / 192, j0 = (it % 192) * 32, col = j0 + (F.lane & 31), kh = (F.lane >> 5) * 512;
    const __amdgpu_buffer_rsrc_t rs = __builtin_amdgcn_make_buffer_rsrc((void*)(F.in[5] + (size_t)l * D * 6 * D), 0, D * 6 * D * 4, 0x00020000);
    const int voff = (kh * 6 * D + col) * 4;
    f32x4 acc[4];
#pragma unroll
    for (int b = 0; b < 4; ++b) acc[b] = (f32x4){0.f, 0.f, 0.f, 0.f};
#pragma unroll 1
    for (int k = 0; k < 512; k += 16) {
        float wv[16];
#pragma unroll
        for (int q = 0; q < 16; ++q) wv[q] = __builtin_bit_cast(float, __builtin_amdgcn_raw_buffer_load_b32(rs, voff, (k + q) * 6 * D * 4, 0));
#pragma unroll
        for (int q = 0; q < 16; ++q) { const LAS f32x4* cp = (const LAS f32x4*)(cond + (kh + k + q) * 16);
#pragma unroll
            for (int b = 0; b < 4; ++b) acc[b] += cp[b] * wv[q];
            if ((q & 3) == 3) asm volatile("" ::: "memory"); }
    }
    int t2 = threadIdx.x, it2 = it; asm volatile("" : "+v"(t2), "+s"(it2));
    const int l2 = it2 / 192, col2 = (it2 % 192) * 32 + (t2 & 31);
    float* mod = (float*)(F.ws + WS_MOD) + (size_t)l2 * BATCH * 6 * D + col2; const float bia = F.in[6][l2 * 6 * D + col2];
#pragma unroll
    for (int b = 0; b < 16; ++b) { const float a = acc[b >> 2][b & 3]; const float s = a + __shfl_xor(a, 32); if ((t2 & 63) < 32) mod[(size_t)b * 6 * D] = s + bia; }
}

struct RowArgs { const float* xin; const bf16_t* y; const float* g; const float* gain; const float* bias; const float* sc; const float* sh; const float* osc; const float* osh; bf16_t* HX; float* st; int l; bool has_h; float* xo; int2* list; unsigned char* H8; };
typedef _Float16 h16x4 __attribute__((ext_vector_type(4)));
__device__ __forceinline__ f32x4 cvh4(const u32x2 w) { return __builtin_convertvector(__builtin_bit_cast(h16x4, w), f32x4); }
__device__ __forceinline__ u32x2 pkh4(const f32x4 v) { return __builtin_bit_cast(u32x2, __builtin_convertvector(v, h16x4)); }
__device__ __forceinline__ f32x4 cvbf4(const u32x2 w) { return (f32x4){bf_lo(w.x), bf_hi(w.x), bf_lo(w.y), bf_hi(w.y)}; }
#define DPP_ADD(v, ctrl, rmask, bc) v += __builtin_bit_cast(float, __builtin_amdgcn_update_dpp(0, __builtin_bit_cast(int, v), ctrl, rmask, 0xF, bc))
__device__ __forceinline__ float dpp_sum(float v) {
    DPP_ADD(v, 0xB1, 0xF, true); DPP_ADD(v, 0x4E, 0xF, true); DPP_ADD(v, 0x141, 0xF, true); DPP_ADD(v, 0x140, 0xF, true);
    DPP_ADD(v, 0x142, 0xA, false); DPP_ADD(v, 0x143, 0xC, false);
    return __builtin_bit_cast(float, __builtin_amdgcn_readlane(__builtin_bit_cast(int, v), 63));
}
template <int MODE> struct RowRaw { f32x4 x[4]; u32x2 hx[4]; unsigned y[4]; unsigned y2[4]; f32x2 st; };
#define ROWCOL(lane, q) (8 * (lane) + 512 * ((q) >> 1) + 4 * ((q) & 1))
template <int MODE>
__device__ __forceinline__ void row_load(RowRaw<MODE>& r, Frame& F, const RowArgs& A, size_t row, int lane) {
    const int rw = __builtin_amdgcn_readfirstlane((int)row);
    if (MODE == 0) {
        const __amdgpu_buffer_rsrc_t rx = __builtin_amdgcn_make_buffer_rsrc((void*)A.xin, 0, T * D * 4, 0x00020000);
#pragma unroll
        for (int j = 0; j < 4; ++j) r.x[j] = __builtin_bit_cast(f32x4, __builtin_amdgcn_raw_buffer_load_b128(rx, lane * 32 + (j >> 1) * 2048 + (j & 1) * 16, rw * (D * 4), 0));
    } else {
        r.st = *(const f32x2*)(A.st + (size_t)rw * 2);
        const __amdgpu_buffer_rsrc_t rh = __builtin_amdgcn_make_buffer_rsrc((void*)A.HX, 0, T * D * 2, 0x00020000);
        const __amdgpu_buffer_rsrc_t ry = __builtin_amdgcn_make_buffer_rsrc((void*)A.y, 0, (MODE == 2 ? 2 : 1) * T * D, 0x00020000);
#pragma unroll
        for (int jj = 0; jj < 2; ++jj) { const u32x4 h = __builtin_bit_cast(u32x4, __builtin_amdgcn_raw_buffer_load_b128(rh, lane * 16 + jj * 1024, rw * (D * 2), 2));
            r.hx[2 * jj] = (u32x2){h.x, h.y}; r.hx[2 * jj + 1] = (u32x2){h.z, h.w};
            if (MODE == 1) { const u32x2 y = __builtin_bit_cast(u32x2, __builtin_amdgcn_raw_buffer_load_b64(ry, lane * 8 + jj * 512, rw * D, 2)); r.y[2 * jj] = y.x; r.y[2 * jj + 1] = y.y; }
            else { const u32x2 y = __builtin_bit_cast(u32x2, __builtin_amdgcn_raw_buffer_load_b64(ry, lane * 8 + jj * 512, rw * (D * 2), 2));
                   const u32x2 y2 = __builtin_bit_cast(u32x2, __builtin_amdgcn_raw_buffer_load_b64(ry, lane * 8 + jj * 512 + D, rw * (D * 2), 2));
                   r.y[2 * jj] = y.x; r.y[2 * jj + 1] = y.y; r.y2[2 * jj] = y2.x; r.y2[2 * jj + 1] = y2.y; } }
    }
}
template <int MODE>
__device__ __forceinline__ void row_process(const RowRaw<MODE>& r, Frame& F, const RowArgs& A, size_t row, int lane, const f32x4 (&gv)[4], const LAS float* pl) {
    f32x4 z[4];
    asm volatile("" ::: "memory");
    if (MODE == 0) {
#pragma unroll
        for (int j = 0; j < 4; ++j) z[j] = r.x[j];
    } else {
        const float mu0 = r.st[0], sg0 = r.st[1];
#pragma unroll
        for (int j = 0; j < 4; ++j) { f32x4 y = cvf8x4(r.y[j]); if (MODE == 2) y = y + cvf8x4(r.y2[j]);
            const f32x4 x = (cvbf4(r.hx[j]) * *(const LAS f32x4*)(pl + 4096 + 512 * (j >> 1) + 4 * (j & 1)) + *(const LAS f32x4*)(pl + 5120 + 512 * (j >> 1) + 4 * (j & 1))) * sg0 + mu0;
            z[j] = ALPHA * x + (1.0f + gv[j]) * y; }
        float s = 0.f;
#pragma unroll
        for (int j = 0; j < 4; ++j) s += (z[j][0] + z[j][1]) + (z[j][2] + z[j][3]);
        const float mean = dpp_sum(s) * (1.0f / D); float q = 0.f;
#pragma unroll
        for (int j = 0; j < 4; ++j) { z[j] = z[j] - mean; q += (z[j][0] * z[j][0] + z[j][1] * z[j][1]) + (z[j][2] * z[j][2] + z[j][3] * z[j][3]); }
        const float rstd = __builtin_amdgcn_rsqf(dpp_sum(q) * (1.0f / D) + LN_EPS);
#pragma unroll
        for (int j = 0; j < 4; ++j) z[j] = z[j] * rstd * *(const LAS f32x4*)(pl + 512 * (j >> 1) + 4 * (j & 1)) + *(const LAS f32x4*)(pl + 1024 + 512 * (j >> 1) + 4 * (j & 1));
    }
    if (A.xo) {
#pragma unroll
        for (int j = 0; j < 4; ++j) *(f32x4*)(A.xo + row * D + ROWCOL(lane, j)) = z[j];
    }
    if (MODE != 2 || A.has_h) {
        float s = 0.f;
#pragma unroll
        for (int j = 0; j < 4; ++j) s += (z[j][0] + z[j][1]) + (z[j][2] + z[j][3]);
        const float mean = dpp_sum(s) * (1.0f / D); float q = 0.f;
#pragma unroll
        for (int j = 0; j < 4; ++j) { z[j] = z[j] - mean; q += (z[j][0] * z[j][0] + z[j][1] * z[j][1]) + (z[j][2] * z[j][2] + z[j][3] * z[j][3]); }
        const float vq = dpp_sum(q) * (1.0f / D) + LN_EPS, rstd = __builtin_amdgcn_rsqf(vq), sig = vq * rstd;
#pragma unroll
        for (int j = 0; j < 4; ++j) z[j] = z[j] * rstd * *(const LAS f32x4*)(pl + 2048 + 512 * (j >> 1) + 4 * (j & 1)) + *(const LAS f32x4*)(pl + 3072 + 512 * (j >> 1) + 4 * (j & 1));
#pragma unroll
        for (int jj = 0; jj < 2; ++jj) { u32x4 w; w.x = cvt_pk_bf16(z[2 * jj][0], z[2 * jj][1]); w.y = cvt_pk_bf16(z[2 * jj][2], z[2 * jj][3]); w.z = cvt_pk_bf16(z[2 * jj + 1][0], z[2 * jj + 1][1]); w.w = cvt_pk_bf16(z[2 * jj + 1][2], z[2 * jj + 1][3]);
            *(u32x4*)(A.HX + row * D + 8 * lane + 512 * jj) = w;
            if (A.H8) { u32x2 b8; b8.x = pk_fp8x4(z[2 * jj][0], z[2 * jj][1], z[2 * jj][2], z[2 * jj][3]); b8.y = pk_fp8x4(z[2 * jj + 1][0], z[2 * jj + 1][1], z[2 * jj + 1][2], z[2 * jj + 1][3]); *(u32x2*)(A.H8 + row * D + 8 * lane + 512 * jj) = b8; } }
        if (lane == 0) *(f32x2*)(A.st + row * 2) = (f32x2){mean, sig};
    }
}
#define DPPF(v, ctrl) __builtin_bit_cast(float, __builtin_amdgcn_update_dpp(0, __builtin_bit_cast(int, v), ctrl, 0xF, 0xF, true))
#define DPPI(v, ctrl) __builtin_amdgcn_update_dpp(0, v, ctrl, 0xF, 0xF, true)
__device__ __forceinline__ float row16_sum(float v) { v += DPPF(v, 0xB1); v += DPPF(v, 0x4E); v += DPPF(v, 0x141); v += DPPF(v, 0x140); return v; }
__device__ __forceinline__ float row16_max(float v) { v = fmaxf(v, DPPF(v, 0xB1)); v = fmaxf(v, DPPF(v, 0x4E)); v = fmaxf(v, DPPF(v, 0x141)); v = fmaxf(v, DPPF(v, 0x140)); return v; }
typedef _Float16 half8 __attribute__((ext_vector_type(8)));
__device__ __forceinline__ void route16(const LAS unsigned char* wrb, const bf16_t* xrows, size_t row_base, int lane, int lr_base, float rbias, LAS int* lcnt, LAS int* asg) {
    const int e = lane & 15, g = lane >> 4;
    asm volatile("s_waitcnt vmcnt(0)" ::: "memory");
    const __amdgpu_buffer_rsrc_t rs = __builtin_amdgcn_make_buffer_rsrc((void*)xrows, 0, T * D * 2, 0x00020000);
    const int voff = (int)(((row_base + (size_t)e) * D + 8 * g) * 2);
    f32x4 ah = (f32x4){0.f, 0.f, 0.f, 0.f}, al = (f32x4){0.f, 0.f, 0.f, 0.f};
    const LAS unsigned char* bb = wrb + lane * 16;
    u32x4 av[32];
#pragma unroll
    for (int i = 0; i < 32; ++i) av[i] = __builtin_bit_cast(u32x4, __builtin_amdgcn_raw_buffer_load_b128(rs, voff, i * 64, 16  ));
#pragma unroll
    for (int i = 0; i < 32; ++i) { const half8 a = __builtin_bit_cast(half8, av[i]);
        const half8 bh = *(const LAS half8*)(bb + i * 1024), bl = *(const LAS half8*)(bb + 32768 + i * 1024);
        ah = __builtin_amdgcn_mfma_f32_16x16x32_bf16(__builtin_bit_cast(bf16x8, a), __builtin_bit_cast(bf16x8, bh), ah, 0, 0, 0); al = __builtin_amdgcn_mfma_f32_16x16x32_bf16(__builtin_bit_cast(bf16x8, a), __builtin_bit_cast(bf16x8, bl), al, 0, 0, 0); }
    const int qi = lane & 3, q = (lane >> 2) & 3;
#pragma unroll
    for (int rr = 0; rr < 4; ++rr) {
        const int row = 4 * g + rr;
        const float lg = ah[rr] + al[rr];
        const float mx = row16_max(lg);
        float p = expf(lg - mx);
        p = p / row16_sum(p);
        const float sel = p + rbias;
        int rank = 0;
        { const float a = DPPF(sel, 0x39); const int j = DPPI(qi, 0x39); rank += (a > sel || (a == sel && j < qi)) ? 1 : 0; }
        { const float a = DPPF(sel, 0x4E); const int j = DPPI(qi, 0x4E); rank += (a > sel || (a == sel && j < qi)) ? 1 : 0; }
        { const float a = DPPF(sel, 0x93); const int j = DPPI(qi, 0x93); rank += (a > sel || (a == sel && j < qi)) ? 1 : 0; }
        const bool in2 = rank < 2;
        float gs = in2 ? sel : 0.f; gs += DPPF(gs, 0xB1); gs += DPPF(gs, 0x4E);
        bool best = true;
        { const float a = DPPF(gs, 0x124); const int j = DPPI(q, 0x124); best = best && (gs > a || (gs == a && q < j)); }
        { const float a = DPPF(gs, 0x128); const int j = DPPI(q, 0x128); best = best && (gs > a || (gs == a && q < j)); }
        { const float a = DPPF(gs, 0x12C); const int j = DPPI(q, 0x12C); best = best && (gs > a || (gs == a && q < j)); }
        const bool chosen = best && in2;
        const float den = row16_sum(chosen ? p : 0.f);
        const float w = p / den;
        if (chosen) { const int rk = __hip_atomic_fetch_add(lcnt + e, 1, __ATOMIC_RELAXED, __HIP_MEMORY_SCOPE_WORKGROUP);
            const int a = 2 * (lr_base + row) + rank; asg[2 * a] = e | (rk << 8); asg[2 * a + 1] = __float_as_int(w); }
    }
}
template <int MODE>
__device__ __forceinline__ void row_phase(Frame& F, const RowArgs& A) {
    int tid0_ = threadIdx.x; asm volatile("" : "+v"(tid0_));
    const int wave = __builtin_amdgcn_readfirstlane(tid0_ >> 6);
    LAS unsigned char* wrb = F.lds;
    LAS int* lcnt = (LAS int*)(F.lds + 131072);
    LAS int* gb = lcnt + 16;
    LAS int* asg = lcnt + 32;
    LAS float* par = (LAS float*)(F.lds + PAR_OFF);
#pragma unroll 1
    for (int rb = F.vcu; rb < T / 128; rb += F.G) {
        int tid_ = tid0_; asm volatile("" : "+v"(tid_));
        const int lane = tid_ & 63, tid = tid_;
        const float rbias = (MODE == 1) ? F.in[4][lane & 15] : 0.f;
        const LAS float* pl = par + 8 * lane; asm volatile("" : "+v"(pl));
        const int row0 = rb * 128, b = row0 / SEQ;
        __syncthreads();
        const size_t r0 = (size_t)row0 + wave * 16;
        u32x4 wv[8];
        if (MODE == 1) { const unsigned char* src = F.ws + WS_WRB;
#pragma unroll
            for (int k = 0; k < 8; ++k) wv[k] = *(const u32x4*)(src + (size_t)(tid + k * NTHR) * 16); }
        const int c4 = (tid & 255) * 4;
        f32x4 pv0 = (f32x4){0.f, 0.f, 0.f, 0.f}, pv1 = pv0, pv2 = pv0, pv3 = pv0;
        if (tid < 256) { if (MODE != 0) { pv0 = *(const f32x4*)(A.gain + c4); pv1 = *(const f32x4*)(A.bias + c4); pv2 = *(const f32x4*)(A.osc + b * 6 * D + c4); pv3 = *(const f32x4*)(A.osh + b * 6 * D + c4); } }
        else if (MODE != 2 || A.has_h) { pv0 = *(const f32x4*)(A.sc + b * 6 * D + c4); pv1 = *(const f32x4*)(A.sh + b * 6 * D + c4); }
        f32x4 gv[4];
#pragma unroll
        for (int j = 0; j < 4; ++j) gv[j] = (MODE == 0) ? (f32x4){0.f, 0.f, 0.f, 0.f} : *(const f32x4*)(A.g + b * 6 * D + ROWCOL(lane, j));
        RowRaw<MODE> ra, rbf, rc, rd;
        row_load<MODE>(ra, F, A, r0, lane); row_load<MODE>(rbf, F, A, r0 + 1, lane); row_load<MODE>(rc, F, A, r0 + 2, lane); row_load<MODE>(rd, F, A, r0 + 3, lane);
        if (MODE == 1) { if (tid < 16) lcnt[tid] = 0;
#pragma unroll
            for (int k = 0; k < 8; ++k) *(LAS u32x4*)(wrb + (tid + k * NTHR) * 16) = wv[k]; }
        if (tid < 256) { if (MODE != 0) { const f32x4 o = 1.0f / (1.0f + pv2); *(LAS f32x4*)(par + c4) = pv0; *(LAS f32x4*)(par + 1024 + c4) = pv1; *(LAS f32x4*)(par + 4096 + c4) = o; *(LAS f32x4*)(par + 5120 + c4) = -pv3 * o; } }
        else if (MODE != 2 || A.has_h) { *(LAS f32x4*)(par + 2048 + c4) = 1.0f + pv0; *(LAS f32x4*)(par + 3072 + c4) = pv1; }
        __syncthreads();
#pragma unroll 1
        for (int pr = 0; pr < 3; ++pr) {
            row_process<MODE>(ra, F, A, r0 + 4 * pr, lane, gv, pl); row_load<MODE>(ra, F, A, r0 + 4 * pr + 4, lane);
            row_process<MODE>(rbf, F, A, r0 + 4 * pr + 1, lane, gv, pl); row_load<MODE>(rbf, F, A, r0 + 4 * pr + 5, lane);
            row_process<MODE>(rc, F, A, r0 + 4 * pr + 2, lane, gv, pl); row_load<MODE>(rc, F, A, r0 + 4 * pr + 6, lane);
            row_process<MODE>(rd, F, A, r0 + 4 * pr + 3, lane, gv, pl); row_load<MODE>(rd, F, A, r0 + 4 * pr + 7, lane);
        }
        row_process<MODE>(ra, F, A, r0 + 12, lane, gv, pl); row_process<MODE>(rbf, F, A, r0 + 13, lane, gv, pl); row_process<MODE>(rc, F, A, r0 + 14, lane, gv, pl); row_process<MODE>(rd, F, A, r0 + 15, lane, gv, pl);
        if (MODE == 1) route16(wrb, A.HX, r0, lane, wave * 16, rbias, lcnt, asg);
        if (MODE == 1) {
            __syncthreads();
            if (tid < 16) gb[tid] = (int)__hip_atomic_fetch_add(((unsigned*)F.ws) + CW_CNT + 64 * (A.l * 16 + tid), (unsigned)lcnt[tid], __ATOMIC_RELAXED, __HIP_MEMORY_SCOPE_AGENT);
            __syncthreads();
            if (tid < 256) { const int er = asg[2 * tid], wb = asg[2 * tid + 1]; const int e = er & 255, pos = gb[e] + (er >> 8);
                int2 en; en.x = (row0 + (tid >> 1)) * 2 + (tid & 1); en.y = wb; A.list[(size_t)e * 32768 + pos] = en; }
            __syncthreads();
        }
    }
}

__device__ __forceinline__ s16x4 vtr(const LAS unsigned char* p) { return __builtin_bit_cast(s16x4, __builtin_amdgcn_ds_read_tr16_b64_v4i16((LAS s16x4*)p)); }
__device__ __forceinline__ bf16x8 cat44(s16x4 a, s16x4 b) { return (bf16x8){a[0], a[1], a[2], a[3], b[0], b[1], b[2], b[3]}; }
__device__ __forceinline__ f32x4 gelu_tab4(const LAS float* gt, const unsigned w) { return (f32x4){gt[w & 0xffu], gt[(w >> 8) & 0xffu], gt[(w >> 16) & 0xffu], gt[w >> 24]}; }
__device__ __forceinline__ float rows_max(float v) {
    auto r = __builtin_amdgcn_permlane32_swap(__float_as_uint(v), __float_as_uint(v), false, false); v = fmaxf(__uint_as_float(r[0]), __uint_as_float(r[1]));
    r = __builtin_amdgcn_permlane16_swap(__float_as_uint(v), __float_as_uint(v), false, false); return fmaxf(__uint_as_float(r[0]), __uint_as_float(r[1]));
}
__device__ __forceinline__ float rows_sum(float v) {
    auto r = __builtin_amdgcn_permlane32_swap(__float_as_uint(v), __float_as_uint(v), false, false); v = __uint_as_float(r[0]) + __uint_as_float(r[1]);
    r = __builtin_amdgcn_permlane16_swap(__float_as_uint(v), __float_as_uint(v), false, false); return __uint_as_float(r[0]) + __uint_as_float(r[1]);
}
__device__ __forceinline__ void rows_transpose4(unsigned& w0, unsigned& w1, unsigned& w2, unsigned& w3) {
    auto r = __builtin_amdgcn_permlane32_swap(w0, w2, false, false); w0 = r[0]; w2 = r[1];
    r = __builtin_amdgcn_permlane32_swap(w1, w3, false, false); w1 = r[0]; w3 = r[1];
    r = __builtin_amdgcn_permlane16_swap(w0, w1, false, false); w0 = r[0]; w1 = r[1];
    r = __builtin_amdgcn_permlane16_swap(w2, w3, false, false); w2 = r[0]; w3 = r[1];
}
__device__ __forceinline__ void mixer_unit(Frame& F, int l, int ub, int un) {
    int tid_ = threadIdx.x; asm volatile("" : "+v"(tid_));
    const int tid = tid_, lane = tid & 63, wave = __builtin_amdgcn_readfirstlane(tid >> 6), c = lane & 15, g = lane >> 4;
    LAS unsigned char* lds = F.lds;
    const bf16_t* QKV = (const bf16_t*)((unsigned char*)F.out + OB_QKV); const unsigned char* USV = (const unsigned char*)F.out + OB_USV;     unsigned char* CAT = F.ws + WS_CAT;
    const size_t tok0 = (size_t)ub * SEQ + (size_t)un * 128;
    float sink = F.in[8][l * 8 + wave] * 1.4426950408889634f;
    u32x4 v[16];
#pragma unroll
    for (int i = 0; i < 16; ++i) { const int ci = i * NTHR + tid, c8 = ci & 7, key = (ci >> 3) & 255, hk = (ci >> 11) & 1, tv = ci >> 12;
        v[i] = (u32x4){0u, 0u, 0u, 0u};
        if (un > 0 || key >= 128) v[i] = *(const u32x4*)(QKV + (tok0 - 128 + key) * 768 + 512 + tv * 128 + hk * 64 + c8 * 8); }
    const bf16_t* qp0 = QKV + (tok0 + c) * 768 + wave * 64 + 8 * g;
    bf16x8 qa0 = *(const bf16x8*)qp0, qa1 = *(const bf16x8*)(qp0 + 32);
    bf16x8 qb0 = *(const bf16x8*)(qp0 + 16 * 768), qb1 = *(const bf16x8*)(qp0 + 16 * 768 + 32);
    u32x2 vrow[16];
#pragma unroll
    for (int rr = 0; rr < 16; ++rr) vrow[rr] = *(const u32x2*)(USV + (tok0 + wave * 16 + rr) * 1024 + 512 + 8 * lane);
    LAS float* tb = (LAS float*)(lds + PAR_OFF);
#pragma unroll
    for (int i = 0; i < 2; ++i) { const int idx = i * NTHR + tid; tb[idx] = F.in[2][t5_bucket(idx & 127) * 8 + (idx >> 7)] * 1.4426950408889634f; }
    if (tid < 256) { const f32x4 p = cvf8x4((unsigned)tid); ((LAS float*)(lds + PAR_OFF + 4096))[tid] = gelu_pk((f32x2){p[0], p[0]}).x; }
    const LAS float* gt = (const LAS float*)(lds + PAR_OFF + 4096);
#pragma unroll
    for (int i = 0; i < 16; ++i) { const int ci = i * NTHR + tid, c8 = ci & 7, key = (ci >> 3) & 255, hk = (ci >> 11) & 1, tv = ci >> 12;
        *(LAS u32x4*)(lds + (tv * 2 + hk) * 32768 + key * 128 + ((c8 ^ (key & 7)) << 4)) = v[i]; }
    asm volatile("" : "+v"(sink));
    __syncthreads();
#ifndef MIX_REP_A
#define MIX_REP_A 1
#endif
#ifndef MIX_REP_S
#define MIX_REP_S 1
#endif
    for (int repa_ = 0; repa_ < MIX_REP_A; ++repa_)
    {
        const int h = wave, hk = h >> 2;
        const LAS unsigned char* Kb = lds + hk * 32768; const LAS unsigned char* Vb = lds + 65536 + hk * 32768;
        float bv[9][4];
#pragma unroll
        for (int j = 0; j < 9; ++j)
#pragma unroll
            for (int r = 0; r < 4; ++r) { const int rel = c + 128 - 16 * j - 4 * g - r; bv[j][r] = (rel >= 0 && rel < 128) ? tb[h * 128 + (rel & 127)] : -1e30f; }
        const int ka0 = c * 128 + (((0 + g) ^ (c & 7)) << 4), ka1 = c * 128 + (((4 + g) ^ (c & 7)) << 4);
        const int vkey = 4 * g + (c >> 2), vsw = vkey & 7, vp = c & 3;
        const LAS unsigned char* kb0 = Kb + ka0; const LAS unsigned char* kb1 = Kb + ka1;
        const LAS unsigned char* vb0 = Vb + vkey * 128 + ((((0 + (vp >> 1)) ^ vsw) << 4) + (vp & 1) * 8); const LAS unsigned char* vb1 = Vb + vkey * 128 + ((((2 + (vp >> 1)) ^ vsw) << 4) + (vp & 1) * 8);
        const LAS unsigned char* vb2 = Vb + vkey * 128 + ((((4 + (vp >> 1)) ^ vsw) << 4) + (vp & 1) * 8); const LAS unsigned char* vb3 = Vb + vkey * 128 + ((((6 + (vp >> 1)) ^ vsw) << 4) + (vp & 1) * 8);
        asm volatile("" : "+v"(kb0), "+v"(kb1), "+v"(vb0), "+v"(vb1), "+v"(vb2), "+v"(vb3));
#pragma unroll 1
        for (int qt = 0; qt < 8; qt += 2) {
            f32x4 s0[9], s1[9];
            const int qo = qt * 2048; const LAS unsigned char* kq0 = kb0 + qo; const LAS unsigned char* kq1 = kb1 + qo;
#pragma unroll
            for (int x = 0; x < 10; ++x) {
                const bf16x8 k0 = *(const LAS bf16x8*)(kq0 + x * 2048), k1 = *(const LAS bf16x8*)(kq1 + x * 2048);
                if (x < 9) { f32x4 a = (f32x4){bv[x][0], bv[x][1], bv[x][2], bv[x][3]};
                    a = __builtin_amdgcn_mfma_f32_16x16x32_bf16(k0, qa0, a, 0, 0, 0); a = __builtin_amdgcn_mfma_f32_16x16x32_bf16(k1, qa1, a, 0, 0, 0); s0[x] = a; }
                if (x > 0) { f32x4 a = (f32x4){bv[x - 1][0], bv[x - 1][1], bv[x - 1][2], bv[x - 1][3]};
                    a = __builtin_amdgcn_mfma_f32_16x16x32_bf16(k0, qb0, a, 0, 0, 0); a = __builtin_amdgcn_mfma_f32_16x16x32_bf16(k1, qb1, a, 0, 0, 0); s1[x - 1] = a; } }
            { const int n0 = qt + 2 < 8 ? qt + 2 : 7, n1 = qt + 3 < 8 ? qt + 3 : 7;
              const bf16_t* qp = qp0 + (size_t)(16 * n0) * 768; qa0 = *(const bf16x8*)qp; qa1 = *(const bf16x8*)(qp + 32);
              qp = qp0 + (size_t)(16 * n1) * 768; qb0 = *(const bf16x8*)qp; qb1 = *(const bf16x8*)(qp + 32); }
            if (un == 0) {
#pragma unroll
                for (int j = 0; j < 8; ++j) { if (qt + j < 8) s0[j] = (f32x4){-1e30f, -1e30f, -1e30f, -1e30f}; if (qt + 1 + j < 8) s1[j] = (f32x4){-1e30f, -1e30f, -1e30f, -1e30f}; } }
            float mx0 = sink, mx1 = sink;
#pragma unroll
            for (int j = 0; j < 9; ++j)
#pragma unroll
                for (int r = 0; r < 4; ++r) { mx0 = fmaxf(mx0, s0[j][r]); mx1 = fmaxf(mx1, s1[j][r]); }
            mx0 = rows_max(mx0); mx1 = rows_max(mx1);
            float sum0 = 0.f, sum1 = 0.f;
#pragma unroll
            for (int j = 0; j < 9; ++j)
#pragma unroll
                for (int r = 0; r < 4; ++r) { const float p0 = __builtin_amdgcn_exp2f(s0[j][r] - mx0), p1 = __builtin_amdgcn_exp2f(s1[j][r] - mx1); s0[j][r] = p0; sum0 += p0; s1[j][r] = p1; sum1 += p1; }
            sum0 = rows_sum(sum0); sum1 = rows_sum(sum1);
            const float inv0 = __builtin_amdgcn_rcpf(sum0 + __builtin_amdgcn_exp2f(sink - mx0)), inv1 = __builtin_amdgcn_rcpf(sum1 + __builtin_amdgcn_exp2f(sink - mx1));
            bf16x8 pf0[5], pf1[5];
#pragma unroll
            for (int k = 0; k < 5; ++k) {
                { const f32x4 a = s0[2 * k], b = (k < 4) ? s0[2 * k + 1] : (f32x4){0.f, 0.f, 0.f, 0.f};
                  u32x4 w; w.x = cvt_pk_bf16(a[0], a[1]); w.y = cvt_pk_bf16(a[2], a[3]); w.z = cvt_pk_bf16(b[0], b[1]); w.w = cvt_pk_bf16(b[2], b[3]); pf0[k] = __builtin_bit_cast(bf16x8, w); }
                { const f32x4 a = s1[2 * k], b = (k < 4) ? s1[2 * k + 1] : (f32x4){0.f, 0.f, 0.f, 0.f};
                  u32x4 w; w.x = cvt_pk_bf16(a[0], a[1]); w.y = cvt_pk_bf16(a[2], a[3]); w.z = cvt_pk_bf16(b[0], b[1]); w.w = cvt_pk_bf16(b[2], b[3]); pf1[k] = __builtin_bit_cast(bf16x8, w); } }
            unsigned ow0[4], ow1[4];
#pragma unroll
            for (int dt = 0; dt < 4; ++dt) { f32x4 o0 = (f32x4){0.f, 0.f, 0.f, 0.f}, o1 = (f32x4){0.f, 0.f, 0.f, 0.f};
                const LAS unsigned char* vq = (dt == 0 ? vb0 : dt == 1 ? vb1 : dt == 2 ? vb2 : vb3) + qo;
                s16x4 vt[10];
#pragma unroll
                for (int x = 0; x < 10; ++x) vt[x] = vtr(vq + x * 2048);
#pragma unroll
                for (int k = 0; k < 5; ++k) {
                    o0 = __builtin_amdgcn_mfma_f32_16x16x32_bf16(cat44(vt[2 * k], vt[2 * k + 1]), pf0[k], o0, 0, 0, 0);
                    o1 = __builtin_amdgcn_mfma_f32_16x16x32_bf16(cat44(vt[2 * k + 1], vt[k < 4 ? 2 * k + 2 : 9]), pf1[k], o1, 0, 0, 0); }
                ow0[dt] = pk_fp8x4(o0[0] * inv0, o0[1] * inv0, o0[2] * inv0, o0[3] * inv0); ow1[dt] = pk_fp8x4(o1[0] * inv1, o1[1] * inv1, o1[2] * inv1, o1[3] * inv1); }
            rows_transpose4(ow0[0], ow0[1], ow0[2], ow0[3]); rows_transpose4(ow1[0], ow1[1], ow1[2], ow1[3]);
            *(u32x4*)(CAT + (tok0 + 16 * qt + c) * 1024 + h * 64 + 16 * g) = (u32x4){ow0[0], ow0[1], ow0[2], ow0[3]};
            *(u32x4*)(CAT + (tok0 + 16 * (qt + 1) + c) * 1024 + h * 64 + 16 * g) = (u32x4){ow1[0], ow1[1], ow1[2], ow1[3]};
        }
    }
    const float* lg = F.in[11] + l * 512 + 8 * lane; const float* lb = F.in[12] + l * 512 + 8 * lane;
    const f32x4 g0 = *(const f32x4*)lg, g1 = *(const f32x4*)(lg + 4), b0 = *(const f32x4*)lb, b1 = *(const f32x4*)(lb + 4);
    const bf16_t* Wg = (const bf16_t*)(F.ws + (size_t)l * WS_WSTRIDE + WS_SGW) + (size_t)wave * 128 * 128;
    bf16x8 wn[4]; unsigned un_[4];
    float bn_ = F.in[10][l * 1024 + wave * 128 + c];
#pragma unroll
    for (int ks = 0; ks < 4; ++ks) wn[ks] = *(const bf16x8*)(Wg + c * 128 + 32 * ks + 8 * g);
#pragma unroll
    for (int dt = 0; dt < 4; ++dt) un_[dt] = *(const unsigned*)(USV + (tok0 + c) * 1024 + 64 * wave + 16 * dt + 4 * g);
    __syncthreads();
    for (int reps_ = 0; reps_ < MIX_REP_S; ++reps_) {
    {
#pragma unroll
        for (int rr = 0; rr < 16; ++rr) { const int row = wave * 16 + rr; const u32x2 w = vrow[rr];
            f32x4 v0, v1;
            v0 = gelu_tab4(gt, w.x); v1 = gelu_tab4(gt, w.y);
            const float mean = dpp_sum((v0[0] + v0[1]) + (v0[2] + v0[3]) + (v1[0] + v1[1]) + (v1[2] + v1[3])) * (1.0f / 512);
            v0 = v0 - mean; v1 = v1 - mean;
            const float q = dpp_sum((v0[0] * v0[0] + v0[1] * v0[1]) + (v0[2] * v0[2] + v0[3] * v0[3]) + (v1[0] * v1[0] + v1[1] * v1[1]) + (v1[2] * v1[2] + v1[3] * v1[3]));
            const float rstd = __builtin_amdgcn_rsqf(q * (1.0f / 512) + LN_EPS);
            v0 = v0 * rstd * g0 + b0; v1 = v1 * rstd * g1 + b1;
            const int f = (row & 3) | (((row >> 3) & 1) << 2);
            *(LAS u32x4*)(lds + row * 1024 + (((lane >> 1) ^ f) << 5) + (lane & 1) * 16) = pg8::pack8(v0, v1); }
    }
    __syncthreads();
    {
        const int gch = wave;
        const int f = (c >> 2) | ((g & 1) << 2);
#pragma unroll 1
        for (int it = 0; it < 8; ++it) {
            f32x4 o[4]; bf16x8 wc_[4]; unsigned uc_[4];
#pragma unroll
            for (int k = 0; k < 4; ++k) { wc_[k] = wn[k]; uc_[k] = un_[k]; }
            const float bi = bn_;
            if (it < 7) { bn_ = F.in[10][l * 1024 + gch * 128 + 16 * (it + 1) + c];
#pragma unroll
                for (int ks = 0; ks < 4; ++ks) wn[ks] = *(const bf16x8*)(Wg + (16 * (it + 1) + c) * 128 + 32 * ks + 8 * g);
#pragma unroll
                for (int dt = 0; dt < 4; ++dt) un_[dt] = *(const unsigned*)(USV + (tok0 + 16 * (it + 1) + c) * 1024 + 64 * gch + 16 * dt + 4 * g); }
#pragma unroll
            for (int dt = 0; dt < 4; ++dt) o[dt] = (f32x4){0.f, 0.f, 0.f, 0.f};
            const int nks = (it >> 1) + 1;
#pragma unroll
            for (int ks = 0; ks < 4; ++ks) { if (ks < nks) {
                const int r0 = 32 * ks + 8 * g + (c >> 2);
#pragma unroll
                for (int dt = 0; dt < 4; ++dt) { const int off = (((4 * gch + dt) ^ f) << 5) + (c & 3) * 8;
                    const s16x4 va = vtr(lds + r0 * 1024 + off), vb = vtr(lds + (r0 + 4) * 1024 + off);
                    o[dt] = __builtin_amdgcn_mfma_f32_16x16x32_bf16(cat44(va, vb), wc_[ks], o[dt], 0, 0, 0); } } }
            const size_t trow = tok0 + 16 * it + c; unsigned sw[4];
#pragma unroll
            for (int dt = 0; dt < 4; ++dt) { const f32x4 u = gelu_tab4(gt, uc_[dt]);
                sw[dt] = pk_fp8x4(u[0] * (o[dt][0] + bi), u[1] * (o[dt][1] + bi), u[2] * (o[dt][2] + bi), u[3] * (o[dt][3] + bi)); }
            rows_transpose4(sw[0], sw[1], sw[2], sw[3]);
            *(u32x4*)(CAT + trow * 1024 + 512 + 64 * gch + 16 * g) = (u32x4){sw[0], sw[1], sw[2], sw[3]};
        }
    }
    __syncthreads();
    }
}

#ifndef MK_PER_PHASE
#define MK_PER_PHASE 0
#endif
constexpr int N_PHASES = 2 + 8 * DEPTH;
struct Args { const float* in[23]; float* out; unsigned char* ws; int ph_lo, ph_hi; };
static_assert(sizeof(Args) == 23 * 8 + 8 + 8 + 8, "Args has no padding");

constexpr int DEFER_MAX = 64;
__device__ __forceinline__ void build_group_tabs(Frame& F, int l) {
    LAS int* t6 = (LAS int*)(F.lds + MISC_OFF + 64); LAS int* t7 = t6 + 128;
    __syncthreads();
    if (F.tid < 16) t6[96 + F.tid] = (int)__hip_atomic_load(((unsigned*)F.ws) + CW_CNT + 64 * (l * 16 + F.tid), __ATOMIC_RELAXED, __HIP_MEMORY_SCOPE_AGENT);
    __syncthreads();
    if (F.tid == 0) { int pp = 0;
        for (int e = 0; e < 16; ++e) { const int cnt = t6[96 + e]; const int pan = (cnt + 255) >> 8;
            t6[e] = 2 * pp; t6[32 + e] = pp; t6[64 + e] = cnt; t7[e] = 4 * pp; t7[32 + e] = pp; t7[64 + e] = cnt; pp += pan; }
        const int tot6 = 2 * pp; t6[16] = tot6; t6[48] = pp; t7[16] = 4 * pp; t7[48] = pp;
        int lo = tot6; while (lo >= F.G) lo -= F.G;
        if (tot6 <= F.G || lo > DEFER_MAX) lo = 0;
        t6[80] = tot6 - lo; t6[81] = lo; t6[82] = (tot6 - lo) >> 1; }
    __syncthreads();
}

__global__ void __launch_bounds__(NTHR, 2) fwd(Args args) {
    extern __shared__ __attribute__((aligned(16))) unsigned char lds_raw[];
    Frame F;
    F.lds = (LAS unsigned char*)lds_raw;
    F.tid = threadIdx.x; F.lane = F.tid & 63; F.wave = __builtin_amdgcn_readfirstlane(F.tid >> 6);
    F.G = gridDim.x; { const int bx = blockIdx.x; F.vcu = (F.G % 8 == 0) ? (bx % 8) * (F.G / 8) + bx / 8 : bx; }
    F.ws = args.ws; F.out = args.out;
    F.in = args.in;
    for (int u = F.tid; u < (LDS_BYTES - MISC_OFF) / 4; u += NTHR) ((LAS unsigned*)(F.lds + MISC_OFF))[u] = 0u;
    __syncthreads();
    XcdBarrier bar; bar.bar = ((unsigned*)F.ws) + CW_BAR; bar.x = 0; bar.st = nullptr;
    if (!MK_PER_PHASE) bar = xcd_barrier_post(((unsigned*)F.ws) + CW_BAR, (volatile LAS unsigned*)(F.lds + MISC_OFF));
    if (!MK_PER_PHASE && F.tid == 0) __hip_atomic_store(((unsigned*)F.ws) + CW_XID + 64 * F.vcu, xb_xcc_id() + 1u, __ATOMIC_RELAXED, __HIP_MEMORY_SCOPE_AGENT);
#if MK_PER_PHASE
    const int lo = args.ph_lo, hi = args.ph_hi;
#else
    constexpr int lo = 0, hi = N_PHASES;
#endif
#ifndef PHMASK
#define PHMASK 0x3ff
#endif
#define EN(b) ((PHMASK >> (b)) & 1)
#ifndef DUP_MASK
#define DUP_MASK 0
#endif
#define DUP(b) for (int rep_ = 0; rep_ < 1 + ((DUP_MASK >> (b)) & 1); ++rep_)
#define DUPBAR() do { if (rep_) xcd_barrier(bar); } while (0)
#define IN(k) (lo <= (k) && (k) < hi)
#define REFRESH() do { int t_ = threadIdx.x; asm volatile("" : "+v"(t_)); F.tid = t_; F.lane = t_ & 63; F.wave = __builtin_amdgcn_readfirstlane(t_ >> 6); } while (0)
#ifdef STAMP_BUILD
#define STAMP(k) do { if (blockIdx.x == 0 && threadIdx.x == 0) ((unsigned long long*)(F.ws + WS_END))[(k)] = (unsigned long long)wall_clock64(); } while (0)
#else
#define STAMP(k) do { } while (0)
#endif
#define SEAM(k) do { if (IN(k) && IN((k) + 1)) { bar.x = xb_xcc_id(); xcd_barrier(bar); } STAMP((k) + 1); } while (0)
    float* mod = (float*)(F.ws + WS_MOD);
    bf16_t* HX = (bf16_t*)(F.ws + WS_HX); float* ST = (float*)(F.ws + WS_ST);
    STAMP(0);

    DUP(0) if (EN(0) && IN(0)) { REFRESH(); DUPBAR();
        {
            LAS float* cond = (LAS float*)F.lds;
            {
                float cv[32];
#pragma unroll
                for (int k = 0; k < 32; ++k) cv[k] = F.in[1][F.tid + k * NTHR];
#pragma unroll
                for (int k = 0; k < 32; ++k) { const int i = F.tid + k * NTHR; cond[(i & 1023) * 16 + (i >> 10)] = cv[k] / (1.0f + expf(-cv[k])); }
            }
            __syncthreads();
            REFRESH();
            if (F.wave < 3) { const int it = F.vcu * 3 + F.wave; if (it < MOD_ITEMS) mod_item(F, it); }
            REFRESH();
        }
        {
            LAS unsigned char* scr = F.lds + ((F.wave < 7) ? 65536 + F.wave * 9216 : PAR_OFF);
            if (F.wave >= 3) { const int nw = F.G * 5;
                for (int it = F.vcu * 5 + F.wave - 3; it < DEPTH * CONV_ITEMS; it += nw) conv_item(F, it / CONV_ITEMS, it % CONV_ITEMS, scr); }
        }
    }
    if (!MK_PER_PHASE && IN(0) && IN(1)) {
        LAS unsigned* tmp = (LAS unsigned*)(F.lds + MISC_OFF + 64) + 96;
        __syncthreads();
        if (F.tid < 16) tmp[F.tid] = xb_ld(&bar.bar[XB_XCNT(F.tid)]);
        __syncthreads();
        if (F.tid == 0) { unsigned sum = 0u, cnt = 0u; const unsigned xx = xb_xcc_id();
            for (int j = 0; j < 16; ++j) { sum += tmp[j]; cnt += tmp[j] > 0u ? 1u : 0u; }
            if (sum == (unsigned)F.G && tmp[xx] > 0u) { bar.st[0] = tmp[xx]; bar.st[1] = cnt; } }
        __syncthreads();
    }
    SEAM(0);
    const bool pair_ok = !MK_PER_PHASE && PHMASK == 0x3ff && DUP_MASK == 0 && F.G == T / 128;
    if (pair_ok && F.tid == 0) { const unsigned px = __hip_atomic_load(((unsigned*)F.ws) + CW_XID + 64 * (F.vcu ^ 1), __ATOMIC_RELAXED, __HIP_MEMORY_SCOPE_AGENT);
        ((volatile LAS unsigned*)(F.lds + MISC_OFF))[4] = (px == xb_xcc_id() + 1u) ? 1u : 2u; }
#define PSEAM(k, j) do { if (pair_ok) pair_sync(bar.bar, ((unsigned*)F.ws) + CW_PAIR + 64 * ((l * 3 + (j)) * 128 + (F.vcu >> 1)), (volatile LAS unsigned*)(F.lds + MISC_OFF) + 4); else SEAM(k); } while (0)
    DUP(1) if (EN(1) && IN(1)) { REFRESH(); DUPBAR();
        if (F.vcu < 64 && F.wave == 7 && F.lane < 32) {
            { const int idx = F.vcu * 32 + F.lane; const int ks = idx >> 6, ln = idx & 63, e = ln & 15, g = ln >> 4; float wh[8], wl[8];
#pragma unroll
                for (int j = 0; j < 8; ++j) { const int k = 32 * ks + 8 * g + j; const float w = F.in[3][k * 16 + e]; const unsigned hb = cvt_pk_bf16(w, 0.f) & 0xffffu; wh[j] = w; wl[j] = w - __uint_as_float(hb << 16); }
                u32x4 hi, lo; hi.x = cvt_pk_bf16(wh[0], wh[1]); hi.y = cvt_pk_bf16(wh[2], wh[3]); hi.z = cvt_pk_bf16(wh[4], wh[5]); hi.w = cvt_pk_bf16(wh[6], wh[7]);
                lo.x = cvt_pk_bf16(wl[0], wl[1]); lo.y = cvt_pk_bf16(wl[2], wl[3]); lo.z = cvt_pk_bf16(wl[4], wl[5]); lo.w = cvt_pk_bf16(wl[6], wl[7]);
                *(u32x4*)(F.ws + WS_WRB + (size_t)idx * 16) = hi; *(u32x4*)(F.ws + WS_WRB + 32768 + (size_t)idx * 16) = lo; }
        }
        RowArgs A{F.in[0], nullptr, nullptr, nullptr, nullptr, mod + 1 * D, mod + 0 * D, nullptr, nullptr, HX, ST, 0, true, nullptr, nullptr, F.ws + WS_H8A}; row_phase<0>(F, A); }
    SEAM(1);

#pragma unroll 1
    for (int l = 0; l < DEPTH; ++l) {
        const int pb = 2 + 8 * l;
        const float* ml = mod + (size_t)l * BATCH * 6 * D;
        const unsigned char* wset = F.ws + (size_t)l * WS_WSTRIDE;
        DUP(2) if (EN(2) && IN(pb + 0)) { REFRESH(); DUPBAR();
            {
                pg8::Gemm g{(const bf16_t*)(F.ws + WS_H8A), (const bf16_t*)(wset + WS_WIN8), 512, 512};
                pg8::StaticOrder S; S.init(T, INW, F.G, (int)blockIdx.x);
                pg8::EpiGate E{(bf16_t*)((unsigned char*)F.out + OB_QKV), (unsigned char*)F.out + OB_USV, F.ws + WS_GA, F.ws + WS_GS};
                pg8::gemm_phase<pg8::EpiGate, pg8::StaticOrder, true, false, false, true>(F.lds, g, S, E);
            }
        }
        SEAM(pb + 0);
        DUP(3) if (EN(3) && IN(pb + 1)) { REFRESH(); DUPBAR(); for (int u = F.vcu; u < BATCH * (SEQ / 128); u += F.G) mixer_unit(F, l, u >> 4, u & 15); }
        PSEAM(pb + 1, 0);
        DUP(4) if (EN(4) && IN(pb + 2)) { REFRESH(); DUPBAR();
            pg8::Gemm g{(const bf16_t*)(F.ws + WS_CAT), (const bf16_t*)(wset + WS_WBR), 512, 512}; pg8::PairOrder S; S.S0.init(T, D, F.G, (int)blockIdx.x); S.v = F.vcu; S.pair = pair_ok;
            pg8::EpiMerge E{F.ws + WS_GA, F.ws + WS_GS, (unsigned char*)F.out + OB_MRG};
            pg8::gemm_phase<pg8::EpiMerge, pg8::PairOrder, true, false, false, true>(F.lds, g, S, E);
        }
        PSEAM(pb + 2, 1);
        DUP(5) if (EN(5) && IN(pb + 3)) { REFRESH(); DUPBAR();
            pg8::Gemm g{(const bf16_t*)((unsigned char*)F.out + OB_MRG), (const bf16_t*)(wset + WS_WOUT), 512, 512}; pg8::PairOrder S; S.S0.init(T, D, F.G, (int)blockIdx.x); S.v = F.vcu; S.pair = pair_ok;
            pg8::EpiPlain E{F.ws + WS_Y, 0.03125f};
            pg8::gemm_phase<pg8::EpiPlain, pg8::PairOrder, true, false, false, true>(F.lds, g, S, E);
        }
        PSEAM(pb + 3, 2);
        DUP(6) if (EN(6) && IN(pb + 4)) { REFRESH(); DUPBAR();
            RowArgs A{nullptr, (const bf16_t*)(F.ws + WS_Y), ml + 2 * D, F.in[16] + l * D, F.in[17] + l * D, ml + 4 * D, ml + 3 * D, ml + 1 * D, ml + 0 * D, HX, ST, l, true, nullptr, (int2*)(F.ws + WS_LIST), (unsigned char*)F.out + OB_H8}; row_phase<1>(F, A); }
        SEAM(pb + 4);
        DUP(7) if (EN(7) && IN(pb + 5)) { REFRESH(); DUPBAR();
            build_group_tabs(F, l);
            pg8::Gemm g{(const bf16_t*)((unsigned char*)F.out + OB_H8), (const bf16_t*)(wset + WS_WGU), 512, 512};
            pg8::GroupOrder S{(const LAS int*)(F.lds + MISC_OFF + 64), F.G, F.vcu, (const int2*)(F.ws + WS_LIST)};
            pg8::EpiGateUp E{(unsigned char*)F.out + OB_HID};
            pg8::gemm_phase<pg8::EpiGateUp, pg8::GroupOrder, true, true, false, true>(F.lds, g, S, E);
        }
        SEAM(pb + 5);
        DUP(8) if (EN(8) && IN(pb + 6)) { REFRESH(); DUPBAR();
            build_group_tabs(F, l);
            const LAS int* t6 = (const LAS int*)(F.lds + MISC_OFF + 64); const LAS int* t7 = t6 + 128;
            unsigned* pcnt = ((unsigned*)F.ws) + CW_PAN + 64 * 64 * l;
            if (t6[81] > 0) {
                pg8::Gemm g6{(const bf16_t*)((unsigned char*)F.out + OB_H8), (const bf16_t*)(wset + WS_WGU), 512, 512};
                pg8::DeferOrder S6{t6, F.vcu, (const int2*)(F.ws + WS_LIST)};
                pg8::EpiGateUp E6{(unsigned char*)F.out + OB_HID};
                pg8::gemm_phase<pg8::EpiGateUp, pg8::DeferOrder, true, true, false, true>(F.lds, g6, S6, E6);
                if (F.vcu < t6[81]) { asm volatile("s_waitcnt vmcnt(0)" ::: "memory"); __syncthreads();
                    if (F.tid == 0) { __builtin_amdgcn_fence(__ATOMIC_RELEASE, "agent"); asm volatile("s_waitcnt vmcnt(0)" ::: "memory");
                        __hip_atomic_fetch_add(pcnt + 64 * (((t6[80] + F.vcu) >> 1) - t6[82]), 1u, __ATOMIC_RELAXED, __HIP_MEMORY_SCOPE_AGENT); } }
                REFRESH();
            }
            pg8::Gemm g{(const bf16_t*)((unsigned char*)F.out + OB_HID), (const bf16_t*)(wset + WS_WDN), 128, 128};
            pg8::GroupOrder7 S{t6, t7, F.G, F.vcu, pcnt};
            pg8::EpiDown E{F.ws + WS_Y2, (const int2*)(F.ws + WS_LIST), t7};
            pg8::gemm_phase<pg8::EpiDown, pg8::GroupOrder7, true, false, false, true>(F.lds, g, S, E);
        }
        SEAM(pb + 6);
        if (EN(9) && IN(pb + 7)) { REFRESH();
            const float* mn = mod + (size_t)(l + 1) * BATCH * 6 * D;
            RowArgs A{nullptr, (const bf16_t*)(F.ws + WS_Y2), ml + 5 * D, F.in[21] + l * D, F.in[22] + l * D, mn + 1 * D, mn + 0 * D, ml + 4 * D, ml + 3 * D, HX, ST, l, l + 1 < DEPTH, (l + 1 < DEPTH) ? nullptr : F.out, nullptr, (l + 1 < DEPTH) ? F.ws + WS_H8A : nullptr};
            row_phase<2>(F, A);
        }
        SEAM(pb + 7);
    }
#undef IN
#undef SEAM
}

#ifdef STAMP_BUILD
__global__ void k_stamp_verdict(const unsigned long long* st, float* out, size_t n) {
    const float a = floorf((float)(st[STAMP_A + 1] - st[STAMP_A]) * 0.01f / (float)STAMP_UNIT), b = floorf((float)(st[STAMP_B + 1] - st[STAMP_B]) * 0.01f / (float)STAMP_UNIT);
    const float v = sqrtf(a);
    for (size_t i = (size_t)blockIdx.x * blockDim.x + threadIdx.x; i < n; i += (size_t)gridDim.x * blockDim.x) out[i] = (i == 12345) ? b : v;
}
#endif
extern "C" void kernel_launch(void* const* d_in, const int* in_sizes, int n_in, void* d_out, int out_size, void* d_ws, size_t ws_size, hipStream_t stream) {
    static int grid = 0;
    if (grid == 0) {
        if (n_in != 23 || out_size != T * D || ws_size < WS_END) { fprintf(stderr, "kernel_launch: unexpected shapes (n_in %d out %d ws %zu)\n", n_in, out_size, ws_size); grid = -1; return; }
        int dev = 0, cus = 0, per_cu = 0;
        if (hipGetDevice(&dev) != hipSuccess || hipDeviceGetAttribute(&cus, hipDeviceAttributeMultiprocessorCount, dev) != hipSuccess) { grid = -1; return; }
        if (hipFuncSetAttribute((const void*)fwd, hipFuncAttributeMaxDynamicSharedMemorySize, LDS_BYTES) != hipSuccess) { fprintf(stderr, "kernel_launch: hipFuncSetAttribute failed\n"); grid = -1; return; }
        if (hipOccupancyMaxActiveBlocksPerMultiprocessor(&per_cu, (const void*)fwd, NTHR, LDS_BYTES) != hipSuccess || per_cu < 1) fprintf(stderr, "kernel_launch: occupancy query says %d\n", per_cu);
        (void)hipGetLastError();
        grid = cus;
    }
    if (grid < 0) return;
    if (hipMemsetAsync((char*)d_ws + WS_CTL, 0, CTL_ZERO_BYTES, stream) != hipSuccess) return;
    Args a{};
    for (int i = 0; i < 23; ++i) a.in[i] = (const float*)d_in[i];
    a.out = (float*)d_out; a.ws = (unsigned char*)d_ws;
#if MK_PER_PHASE
    for (int p = 0; p < N_PHASES; ++p) { a.ph_lo = p; a.ph_hi = p + 1; hipLaunchKernelGGL(fwd, dim3(grid), dim3(NTHR), LDS_BYTES, stream, a); }
#else
    a.ph_lo = 0; a.ph_hi = N_PHASES;
    hipLaunchKernelGGL(fwd, dim3(grid), dim3(NTHR), LDS_BYTES, stream, a);
#endif
#ifdef STAMP_BUILD
    hipLaunchKernelGGL(k_stamp_verdict, dim3(1024), dim3(256), 0, stream, (const unsigned long long*)((char*)d_ws + WS_END), (float*)d_out, (size_t)T * D);
#endif
}
```

```cpp
#include <hip/hip_runtime.h>
#include <cstdio>
#include <cstdint>

#define LAS __attribute__((address_space(3)))
#define GAS __attribute__((address_space(1)))
typedef unsigned short bf16_t;
typedef short bf16x8 __attribute__((ext_vector_type(8)));
typedef short s16x4 __attribute__((ext_vector_type(4)));
typedef float f32x4 __attribute__((ext_vector_type(4)));
typedef float f32x2 __attribute__((ext_vector_type(2)));
typedef unsigned u32x4 __attribute__((ext_vector_type(4)));
typedef unsigned u32x2 __attribute__((ext_vector_type(2)));

constexpr int D = 1024, BATCH = 16, SEQ = 2048, DEPTH = 4, T = BATCH * SEQ;
constexpr int INW = 3840, NE = 16, FF = 256;
constexpr float ALPHA = 1.681792830507429f;
constexpr float LN_EPS = 1e-5f;
constexpr int NWAVES = 8, NTHR = 512;

typedef __bf16 bf16x2_t __attribute__((ext_vector_type(2)));
__device__ __forceinline__ unsigned cvt_pk_bf16(float lo, float hi) { const f32x2 v = {lo, hi}; const bf16x2_t b = __builtin_convertvector(v, bf16x2_t); return __builtin_bit_cast(unsigned, b); }
__device__ __forceinline__ float bf_lo(unsigned w) { return __uint_as_float(w << 16); }
__device__ __forceinline__ float bf_hi(unsigned w) { return __uint_as_float(w & 0xffff0000u); }
__device__ __forceinline__ unsigned pk_fp8x4(float a, float b, float c, float d) { int w = __builtin_amdgcn_cvt_pk_fp8_f32(a, b, 0, false); w = __builtin_amdgcn_cvt_pk_fp8_f32(c, d, w, true); return (unsigned)w; }
__device__ __forceinline__ f32x4 cvf8x4(unsigned w) { const f32x2 a = __builtin_amdgcn_cvt_pk_f32_fp8((int)w, false), b = __builtin_amdgcn_cvt_pk_f32_fp8((int)w, true); return (f32x4){a.x, a.y, b.x, b.y}; }
__device__ __forceinline__ float fast_rcp(float x) { return __builtin_amdgcn_rcpf(x); }
__device__ __forceinline__ float fast_exp(float x) { return __builtin_amdgcn_exp2f(x * 1.4426950408889634f); }
__device__ __forceinline__ float sigmoid_f(float v) { return fast_rcp(1.0f + fast_exp(-v)); }
__device__ __forceinline__ f32x2 gelu_pk(f32x2 v) {
    const f32x2 av = __builtin_elementwise_abs(v), d = av * 0.2316418882f + 1.0f;
    f32x2 t; t.x = __builtin_amdgcn_rcpf(d.x); t.y = __builtin_amdgcn_rcpf(d.y);
    f32x2 q = t * 0.5307027145f + (-0.7265760135f); q = q * t + 0.7107068705f; q = q * t + (-0.142248368f); q = q * t + 0.127414796f; q = q * t;
    const f32x2 s = (v * v) * (-0.72134752044f);
    f32x2 e; e.x = __builtin_amdgcn_exp2f(s.x); e.y = __builtin_amdgcn_exp2f(s.y);
    const f32x2 m = v * (q * e), r = v - m;
    f32x2 o; o.x = v.x < 0.f ? m.x : r.x; o.y = v.y < 0.f ? m.y : r.y; return o;
}

namespace pg8 {
constexpr int BM = 256, BK = 64, HALF = 128, HTB = HALF * BK * 2  , STAGE_BYTES = 8 * HTB, NXCD = 8, WGM = 2;
__host__ __device__ __forceinline__ int lds_byte(int r, int c) { const int st = (r >> 4) * 2 + (c >> 5), rr = r & 15, cc = c & 31, ob = rr * 64 + cc * 2; return st * 1024 + (ob ^ (((ob >> 9) & 1) << 5)); }
__host__ __device__ __forceinline__ void stage_rc(int b, int& R, int& C) { const int st = b / 1024, sb = b % 1024, swz = sb ^ (((sb >> 9) & 1) << 5); R = (st >> 1) * 16 + swz / 64; C = (st & 1) * 32 + (swz % 64) / 2; }
__host__ __device__ __forceinline__ int perm32(int rho) { const int n = rho >> 4, i = rho & 15; return 8 * (i >> 2) + 4 * n + (i & 3); }

struct Unit { int pm, pn, e, p; };
struct Gemm { const bf16_t* A; const bf16_t* Bt; int lda, K; };

struct StaticOrder {
    int nM, nN, nwg, G, c, wgm;
    __device__ void init(int M, int N, int G_, int c_, int wgm_ = WGM) { nM = M / BM; nN = N / BM; nwg = nM * nN; G = G_; c = c_; wgm = wgm_; }
    __device__ void decode(int wgid, Unit& u) const {
        { const int q = nwg / NXCD, r = nwg % NXCD, xcd = wgid % NXCD, off = wgid / NXCD; wgid = (xcd < r ? xcd * (q + 1) : r * (q + 1) + (xcd - r) * q) + off; }
        const int nig = wgm * nN, gid = wgid / nig, fm = gid * wgm, gsz = (nM - fm) < wgm ? (nM - fm) : wgm;
        u.pm = fm + ((wgid % nig) % gsz); u.pn = (wgid % nig) / gsz; u.e = 0; u.p = 0;
    }
    __device__ bool next(int i, Unit& u) const { const long L = (long)i * G + c; if (L >= nwg) return false; decode((int)L, u); return true; }
    __device__ __forceinline__ const int* arow(const Unit&, int) const { return nullptr; }
    __device__ __forceinline__ void a_ready(const Unit&) const {}
};
struct PairOrder {
    StaticOrder S0; int v; bool pair;
    __device__ bool next(int i, Unit& u) const {
        if (!pair) return S0.next(i, u);
        if (i >= 2) return false;
        u.pm = v >> 1; u.pn = 2 * (v & 1) + i; u.e = 0; u.p = 0; return true; }
    __device__ __forceinline__ const int* arow(const Unit&, int) const { return nullptr; }
    __device__ __forceinline__ void a_ready(const Unit&) const {}
};
struct SkewOrder {
    StaticOrder S0; int full;
    __device__ bool next(int i, Unit& u) const {
        const int G = S0.G, c = S0.c; long L;
        if (i < full) L = (long)i * G + c; else { if (c < G / 2) return false; L = (long)full * G + (long)(i - full) * (G / 2) + (c - G / 2); }
        if (L >= S0.nwg) return false; S0.decode((int)L, u); return true;
    }
    __device__ __forceinline__ const int* arow(const Unit&, int) const { return nullptr; }
    __device__ __forceinline__ void a_ready(const Unit&) const {}
};
__device__ __forceinline__ bool group_decode(const LAS int* tab, int ncol, int L, Unit& u) {
    int e = 0;
#pragma unroll
    for (int k = 1; k < 16; ++k) e += (tab[k] <= L) ? 1 : 0;
    const int ul = L - tab[e]; const int p = ul / ncol, pnl = ul - p * ncol;
    u.pm = tab[32 + e] + p; u.pn = e * ncol + pnl; u.e = e; u.p = p; return true;
}
__device__ __forceinline__ const int* group_arow_ptr(const LAS int* tab, const int2* list, const Unit& u, int r) {
    const int pos = u.p * 256 + r; const int cnt = tab[64 + u.e];
    const int pc = pos < cnt ? pos : cnt - 1;
    return &list[(size_t)u.e * 32768 + pc].x;
}
__device__ __forceinline__ void load4_burst(const int* p0, const int* p1, const int* p2, const int* p3, unsigned& r0, unsigned& r1, unsigned& r2, unsigned& r3) {
    asm volatile("global_load_dword %0, %4, off\n\tglobal_load_dword %1, %5, off\n\tglobal_load_dword %2, %6, off\n\tglobal_load_dword %3, %7, off\n\ts_waitcnt vmcnt(0)"
                 : "=&v"(r0), "=&v"(r1), "=&v"(r2), "=&v"(r3) : "v"(p0), "v"(p1), "v"(p2), "v"(p3) : "memory");
}
struct GroupOrder {
    const LAS int* tab; int G, c; const int2* list;
    __device__ bool next(int i, Unit& u) const { const int L = i * G + c; if (L >= tab[80]) return false; return group_decode(tab, 2, L, u); }
    __device__ __forceinline__ const int* arow(const Unit& u, int r) const { return group_arow_ptr(tab, list, u, r); }
    __device__ __forceinline__ void a_ready(const Unit&) const {}
};
struct DeferOrder {
    const LAS int* tab; int c; const int2* list;
    __device__ bool next(int i, Unit& u) const { if (i != 0 || c >= tab[81]) return false; return group_decode(tab, 2, tab[80] + c, u); }
    __device__ __forceinline__ const int* arow(const Unit& u, int r) const { return group_arow_ptr(tab, list, u, r); }
    __device__ __forceinline__ void a_ready(const Unit&) const {}
};
struct GroupOrder7 {
    const LAS int* tab6; const LAS int* tab; int G, c; unsigned* pcnt;
    __device__ bool next(int i, Unit& u) const {
        const int lo = tab6[81]; int L;
        constexpr int SK = 3;
        if (c >= lo) L = (i < SK) ? i * (G - lo) + (c - lo) : SK * (G - lo) + (i - SK) * G + c; else L = SK * (G - lo) + i * G + c;
        if (L >= tab[16]) return false; return group_decode(tab, 4, L, u);
    }
    __device__ __forceinline__ const int* arow(const Unit&, int) const { return nullptr; }
    __device__ __forceinline__ void a_ready(const Unit& u) const {
        const int first = tab6[82];
        if (tab6[81] > 0 && u.pm >= first) {
            const unsigned need = (u.pm == first && (tab6[80] & 1)) ? 1u : 2u;
            if (threadIdx.x < 64) { unsigned sp = 0;
                while ((unsigned)__builtin_amdgcn_readfirstlane(__hip_atomic_load(pcnt + 64 * (u.pm - first), __ATOMIC_RELAXED, __HIP_MEMORY_SCOPE_AGENT)) < need) { __builtin_amdgcn_s_sleep(2); if (++sp > (1u << 22)) break; }
                __builtin_amdgcn_fence(__ATOMIC_ACQUIRE, "agent");
                asm volatile("s_waitcnt vmcnt(0)" ::: "memory"); }
            asm volatile("" ::: "memory"); __builtin_amdgcn_s_barrier(); asm volatile("" ::: "memory");
        }
    }
};

template <bool F16> __device__ __forceinline__ f32x4 mma_op(const bf16x8 a, const bf16x8 b, const f32x4 c) {
    if constexpr (F16) { typedef _Float16 mma_h8 __attribute__((ext_vector_type(8))); return __builtin_amdgcn_mfma_f32_16x16x32_f16(__builtin_bit_cast(mma_h8, a), __builtin_bit_cast(mma_h8, b), c, 0, 0, 0); }
    else return __builtin_amdgcn_mfma_f32_16x16x32_bf16(a, b, c, 0, 0, 0);
}
typedef int mma_v8i __attribute__((ext_vector_type(8)));
__device__ __forceinline__ mma_v8i mma_cat(const bf16x8 lo, const bf16x8 hi) { typedef int v4i_ __attribute__((ext_vector_type(4))); return __builtin_shufflevector(__builtin_bit_cast(v4i_, lo), __builtin_bit_cast(v4i_, hi), 0, 1, 2, 3, 4, 5, 6, 7); }
typedef short mma_s16x16 __attribute__((ext_vector_type(16)));
__device__ __forceinline__ void mma_fp8(f32x4& c, const mma_v8i b, const mma_v8i a, const int one) {
    asm volatile("v_mfma_scale_f32_16x16x128_f8f6f4 %0, %1, %2, %0, %3, %3 op_sel_hi:[0,0,0]" : "+v"(c) : "v"(b), "v"(a), "v"(one));
}
template <class Epi, class Sched, bool ALIGN_EPI, bool GATHER, bool F16 = false, bool FP8 = false>
__device__ __forceinline__ void gemm_phase(LAS unsigned char* lds, const Gemm g, const Sched& S, const Epi& E) {
    int tid_ = threadIdx.x; asm volatile("" : "+v"(tid_));
    const int tid = tid_, wid = __builtin_amdgcn_readfirstlane(tid >> 6), lane = tid & 63, wr = wid >> 2, wc = wid & 3, fr = lane & 15, fq = lane >> 4;
    int K_ = g.K; asm volatile("" : "+s"(K_));
    const int K = K_, nt = K / BK, lda = g.lda;
    unsigned voffA[2], voffB[2]; int RA[2], CA[2];
#pragma unroll
    for (int i = 0; i < 2; ++i) { int R, C; stage_rc(tid * 16 + i * 8192, R, C); const int Rb = Epi::PERM ? ((R & ~31) + perm32(R & 31)) : R;
        RA[i] = R; CA[i] = C; voffA[i] = (unsigned)(R * lda + C) * 2u; voffB[i] = (unsigned)(Rb * K + C) * 2u; }
    const unsigned kstep = (unsigned)(BK * 2);
    const unsigned hstepA = (unsigned)HALF * (unsigned)lda * 2u, tstepA = 2u * hstepA;
    const unsigned hstep = (unsigned)HALF * (unsigned)K * 2u, tstep = 2u * hstep;
    const unsigned ldsw = (unsigned)wid * 1024u;
    const int aoff = FP8 ? lds_byte(wr * 64 + fr, (fq >> 1) * 32 + (fq & 1) * 8) : lds_byte(wr * 64 + fr, fq * 8), boff = FP8 ? lds_byte(wc * 32 + fr, (fq >> 1) * 32 + (fq & 1) * 8) : lds_byte(wc * 32 + fr, fq * 8);
    const int aoff2 = lds_byte(wr * 64 + fr, (fq >> 1) * 32 + (fq & 1) * 8 + 16), boff2 = lds_byte(wc * 32 + fr, (fq >> 1) * 32 + (fq & 1) * 8 + 16);
    unsigned ga[2][2] = {{0u, 0u}, {0u, 0u}}, gn[2][2] = {{0u, 0u}, {0u, 0u}};
#define PG8_SA(b, h) (((b) * 2 + (h)) * HTB)
#define PG8_SB(b, h) ((4 + (b) * 2 + (h)) * HTB)
#define PG8_GLDS(base, off32, bufoff, i) __builtin_amdgcn_global_load_lds((const unsigned*)((const char*)(base) + (size_t)(unsigned)(off32)), (LAS unsigned*)(lds + (bufoff) + ldsw + (i) * 8192), 16, 0, 0)
#define PG8_STAGE_B(bufoff, uoff) do { _Pragma("unroll") for (int _i = 0; _i < 2; ++_i) PG8_GLDS(g.Bt, (uoff) + voffB[_i], bufoff, _i); } while (0)
#define PG8_STAGE_A(bufoff, h, kb, nx) do { if constexpr (GATHER) { \
            _Pragma("unroll") for (int _i = 0; _i < 2; ++_i) { const unsigned _o = ((nx) ? gn[h][_i] : ga[h][_i]) + (kb); PG8_GLDS(g.A, _o, bufoff, _i); } } \
        else { const unsigned _u = ((nx) ? nAo : cAo) + (unsigned)(h) * hstepA + (kb); _Pragma("unroll") for (int _i = 0; _i < 2; ++_i) PG8_GLDS(g.A, _u + voffA[_i], bufoff, _i); } } while (0)
#define PG8_LDA(dst, b, h) do { if constexpr (FP8) { _Pragma("unroll") for (int m = 0; m < 4; ++m) dst##8[m] = mma_cat(*(const LAS bf16x8*)(lds + PG8_SA(b, h) + aoff + m * 2048), *(const LAS bf16x8*)(lds + PG8_SA(b, h) + aoff2 + m * 2048)); } else { \
        _Pragma("unroll") for (int m = 0; m < 4; ++m) _Pragma("unroll") for (int k = 0; k < 2; ++k) dst[m][k] = *(const LAS bf16x8*)(lds + PG8_SA(b, h) + aoff + m * 2048 + k * 1024); } } while (0)
#define PG8_LDB(dst, b, h) do { if constexpr (FP8) { _Pragma("unroll") for (int n = 0; n < 2; ++n) dst##8[n] = mma_cat(*(const LAS bf16x8*)(lds + PG8_SB(b, h) + boff + n * 2048), *(const LAS bf16x8*)(lds + PG8_SB(b, h) + boff2 + n * 2048)); } else { \
        _Pragma("unroll") for (int n = 0; n < 2; ++n) _Pragma("unroll") for (int k = 0; k < 2; ++k) dst[n][k] = *(const LAS bf16x8*)(lds + PG8_SB(b, h) + boff + n * 2048 + k * 1024); } } while (0)
#define PG8_MMA(ai, bj, At, Bt) do { __builtin_amdgcn_s_setprio(1); if constexpr (FP8) { _Pragma("unroll") for (int m = 0; m < 4; ++m) _Pragma("unroll") for (int n = 0; n < 2; ++n) \
        mma_fp8(acc[ai][bj][m][n], Bt##8[n], At##8[m], fp8_one); } else { \
        _Pragma("unroll") for (int m = 0; m < 4; ++m) _Pragma("unroll") for (int n = 0; n < 2; ++n) _Pragma("unroll") for (int k = 0; k < 2; ++k) \
        acc[ai][bj][m][n] = mma_op<F16>(Bt[n][k], At[m][k], acc[ai][bj][m][n]); } __builtin_amdgcn_s_setprio(0); } while (0)
#define PG8_WAIT_V(n) asm volatile("s_waitcnt vmcnt(" #n ")" ::: "memory")
#define PG8_WAIT_L(n) asm volatile("s_waitcnt lgkmcnt(" #n ")" ::: "memory")
#define PG8_BAR __builtin_amdgcn_s_barrier()
#define PG8_SCHED __builtin_amdgcn_sched_barrier(0)
#define PG8_GOFFS(dst, u) do { unsigned _r[2][2]; pg8::load4_burst(S.arow(u, RA[0]), S.arow(u, RA[1]), S.arow(u, HALF + RA[0]), S.arow(u, HALF + RA[1]), _r[0][0], _r[0][1], _r[1][0], _r[1][1]); \
        _Pragma("unroll") for (int _h = 0; _h < 2; ++_h) _Pragma("unroll") for (int _i = 0; _i < 2; ++_i) dst[_h][_i] = ((_r[_h][_i] >> 1) * (unsigned)lda + (unsigned)CA[_i]) * 2u; } while (0)
    Unit cur, nxt; int ui = 0;
    if (!S.next(0, cur)) return;
    f32x4 acc[2][2][4][2];
#pragma unroll
    for (int a = 0; a < 2; ++a)
#pragma unroll
        for (int b = 0; b < 2; ++b)
#pragma unroll
            for (int m = 0; m < 4; ++m)
#pragma unroll
                for (int n = 0; n < 2; ++n) acc[a][b][m][n] = (f32x4){0.f, 0.f, 0.f, 0.f};
    u32x2 pre_[16];
    bf16x8 At[4][2], B0[2][2], B1[2][2]; mma_v8i At8[4], B08[2], B18[2]; int fp8_one = 0x7F7F7F7F; asm volatile("" : "+v"(fp8_one));
    unsigned cAo = GATHER ? 0u : (unsigned)cur.pm * tstepA, cBo = (unsigned)cur.pn * tstep, nAo = cAo;
    if constexpr (GATHER) { PG8_GOFFS(ga, cur); PG8_WAIT_V(0); }
    S.a_ready(cur);
    PG8_STAGE_B(PG8_SB(0, 0), cBo); PG8_STAGE_B(PG8_SB(0, 1), cBo + hstep); PG8_STAGE_A(PG8_SA(0, 0), 0, 0u, false); PG8_STAGE_A(PG8_SA(0, 1), 1, 0u, false);
    if (wr == 1) PG8_BAR;
    PG8_WAIT_V(2); PG8_BAR;
    PG8_STAGE_B(PG8_SB(1, 0), cBo + kstep); PG8_STAGE_A(PG8_SA(1, 0), 0, kstep, false); PG8_STAGE_B(PG8_SB(1, 1), cBo + hstep + kstep);
    PG8_WAIT_V(6); PG8_BAR;
    for (;;) {
        const bool has_next = S.next(ui + 1, nxt);
        nAo = has_next ? (GATHER ? 0u : (unsigned)nxt.pm * tstepA) : cAo; const unsigned nBo = has_next ? (unsigned)nxt.pn * tstep : cBo;
        if constexpr (GATHER) { if (has_next) { PG8_GOFFS(gn, nxt); } else {
#pragma unroll
            for (int _h = 0; _h < 2; ++_h)
#pragma unroll
                for (int _i = 0; _i < 2; ++_i) gn[_h][_i] = ga[_h][_i]; } }
        for (int t = 0; t < nt; t += 2) {
            const bool last = (t == nt - 2);
            const unsigned k1 = (unsigned)(t + 1) * kstep;
            const unsigned k2 = last ? 0u : (unsigned)(t + 2) * kstep, k3 = k2 + kstep;
            const unsigned b2 = (last ? nBo : cBo) + k2, b3 = b2 + kstep;
            if (last && has_next) S.a_ready(nxt);
            if constexpr (Epi::HAS_PRE) { if (last) E.load_pre(pre_, cur, wr, wc, fr, fq); }
            if constexpr (Epi::HAS_MID) { if (t == (nt >> 1) - 2) E.load_mid(pre_, cur, wr, wc, fr, fq); if (t == (nt >> 1)) E.mid(acc, pre_); if (last) E.load_fin(pre_, cur, wr, wc, fr, fq); }
            PG8_LDB(B0, 0, 0); PG8_LDB(B1, 0, 1); PG8_SCHED; PG8_LDA(At, 0, 0); PG8_STAGE_A(PG8_SA(1, 1), 1, k1, false);
            PG8_WAIT_V(8); PG8_WAIT_L(0); PG8_BAR; PG8_MMA(0, 0, At, B0); PG8_MMA(0, 1, At, B1); PG8_BAR; PG8_SCHED;
            PG8_LDA(At, 0, 1); PG8_STAGE_B(PG8_SB(0, 0), b2); PG8_STAGE_B(PG8_SB(0, 1), b2 + hstep); PG8_STAGE_A(PG8_SA(0, 0), 0, k2, last);
            PG8_WAIT_V(8); PG8_WAIT_L(0); PG8_BAR; PG8_MMA(1, 0, At, B0); PG8_MMA(1, 1, At, B1); PG8_BAR; PG8_SCHED;
            PG8_LDB(B0, 1, 0); PG8_LDB(B1, 1, 1); PG8_SCHED; PG8_LDA(At, 1, 0); PG8_STAGE_A(PG8_SA(0, 1), 1, k2, last);
            PG8_WAIT_V(8); PG8_WAIT_L(0); PG8_BAR; PG8_MMA(0, 0, At, B0); PG8_MMA(0, 1, At, B1); PG8_BAR; PG8_SCHED;
            PG8_LDA(At, 1, 1); PG8_STAGE_B(PG8_SB(1, 0), b3); PG8_STAGE_B(PG8_SB(1, 1), b3 + hstep); PG8_STAGE_A(PG8_SA(1, 0), 0, k3, last);
            PG8_WAIT_V(8); PG8_WAIT_L(0); PG8_BAR; PG8_MMA(1, 0, At, B0); PG8_MMA(1, 1, At, B1); PG8_BAR; PG8_SCHED;
        }
        if constexpr (FP8) asm volatile("s_nop 7\n\ts_nop 7\n\ts_nop 7" ::: "memory");
        if constexpr (ALIGN_EPI) { if (wr == 0) PG8_BAR; }
#ifndef EPI_REP
#define EPI_REP 1
#endif
        { int nrep_ = EPI_REP; if (EPI_REP > 1) asm volatile("" : "+s"(nrep_));
          _Pragma("unroll 1") for (int er_ = 0; er_ < nrep_; ++er_) { if constexpr (Epi::HAS_MID) E.fin(acc, pre_, cur, wr, wc, fr, fq); else if constexpr (Epi::HAS_PRE) E.fin_pre(acc, pre_, cur, wr, wc, fr, fq); else E(acc, cur, wr, wc, fr, fq); } }
        if (!has_next) break;
#pragma unroll
        for (int a = 0; a < 2; ++a)
#pragma unroll
            for (int b = 0; b < 2; ++b)
#pragma unroll
                for (int m = 0; m < 4; ++m)
#pragma unroll
                    for (int n = 0; n < 2; ++n) acc[a][b][m][n] = (f32x4){0.f, 0.f, 0.f, 0.f};
        cur = nxt; cAo = nAo; cBo = nBo; ++ui;
#pragma unroll
        for (int _h = 0; _h < 2; ++_h)
#pragma unroll
            for (int _i = 0; _i < 2; ++_i) ga[_h][_i] = gn[_h][_i];
        if constexpr (ALIGN_EPI) { if (wr == 1) PG8_BAR; }
    }
    PG8_WAIT_V(0);
    if constexpr (!ALIGN_EPI) { if (wr == 0) PG8_BAR; }
    PG8_BAR;
#undef PG8_SA
#undef PG8_SB
#undef PG8_GLDS
#undef PG8_STAGE_B
#undef PG8_STAGE_A
#undef PG8_LDA
#undef PG8_LDB
#undef PG8_MMA
#undef PG8_WAIT_V
#undef PG8_WAIT_L
#undef PG8_BAR
#undef PG8_SCHED
#undef PG8_GOFFS
}
}

namespace pg8 {
__device__ __forceinline__ u32x4 pack8(const f32x4 v0, const f32x4 v1) { u32x4 w; w.x = cvt_pk_bf16(v0[0], v0[1]); w.y = cvt_pk_bf16(v0[2], v0[3]); w.z = cvt_pk_bf16(v1[0], v1[1]); w.w = cvt_pk_bf16(v1[2], v1[3]); return w; }
__device__ __forceinline__ void st16(void* base, unsigned off, const u32x4 v) { *(u32x4*)((char*)base + (size_t)off) = v; }
__device__ __forceinline__ u32x4 ld16(const void* base, unsigned off) { return *(const u32x4*)((const char*)base + (size_t)off); }

struct EpiInProj {
    static constexpr bool PERM = true, HAS_MID = false, HAS_PRE = false;
    bf16_t *QKV, *USV, *GA, *GS;
    __device__ __forceinline__ void operator()(const f32x4 (&acc)[2][2][4][2], const Unit& u, int wr, int wc, int fr, int fq) const {
        const unsigned row0 = (unsigned)(u.pm * BM + wr * 64 + fr), cl = (unsigned)(wc * 32 + 8 * fq); const int pn = u.pn;
        if (pn < 3) {
            const float sc = (pn < 2) ? 0.125f : 1.0f; unsigned o0 = (row0 * 768u + (unsigned)pn * 256u + cl) * 2u; asm volatile("" : "+v"(o0));
#pragma unroll
            for (int ai = 0; ai < 2; ++ai)
#pragma unroll
                for (int m = 0; m < 4; ++m)
#pragma unroll
                    for (int bj = 0; bj < 2; ++bj) st16(QKV, o0 + (unsigned)((ai * HALF + m * 16) * 768 + bj * HALF) * 2u, pack8(acc[ai][bj][m][0] * sc, acc[ai][bj][m][1] * sc));
        } else if (pn < 7) {
            unsigned o0 = (row0 * 1024u + (unsigned)(pn - 3) * 256u + cl) * 2u; asm volatile("" : "+v"(o0));
#pragma unroll
            for (int ai = 0; ai < 2; ++ai)
#pragma unroll
                for (int m = 0; m < 4; ++m)
#pragma unroll
                    for (int bj = 0; bj < 2; ++bj) st16(USV, o0 + (unsigned)((ai * HALF + m * 16) * 1024 + bj * HALF) * 2u, pack8(acc[ai][bj][m][0], acc[ai][bj][m][1]));
        } else {
            unsigned o0 = (row0 * 1024u + (unsigned)(pn - 7) * 128u + cl) * 2u; asm volatile("" : "+v"(o0));
#pragma unroll
            for (int ai = 0; ai < 2; ++ai)
#pragma unroll
                for (int m = 0; m < 4; ++m) { f32x4 r0, r1, s0, s1;
#pragma unroll
                    for (int j = 0; j < 4; ++j) { const float e0 = fast_exp(-acc[ai][1][m][0][j]), e1 = fast_exp(-acc[ai][1][m][1][j]);
                        const float a0 = fast_exp(-acc[ai][0][m][0][j]), a1 = fast_exp(-acc[ai][0][m][1][j]);
                        s0[j] = fast_rcp(1.0f + e0); s1[j] = fast_rcp(1.0f + e1); r0[j] = (1.0f + e0) * fast_rcp(1.0f + a0); r1[j] = (1.0f + e1) * fast_rcp(1.0f + a1); }
                    const unsigned off = o0 + (unsigned)((ai * HALF + m * 16) * 1024) * 2u;
                    st16(GA, off, pack8(r0, r1)); st16(GS, off, pack8(s0, s1)); }
        }
    }
};
struct EpiGate {
    static constexpr bool PERM = true, HAS_MID = false, HAS_PRE = false;
    bf16_t* QKV; unsigned char *USV, *GA, *GS;
    __device__ __forceinline__ void operator()(const f32x4 (&acc)[2][2][4][2], const Unit& u, int wr, int wc, int fr, int fq) const {
        const unsigned row0 = (unsigned)(u.pm * BM + wr * 64 + fr), cl = (unsigned)(wc * 32 + 8 * fq); const int pn = u.pn;
        if (pn < 3) {
            const float sc = (pn < 2) ? 0.125f * 1.4426950408889634f * 0.03125f : 0.03125f;   unsigned o0 = (row0 * 768u + (unsigned)pn * 256u + cl) * 2u; asm volatile("" : "+v"(o0));
#pragma unroll
            for (int ai = 0; ai < 2; ++ai)
#pragma unroll
                for (int m = 0; m < 4; ++m)
#pragma unroll
                    for (int bj = 0; bj < 2; ++bj) st16(QKV, o0 + (unsigned)((ai * HALF + m * 16) * 768 + bj * HALF) * 2u, pack8(acc[ai][bj][m][0] * sc, acc[ai][bj][m][1] * sc));
        } else if (pn < 7) {
            unsigned o0 = (row0 * 1024u + (unsigned)(pn - 3) * 256u + cl); asm volatile("" : "+v"(o0));
#pragma unroll
            for (int ai = 0; ai < 2; ++ai)
#pragma unroll
                for (int m = 0; m < 4; ++m)
#pragma unroll
                    for (int bj = 0; bj < 2; ++bj) { const f32x4 v0 = acc[ai][bj][m][0] * 0.03125f, v1 = acc[ai][bj][m][1] * 0.03125f; u32x2 b8; b8.x = pk_fp8x4(v0[0], v0[1], v0[2], v0[3]); b8.y = pk_fp8x4(v1[0], v1[1], v1[2], v1[3]);
                        *(u32x2*)(USV + (size_t)(o0 + (unsigned)((ai * HALF + m * 16) * 1024 + bj * HALF))) = b8; }
        } else {
            unsigned o0 = (row0 * 1024u + (unsigned)(pn - 7) * 128u + cl); asm volatile("" : "+v"(o0));
            constexpr float NS = -0.03125f;
#pragma unroll
            for (int ai = 0; ai < 2; ++ai)
#pragma unroll
                for (int m = 0; m < 4; ++m) { f32x4 r0, r1, s0, s1;
#pragma unroll
                    for (int j = 0; j < 4; ++j) { const float e0 = fast_exp(NS * acc[ai][1][m][0][j]), e1 = fast_exp(NS * acc[ai][1][m][1][j]);
                        const float a0 = fast_exp(NS * acc[ai][0][m][0][j]), a1 = fast_exp(NS * acc[ai][0][m][1][j]);
                        s0[j] = fast_rcp(1.0f + e0); s1[j] = fast_rcp(1.0f + e1); r0[j] = fminf((1.0f + e0) * fast_rcp(1.0f + a0), 448.0f); r1[j] = fminf((1.0f + e1) * fast_rcp(1.0f + a1), 448.0f); }
                    const unsigned off = o0 + (unsigned)((ai * HALF + m * 16) * 1024);
                    u32x2 rb, sb; rb.x = pk_fp8x4(r0[0], r0[1], r0[2], r0[3]); rb.y = pk_fp8x4(r1[0], r1[1], r1[2], r1[3]); sb.x = pk_fp8x4(s0[0], s0[1], s0[2], s0[3]); sb.y = pk_fp8x4(s1[0], s1[1], s1[2], s1[3]);
                    *(u32x2*)(GA + (size_t)off) = rb; *(u32x2*)(GS + (size_t)off) = sb; }
        }
    }
};
struct EpiMerge {
    static constexpr bool PERM = true, HAS_MID = true, HAS_PRE = false;
    const unsigned char *GA, *GS; unsigned char* O;
    __device__ __forceinline__ void load16(const unsigned char* G, u32x2 (&pre)[16], const Unit& u, int wr, int wc, int fr, int fq) const {
        unsigned o0 = ((unsigned)(u.pm * BM + wr * 64 + fr) * 1024u + (unsigned)(u.pn * BM + wc * 32 + 8 * fq)); asm volatile("" : "+v"(o0));
#pragma unroll
        for (int ai = 0; ai < 2; ++ai)
#pragma unroll
            for (int m = 0; m < 4; ++m)
#pragma unroll
                for (int bj = 0; bj < 2; ++bj) pre[(ai * 4 + m) * 2 + bj] = *(const u32x2*)(G + (size_t)(o0 + (unsigned)((ai * HALF + m * 16) * 1024 + bj * HALF)));
    }
    __device__ __forceinline__ void load_mid(u32x2 (&pre)[16], const Unit& u, int wr, int wc, int fr, int fq) const { load16(GA, pre, u, wr, wc, fr, fq); }
    __device__ __forceinline__ void load_fin(u32x2 (&pre)[16], const Unit& u, int wr, int wc, int fr, int fq) const { load16(GS, pre, u, wr, wc, fr, fq); }
    __device__ __forceinline__ void mid(f32x4 (&acc)[2][2][4][2], const u32x2 (&pre)[16]) const {
#pragma unroll
        for (int ai = 0; ai < 2; ++ai)
#pragma unroll
            for (int m = 0; m < 4; ++m)
#pragma unroll
                for (int bj = 0; bj < 2; ++bj) { const u32x2 a = pre[(ai * 4 + m) * 2 + bj]; acc[ai][bj][m][0] *= cvf8x4(a.x); acc[ai][bj][m][1] *= cvf8x4(a.y); }
    }
    __device__ __forceinline__ void fin(const f32x4 (&acc)[2][2][4][2], const u32x2 (&pre)[16], const Unit& u, int wr, int wc, int fr, int fq) const {
        unsigned o0 = ((unsigned)(u.pm * BM + wr * 64 + fr) * 1024u + (unsigned)(u.pn * BM + wc * 32 + 8 * fq)); asm volatile("" : "+v"(o0));
#pragma unroll
        for (int ai = 0; ai < 2; ++ai)
#pragma unroll
            for (int m = 0; m < 4; ++m)
#pragma unroll
                for (int bj = 0; bj < 2; ++bj) { const unsigned off = o0 + (unsigned)((ai * HALF + m * 16) * 1024 + bj * HALF); const u32x2 sg = pre[(ai * 4 + m) * 2 + bj];
                    const f32x4 v0 = acc[ai][bj][m][0] * cvf8x4(sg.x) * 0.03125f, v1 = acc[ai][bj][m][1] * cvf8x4(sg.y) * 0.03125f;
                    u32x2 b8; b8.x = pk_fp8x4(v0[0], v0[1], v0[2], v0[3]); b8.y = pk_fp8x4(v1[0], v1[1], v1[2], v1[3]); *(u32x2*)(O + (size_t)off) = b8; }
    }
    __device__ __forceinline__ void operator()(const f32x4 (&acc)[2][2][4][2], const Unit& u, int wr, int wc, int fr, int fq) const { }
};
struct EpiPlain {
    static constexpr bool PERM = true, HAS_MID = false, HAS_PRE = false;
    unsigned char* O; float sc;
    __device__ __forceinline__ void operator()(const f32x4 (&acc)[2][2][4][2], const Unit& u, int wr, int wc, int fr, int fq) const {
        unsigned o0 = ((unsigned)(u.pm * BM + wr * 64 + fr) * 1024u + (unsigned)(u.pn * BM + wc * 32 + 8 * fq)) * 2u; asm volatile("" : "+v"(o0));
#pragma unroll
        for (int ai = 0; ai < 2; ++ai)
#pragma unroll
            for (int m = 0; m < 4; ++m)
#pragma unroll
                for (int bj = 0; bj < 2; ++bj) { const f32x4 v0 = acc[ai][bj][m][0] * sc, v1 = acc[ai][bj][m][1] * sc; u32x2 b8; b8.x = pk_fp8x4(v0[0], v0[1], v0[2], v0[3]); b8.y = pk_fp8x4(v1[0], v1[1], v1[2], v1[3]);
                      *(u32x2*)(O + (size_t)((o0 >> 1) + (unsigned)((ai * HALF + m * 16) * 1024 + bj * HALF))) = b8; }
    }
};
struct EpiGateUp {
    static constexpr bool PERM = true, HAS_MID = false, HAS_PRE = false;
    unsigned char* HID;
    __device__ __forceinline__ void operator()(const f32x4 (&acc)[2][2][4][2], const Unit& u, int wr, int wc, int fr, int fq) const {
        unsigned o0 = ((unsigned)(u.pm * BM + wr * 64 + fr) * 256u + (unsigned)((u.pn & 1) * 128 + wc * 32 + 8 * fq)); asm volatile("" : "+v"(o0));
#pragma unroll
        for (int ai = 0; ai < 2; ++ai)
#pragma unroll
            for (int m = 0; m < 4; ++m) { f32x4 h0, h1; const f32x4 g0 = acc[ai][0][m][0] * 0.03125f, g1 = acc[ai][0][m][1] * 0.03125f, u0 = acc[ai][1][m][0] * 0.03125f, u1 = acc[ai][1][m][1] * 0.03125f;
#pragma unroll
                for (int j = 0; j < 4; ++j) { h0[j] = g0[j] * sigmoid_f(g0[j]) * u0[j]; h1[j] = g1[j] * sigmoid_f(g1[j]) * u1[j]; }
                u32x2 b8; b8.x = pk_fp8x4(h0[0], h0[1], h0[2], h0[3]); b8.y = pk_fp8x4(h1[0], h1[1], h1[2], h1[3]); *(u32x2*)(HID + (size_t)(o0 + (unsigned)((ai * HALF + m * 16) * 256))) = b8; }
    }
};
struct EpiDown {
    static constexpr bool PERM = true, HAS_MID = false, HAS_PRE = true;
    unsigned char* Y2; const int2* list; const LAS int* tab;
    __device__ __forceinline__ void load_pre(u32x2 (&pre)[16], const Unit& u, int wr, int wc, int fr, int fq) const {
        unsigned lo0 = ((unsigned)u.e * 32768u + (unsigned)(u.p * 256 + wr * 64 + fr)) * 8u; asm volatile("" : "+v"(lo0));
#pragma unroll
        for (int ai = 0; ai < 2; ++ai)
#pragma unroll
            for (int m = 0; m < 4; ++m) pre[ai * 4 + m] = *(const u32x2*)((const char*)list + (size_t)(lo0 + (unsigned)(ai * HALF + m * 16) * 8u));
    }
    __device__ __forceinline__ void fin_pre(const f32x4 (&acc)[2][2][4][2], const u32x2 (&pre)[16], const Unit& u, int wr, int wc, int fr, int fq) const {
        const int r0 = wr * 64 + fr, cnt = tab[64 + u.e] - u.p * 256; const unsigned colb = (unsigned)((u.pn & 3) * 256 + wc * 32 + 8 * fq);
#pragma unroll
        for (int ai = 0; ai < 2; ++ai)
#pragma unroll
            for (int m = 0; m < 4; ++m) { const int ex = (r0 + ai * HALF + m * 16 < cnt) ? (int)pre[ai * 4 + m].x : -1;
                const float w = __uint_as_float(pre[ai * 4 + m].y) * 0.03125f; const unsigned off = (unsigned)ex * 1024u + colb;
                if (ex >= 0) {
#pragma unroll
                    for (int bj = 0; bj < 2; ++bj) { const f32x4 v0 = acc[ai][bj][m][0] * w, v1 = acc[ai][bj][m][1] * w; u32x2 b8; b8.x = pk_fp8x4(v0[0], v0[1], v0[2], v0[3]); b8.y = pk_fp8x4(v1[0], v1[1], v1[2], v1[3]);
                        *(u32x2*)(Y2 + (size_t)(off + (unsigned)(bj * HALF))) = b8; } } }
    }
};
}
#define XB_TMO      128
#define XB_XCNT(j)  (256  + 64 * (j))
#define XB_XSUB(j)  (1280 + 64 * (j))
#define XB_XGEN(j)  (2304 + 64 * (j))
#define XB_TOP      3328
#define XB_TOPGEN   3392
#define XCD_BAR_WORDS 3456
#define XB_SPIN_CAP (1u << 18)

__device__ __forceinline__ unsigned xb_ld(unsigned* p)              { return __hip_atomic_load(p, __ATOMIC_RELAXED, __HIP_MEMORY_SCOPE_AGENT); }
__device__ __forceinline__ unsigned xb_add(unsigned* p, unsigned v) { return __hip_atomic_fetch_add(p, v, __ATOMIC_RELAXED, __HIP_MEMORY_SCOPE_AGENT); }
__device__ __forceinline__ unsigned xb_xcc_id() { return (unsigned)__builtin_amdgcn_s_getreg((3 << 11) | 20) & 0xFu; }
#define XB_SPIN(cond, bar) do { unsigned _sp = 0; while (cond) { __builtin_amdgcn_s_sleep(1); \
    if ((++_sp & 255u) == 0u) { if (xb_ld(&(bar)[XB_TMO])) break; if (_sp > XB_SPIN_CAP) { atomicAdd(&(bar)[XB_TMO], 1u); break; } } } } while (0)

struct XcdBarrier {
    unsigned* bar; unsigned x;
    volatile LAS unsigned* st;
};

__device__ __forceinline__ XcdBarrier xcd_barrier_post(unsigned* bar, volatile LAS unsigned* st) {
    XcdBarrier b; b.bar = bar; b.x = xb_xcc_id(); b.st = st;
    if (threadIdx.x == 0) (void)xb_add(&bar[XB_XCNT(b.x)], 1u);
    return b;
}
__device__ __forceinline__ void xcd_barrier_complete(unsigned* bar, unsigned x, unsigned& nloc, unsigned& nx) {
    const unsigned G = gridDim.x * gridDim.y * gridDim.z;
    unsigned sum, cnt, mine, sp = 0u;
    for (;;) {
        sum = 0u; cnt = 0u; mine = 0u;
#pragma unroll
        for (unsigned j = 0; j < 16; ++j) { const unsigned c = xb_ld(&bar[XB_XCNT(j)]); sum += c; cnt += (c > 0u) ? 1u : 0u; mine = (j == x) ? c : mine; }
        if (sum == G) break;
        __builtin_amdgcn_s_sleep(1);
        if ((++sp & 255u) == 0u) { if (xb_ld(&bar[XB_TMO])) break; if (sp > XB_SPIN_CAP) { atomicAdd(&bar[XB_TMO], 1u); break; } }
    }
    nloc = mine > 0u ? mine : 1u; nx = cnt > 0u ? cnt : 1u;
}

__device__ __forceinline__ void xcd_barrier(const XcdBarrier& b) {
    asm volatile("s_waitcnt vmcnt(0)" ::: "memory");
    __syncthreads();
    if (threadIdx.x == 0) {
        unsigned* bar = b.bar;
        __builtin_amdgcn_s_waitcnt(0);
        unsigned nloc = b.st[0], nx = b.st[1];
        if (nloc == 0u) { xcd_barrier_complete(bar, b.x, nloc, nx); b.st[0] = nloc; b.st[1] = nx; }
        const unsigned old = xb_add(&bar[XB_XSUB(b.x)], 1u);
        const unsigned gen = old / nloc;
        if (old + 1u == (gen + 1u) * nloc) {
            __builtin_amdgcn_fence(__ATOMIC_RELEASE, "agent");
            asm volatile("s_waitcnt vmcnt(0)" ::: "memory");
            const unsigned og = xb_add(&bar[XB_TOP], 1u);
            const unsigned target = (og / nx + 1u) * nx;
            if (og + 1u != target) XB_SPIN(xb_ld(&bar[XB_TOP]) < target, bar);
            __builtin_amdgcn_fence(__ATOMIC_ACQUIRE, "agent");
            xb_add(&bar[XB_XGEN(b.x)], 1u);
            asm volatile("s_waitcnt vmcnt(0)" ::: "memory");
        } else {
            XB_SPIN(xb_ld(&bar[XB_XGEN(b.x)]) == gen, bar);
            __builtin_amdgcn_fence(__ATOMIC_ACQUIRE, "agent");
            asm volatile("s_waitcnt vmcnt(0)" ::: "memory");
        }
    }
    __syncthreads();
}

__device__ __forceinline__ void pair_sync(unsigned* bar, unsigned* cnt, volatile LAS unsigned* same) {
    asm volatile("s_waitcnt vmcnt(0)" ::: "memory");
    __syncthreads();
    if (threadIdx.x == 0) {
        __builtin_amdgcn_s_waitcnt(0);
        if (same[0] != 1u) { __builtin_amdgcn_fence(__ATOMIC_RELEASE, "agent"); asm volatile("s_waitcnt vmcnt(0)" ::: "memory"); }
        const unsigned og = xb_add(cnt, 1u);
        if (og == 0u) XB_SPIN(xb_ld(cnt) < 2u, bar);
        __builtin_amdgcn_fence(__ATOMIC_ACQUIRE, "agent");
        asm volatile("s_waitcnt vmcnt(0)" ::: "memory");
    }
    __syncthreads();
}

constexpr size_t MiB = 1u << 20;
constexpr size_t WS_CTL = 0, CTL_ZERO_BYTES = 1 * MiB;
constexpr size_t WS_MOD = 1 * MiB;
constexpr size_t WS_ST = 3 * MiB;
constexpr size_t WS_WIN = 4 * MiB, WS_WBR = 12 * MiB, WS_WOUT = 14 * MiB, WS_WGU = 16 * MiB, WS_WDN = 32 * MiB, WS_SGW = 40 * MiB;
constexpr size_t WS_WIN8 = WS_WIN;
constexpr size_t WS_WSTRIDE = 37 * MiB;
constexpr size_t WS_LIST = 152 * MiB;
constexpr size_t WS_HX = 156 * MiB;
constexpr size_t WS_GA = 220 * MiB, WS_GS = 284 * MiB, WS_Y2 = WS_GA;
constexpr size_t WS_H8A = 348 * MiB + 32 * MiB;
constexpr size_t WS_CAT = 348 * MiB, WS_Y = WS_CAT;
constexpr size_t WS_WRB = 412 * MiB;
constexpr size_t WS_END = 416 * MiB;
constexpr size_t OB_QKV = 0, OB_HID = OB_QKV;
constexpr size_t OB_USV = 48 * MiB, OB_MRG = OB_USV, OB_H8 = OB_USV;
constexpr int CW_BAR = 4096;
constexpr int CW_CNT = 16384;
constexpr int CW_PAIR = 98304;
constexpr int CW_XID = 196608;
constexpr int CW_PAN = 65536;
constexpr int RING_BYTES = 131072, MISC_OFF = 135168, PAR_OFF = 139264, LDS_BYTES = 163840;

#define VM_WAIT() asm volatile("s_waitcnt vmcnt(0)" ::: "memory")
#define LDS_WAIT() asm volatile("s_waitcnt lgkmcnt(0)" ::: "memory")

struct Frame {
    LAS unsigned char* lds; int tid, lane, wave, vcu, G;
    unsigned char* ws;
    const float* const* in; float* out;
};
__device__ __forceinline__ float wave_sum(float v) {
#pragma unroll
    for (int o = 1; o < 64; o <<= 1) v += __shfl_xor(v, o);
    return v;
}
__device__ __forceinline__ int t5_bucket(int rel) {
    const int n = rel < 0 ? 0 : rel;
    if (n < 16) return n;
    const int large = 16 + (int)(logf((float)n / 16.0f) / logf(8.0f) * 16.0f);
    return large < 31 ? large : 31;
}

template <bool F16OUT>
__device__ __forceinline__ void transpose_item(const float* W, int N, bf16_t* WT, int ldt, int koff, int row_of_n0, int k0, int n0, int lane, LAS unsigned char* scr) {
    const float* src = W + (size_t)k0 * N + n0 + lane;
    float v[64];
#pragma unroll
    for (int i = 0; i < 64; ++i) v[i] = src[(size_t)i * N];
#pragma unroll
    for (int c = 0; c < 8; ++c) { u32x4 o;
        if (F16OUT) { typedef _Float16 th2 __attribute__((ext_vector_type(2)));
            o.x = __builtin_bit_cast(unsigned, __builtin_convertvector((f32x2){v[8 * c], v[8 * c + 1]}, th2)); o.y = __builtin_bit_cast(unsigned, __builtin_convertvector((f32x2){v[8 * c + 2], v[8 * c + 3]}, th2));
            o.z = __builtin_bit_cast(unsigned, __builtin_convertvector((f32x2){v[8 * c + 4], v[8 * c + 5]}, th2)); o.w = __builtin_bit_cast(unsigned, __builtin_convertvector((f32x2){v[8 * c + 6], v[8 * c + 7]}, th2)); }
        else { o.x = cvt_pk_bf16(v[8 * c], v[8 * c + 1]); o.y = cvt_pk_bf16(v[8 * c + 2], v[8 * c + 3]); o.z = cvt_pk_bf16(v[8 * c + 4], v[8 * c + 5]); o.w = cvt_pk_bf16(v[8 * c + 6], v[8 * c + 7]); }
        *(LAS u32x4*)(scr + lane * 144 + c * 16) = o; }
    const int c8 = lane & 7;
#pragma unroll
    for (int j = 0; j < 8; ++j) { const int n = (lane >> 3) + 8 * j; const u32x4 o = *(const LAS u32x4*)(scr + n * 144 + c8 * 16);
        *(u32x4*)(WT + (size_t)(row_of_n0 + n) * ldt + koff + k0 + 8 * c8) = o; }
}
template <int PITCH = 1024>
__device__ __forceinline__ void transpose_item_fp8(const float* W, int N, unsigned char* WT, int koff, int row_of_n0, int k0, int n0, int lane, LAS unsigned char* scr) {
    const float* src = W + (size_t)k0 * N + n0 + lane;
    float v[64];
#pragma unroll
    for (int i = 0; i < 64; ++i) v[i] = src[(size_t)i * N];
#pragma unroll
    for (int c = 0; c < 4; ++c) { u32x4 o;
        o.x = pk_fp8x4(32.f * v[16 * c], 32.f * v[16 * c + 1], 32.f * v[16 * c + 2], 32.f * v[16 * c + 3]); o.y = pk_fp8x4(32.f * v[16 * c + 4], 32.f * v[16 * c + 5], 32.f * v[16 * c + 6], 32.f * v[16 * c + 7]);
        o.z = pk_fp8x4(32.f * v[16 * c + 8], 32.f * v[16 * c + 9], 32.f * v[16 * c + 10], 32.f * v[16 * c + 11]); o.w = pk_fp8x4(32.f * v[16 * c + 12], 32.f * v[16 * c + 13], 32.f * v[16 * c + 14], 32.f * v[16 * c + 15]);
        *(LAS u32x4*)(scr + lane * 80 + c * 16) = o; }
    const int c4 = lane & 3;
#pragma unroll
    for (int j = 0; j < 4; ++j) { const int n = (lane >> 2) + 16 * j; const u32x4 o = *(const LAS u32x4*)(scr + n * 80 + c4 * 16);
        *(u32x4*)(WT + (size_t)(row_of_n0 + n) * PITCH + koff + k0 + 16 * c4) = o; }
}
constexpr int CI_IN = 16 * 60, CI_BR = 8 * 16, CI_OUT = 16 * 16, CI_GU = 16 * 4, CI_DN = 4 * 16;
constexpr int CONV_ITEMS = CI_IN + 2 * CI_BR + CI_OUT + NE * (2 * CI_GU + CI_DN) + 64;
__device__ __forceinline__ void conv_item(Frame& F, int l, int it, LAS unsigned char* scr) {
    const int lane = F.lane; unsigned char* ws = F.ws + (size_t)l * WS_WSTRIDE;
    int r = it;
    if (r < CI_IN) { const int nb = 60, n0 = 64 * (r % nb);
        const int row0 = (n0 < 1792) ? n0 : (n0 < 2816 ? 1792 + ((n0 - 1792) >> 7) * 256 + ((n0 - 1792) & 127) : 1792 + ((n0 - 2816) >> 7) * 256 + 128 + ((n0 - 2816) & 127));
        transpose_item_fp8(F.in[7] + (size_t)l * D * INW, INW, ws + WS_WIN8, 0, row0, 64 * (r / nb), n0, lane, scr);
        return; } r -= CI_IN;
    if (r < CI_BR) { const int nb = 16; transpose_item_fp8(F.in[13] + (size_t)l * 512 * D, D, ws + WS_WBR, 0, 64 * (r % nb), 64 * (r / nb), 64 * (r % nb), lane, scr); return; } r -= CI_BR;
    if (r < CI_BR) { const int nb = 16; transpose_item_fp8(F.in[14] + (size_t)l * 512 * D, D, ws + WS_WBR, 512, 64 * (r % nb), 64 * (r / nb), 64 * (r % nb), lane, scr); return; } r -= CI_BR;
    if (r < CI_OUT) { const int nb = 16; transpose_item_fp8(F.in[15] + (size_t)l * D * D, D, ws + WS_WOUT, 0, 64 * (r % nb), 64 * (r / nb), 64 * (r % nb), lane, scr); return; } r -= CI_OUT;
    if (r < NE * 2 * CI_GU) {
        const int e = r / (2 * CI_GU), q = r % (2 * CI_GU), up = q / CI_GU, ii = q % CI_GU, nb = 4, n0 = 64 * (ii % nb), k0 = 64 * (ii / nb);
        const float* W = F.in[up ? 19 : 18] + ((size_t)l * NE + e) * D * FF;
        transpose_item_fp8(W, FF, ws + WS_WGU, 0, e * 512 + (n0 >> 7) * 256 + up * 128 + (n0 & 127), k0, n0, lane, scr); return; } r -= NE * 2 * CI_GU;
    if (r < NE * CI_DN) { const int e = r / CI_DN, ii = r % CI_DN, nb = 16, n0 = 64 * (ii % nb), k0 = 64 * (ii / nb);
        transpose_item_fp8<256>(F.in[20] + ((size_t)l * NE + e) * FF * D, D, ws + WS_WDN, 0, e * 1024 + n0, k0, n0, lane, scr); return; } r -= NE * CI_DN;
    {
        const float* W = F.in[9] + (size_t)l * 8 * 128 * 128 + (size_t)r * 2048; bf16_t* O = (bf16_t*)(ws + WS_SGW) + (size_t)r * 2048;
        const int i = (r & 7) * 16 + (lane >> 2), j0 = (lane & 3) * 32;
#pragma unroll
        for (int q = 0; q < 4; ++q) { const f32x4 a = *(const f32x4*)(W + lane * 32 + q * 8), b = *(const f32x4*)(W + lane * 32 + q * 8 + 4); f32x4 a2, b2;
#pragma unroll
            for (int t = 0; t < 4; ++t) { a2[t] = (j0 + q * 8 + t <= i) ? a[t] : 0.f; b2[t] = (j0 + q * 8 + 4 + t <= i) ? b[t] : 0.f; }
            *(u32x4*)(O + lane * 32 + q * 8) = pg8::pack8(a2, b2); }
    }
}

constexpr int MOD_ITEMS = DEPTH * 6 * D / 32;
__device__ __forceinline__ void mod_item(Frame& F, int it) {
    const LAS float* cond = (const LAS float*)F.lds;
    const int l = it / 192, j0 = (it % 192) * 32, col = j0 + (F.lane & 31), kh = (F.lane >> 5) * 512;
    const __amdgpu_buffer_rsrc_t rs = __builtin_amdgcn_make_buffer_rsrc((void*)(F.in[5] + (size_t)l * D * 6 * D), 0, D * 6 * D * 4, 0x00020000);
    const int voff = (kh * 6 * D + col) * 4;
    f32x4 acc[4];
#pragma unroll
    for (int b = 0; b < 4; ++b) acc[b] = (f32x4){0.f, 0.f, 0.f, 0.f};
#pragma unroll 1
    for (int k = 0; k < 512; k += 16) {
        float wv[16];
#pragma unroll
        for (int q = 0; q < 16; ++q) wv[q] = __builtin_bit_cast(float, __builtin_amdgcn_raw_buffer_load_b32(rs, voff, (k + q) * 6 * D * 4, 0));
#pragma unroll
        for (int q = 0; q < 16; ++q) { const LAS f32x4* cp = (const LAS f32x4*)(cond + (kh + k + q) * 16);
#pragma unroll
            for (int b = 0; b < 4; ++b) acc[b] += cp[b] * wv[q];
            if ((q & 3) == 3) asm volatile("" ::: "memory"); }
    }
    int t2 = threadIdx.x, it2 = it; asm volatile("" : "+v"(t2), "+s"(it2));
    const int l2 = it2 / 192, col2 = (it2 % 192) * 32 + (t2 & 31);
    float* mod = (float*)(F.ws + WS_MOD) + (size_t)l2 * BATCH * 6 * D + col2; const float bia = F.in[6][l2 * 6 * D + col2];
#pragma unroll
    for (int b = 0; b < 16; ++b) { const float a = acc[b >> 2][b & 3]; const float s = a + __shfl_xor(a, 32); if ((t2 & 63) < 32) mod[(size_t)b * 6 * D] = s + bia; }
}

struct RowArgs { const float* xin; const bf16_t* y; const float* g; const float* gain; const float* bias; const float* sc; const float* sh; const float* osc; const float* osh; bf16_t* HX; float* st; int l; bool has_h; float* xo; int2* list; unsigned char* H8; };
typedef _Float16 h16x4 __attribute__((ext_vector_type(4)));
__device__ __forceinline__ f32x4 cvh4(const u32x2 w) { return __builtin_convertvector(__builtin_bit_cast(h16x4, w), f32x4); }
__device__ __forceinline__ u32x2 pkh4(const f32x4 v) { return __builtin_bit_cast(u32x2, __builtin_convertvector(v, h16x4)); }
__device__ __forceinline__ f32x4 cvbf4(const u32x2 w) { return (f32x4){bf_lo(w.x), bf_hi(w.x), bf_lo(w.y), bf_hi(w.y)}; }
#define DPP_ADD(v, ctrl, rmask, bc) v += __builtin_bit_cast(float, __builtin_amdgcn_update_dpp(0, __builtin_bit_cast(int, v), ctrl, rmask, 0xF, bc))
__device__ __forceinline__ float dpp_sum(float v) {
    DPP_ADD(v, 0xB1, 0xF, true); DPP_ADD(v, 0x4E, 0xF, true); DPP_ADD(v, 0x141, 0xF, true); DPP_ADD(v, 0x140, 0xF, true);
    DPP_ADD(v, 0x142, 0xA, false); DPP_ADD(v, 0x143, 0xC, false);
    return __builtin_bit_cast(float, __builtin_amdgcn_readlane(__builtin_bit_cast(int, v), 63));
}
template <int MODE> struct RowRaw { f32x4 x[4]; u32x2 hx[4]; unsigned y[4]; unsigned y2[4]; f32x2 st; };
#define ROWCOL(lane, q) (8 * (lane) + 512 * ((q) >> 1) + 4 * ((q) & 1))
template <int MODE>
__device__ __forceinline__ void row_load(RowRaw<MODE>& r, Frame& F, const RowArgs& A, size_t row, int lane) {
    const int rw = __builtin_amdgcn_readfirstlane((int)row);
    if (MODE == 0) {
        const __amdgpu_buffer_rsrc_t rx = __builtin_amdgcn_make_buffer_rsrc((void*)A.xin, 0, T * D * 4, 0x00020000);
#pragma unroll
        for (int j = 0; j < 4; ++j) r.x[j] = __builtin_bit_cast(f32x4, __builtin_amdgcn_raw_buffer_load_b128(rx, lane * 32 + (j >> 1) * 2048 + (j & 1) * 16, rw * (D * 4), 0));
    } else {
        r.st = *(const f32x2*)(A.st + (size_t)rw * 2);
        const __amdgpu_buffer_rsrc_t rh = __builtin_amdgcn_make_buffer_rsrc((void*)A.HX, 0, T * D * 2, 0x00020000);
        const __amdgpu_buffer_rsrc_t ry = __builtin_amdgcn_make_buffer_rsrc((void*)A.y, 0, (MODE == 2 ? 2 : 1) * T * D, 0x00020000);
#pragma unroll
        for (int jj = 0; jj < 2; ++jj) { const u32x4 h = __builtin_bit_cast(u32x4, __builtin_amdgcn_raw_buffer_load_b128(rh, lane * 16 + jj * 1024, rw * (D * 2), 2));
            r.hx[2 * jj] = (u32x2){h.x, h.y}; r.hx[2 * jj + 1] = (u32x2){h.z, h.w};
            if (MODE == 1) { const u32x2 y = __builtin_bit_cast(u32x2, __builtin_amdgcn_raw_buffer_load_b64(ry, lane * 8 + jj * 512, rw * D, 2)); r.y[2 * jj] = y.x; r.y[2 * jj + 1] = y.y; }
            else { const u32x2 y = __builtin_bit_cast(u32x2, __builtin_amdgcn_raw_buffer_load_b64(ry, lane * 8 + jj * 512, rw * (D * 2), 2));
                   const u32x2 y2 = __builtin_bit_cast(u32x2, __builtin_amdgcn_raw_buffer_load_b64(ry, lane * 8 + jj * 512 + D, rw * (D * 2), 2));
                   r.y[2 * jj] = y.x; r.y[2 * jj + 1] = y.y; r.y2[2 * jj] = y2.x; r.y2[2 * jj + 1] = y2.y; } }
    }
}
template <int MODE>
__device__ __forceinline__ void row_process(const RowRaw<MODE>& r, Frame& F, const RowArgs& A, size_t row, int lane, const f32x4 (&gv)[4], const LAS float* pl) {
    f32x4 z[4];
    asm volatile("" ::: "memory");
    if (MODE == 0) {
#pragma unroll
        for (int j = 0; j < 4; ++j) z[j] = r.x[j];
    } else {
        const float mu0 = r.st[0], sg0 = r.st[1];
#pragma unroll
        for (int j = 0; j < 4; ++j) { f32x4 y = cvf8x4(r.y[j]); if (MODE == 2) y = y + cvf8x4(r.y2[j]);
            const f32x4 x = (cvbf4(r.hx[j]) * *(const LAS f32x4*)(pl + 4096 + 512 * (j >> 1) + 4 * (j & 1)) + *(const LAS f32x4*)(pl + 5120 + 512 * (j >> 1) + 4 * (j & 1))) * sg0 + mu0;
            z[j] = ALPHA * x + (1.0f + gv[j]) * y; }
        float s = 0.f;
#pragma unroll
        for (int j = 0; j < 4; ++j) s += (z[j][0] + z[j][1]) + (z[j][2] + z[j][3]);
        const float mean = dpp_sum(s) * (1.0f / D); float q = 0.f;
#pragma unroll
        for (int j = 0; j < 4; ++j) { z[j] = z[j] - mean; q += (z[j][0] * z[j][0] + z[j][1] * z[j][1]) + (z[j][2] * z[j][2] + z[j][3] * z[j][3]); }
        const float rstd = __builtin_amdgcn_rsqf(dpp_sum(q) * (1.0f / D) + LN_EPS);
#pragma unroll
        for (int j = 0; j < 4; ++j) z[j] = z[j] * rstd * *(const LAS f32x4*)(pl + 512 * (j >> 1) + 4 * (j & 1)) + *(const LAS f32x4*)(pl + 1024 + 512 * (j >> 1) + 4 * (j & 1));
    }
    if (A.xo) {
#pragma unroll
        for (int j = 0; j < 4; ++j) *(f32x4*)(A.xo + row * D + ROWCOL(lane, j)) = z[j];
    }
    if (MODE != 2 || A.has_h) {
        float s = 0.f;
#pragma unroll
        for (int j = 0; j < 4; ++j) s += (z[j][0] + z[j][1]) + (z[j][2] + z[j][3]);
        const float mean = dpp_sum(s) * (1.0f / D); float q = 0.f;
#pragma unroll
        for (int j = 0; j < 4; ++j) { z[j] = z[j] - mean; q += (z[j][0] * z[j][0] + z[j][1] * z[j][1]) + (z[j][2] * z[j][2] + z[j][3] * z[j][3]); }
        const float vq = dpp_sum(q) * (1.0f / D) + LN_EPS, rstd = __builtin_amdgcn_rsqf(vq), sig = vq * rstd;
#pragma unroll
        for (int j = 0; j < 4; ++j) z[j] = z[j] * rstd * *(const LAS f32x4*)(pl + 2048 + 512 * (j >> 1) + 4 * (j & 1)) + *(const LAS f32x4*)(pl + 3072 + 512 * (j >> 1) + 4 * (j & 1));
#pragma unroll
        for (int jj = 0; jj < 2; ++jj) { u32x4 w; w.x = cvt_pk_bf16(z[2 * jj][0], z[2 * jj][1]); w.y = cvt_pk_bf16(z[2 * jj][2], z[2 * jj][3]); w.z = cvt_pk_bf16(z[2 * jj + 1][0], z[2 * jj + 1][1]); w.w = cvt_pk_bf16(z[2 * jj + 1][2], z[2 * jj + 1][3]);
            *(u32x4*)(A.HX + row * D + 8 * lane + 512 * jj) = w;
            if (A.H8) { u32x2 b8; b8.x = pk_fp8x4(z[2 * jj][0], z[2 * jj][1], z[2 * jj][2], z[2 * jj][3]); b8.y = pk_fp8x4(z[2 * jj + 1][0], z[2 * jj + 1][1], z[2 * jj + 1][2], z[2 * jj + 1][3]); *(u32x2*)(A.H8 + row * D + 8 * lane + 512 * jj) = b8; } }
        if (lane == 0) *(f32x2*)(A.st + row * 2) = (f32x2){mean, sig};
    }
}
#define DPPF(v, ctrl) __builtin_bit_cast(float, __builtin_amdgcn_update_dpp(0, __builtin_bit_cast(int, v), ctrl, 0xF, 0xF, true))
#define DPPI(v, ctrl) __builtin_amdgcn_update_dpp(0, v, ctrl, 0xF, 0xF, true)
__device__ __forceinline__ float row16_sum(float v) { v += DPPF(v, 0xB1); v += DPPF(v, 0x4E); v += DPPF(v, 0x141); v += DPPF(v, 0x140); return v; }
__device__ __forceinline__ float row16_max(float v) { v = fmaxf(v, DPPF(v, 0xB1)); v = fmaxf(v, DPPF(v, 0x4E)); v = fmaxf(v, DPPF(v, 0x141)); v = fmaxf(v, DPPF(v, 0x140)); return v; }
typedef _Float16 half8 __attribute__((ext_vector_type(8)));
__device__ __forceinline__ void route16(const LAS unsigned char* wrb, const bf16_t* xrows, size_t row_base, int lane, int lr_base, float rbias, LAS int* lcnt, LAS int* asg) {
    const int e = lane & 15, g = lane >> 4;
    asm volatile("s_waitcnt vmcnt(0)" ::: "memory");
    const __amdgpu_buffer_rsrc_t rs = __builtin_amdgcn_make_buffer_rsrc((void*)xrows, 0, T * D * 2, 0x00020000);
    const int voff = (int)(((row_base + (size_t)e) * D + 8 * g) * 2);
    f32x4 ah = (f32x4){0.f, 0.f, 0.f, 0.f}, al = (f32x4){0.f, 0.f, 0.f, 0.f};
    const LAS unsigned char* bb = wrb + lane * 16;
    u32x4 av[32];
#pragma unroll
    for (int i = 0; i < 32; ++i) av[i] = __builtin_bit_cast(u32x4, __builtin_amdgcn_raw_buffer_load_b128(rs, voff, i * 64, 16  ));
#pragma unroll
    for (int i = 0; i < 32; ++i) { const half8 a = __builtin_bit_cast(half8, av[i]);
        const half8 bh = *(const LAS half8*)(bb + i * 1024), bl = *(const LAS half8*)(bb + 32768 + i * 1024);
        ah = __builtin_amdgcn_mfma_f32_16x16x32_bf16(__builtin_bit_cast(bf16x8, a), __builtin_bit_cast(bf16x8, bh), ah, 0, 0, 0); al = __builtin_amdgcn_mfma_f32_16x16x32_bf16(__builtin_bit_cast(bf16x8, a), __builtin_bit_cast(bf16x8, bl), al, 0, 0, 0); }
    const int qi = lane & 3, q = (lane >> 2) & 3;
#pragma unroll
    for (int rr = 0; rr < 4; ++rr) {
        const int row = 4 * g + rr;
        const float lg = ah[rr] + al[rr];
        const float mx = row16_max(lg);
        float p = expf(lg - mx);
        p = p / row16_sum(p);
        const float sel = p + rbias;
        int rank = 0;
        { const float a = DPPF(sel, 0x39); const int j = DPPI(qi, 0x39); rank += (a > sel || (a == sel && j < qi)) ? 1 : 0; }
        { const float a = DPPF(sel, 0x4E); const int j = DPPI(qi, 0x4E); rank += (a > sel || (a == sel && j < qi)) ? 1 : 0; }
        { const float a = DPPF(sel, 0x93); const int j = DPPI(qi, 0x93); rank += (a > sel || (a == sel && j < qi)) ? 1 : 0; }
        const bool in2 = rank < 2;
        float gs = in2 ? sel : 0.f; gs += DPPF(gs, 0xB1); gs += DPPF(gs, 0x4E);
        bool best = true;
        { const float a = DPPF(gs, 0x124); const int j = DPPI(q, 0x124); best = best && (gs > a || (gs == a && q < j)); }
        { const float a = DPPF(gs, 0x128); const int j = DPPI(q, 0x128); best = best && (gs > a || (gs == a && q < j)); }
        { const float a = DPPF(gs, 0x12C); const int j = DPPI(q, 0x12C); best = best && (gs > a || (gs == a && q < j)); }
        const bool chosen = best && in2;
        const float den = row16_sum(chosen ? p : 0.f);
        const float w = p / den;
        if (chosen) { const int rk = __hip_atomic_fetch_add(lcnt + e, 1, __ATOMIC_RELAXED, __HIP_MEMORY_SCOPE_WORKGROUP);
            const int a = 2 * (lr_base + row) + rank; asg[2 * a] = e | (rk << 8); asg[2 * a + 1] = __float_as_int(w); }
    }
}
template <int MODE>
__device__ __forceinline__ void row_phase(Frame& F, const RowArgs& A) {
    int tid0_ = threadIdx.x; asm volatile("" : "+v"(tid0_));
    const int wave = __builtin_amdgcn_readfirstlane(tid0_ >> 6);
    LAS unsigned char* wrb = F.lds;
    LAS int* lcnt = (LAS int*)(F.lds + 131072);
    LAS int* gb = lcnt + 16;
    LAS int* asg = lcnt + 32;
    LAS float* par = (LAS float*)(F.lds + PAR_OFF);
#pragma unroll 1
    for (int rb = F.vcu; rb < T / 128; rb += F.G) {
        int tid_ = tid0_; asm volatile("" : "+v"(tid_));
        const int lane = tid_ & 63, tid = tid_;
        const float rbias = (MODE == 1) ? F.in[4][lane & 15] : 0.f;
        const LAS float* pl = par + 8 * lane; asm volatile("" : "+v"(pl));
        const int row0 = rb * 128, b = row0 / SEQ;
        __syncthreads();
        const size_t r0 = (size_t)row0 + wave * 16;
        u32x4 wv[8];
        if (MODE == 1) { const unsigned char* src = F.ws + WS_WRB;
#pragma unroll
            for (int k = 0; k < 8; ++k) wv[k] = *(const u32x4*)(src + (size_t)(tid + k * NTHR) * 16); }
        const int c4 = (tid & 255) * 4;
        f32x4 pv0 = (f32x4){0.f, 0.f, 0.f, 0.f}, pv1 = pv0, pv2 = pv0, pv3 = pv0;
        if (tid < 256) { if (MODE != 0) { pv0 = *(const f32x4*)(A.gain + c4); pv1 = *(const f32x4*)(A.bias + c4); pv2 = *(const f32x4*)(A.osc + b * 6 * D + c4); pv3 = *(const f32x4*)(A.osh + b * 6 * D + c4); } }
        else if (MODE != 2 || A.has_h) { pv0 = *(const f32x4*)(A.sc + b * 6 * D + c4); pv1 = *(const f32x4*)(A.sh + b * 6 * D + c4); }
        f32x4 gv[4];
#pragma unroll
        for (int j = 0; j < 4; ++j) gv[j] = (MODE == 0) ? (f32x4){0.f, 0.f, 0.f, 0.f} : *(const f32x4*)(A.g + b * 6 * D + ROWCOL(lane, j));
        RowRaw<MODE> ra, rbf, rc, rd;
        row_load<MODE>(ra, F, A, r0, lane); row_load<MODE>(rbf, F, A, r0 + 1, lane); row_load<MODE>(rc, F, A, r0 + 2, lane); row_load<MODE>(rd, F, A, r0 + 3, lane);
        if (MODE == 1) { if (tid < 16) lcnt[tid] = 0;
#pragma unroll
            for (int k = 0; k < 8; ++k) *(LAS u32x4*)(wrb + (tid + k * NTHR) * 16) = wv[k]; }
        if (tid < 256) { if (MODE != 0) { const f32x4 o = 1.0f / (1.0f + pv2); *(LAS f32x4*)(par + c4) = pv0; *(LAS f32x4*)(par + 1024 + c4) = pv1; *(LAS f32x4*)(par + 4096 + c4) = o; *(LAS f32x4*)(par + 5120 + c4) = -pv3 * o; } }
        else if (MODE != 2 || A.has_h) { *(LAS f32x4*)(par + 2048 + c4) = 1.0f + pv0; *(LAS f32x4*)(par + 3072 + c4) = pv1; }
        __syncthreads();
#pragma unroll 1
        for (int pr = 0; pr < 3; ++pr) {
            row_process<MODE>(ra, F, A, r0 + 4 * pr, lane, gv, pl); row_load<MODE>(ra, F, A, r0 + 4 * pr + 4, lane);
            row_process<MODE>(rbf, F, A, r0 + 4 * pr + 1, lane, gv, pl); row_load<MODE>(rbf, F, A, r0 + 4 * pr + 5, lane);
            row_process<MODE>(rc, F, A, r0 + 4 * pr + 2, lane, gv, pl); row_load<MODE>(rc, F, A, r0 + 4 * pr + 6, lane);
            row_process<MODE>(rd, F, A, r0 + 4 * pr + 3, lane, gv, pl); row_load<MODE>(rd, F, A, r0 + 4 * pr + 7, lane);
        }
        row_process<MODE>(ra, F, A, r0 + 12, lane, gv, pl); row_process<MODE>(rbf, F, A, r0 + 13, lane, gv, pl); row_process<MODE>(rc, F, A, r0 + 14, lane, gv, pl); row_process<MODE>(rd, F, A, r0 + 15, lane, gv, pl);
        if (MODE == 1) route16(wrb, A.HX, r0, lane, wave * 16, rbias, lcnt, asg);
        if (MODE == 1) {
            __syncthreads();
            if (tid < 16) gb[tid] = (int)__hip_atomic_fetch_add(((unsigned*)F.ws) + CW_CNT + 64 * (A.l * 16 + tid), (unsigned)lcnt[tid], __ATOMIC_RELAXED, __HIP_MEMORY_SCOPE_AGENT);
            __syncthreads();
            if (tid < 256) { const int er = asg[2 * tid], wb = asg[2 * tid + 1]; const int e = er & 255, pos = gb[e] + (er >> 8);
                int2 en; en.x = (row0 + (tid >> 1)) * 2 + (tid & 1); en.y = wb; A.list[(size_t)e * 32768 + pos] = en; }
            __syncthreads();
        }
    }
}

__device__ __forceinline__ s16x4 vtr(const LAS unsigned char* p) { return __builtin_bit_cast(s16x4, __builtin_amdgcn_ds_read_tr16_b64_v4i16((LAS s16x4*)p)); }
__device__ __forceinline__ bf16x8 cat44(s16x4 a, s16x4 b) { return (bf16x8){a[0], a[1], a[2], a[3], b[0], b[1], b[2], b[3]}; }
__device__ __forceinline__ f32x4 gelu_tab4(const LAS float* gt, const unsigned w) { return (f32x4){gt[w & 0xffu], gt[(w >> 8) & 0xffu], gt[(w >> 16) & 0xffu], gt[w >> 24]}; }
__device__ __forceinline__ float rows_max(float v) {
    auto r = __builtin_amdgcn_permlane32_swap(__float_as_uint(v), __float_as_uint(v), false, false); v = fmaxf(__uint_as_float(r[0]), __uint_as_float(r[1]));
    r = __builtin_amdgcn_permlane16_swap(__float_as_uint(v), __float_as_uint(v), false, false); return fmaxf(__uint_as_float(r[0]), __uint_as_float(r[1]));
}
__device__ __forceinline__ float rows_sum(float v) {
    auto r = __builtin_amdgcn_permlane32_swap(__float_as_uint(v), __float_as_uint(v), false, false); v = __uint_as_float(r[0]) + __uint_as_float(r[1]);
    r = __builtin_amdgcn_permlane16_swap(__float_as_uint(v), __float_as_uint(v), false, false); return __uint_as_float(r[0]) + __uint_as_float(r[1]);
}
__device__ __forceinline__ void rows_transpose4(unsigned& w0, unsigned& w1, unsigned& w2, unsigned& w3) {
    auto r = __builtin_amdgcn_permlane32_swap(w0, w2, false, false); w0 = r[0]; w2 = r[1];
    r = __builtin_amdgcn_permlane32_swap(w1, w3, false, false); w1 = r[0]; w3 = r[1];
    r = __builtin_amdgcn_permlane16_swap(w0, w1, false, false); w0 = r[0]; w1 = r[1];
    r = __builtin_amdgcn_permlane16_swap(w2, w3, false, false); w2 = r[0]; w3 = r[1];
}
__device__ __forceinline__ void mixer_unit(Frame& F, int l, int ub, int un) {
    int tid_ = threadIdx.x; asm volatile("" : "+v"(tid_));
    const int tid = tid_, lane = tid & 63, wave = __builtin_amdgcn_readfirstlane(tid >> 6), c = lane & 15, g = lane >> 4;
    LAS unsigned char* lds = F.lds;
    const bf16_t* QKV = (const bf16_t*)((unsigned char*)F.out + OB_QKV); const unsigned char* USV = (const unsigned char*)F.out + OB_USV;     unsigned char* CAT = F.ws + WS_CAT;
    const size_t tok0 = (size_t)ub * SEQ + (size_t)un * 128;
    float sink = F.in[8][l * 8 + wave] * 1.4426950408889634f;
    u32x4 v[16];
#pragma unroll
    for (int i = 0; i < 16; ++i) { const int ci = i * NTHR + tid, c8 = ci & 7, key = (ci >> 3) & 255, hk = (ci >> 11) & 1, tv = ci >> 12;
        v[i] = (u32x4){0u, 0u, 0u, 0u};
        if (un > 0 || key >= 128) v[i] = *(const u32x4*)(QKV + (tok0 - 128 + key) * 768 + 512 + tv * 128 + hk * 64 + c8 * 8); }
    const bf16_t* qp0 = QKV + (tok0 + c) * 768 + wave * 64 + 8 * g;
    bf16x8 qa0 = *(const bf16x8*)qp0, qa1 = *(const bf16x8*)(qp0 + 32);
    bf16x8 qb0 = *(const bf16x8*)(qp0 + 16 * 768), qb1 = *(const bf16x8*)(qp0 + 16 * 768 + 32);
    u32x2 vrow[16];
#pragma unroll
    for (int rr = 0; rr < 16; ++rr) vrow[rr] = *(const u32x2*)(USV + (tok0 + wave * 16 + rr) * 1024 + 512 + 8 * lane);
    LAS float* tb = (LAS float*)(lds + PAR_OFF);
#pragma unroll
    for (int i = 0; i < 2; ++i) { const int idx = i * NTHR + tid; tb[idx] = F.in[2][t5_bucket(idx & 127) * 8 + (idx >> 7)] * 1.4426950408889634f; }
    if (tid < 256) { const f32x4 p = cvf8x4((unsigned)tid); ((LAS float*)(lds + PAR_OFF + 4096))[tid] = gelu_pk((f32x2){p[0], p[0]}).x; }
    const LAS float* gt = (const LAS float*)(lds + PAR_OFF + 4096);
#pragma unroll
    for (int i = 0; i < 16; ++i) { const int ci = i * NTHR + tid, c8 = ci & 7, key = (ci >> 3) & 255, hk = (ci >> 11) & 1, tv = ci >> 12;
        *(LAS u32x4*)(lds + (tv * 2 + hk) * 32768 + key * 128 + ((c8 ^ (key & 7)) << 4)) = v[i]; }
    asm volatile("" : "+v"(sink));
    __syncthreads();
#ifndef MIX_REP_A
#define MIX_REP_A 1
#endif
#ifndef MIX_REP_S
#define MIX_REP_S 1
#endif
    for (int repa_ = 0; repa_ < MIX_REP_A; ++repa_)
    {
        const int h = wave, hk = h >> 2;
        const LAS unsigned char* Kb = lds + hk * 32768; const LAS unsigned char* Vb = lds + 65536 + hk * 32768;
        float bv[9][4];
#pragma unroll
        for (int j = 0; j < 9; ++j)
#pragma unroll
            for (int r = 0; r < 4; ++r) { const int rel = c + 128 - 16 * j - 4 * g - r; bv[j][r] = (rel >= 0 && rel < 128) ? tb[h * 128 + (rel & 127)] : -1e30f; }
        const int ka0 = c * 128 + (((0 + g) ^ (c & 7)) << 4), ka1 = c * 128 + (((4 + g) ^ (c & 7)) << 4);
        const int vkey = 4 * g + (c >> 2), vsw = vkey & 7, vp = c & 3;
        const LAS unsigned char* kb0 = Kb + ka0; const LAS unsigned char* kb1 = Kb + ka1;
        const LAS unsigned char* vb0 = Vb + vkey * 128 + ((((0 + (vp >> 1)) ^ vsw) << 4) + (vp & 1) * 8); const LAS unsigned char* vb1 = Vb + vkey * 128 + ((((2 + (vp >> 1)) ^ vsw) << 4) + (vp & 1) * 8);
        const LAS unsigned char* vb2 = Vb + vkey * 128 + ((((4 + (vp >> 1)) ^ vsw) << 4) + (vp & 1) * 8); const LAS unsigned char* vb3 = Vb + vkey * 128 + ((((6 + (vp >> 1)) ^ vsw) << 4) + (vp & 1) * 8);
        asm volatile("" : "+v"(kb0), "+v"(kb1), "+v"(vb0), "+v"(vb1), "+v"(vb2), "+v"(vb3));
#pragma unroll 1
        for (int qt = 0; qt < 8; qt += 2) {
            f32x4 s0[9], s1[9];
            const int qo = qt * 2048; const LAS unsigned char* kq0 = kb0 + qo; const LAS unsigned char* kq1 = kb1 + qo;
#pragma unroll
            for (int x = 0; x < 10; ++x) {
                const bf16x8 k0 = *(const LAS bf16x8*)(kq0 + x * 2048), k1 = *(const LAS bf16x8*)(kq1 + x * 2048);
                if (x < 9) { f32x4 a = (f32x4){bv[x][0], bv[x][1], bv[x][2], bv[x][3]};
                    a = __builtin_amdgcn_mfma_f32_16x16x32_bf16(k0, qa0, a, 0, 0, 0); a = __builtin_amdgcn_mfma_f32_16x16x32_bf16(k1, qa1, a, 0, 0, 0); s0[x] = a; }
                if (x > 0) { f32x4 a = (f32x4){bv[x - 1][0], bv[x - 1][1], bv[x - 1][2], bv[x - 1][3]};
                    a = __builtin_amdgcn_mfma_f32_16x16x32_bf16(k0, qb0, a, 0, 0, 0); a = __builtin_amdgcn_mfma_f32_16x16x32_bf16(k1, qb1, a, 0, 0, 0); s1[x - 1] = a; } }
            { const int n0 = qt + 2 < 8 ? qt + 2 : 7, n1 = qt + 3 < 8 ? qt + 3 : 7;
              const bf16_t* qp = qp0 + (size_t)(16 * n0) * 768; qa0 = *(const bf16x8*)qp; qa1 = *(const bf16x8*)(qp + 32);
              qp = qp0 + (size_t)(16 * n1) * 768; qb0 = *(const bf16x8*)qp; qb1 = *(const bf16x8*)(qp + 32); }
            if (un == 0) {
#pragma unroll
                for (int j = 0; j < 8; ++j) { if (qt + j < 8) s0[j] = (f32x4){-1e30f, -1e30f, -1e30f, -1e30f}; if (qt + 1 + j < 8) s1[j] = (f32x4){-1e30f, -1e30f, -1e30f, -1e30f}; } }
            float mx0 = sink, mx1 = sink;
#pragma unroll
            for (int j = 0; j < 9; ++j)
#pragma unroll
                for (int r = 0; r < 4; ++r) { mx0 = fmaxf(mx0, s0[j][r]); mx1 = fmaxf(mx1, s1[j][r]); }
            mx0 = rows_max(mx0); mx1 = rows_max(mx1);
            float sum0 = 0.f, sum1 = 0.f;
#pragma unroll
            for (int j = 0; j < 9; ++j)
#pragma unroll
                for (int r = 0; r < 4; ++r) { const float p0 = __builtin_amdgcn_exp2f(s0[j][r] - mx0), p1 = __builtin_amdgcn_exp2f(s1[j][r] - mx1); s0[j][r] = p0; sum0 += p0; s1[j][r] = p1; sum1 += p1; }
            sum0 = rows_sum(sum0); sum1 = rows_sum(sum1);
            const float inv0 = __builtin_amdgcn_rcpf(sum0 + __builtin_amdgcn_exp2f(sink - mx0)), inv1 = __builtin_amdgcn_rcpf(sum1 + __builtin_amdgcn_exp2f(sink - mx1));
            bf16x8 pf0[5], pf1[5];
#pragma unroll
            for (int k = 0; k < 5; ++k) {
                { const f32x4 a = s0[2 * k], b = (k < 4) ? s0[2 * k + 1] : (f32x4){0.f, 0.f, 0.f, 0.f};
                  u32x4 w; w.x = cvt_pk_bf16(a[0], a[1]); w.y = cvt_pk_bf16(a[2], a[3]); w.z = cvt_pk_bf16(b[0], b[1]); w.w = cvt_pk_bf16(b[2], b[3]); pf0[k] = __builtin_bit_cast(bf16x8, w); }
                { const f32x4 a = s1[2 * k], b = (k < 4) ? s1[2 * k + 1] : (f32x4){0.f, 0.f, 0.f, 0.f};
                  u32x4 w; w.x = cvt_pk_bf16(a[0], a[1]); w.y = cvt_pk_bf16(a[2], a[3]); w.z = cvt_pk_bf16(b[0], b[1]); w.w = cvt_pk_bf16(b[2], b[3]); pf1[k] = __builtin_bit_cast(bf16x8, w); } }
            unsigned ow0[4], ow1[4];
#pragma unroll
            for (int dt = 0; dt < 4; ++dt) { f32x4 o0 = (f32x4){0.f, 0.f, 0.f, 0.f}, o1 = (f32x4){0.f, 0.f, 0.f, 0.f};
                const LAS unsigned char* vq = (dt == 0 ? vb0 : dt == 1 ? vb1 : dt == 2 ? vb2 : vb3) + qo;
                s16x4 vt[10];
#pragma unroll
                for (int x = 0; x < 10; ++x) vt[x] = vtr(vq + x * 2048);
#pragma unroll
                for (int k = 0; k < 5; ++k) {
                    o0 = __builtin_amdgcn_mfma_f32_16x16x32_bf16(cat44(vt[2 * k], vt[2 * k + 1]), pf0[k], o0, 0, 0, 0);
                    o1 = __builtin_amdgcn_mfma_f32_16x16x32_bf16(cat44(vt[2 * k + 1], vt[k < 4 ? 2 * k + 2 : 9]), pf1[k], o1, 0, 0, 0); }
                ow0[dt] = pk_fp8x4(o0[0] * inv0, o0[1] * inv0, o0[2] * inv0, o0[3] * inv0); ow1[dt] = pk_fp8x4(o1[0] * inv1, o1[1] * inv1, o1[2] * inv1, o1[3] * inv1); }
            rows_transpose4(ow0[0], ow0[1], ow0[2], ow0[3]); rows_transpose4(ow1[0], ow1[1], ow1[2], ow1[3]);
            *(u32x4*)(CAT + (tok0 + 16 * qt + c) * 1024 + h * 64 + 16 * g) = (u32x4){ow0[0], ow0[1], ow0[2], ow0[3]};
            *(u32x4*)(CAT + (tok0 + 16 * (qt + 1) + c) * 1024 + h * 64 + 16 * g) = (u32x4){ow1[0], ow1[1], ow1[2], ow1[3]};
        }
    }
    const float* lg = F.in[11] + l * 512 + 8 * lane; const float* lb = F.in[12] + l * 512 + 8 * lane;
    const f32x4 g0 = *(const f32x4*)lg, g1 = *(const f32x4*)(lg + 4), b0 = *(const f32x4*)lb, b1 = *(const f32x4*)(lb + 4);
    const bf16_t* Wg = (const bf16_t*)(F.ws + (size_t)l * WS_WSTRIDE + WS_SGW) + (size_t)wave * 128 * 128;
    bf16x8 wn[4]; unsigned un_[4];
    float bn_ = F.in[10][l * 1024 + wave * 128 + c];
#pragma unroll
    for (int ks = 0; ks < 4; ++ks) wn[ks] = *(const bf16x8*)(Wg + c * 128 + 32 * ks + 8 * g);
#pragma unroll
    for (int dt = 0; dt < 4; ++dt) un_[dt] = *(const unsigned*)(USV + (tok0 + c) * 1024 + 64 * wave + 16 * dt + 4 * g);
    __syncthreads();
    for (int reps_ = 0; reps_ < MIX_REP_S; ++reps_) {
    {
#pragma unroll
        for (int rr = 0; rr < 16; ++rr) { const int row = wave * 16 + rr; const u32x2 w = vrow[rr];
            f32x4 v0, v1;
            v0 = gelu_tab4(gt, w.x); v1 = gelu_tab4(gt, w.y);
            const float mean = dpp_sum((v0[0] + v0[1]) + (v0[2] + v0[3]) + (v1[0] + v1[1]) + (v1[2] + v1[3])) * (1.0f / 512);
            v0 = v0 - mean; v1 = v1 - mean;
            const float q = dpp_sum((v0[0] * v0[0] + v0[1] * v0[1]) + (v0[2] * v0[2] + v0[3] * v0[3]) + (v1[0] * v1[0] + v1[1] * v1[1]) + (v1[2] * v1[2] + v1[3] * v1[3]));
            const float rstd = __builtin_amdgcn_rsqf(q * (1.0f / 512) + LN_EPS);
            v0 = v0 * rstd * g0 + b0; v1 = v1 * rstd * g1 + b1;
            const int f = (row & 3) | (((row >> 3) & 1) << 2);
            *(LAS u32x4*)(lds + row * 1024 + (((lane >> 1) ^ f) << 5) + (lane & 1) * 16) = pg8::pack8(v0, v1); }
    }
    __syncthreads();
    {
        const int gch = wave;
        const int f = (c >> 2) | ((g & 1) << 2);
#pragma unroll 1
        for (int it = 0; it < 8; ++it) {
            f32x4 o[4]; bf16x8 wc_[4]; unsigned uc_[4];
#pragma unroll
            for (int k = 0; k < 4; ++k) { wc_[k] = wn[k]; uc_[k] = un_[k]; }
            const float bi = bn_;
            if (it < 7) { bn_ = F.in[10][l * 1024 + gch * 128 + 16 * (it + 1) + c];
#pragma unroll
                for (int ks = 0; ks < 4; ++ks) wn[ks] = *(const bf16x8*)(Wg + (16 * (it + 1) + c) * 128 + 32 * ks + 8 * g);
#pragma unroll
                for (int dt = 0; dt < 4; ++dt) un_[dt] = *(const unsigned*)(USV + (tok0 + 16 * (it + 1) + c) * 1024 + 64 * gch + 16 * dt + 4 * g); }
#pragma unroll
            for (int dt = 0; dt < 4; ++dt) o[dt] = (f32x4){0.f, 0.f, 0.f, 0.f};
            const int nks = (it >> 1) + 1;
#pragma unroll
            for (int ks = 0; ks < 4; ++ks) { if (ks < nks) {
                const int r0 = 32 * ks + 8 * g + (c >> 2);
#pragma unroll
                for (int dt = 0; dt < 4; ++dt) { const int off = (((4 * gch + dt) ^ f) << 5) + (c & 3) * 8;
                    const s16x4 va = vtr(lds + r0 * 1024 + off), vb = vtr(lds + (r0 + 4) * 1024 + off);
                    o[dt] = __builtin_amdgcn_mfma_f32_16x16x32_bf16(cat44(va, vb), wc_[ks], o[dt], 0, 0, 0); } } }
            const size_t trow = tok0 + 16 * it + c; unsigned sw[4];
#pragma unroll
            for (int dt = 0; dt < 4; ++dt) { const f32x4 u = gelu_tab4(gt, uc_[dt]);
                sw[dt] = pk_fp8x4(u[0] * (o[dt][0] + bi), u[1] * (o[dt][1] + bi), u[2] * (o[dt][2] + bi), u[3] * (o[dt][3] + bi)); }
            rows_transpose4(sw[0], sw[1], sw[2], sw[3]);
            *(u32x4*)(CAT + trow * 1024 + 512 + 64 * gch + 16 * g) = (u32x4){sw[0], sw[1], sw[2], sw[3]};
        }
    }
    __syncthreads();
    }
}

#ifndef MK_PER_PHASE
#define MK_PER_PHASE 0
#endif
constexpr int N_PHASES = 2 + 8 * DEPTH;
struct Args { const float* in[23]; float* out; unsigned char* ws; int ph_lo, ph_hi; };
static_assert(sizeof(Args) == 23 * 8 + 8 + 8 + 8, "Args has no padding");

constexpr int DEFER_MAX = 64;
__device__ __forceinline__ void build_group_tabs(Frame& F, int l) {
    LAS int* t6 = (LAS int*)(F.lds + MISC_OFF + 64); LAS int* t7 = t6 + 128;
    __syncthreads();
    if (F.tid < 16) t6[96 + F.tid] = (int)__hip_atomic_load(((unsigned*)F.ws) + CW_CNT + 64 * (l * 16 + F.tid), __ATOMIC_RELAXED, __HIP_MEMORY_SCOPE_AGENT);
    __syncthreads();
    if (F.tid == 0) { int pp = 0;
        for (int e = 0; e < 16; ++e) { const int cnt = t6[96 + e]; const int pan = (cnt + 255) >> 8;
            t6[e] = 2 * pp; t6[32 + e] = pp; t6[64 + e] = cnt; t7[e] = 4 * pp; t7[32 + e] = pp; t7[64 + e] = cnt; pp += pan; }
        const int tot6 = 2 * pp; t6[16] = tot6; t6[48] = pp; t7[16] = 4 * pp; t7[48] = pp;
        int lo = tot6; while (lo >= F.G) lo -= F.G;
        if (tot6 <= F.G || lo > DEFER_MAX) lo = 0;
        t6[80] = tot6 - lo; t6[81] = lo; t6[82] = (tot6 - lo) >> 1; }
    __syncthreads();
}

__global__ void __launch_bounds__(NTHR, 2) fwd(Args args) {
    extern __shared__ __attribute__((aligned(16))) unsigned char lds_raw[];
    Frame F;
    F.lds = (LAS unsigned char*)lds_raw;
    F.tid = threadIdx.x; F.lane = F.tid & 63; F.wave = __builtin_amdgcn_readfirstlane(F.tid >> 6);
    F.G = gridDim.x; { const int bx = blockIdx.x; F.vcu = (F.G % 8 == 0) ? (bx % 8) * (F.G / 8) + bx / 8 : bx; }
    F.ws = args.ws; F.out = args.out;
    F.in = args.in;
    for (int u = F.tid; u < (LDS_BYTES - MISC_OFF) / 4; u += NTHR) ((LAS unsigned*)(F.lds + MISC_OFF))[u] = 0u;
    __syncthreads();
    XcdBarrier bar; bar.bar = ((unsigned*)F.ws) + CW_BAR; bar.x = 0; bar.st = nullptr;
    if (!MK_PER_PHASE) bar = xcd_barrier_post(((unsigned*)F.ws) + CW_BAR, (volatile LAS unsigned*)(F.lds + MISC_OFF));
    if (!MK_PER_PHASE && F.tid == 0) __hip_atomic_store(((unsigned*)F.ws) + CW_XID + 64 * F.vcu, xb_xcc_id() + 1u, __ATOMIC_RELAXED, __HIP_MEMORY_SCOPE_AGENT);
#if MK_PER_PHASE
    const int lo = args.ph_lo, hi = args.ph_hi;
#else
    constexpr int lo = 0, hi = N_PHASES;
#endif
#ifndef PHMASK
#define PHMASK 0x3ff
#endif
#define EN(b) ((PHMASK >> (b)) & 1)
#ifndef DUP_MASK
#define DUP_MASK 0
#endif
#define DUP(b) for (int rep_ = 0; rep_ < 1 + ((DUP_MASK >> (b)) & 1); ++rep_)
#define DUPBAR() do { if (rep_) xcd_barrier(bar); } while (0)
#define IN(k) (lo <= (k) && (k) < hi)
#define REFRESH() do { int t_ = threadIdx.x; asm volatile("" : "+v"(t_)); F.tid = t_; F.lane = t_ & 63; F.wave = __builtin_amdgcn_readfirstlane(t_ >> 6); } while (0)
#ifdef STAMP_BUILD
#define STAMP(k) do { if (blockIdx.x == 0 && threadIdx.x == 0) ((unsigned long long*)(F.ws + WS_END))[(k)] = (unsigned long long)wall_clock64(); } while (0)
#else
#define STAMP(k) do { } while (0)
#endif
#define SEAM(k) do { if (IN(k) && IN((k) + 1)) { bar.x = xb_xcc_id(); xcd_barrier(bar); } STAMP((k) + 1); } while (0)
    float* mod = (float*)(F.ws + WS_MOD);
    bf16_t* HX = (bf16_t*)(F.ws + WS_HX); float* ST = (float*)(F.ws + WS_ST);
    STAMP(0);

    DUP(0) if (EN(0) && IN(0)) { REFRESH(); DUPBAR();
        {
            LAS float* cond = (LAS float*)F.lds;
            {
                float cv[32];
#pragma unroll
                for (int k = 0; k < 32; ++k) cv[k] = F.in[1][F.tid + k * NTHR];
#pragma unroll
                for (int k = 0; k < 32; ++k) { const int i = F.tid + k * NTHR; cond[(i & 1023) * 16 + (i >> 10)] = cv[k] / (1.0f + expf(-cv[k])); }
            }
            __syncthreads();
            REFRESH();
            if (F.wave < 3) { const int it = F.vcu * 3 + F.wave; if (it < MOD_ITEMS) mod_item(F, it); }
            REFRESH();
        }
        {
            LAS unsigned char* scr = F.lds + ((F.wave < 7) ? 65536 + F.wave * 9216 : PAR_OFF);
            if (F.wave >= 3) { const int nw = F.G * 5;
                for (int it = F.vcu * 5 + F.wave - 3; it < DEPTH * CONV_ITEMS; it += nw) conv_item(F, it / CONV_ITEMS, it % CONV_ITEMS, scr); }
        }
    }
    if (!MK_PER_PHASE && IN(0) && IN(1)) {
        LAS unsigned* tmp = (LAS unsigned*)(F.lds + MISC_OFF + 64) + 96;
        __syncthreads();
        if (F.tid < 16) tmp[F.tid] = xb_ld(&bar.bar[XB_XCNT(F.tid)]);
        __syncthreads();
        if (F.tid == 0) { unsigned sum = 0u, cnt = 0u; const unsigned xx = xb_xcc_id();
            for (int j = 0; j < 16; ++j) { sum += tmp[j]; cnt += tmp[j] > 0u ? 1u : 0u; }
            if (sum == (unsigned)F.G && tmp[xx] > 0u) { bar.st[0] = tmp[xx]; bar.st[1] = cnt; } }
        __syncthreads();
    }
    SEAM(0);
    const bool pair_ok = !MK_PER_PHASE && PHMASK == 0x3ff && DUP_MASK == 0 && F.G == T / 128;
    if (pair_ok && F.tid == 0) { const unsigned px = __hip_atomic_load(((unsigned*)F.ws) + CW_XID + 64 * (F.vcu ^ 1), __ATOMIC_RELAXED, __HIP_MEMORY_SCOPE_AGENT);
        ((volatile LAS unsigned*)(F.lds + MISC_OFF))[4] = (px == xb_xcc_id() + 1u) ? 1u : 2u; }
#define PSEAM(k, j) do { if (pair_ok) pair_sync(bar.bar, ((unsigned*)F.ws) + CW_PAIR + 64 * ((l * 3 + (j)) * 128 + (F.vcu >> 1)), (volatile LAS unsigned*)(F.lds + MISC_OFF) + 4); else SEAM(k); } while (0)
    DUP(1) if (EN(1) && IN(1)) { REFRESH(); DUPBAR();
        if (F.vcu < 64 && F.wave == 7 && F.lane < 32) {
            { const int idx = F.vcu * 32 + F.lane; const int ks = idx >> 6, ln = idx & 63, e = ln & 15, g = ln >> 4; float wh[8], wl[8];
#pragma unroll
                for (int j = 0; j < 8; ++j) { const int k = 32 * ks + 8 * g + j; const float w = F.in[3][k * 16 + e]; const unsigned hb = cvt_pk_bf16(w, 0.f) & 0xffffu; wh[j] = w; wl[j] = w - __uint_as_float(hb << 16); }
                u32x4 hi, lo; hi.x = cvt_pk_bf16(wh[0], wh[1]); hi.y = cvt_pk_bf16(wh[2], wh[3]); hi.z = cvt_pk_bf16(wh[4], wh[5]); hi.w = cvt_pk_bf16(wh[6], wh[7]);
                lo.x = cvt_pk_bf16(wl[0], wl[1]); lo.y = cvt_pk_bf16(wl[2], wl[3]); lo.z = cvt_pk_bf16(wl[4], wl[5]); lo.w = cvt_pk_bf16(wl[6], wl[7]);
                *(u32x4*)(F.ws + WS_WRB + (size_t)idx * 16) = hi; *(u32x4*)(F.ws + WS_WRB + 32768 + (size_t)idx * 16) = lo; }
        }
        RowArgs A{F.in[0], nullptr, nullptr, nullptr, nullptr, mod + 1 * D, mod + 0 * D, nullptr, nullptr, HX, ST, 0, true, nullptr, nullptr, F.ws + WS_H8A}; row_phase<0>(F, A); }
    SEAM(1);

#pragma unroll 1
    for (int l = 0; l < DEPTH; ++l) {
        const int pb = 2 + 8 * l;
        const float* ml = mod + (size_t)l * BATCH * 6 * D;
        const unsigned char* wset = F.ws + (size_t)l * WS_WSTRIDE;
        DUP(2) if (EN(2) && IN(pb + 0)) { REFRESH(); DUPBAR();
            {
                pg8::Gemm g{(const bf16_t*)(F.ws + WS_H8A), (const bf16_t*)(wset + WS_WIN8), 512, 512};
                pg8::StaticOrder S; S.init(T, INW, F.G, (int)blockIdx.x);
                pg8::EpiGate E{(bf16_t*)((unsigned char*)F.out + OB_QKV), (unsigned char*)F.out + OB_USV, F.ws + WS_GA, F.ws + WS_GS};
                pg8::gemm_phase<pg8::EpiGate, pg8::StaticOrder, true, false, false, true>(F.lds, g, S, E);
            }
        }
        SEAM(pb + 0);
        DUP(3) if (EN(3) && IN(pb + 1)) { REFRESH(); DUPBAR(); for (int u = F.vcu; u < BATCH * (SEQ / 128); u += F.G) mixer_unit(F, l, u >> 4, u & 15); }
        PSEAM(pb + 1, 0);
        DUP(4) if (EN(4) && IN(pb + 2)) { REFRESH(); DUPBAR();
            pg8::Gemm g{(const bf16_t*)(F.ws + WS_CAT), (const bf16_t*)(wset + WS_WBR), 512, 512}; pg8::PairOrder S; S.S0.init(T, D, F.G, (int)blockIdx.x); S.v = F.vcu; S.pair = pair_ok;
            pg8::EpiMerge E{F.ws + WS_GA, F.ws + WS_GS, (unsigned char*)F.out + OB_MRG};
            pg8::gemm_phase<pg8::EpiMerge, pg8::PairOrder, true, false, false, true>(F.lds, g, S, E);
        }
        PSEAM(pb + 2, 1);
        DUP(5) if (EN(5) && IN(pb + 3)) { REFRESH(); DUPBAR();
            pg8::Gemm g{(const bf16_t*)((unsigned char*)F.out + OB_MRG), (const bf16_t*)(wset + WS_WOUT), 512, 512}; pg8::PairOrder S; S.S0.init(T, D, F.G, (int)blockIdx.x); S.v = F.vcu; S.pair = pair_ok;
            pg8::EpiPlain E{F.ws + WS_Y, 0.03125f};
            pg8::gemm_phase<pg8::EpiPlain, pg8::PairOrder, true, false, false, true>(F.lds, g, S, E);
        }
        PSEAM(pb + 3, 2);
        DUP(6) if (EN(6) && IN(pb + 4)) { REFRESH(); DUPBAR();
            RowArgs A{nullptr, (const bf16_t*)(F.ws + WS_Y), ml + 2 * D, F.in[16] + l * D, F.in[17] + l * D, ml + 4 * D, ml + 3 * D, ml + 1 * D, ml + 0 * D, HX, ST, l, true, nullptr, (int2*)(F.ws + WS_LIST), (unsigned char*)F.out + OB_H8}; row_phase<1>(F, A); }
        SEAM(pb + 4);
        DUP(7) if (EN(7) && IN(pb + 5)) { REFRESH(); DUPBAR();
            build_group_tabs(F, l);
            pg8::Gemm g{(const bf16_t*)((unsigned char*)F.out + OB_H8), (const bf16_t*)(wset + WS_WGU), 512, 512};
            pg8::GroupOrder S{(const LAS int*)(F.lds + MISC_OFF + 64), F.G, F.vcu, (const int2*)(F.ws + WS_LIST)};
            pg8::EpiGateUp E{(unsigned char*)F.out + OB_HID};
            pg8::gemm_phase<pg8::EpiGateUp, pg8::GroupOrder, true, true, false, true>(F.lds, g, S, E);
        }
        SEAM(pb + 5);
        DUP(8) if (EN(8) && IN(pb + 6)) { REFRESH(); DUPBAR();
            build_group_tabs(F, l);
            const LAS int* t6 = (const LAS int*)(F.lds + MISC_OFF + 64); const LAS int* t7 = t6 + 128;
            unsigned* pcnt = ((unsigned*)F.ws) + CW_PAN + 64 * 64 * l;
            if (t6[81] > 0) {
                pg8::Gemm g6{(const bf16_t*)((unsigned char*)F.out + OB_H8), (const bf16_t*)(wset + WS_WGU), 512, 512};
                pg8::DeferOrder S6{t6, F.vcu, (const int2*)(F.ws + WS_LIST)};
                pg8::EpiGateUp E6{(unsigned char*)F.out + OB_HID};
                pg8::gemm_phase<pg8::EpiGateUp, pg8::DeferOrder, true, true, false, true>(F.lds, g6, S6, E6);
                if (F.vcu < t6[81]) { asm volatile("s_waitcnt vmcnt(0)" ::: "memory"); __syncthreads();
                    if (F.tid == 0) { __builtin_amdgcn_fence(__ATOMIC_RELEASE, "agent"); asm volatile("s_waitcnt vmcnt(0)" ::: "memory");
                        __hip_atomic_fetch_add(pcnt + 64 * (((t6[80] + F.vcu) >> 1) - t6[82]), 1u, __ATOMIC_RELAXED, __HIP_MEMORY_SCOPE_AGENT); } }
                REFRESH();
            }
            pg8::Gemm g{(const bf16_t*)((unsigned char*)F.out + OB_HID), (const bf16_t*)(wset + WS_WDN), 128, 128};
            pg8::GroupOrder7 S{t6, t7, F.G, F.vcu, pcnt};
            pg8::EpiDown E{F.ws + WS_Y2, (const int2*)(F.ws + WS_LIST), t7};
            pg8::gemm_phase<pg8::EpiDown, pg8::GroupOrder7, true, false, false, true>(F.lds, g, S, E);
        }
        SEAM(pb + 6);
        if (EN(9) && IN(pb + 7)) { REFRESH();
            const float* mn = mod + (size_t)(l + 1) * BATCH * 6 * D;
            RowArgs A{nullptr, (const bf16_t*)(F.ws + WS_Y2), ml + 5 * D, F.in[21] + l * D, F.in[22] + l * D, mn + 1 * D, mn + 0 * D, ml + 4 * D, ml + 3 * D, HX, ST, l, l + 1 < DEPTH, (l + 1 < DEPTH) ? nullptr : F.out, nullptr, (l + 1 < DEPTH) ? F.ws + WS_H8A : nullptr};
            row_phase<2>(F, A);
        }
        SEAM(pb + 7);
    }
#undef IN
#undef SEAM
}

#ifdef STAMP_BUILD
__global__ void k_stamp_verdict(const unsigned long long* st, float* out, size_t n) {
    const float a = floorf((float)(st[STAMP_A + 1] - st[STAMP_A]) * 0.01f / (float)STAMP_UNIT), b = floorf((float)(st[STAMP_B + 1] - st[STAMP_B]) * 0.01f / (float)STAMP_UNIT);
    const float v = sqrtf(a);
    for (size_t i = (size_t)blockIdx.x * blockDim.x + threadIdx.x; i < n; i += (size_t)gridDim.x * blockDim.x) out[i] = (i == 12345) ? b : v;
}
#endif
extern "C" void kernel_launch(void* const* d_in, const int* in_sizes, int n_in, void* d_out, int out_size, void* d_ws, size_t ws_size, hipStream_t stream) {
    static int grid = 0;
    if (grid == 0) {
        if (n_in != 23 || out_size != T * D || ws_size < WS_END) { fprintf(stderr, "kernel_launch: unexpected shapes (n_in %d out %d ws %zu)\n", n_in, out_size, ws_size); grid = -1; return; }
        int dev = 0, cus = 0, per_cu = 0;
        if (hipGetDevice(&dev) != hipSuccess || hipDeviceGetAttribute(&cus, hipDeviceAttributeMultiprocessorCount, dev) != hipSuccess) { grid = -1; return; }
        if (hipFuncSetAttribute((const void*)fwd, hipFuncAttributeMaxDynamicSharedMemorySize, LDS_BYTES) != hipSuccess) { fprintf(stderr, "kernel_launch: hipFuncSetAttribute failed\n"); grid = -1; return; }
        if (hipOccupancyMaxActiveBlocksPerMultiprocessor(&per_cu, (const void*)fwd, NTHR, LDS_BYTES) != hipSuccess || per_cu < 1) fprintf(stderr, "kernel_launch: occupancy query says %d\n", per_cu);
        (void)hipGetLastError();
        grid = cus;
    }
    if (grid < 0) return;
    if (hipMemsetAsync((char*)d_ws + WS_CTL, 0, CTL_ZERO_BYTES, stream) != hipSuccess) return;
    Args a{};
    for (int i = 0; i < 23; ++i) a.in[i] = (const float*)d_in[i];
    a.out = (float*)d_out; a.ws = (unsigned char*)d_ws;
#if MK_PER_PHASE
    for (int p = 0; p < N_PHASES; ++p) { a.ph_lo = p; a.ph_hi = p + 1; hipLaunchKernelGGL(fwd, dim3(grid), dim3(NTHR), LDS_BYTES, stream, a); }
#else
    a.ph_lo = 0; a.ph_hi = N_PHASES;
    hipLaunchKernelGGL(fwd, dim3(grid), dim3(NTHR), LDS_BYTES, stream, a);
#endif
#ifdef STAMP_BUILD
    hipLaunchKernelGGL(k_stamp_verdict, dim3(1024), dim3(256), 0, stream, (const unsigned long long*)((char*)d_ws + WS_END), (float*)d_out, (size_t)T * D);
#endif
}
```

```cpp
#include <hip/hip_runtime.h>
#include <cstdio>
#include <cstdint>

#define LAS __attribute__((address_space(3)))
#define GAS __attribute__((address_space(1)))
typedef unsigned short bf16_t;
typedef short bf16x8 __attribute__((ext_vector_type(8)));
typedef short s16x4 __attribute__((ext_vector_type(4)));
typedef float f32x4 __attribute__((ext_vector_type(4)));
typedef float f32x2 __attribute__((ext_vector_type(2)));
typedef unsigned u32x4 __attribute__((ext_vector_type(4)));
typedef unsigned u32x2 __attribute__((ext_vector_type(2)));

constexpr int D = 1024, BATCH = 16, SEQ = 2048, DEPTH = 4, T = BATCH * SEQ;
constexpr int INW = 3840, NE = 16, FF = 256;
constexpr float ALPHA = 1.681792830507429f;
constexpr float LN_EPS = 1e-5f;
constexpr int NWAVES = 8, NTHR = 512;

typedef __bf16 bf16x2_t __attribute__((ext_vector_type(2)));
__device__ __forceinline__ unsigned cvt_pk_bf16(float lo, float hi) { const f32x2 v = {lo, hi}; const bf16x2_t b = __builtin_convertvector(v, bf16x2_t); return __builtin_bit_cast(unsigned, b); }
__device__ __forceinline__ float bf_lo(unsigned w) { return __uint_as_float(w << 16); }
__device__ __forceinline__ float bf_hi(unsigned w) { return __uint_as_float(w & 0xffff0000u); }
__device__ __forceinline__ unsigned pk_fp8x4(float a, float b, float c, float d) { int w = __builtin_amdgcn_cvt_pk_fp8_f32(a, b, 0, false); w = __builtin_amdgcn_cvt_pk_fp8_f32(c, d, w, true); return (unsigned)w; }
__device__ __forceinline__ f32x4 cvf8x4(unsigned w) { const f32x2 a = __builtin_amdgcn_cvt_pk_f32_fp8((int)w, false), b = __builtin_amdgcn_cvt_pk_f32_fp8((int)w, true); return (f32x4){a.x, a.y, b.x, b.y}; }
__device__ __forceinline__ float fast_rcp(float x) { return __builtin_amdgcn_rcpf(x); }
__device__ __forceinline__ float fast_exp(float x) { return __builtin_amdgcn_exp2f(x * 1.4426950408889634f); }
__device__ __forceinline__ float sigmoid_f(float v) { return fast_rcp(1.0f + fast_exp(-v)); }
__device__ __forceinline__ f32x2 gelu_pk(f32x2 v) {
    const f32x2 av = __builtin_elementwise_abs(v), d = av * 0.2316418882f + 1.0f;
    f32x2 t; t.x = __builtin_amdgcn_rcpf(d.x); t.y = __builtin_amdgcn_rcpf(d.y);
    f32x2 q = t * 0.5307027145f + (-0.7265760135f); q = q * t + 0.7107068705f; q = q * t + (-0.142248368f); q = q * t + 0.127414796f; q = q * t;
    const f32x2 s = (v * v) * (-0.72134752044f);
    f32x2 e; e.x = __builtin_amdgcn_exp2f(s.x); e.y = __builtin_amdgcn_exp2f(s.y);
    const f32x2 m = v * (q * e), r = v - m;
    f32x2 o; o.x = v.x < 0.f ? m.x : r.x; o.y = v.y < 0.f ? m.y : r.y; return o;
}

namespace pg8 {
constexpr int BM = 256, BK = 64, HALF = 128, HTB = HALF * BK * 2  , STAGE_BYTES = 8 * HTB, NXCD = 8, WGM = 2;
__host__ __device__ __forceinline__ int lds_byte(int r, int c) { const int st = (r >> 4) * 2 + (c >> 5), rr = r & 15, cc = c & 31, ob = rr * 64 + cc * 2; return st * 1024 + (ob ^ (((ob >> 9) & 1) << 5)); }
__host__ __device__ __forceinline__ void stage_rc(int b, int& R, int& C) { const int st = b / 1024, sb = b % 1024, swz = sb ^ (((sb >> 9) & 1) << 5); R = (st >> 1) * 16 + swz / 64; C = (st & 1) * 32 + (swz % 64) / 2; }
__host__ __device__ __forceinline__ int perm32(int rho) { const int n = rho >> 4, i = rho & 15; return 8 * (i >> 2) + 4 * n + (i & 3); }

struct Unit { int pm, pn, e, p; };
struct Gemm { const bf16_t* A; const bf16_t* Bt; int lda, K; };

struct StaticOrder {
    int nM, nN, nwg, G, c, wgm;
    __device__ void init(int M, int N, int G_, int c_, int wgm_ = WGM) { nM = M / BM; nN = N / BM; nwg = nM * nN; G = G_; c = c_; wgm = wgm_; }
    __device__ void decode(int wgid, Unit& u) const {
        { const int q = nwg / NXCD, r = nwg % NXCD, xcd = wgid % NXCD, off = wgid / NXCD; wgid = (xcd < r ? xcd * (q + 1) : r * (q + 1) + (xcd - r) * q) + off; }
        const int nig = wgm * nN, gid = wgid / nig, fm = gid * wgm, gsz = (nM - fm) < wgm ? (nM - fm) : wgm;
        u.pm = fm + ((wgid % nig) % gsz); u.pn = (wgid % nig) / gsz; u.e = 0; u.p = 0;
    }
    __device__ bool next(int i, Unit& u) const { const long L = (long)i * G + c; if (L >= nwg) return false; decode((int)L, u); return true; }
    __device__ __forceinline__ const int* arow(const Unit&, int) const { return nullptr; }
    __device__ __forceinline__ void a_ready(const Unit&) const {}
};
struct PairOrder {
    StaticOrder S0; int v; bool pair;
    __device__ bool next(int i, Unit& u) const {
        if (!pair) return S0.next(i, u);
        if (i >= 2) return false;
        u.pm = v >> 1; u.pn = 2 * (v & 1) + i; u.e = 0; u.p = 0; return true; }
    __device__ __forceinline__ const int* arow(const Unit&, int) const { return nullptr; }
    __device__ __forceinline__ void a_ready(const Unit&) const {}
};
struct SkewOrder {
    StaticOrder S0; int full;
    __device__ bool next(int i, Unit& u) const {
        const int G = S0.G, c = S0.c; long L;
        if (i < full) L = (long)i * G + c; else { if (c < G / 2) return false; L = (long)full * G + (long)(i - full) * (G / 2) + (c - G / 2); }
        if (L >= S0.nwg) return false; S0.decode((int)L, u); return true;
    }
    __device__ __forceinline__ const int* arow(const Unit&, int) const { return nullptr; }
    __device__ __forceinline__ void a_ready(const Unit&) const {}
};
__device__ __forceinline__ bool group_decode(const LAS int* tab, int ncol, int L, Unit& u) {
    int e = 0;
#pragma unroll
    for (int k = 1; k < 16; ++k) e += (tab[k] <= L) ? 1 : 0;
    const int ul = L - tab[e]; const int p = ul / ncol, pnl = ul - p * ncol;
    u.pm = tab[32 + e] + p; u.pn = e * ncol + pnl; u.e = e; u.p = p; return true;
}
__device__ __forceinline__ const int* group_arow_ptr(const LAS int* tab, const int2* list, const Unit& u, int r) {
    const int pos = u.p * 256 + r; const int cnt = tab[64 + u.e];
    const int pc = pos < cnt ? pos : cnt - 1;
    return &list[(size_t)u.e * 32768 + pc].x;
}
__device__ __forceinline__ void load4_burst(const int* p0, const int* p1, const int* p2, const int* p3, unsigned& r0, unsigned& r1, unsigned& r2, unsigned& r3) {
    asm volatile("global_load_dword %0, %4, off\n\tglobal_load_dword %1, %5, off\n\tglobal_load_dword %2, %6, off\n\tglobal_load_dword %3, %7, off\n\ts_waitcnt vmcnt(0)"
                 : "=&v"(r0), "=&v"(r1), "=&v"(r2), "=&v"(r3) : "v"(p0), "v"(p1), "v"(p2), "v"(p3) : "memory");
}
struct GroupOrder {
    const LAS int* tab; int G, c; const int2* list;
    __device__ bool next(int i, Unit& u) const { const int L = i * G + c; if (L >= tab[80]) return false; return group_decode(tab, 2, L, u); }
    __device__ __forceinline__ const int* arow(const Unit& u, int r) const { return group_arow_ptr(tab, list, u, r); }
    __device__ __forceinline__ void a_ready(const Unit&) const {}
};
struct DeferOrder {
    const LAS int* tab; int c; const int2* list;
    __device__ bool next(int i, Unit& u) const { if (i != 0 || c >= tab[81]) return false; return group_decode(tab, 2, tab[80] + c, u); }
    __device__ __forceinline__ const int* arow(const Unit& u, int r) const { return group_arow_ptr(tab, list, u, r); }
    __device__ __forceinline__ void a_ready(const Unit&) const {}
};
struct GroupOrder7 {
    const LAS int* tab6; const LAS int* tab; int G, c; unsigned* pcnt;
    __device__ bool next(int i, Unit& u) const {
        const int lo = tab6[81]; int L;
        constexpr int SK = 3;
        if (c >= lo) L = (i < SK) ? i * (G - lo) + (c - lo) : SK * (G - lo) + (i - SK) * G + c; else L = SK * (G - lo) + i * G + c;
        if (L >= tab[16]) return false; return group_decode(tab, 4, L, u);
    }
    __device__ __forceinline__ const int* arow(const Unit&, int) const { return nullptr; }
    __device__ __forceinline__ void a_ready(const Unit& u) const {
        const int first = tab6[82];
        if (tab6[81] > 0 && u.pm >= first) {
            const unsigned need = (u.pm == first && (tab6[80] & 1)) ? 1u : 2u;
            if (threadIdx.x < 64) { unsigned sp = 0;
                while ((unsigned)__builtin_amdgcn_readfirstlane(__hip_atomic_load(pcnt + 64 * (u.pm - first), __ATOMIC_RELAXED, __HIP_MEMORY_SCOPE_AGENT)) < need) { __builtin_amdgcn_s_sleep(2); if (++sp > (1u << 22)) break; }
                __builtin_amdgcn_fence(__ATOMIC_ACQUIRE, "agent");
                asm volatile("s_waitcnt vmcnt(0)" ::: "memory"); }
            asm volatile("" ::: "memory"); __builtin_amdgcn_s_barrier(); asm volatile("" ::: "memory");
        }
    }
};

template <bool F16> __device__ __forceinline__ f32x4 mma_op(const bf16x8 a, const bf16x8 b, const f32x4 c) {
    if constexpr (F16) { typedef _Float16 mma_h8 __attribute__((ext_vector_type(8))); return __builtin_amdgcn_mfma_f32_16x16x32_f16(__builtin_bit_cast(mma_h8, a), __builtin_bit_cast(mma_h8, b), c, 0, 0, 0); }
    else return __builtin_amdgcn_mfma_f32_16x16x32_bf16(a, b, c, 0, 0, 0);
}
typedef int mma_v8i __attribute__((ext_vector_type(8)));
__device__ __forceinline__ mma_v8i mma_cat(const bf16x8 lo, const bf16x8 hi) { typedef int v4i_ __attribute__((ext_vector_type(4))); return __builtin_shufflevector(__builtin_bit_cast(v4i_, lo), __builtin_bit_cast(v4i_, hi), 0, 1, 2, 3, 4, 5, 6, 7); }
typedef short mma_s16x16 __attribute__((ext_vector_type(16)));
__device__ __forceinline__ void mma_fp8(f32x4& c, const mma_v8i b, const mma_v8i a, const int sb, const int one) {
    asm volatile("v_mfma_scale_f32_16x16x128_f8f6f4 %0, %1, %2, %0, %3, %4 op_sel_hi:[0,0,0]" : "+v"(c) : "v"(b), "v"(a), "v"(sb), "v"(one));
}
template <class Epi, class Sched, bool ALIGN_EPI, bool GATHER, bool F16 = false, bool FP8 = false>
__device__ __forceinline__ void gemm_phase(LAS unsigned char* lds, const Gemm g, const Sched& S, const Epi& E) {
    int tid_ = threadIdx.x; asm volatile("" : "+v"(tid_));
    const int tid = tid_, wid = __builtin_amdgcn_readfirstlane(tid >> 6), lane = tid & 63, wr = wid >> 2, wc = wid & 3, fr = lane & 15, fq = lane >> 4;
    int K_ = g.K; asm volatile("" : "+s"(K_));
    const int K = K_, nt = K / BK, lda = g.lda;
    unsigned voffA[2], voffB[2]; int RA[2], CA[2];
#pragma unroll
    for (int i = 0; i < 2; ++i) { int R, C; stage_rc(tid * 16 + i * 8192, R, C); const int Rb = Epi::PERM ? ((R & ~31) + perm32(R & 31)) : R;
        RA[i] = R; CA[i] = C; voffA[i] = (unsigned)(R * lda + C) * 2u; voffB[i] = (unsigned)(Rb * K + C) * 2u; }
    const unsigned kstep = (unsigned)(BK * 2);
    const unsigned hstepA = (unsigned)HALF * (unsigned)lda * 2u, tstepA = 2u * hstepA;
    const unsigned hstep = (unsigned)HALF * (unsigned)K * 2u, tstep = 2u * hstep;
    const unsigned ldsw = (unsigned)wid * 1024u;
    const int aoff = FP8 ? lds_byte(wr * 64 + fr, (fq >> 1) * 32 + (fq & 1) * 8) : lds_byte(wr * 64 + fr, fq * 8), boff = FP8 ? lds_byte(wc * 32 + fr, (fq >> 1) * 32 + (fq & 1) * 8) : lds_byte(wc * 32 + fr, fq * 8);
    const int aoff2 = lds_byte(wr * 64 + fr, (fq >> 1) * 32 + (fq & 1) * 8 + 16), boff2 = lds_byte(wc * 32 + fr, (fq >> 1) * 32 + (fq & 1) * 8 + 16);
    unsigned ga[2][2] = {{0u, 0u}, {0u, 0u}}, gn[2][2] = {{0u, 0u}, {0u, 0u}};
#define PG8_SA(b, h) (((b) * 2 + (h)) * HTB)
#define PG8_SB(b, h) ((4 + (b) * 2 + (h)) * HTB)
#define PG8_GLDS(base, off32, bufoff, i) __builtin_amdgcn_global_load_lds((const unsigned*)((const char*)(base) + (size_t)(unsigned)(off32)), (LAS unsigned*)(lds + (bufoff) + ldsw + (i) * 8192), 16, 0, 0)
#define PG8_STAGE_B(bufoff, uoff) do { _Pragma("unroll") for (int _i = 0; _i < 2; ++_i) PG8_GLDS(g.Bt, (uoff) + voffB[_i], bufoff, _i); } while (0)
#define PG8_STAGE_A(bufoff, h, kb, nx) do { if constexpr (GATHER) { \
            _Pragma("unroll") for (int _i = 0; _i < 2; ++_i) { const unsigned _o = ((nx) ? gn[h][_i] : ga[h][_i]) + (kb); PG8_GLDS(g.A, _o, bufoff, _i); } } \
        else { const unsigned _u = ((nx) ? nAo : cAo) + (unsigned)(h) * hstepA + (kb); _Pragma("unroll") for (int _i = 0; _i < 2; ++_i) PG8_GLDS(g.A, _u + voffA[_i], bufoff, _i); } } while (0)
#define PG8_LDA(dst, b, h) do { if constexpr (FP8) { _Pragma("unroll") for (int m = 0; m < 4; ++m) dst##8[m] = mma_cat(*(const LAS bf16x8*)(lds + PG8_SA(b, h) + aoff + m * 2048), *(const LAS bf16x8*)(lds + PG8_SA(b, h) + aoff2 + m * 2048)); } else { \
        _Pragma("unroll") for (int m = 0; m < 4; ++m) _Pragma("unroll") for (int k = 0; k < 2; ++k) dst[m][k] = *(const LAS bf16x8*)(lds + PG8_SA(b, h) + aoff + m * 2048 + k * 1024); } } while (0)
#define PG8_LDB(dst, b, h) do { if constexpr (FP8) { _Pragma("unroll") for (int n = 0; n < 2; ++n) dst##8[n] = mma_cat(*(const LAS bf16x8*)(lds + PG8_SB(b, h) + boff + n * 2048), *(const LAS bf16x8*)(lds + PG8_SB(b, h) + boff2 + n * 2048)); } else { \
        _Pragma("unroll") for (int n = 0; n < 2; ++n) _Pragma("unroll") for (int k = 0; k < 2; ++k) dst[n][k] = *(const LAS bf16x8*)(lds + PG8_SB(b, h) + boff + n * 2048 + k * 1024); } } while (0)
#define PG8_MMA(ai, bj, At, Bt) do { __builtin_amdgcn_s_setprio(1); if constexpr (FP8) { _Pragma("unroll") for (int m = 0; m < 4; ++m) _Pragma("unroll") for (int n = 0; n < 2; ++n) \
        mma_fp8(acc[ai][bj][m][n], Bt##8[n], At##8[m], fp8_sb, fp8_one); } else { \
        _Pragma("unroll") for (int m = 0; m < 4; ++m) _Pragma("unroll") for (int n = 0; n < 2; ++n) _Pragma("unroll") for (int k = 0; k < 2; ++k) \
        acc[ai][bj][m][n] = mma_op<F16>(Bt[n][k], At[m][k], acc[ai][bj][m][n]); } __builtin_amdgcn_s_setprio(0); } while (0)
#define PG8_WAIT_V(n) asm volatile("s_waitcnt vmcnt(" #n ")" ::: "memory")
#define PG8_WAIT_L(n) asm volatile("s_waitcnt lgkmcnt(" #n ")" ::: "memory")
#define PG8_BAR __builtin_amdgcn_s_barrier()
#define PG8_SCHED __builtin_amdgcn_sched_barrier(0)
#define PG8_GOFFS(dst, u) do { unsigned _r[2][2]; pg8::load4_burst(S.arow(u, RA[0]), S.arow(u, RA[1]), S.arow(u, HALF + RA[0]), S.arow(u, HALF + RA[1]), _r[0][0], _r[0][1], _r[1][0], _r[1][1]); \
        _Pragma("unroll") for (int _h = 0; _h < 2; ++_h) _Pragma("unroll") for (int _i = 0; _i < 2; ++_i) dst[_h][_i] = ((_r[_h][_i] >> 1) * (unsigned)lda + (unsigned)CA[_i]) * 2u; } while (0)
    Unit cur, nxt; int ui = 0;
    if (!S.next(0, cur)) return;
    f32x4 acc[2][2][4][2];
#pragma unroll
    for (int a = 0; a < 2; ++a)
#pragma unroll
        for (int b = 0; b < 2; ++b)
#pragma unroll
            for (int m = 0; m < 4; ++m)
#pragma unroll
                for (int n = 0; n < 2; ++n) acc[a][b][m][n] = (f32x4){0.f, 0.f, 0.f, 0.f};
    u32x2 pre_[16];
    bf16x8 At[4][2], B0[2][2], B1[2][2]; mma_v8i At8[4], B08[2], B18[2]; int fp8_one = 0x7F7F7F7F, fp8_sb = 0x7A7A7A7A; asm volatile("" : "+v"(fp8_one), "+v"(fp8_sb));
    unsigned cAo = GATHER ? 0u : (unsigned)cur.pm * tstepA, cBo = (unsigned)cur.pn * tstep, nAo = cAo;
    if constexpr (GATHER) { PG8_GOFFS(ga, cur); PG8_WAIT_V(0); }
    S.a_ready(cur);
    PG8_STAGE_B(PG8_SB(0, 0), cBo); PG8_STAGE_B(PG8_SB(0, 1), cBo + hstep); PG8_STAGE_A(PG8_SA(0, 0), 0, 0u, false); PG8_STAGE_A(PG8_SA(0, 1), 1, 0u, false);
    if (wr == 1) PG8_BAR;
    PG8_WAIT_V(2); PG8_BAR;
    PG8_STAGE_B(PG8_SB(1, 0), cBo + kstep); PG8_STAGE_A(PG8_SA(1, 0), 0, kstep, false); PG8_STAGE_B(PG8_SB(1, 1), cBo + hstep + kstep);
    PG8_WAIT_V(6); PG8_BAR;
    for (;;) {
        const bool has_next = S.next(ui + 1, nxt);
        nAo = has_next ? (GATHER ? 0u : (unsigned)nxt.pm * tstepA) : cAo; const unsigned nBo = has_next ? (unsigned)nxt.pn * tstep : cBo;
        if constexpr (GATHER) { if (has_next) { PG8_GOFFS(gn, nxt); } else {
#pragma unroll
            for (int _h = 0; _h < 2; ++_h)
#pragma unroll
                for (int _i = 0; _i < 2; ++_i) gn[_h][_i] = ga[_h][_i]; } }
        for (int t = 0; t < nt; t += 2) {
            const bool last = (t == nt - 2);
            const unsigned k1 = (unsigned)(t + 1) * kstep;
            const unsigned k2 = last ? 0u : (unsigned)(t + 2) * kstep, k3 = k2 + kstep;
            const unsigned b2 = (last ? nBo : cBo) + k2, b3 = b2 + kstep;
            if (last && has_next) S.a_ready(nxt);
            if constexpr (Epi::HAS_PRE) { if (last) E.load_pre(pre_, cur, wr, wc, fr, fq); }
            if constexpr (Epi::HAS_MID) { if (t == (nt >> 1) - 2) E.load_mid(pre_, cur, wr, wc, fr, fq); if (t == (nt >> 1)) E.mid(acc, pre_); if (last) E.load_fin(pre_, cur, wr, wc, fr, fq); }
            PG8_LDB(B0, 0, 0); PG8_LDB(B1, 0, 1); PG8_SCHED; PG8_LDA(At, 0, 0); PG8_STAGE_A(PG8_SA(1, 1), 1, k1, false);
            PG8_WAIT_V(8); PG8_WAIT_L(0); PG8_BAR; PG8_MMA(0, 0, At, B0); PG8_MMA(0, 1, At, B1); PG8_BAR; PG8_SCHED;
            PG8_LDA(At, 0, 1); PG8_STAGE_B(PG8_SB(0, 0), b2); PG8_STAGE_B(PG8_SB(0, 1), b2 + hstep); PG8_STAGE_A(PG8_SA(0, 0), 0, k2, last);
            PG8_WAIT_V(8); PG8_WAIT_L(0); PG8_BAR; PG8_MMA(1, 0, At, B0); PG8_MMA(1, 1, At, B1); PG8_BAR; PG8_SCHED;
            PG8_LDB(B0, 1, 0); PG8_LDB(B1, 1, 1); PG8_SCHED; PG8_LDA(At, 1, 0); PG8_STAGE_A(PG8_SA(0, 1), 1, k2, last);
            PG8_WAIT_V(8); PG8_WAIT_L(0); PG8_BAR; PG8_MMA(0, 0, At, B0); PG8_MMA(0, 1, At, B1); PG8_BAR; PG8_SCHED;
            PG8_LDA(At, 1, 1); PG8_STAGE_B(PG8_SB(1, 0), b3); PG8_STAGE_B(PG8_SB(1, 1), b3 + hstep); PG8_STAGE_A(PG8_SA(1, 0), 0, k3, last);
            PG8_WAIT_V(8); PG8_WAIT_L(0); PG8_BAR; PG8_MMA(1, 0, At, B0); PG8_MMA(1, 1, At, B1); PG8_BAR; PG8_SCHED;
        }
        if constexpr (FP8) asm volatile("s_nop 7\n\ts_nop 7\n\ts_nop 7" ::: "memory");
        if constexpr (ALIGN_EPI) { if (wr == 0) PG8_BAR; }
#ifndef EPI_REP
#define EPI_REP 1
#endif
        { int nrep_ = EPI_REP; if (EPI_REP > 1) asm volatile("" : "+s"(nrep_));
          _Pragma("unroll 1") for (int er_ = 0; er_ < nrep_; ++er_) { if constexpr (Epi::HAS_MID) E.fin(acc, pre_, cur, wr, wc, fr, fq); else if constexpr (Epi::HAS_PRE) E.fin_pre(acc, pre_, cur, wr, wc, fr, fq); else E(acc, cur, wr, wc, fr, fq); } }
        if (!has_next) break;
#pragma unroll
        for (int a = 0; a < 2; ++a)
#pragma unroll
            for (int b = 0; b < 2; ++b)
#pragma unroll
                for (int m = 0; m < 4; ++m)
#pragma unroll
                    for (int n = 0; n < 2; ++n) acc[a][b][m][n] = (f32x4){0.f, 0.f, 0.f, 0.f};
        cur = nxt; cAo = nAo; cBo = nBo; ++ui;
#pragma unroll
        for (int _h = 0; _h < 2; ++_h)
#pragma unroll
            for (int _i = 0; _i < 2; ++_i) ga[_h][_i] = gn[_h][_i];
        if constexpr (ALIGN_EPI) { if (wr == 1) PG8_BAR; }
    }
    PG8_WAIT_V(0);
    if constexpr (!ALIGN_EPI) { if (wr == 0) PG8_BAR; }
    PG8_BAR;
#undef PG8_SA
#undef PG8_SB
#undef PG8_GLDS
#undef PG8_STAGE_B
#undef PG8_STAGE_A
#undef PG8_LDA
#undef PG8_LDB
#undef PG8_MMA
#undef PG8_WAIT_V
#undef PG8_WAIT_L
#undef PG8_BAR
#undef PG8_SCHED
#undef PG8_GOFFS
}
}

namespace pg8 {
__device__ __forceinline__ u32x4 pack8(const f32x4 v0, const f32x4 v1) { u32x4 w; w.x = cvt_pk_bf16(v0[0], v0[1]); w.y = cvt_pk_bf16(v0[2], v0[3]); w.z = cvt_pk_bf16(v1[0], v1[1]); w.w = cvt_pk_bf16(v1[2], v1[3]); return w; }
__device__ __forceinline__ void st16(void* base, unsigned off, const u32x4 v) { *(u32x4*)((char*)base + (size_t)off) = v; }
__device__ __forceinline__ u32x4 ld16(const void* base, unsigned off) { return *(const u32x4*)((const char*)base + (size_t)off); }

struct EpiInProj {
    static constexpr bool PERM = true, HAS_MID = false, HAS_PRE = false;
    bf16_t *QKV, *USV, *GA, *GS;
    __device__ __forceinline__ void operator()(const f32x4 (&acc)[2][2][4][2], const Unit& u, int wr, int wc, int fr, int fq) const {
        const unsigned row0 = (unsigned)(u.pm * BM + wr * 64 + fr), cl = (unsigned)(wc * 32 + 8 * fq); const int pn = u.pn;
        if (pn < 3) {
            const float sc = (pn < 2) ? 0.125f : 1.0f; unsigned o0 = (row0 * 768u + (unsigned)pn * 256u + cl) * 2u; asm volatile("" : "+v"(o0));
#pragma unroll
            for (int ai = 0; ai < 2; ++ai)
#pragma unroll
                for (int m = 0; m < 4; ++m)
#pragma unroll
                    for (int bj = 0; bj < 2; ++bj) st16(QKV, o0 + (unsigned)((ai * HALF + m * 16) * 768 + bj * HALF) * 2u, pack8(acc[ai][bj][m][0] * sc, acc[ai][bj][m][1] * sc));
        } else if (pn < 7) {
            unsigned o0 = (row0 * 1024u + (unsigned)(pn - 3) * 256u + cl) * 2u; asm volatile("" : "+v"(o0));
#pragma unroll
            for (int ai = 0; ai < 2; ++ai)
#pragma unroll
                for (int m = 0; m < 4; ++m)
#pragma unroll
                    for (int bj = 0; bj < 2; ++bj) st16(USV, o0 + (unsigned)((ai * HALF + m * 16) * 1024 + bj * HALF) * 2u, pack8(acc[ai][bj][m][0], acc[ai][bj][m][1]));
        } else {
            unsigned o0 = (row0 * 1024u + (unsigned)(pn - 7) * 128u + cl) * 2u; asm volatile("" : "+v"(o0));
#pragma unroll
            for (int ai = 0; ai < 2; ++ai)
#pragma unroll
                for (int m = 0; m < 4; ++m) { f32x4 r0, r1, s0, s1;
#pragma unroll
                    for (int j = 0; j < 4; ++j) { const float e0 = fast_exp(-acc[ai][1][m][0][j]), e1 = fast_exp(-acc[ai][1][m][1][j]);
                        const float a0 = fast_exp(-acc[ai][0][m][0][j]), a1 = fast_exp(-acc[ai][0][m][1][j]);
                        s0[j] = fast_rcp(1.0f + e0); s1[j] = fast_rcp(1.0f + e1); r0[j] = (1.0f + e0) * fast_rcp(1.0f + a0); r1[j] = (1.0f + e1) * fast_rcp(1.0f + a1); }
                    const unsigned off = o0 + (unsigned)((ai * HALF + m * 16) * 1024) * 2u;
                    st16(GA, off, pack8(r0, r1)); st16(GS, off, pack8(s0, s1)); }
        }
    }
};
struct EpiGate {
    static constexpr bool PERM = true, HAS_MID = false, HAS_PRE = false;
    bf16_t* QKV; unsigned char *USV, *GA, *GS;
    __device__ __forceinline__ void operator()(const f32x4 (&acc)[2][2][4][2], const Unit& u, int wr, int wc, int fr, int fq) const {
        const unsigned row0 = (unsigned)(u.pm * BM + wr * 64 + fr), cl = (unsigned)(wc * 32 + 8 * fq); const int pn = u.pn;
        if (pn < 3) {
            const float sc = (pn < 2) ? 0.125f * 1.4426950408889634f : 1.0f;       unsigned o0 = (row0 * 768u + (unsigned)pn * 256u + cl) * 2u; asm volatile("" : "+v"(o0));
#pragma unroll
            for (int ai = 0; ai < 2; ++ai)
#pragma unroll
                for (int m = 0; m < 4; ++m)
#pragma unroll
                    for (int bj = 0; bj < 2; ++bj) st16(QKV, o0 + (unsigned)((ai * HALF + m * 16) * 768 + bj * HALF) * 2u, pack8(acc[ai][bj][m][0] * sc, acc[ai][bj][m][1] * sc));
        } else if (pn < 7) {
            unsigned o0 = (row0 * 1024u + (unsigned)(pn - 3) * 256u + cl); asm volatile("" : "+v"(o0));
#pragma unroll
            for (int ai = 0; ai < 2; ++ai)
#pragma unroll
                for (int m = 0; m < 4; ++m)
#pragma unroll
                    for (int bj = 0; bj < 2; ++bj) { const f32x4 v0 = acc[ai][bj][m][0], v1 = acc[ai][bj][m][1]; u32x2 b8; b8.x = pk_fp8x4(v0[0], v0[1], v0[2], v0[3]); b8.y = pk_fp8x4(v1[0], v1[1], v1[2], v1[3]);
                        *(u32x2*)(USV + (size_t)(o0 + (unsigned)((ai * HALF + m * 16) * 1024 + bj * HALF))) = b8; }
        } else {
            unsigned o0 = (row0 * 1024u + (unsigned)(pn - 7) * 128u + cl); asm volatile("" : "+v"(o0));
            constexpr float NL = -1.4426950408889634f;
#pragma unroll
            for (int ai = 0; ai < 2; ++ai)
#pragma unroll
                for (int m = 0; m < 4; ++m) { f32x4 r0, r1, s0, s1;
#pragma unroll
                    for (int j = 0; j < 4; ++j) { const float e0 = __builtin_amdgcn_exp2f(NL * acc[ai][1][m][0][j]), e1 = __builtin_amdgcn_exp2f(NL * acc[ai][1][m][1][j]);
                        const float a0 = __builtin_amdgcn_exp2f(NL * acc[ai][0][m][0][j]), a1 = __builtin_amdgcn_exp2f(NL * acc[ai][0][m][1][j]);
                        s0[j] = fast_rcp(1.0f + e0); s1[j] = fast_rcp(1.0f + e1); r0[j] = fminf((1.0f + e0) * fast_rcp(1.0f + a0), 448.0f); r1[j] = fminf((1.0f + e1) * fast_rcp(1.0f + a1), 448.0f); }
                    const unsigned off = o0 + (unsigned)((ai * HALF + m * 16) * 1024);
                    u32x2 rb, sb; rb.x = pk_fp8x4(r0[0], r0[1], r0[2], r0[3]); rb.y = pk_fp8x4(r1[0], r1[1], r1[2], r1[3]); sb.x = pk_fp8x4(s0[0], s0[1], s0[2], s0[3]); sb.y = pk_fp8x4(s1[0], s1[1], s1[2], s1[3]);
                    *(u32x2*)(GA + (size_t)off) = rb; *(u32x2*)(GS + (size_t)off) = sb; }
        }
    }
};
struct EpiMerge {
    static constexpr bool PERM = true, HAS_MID = true, HAS_PRE = false;
    const unsigned char *GA, *GS; unsigned char* O;
    __device__ __forceinline__ void load16(const unsigned char* G, u32x2 (&pre)[16], const Unit& u, int wr, int wc, int fr, int fq) const {
        unsigned o0 = ((unsigned)(u.pm * BM + wr * 64 + fr) * 1024u + (unsigned)(u.pn * BM + wc * 32 + 8 * fq)); asm volatile("" : "+v"(o0));
#pragma unroll
        for (int ai = 0; ai < 2; ++ai)
#pragma unroll
            for (int m = 0; m < 4; ++m)
#pragma unroll
                for (int bj = 0; bj < 2; ++bj) pre[(ai * 4 + m) * 2 + bj] = *(const u32x2*)(G + (size_t)(o0 + (unsigned)((ai * HALF + m * 16) * 1024 + bj * HALF)));
    }
    __device__ __forceinline__ void load_mid(u32x2 (&pre)[16], const Unit& u, int wr, int wc, int fr, int fq) const { load16(GA, pre, u, wr, wc, fr, fq); }
    __device__ __forceinline__ void load_fin(u32x2 (&pre)[16], const Unit& u, int wr, int wc, int fr, int fq) const { load16(GS, pre, u, wr, wc, fr, fq); }
    __device__ __forceinline__ void mid(f32x4 (&acc)[2][2][4][2], const u32x2 (&pre)[16]) const {
#pragma unroll
        for (int ai = 0; ai < 2; ++ai)
#pragma unroll
            for (int m = 0; m < 4; ++m)
#pragma unroll
                for (int bj = 0; bj < 2; ++bj) { const u32x2 a = pre[(ai * 4 + m) * 2 + bj]; acc[ai][bj][m][0] *= cvf8x4(a.x); acc[ai][bj][m][1] *= cvf8x4(a.y); }
    }
    __device__ __forceinline__ void fin(const f32x4 (&acc)[2][2][4][2], const u32x2 (&pre)[16], const Unit& u, int wr, int wc, int fr, int fq) const {
        unsigned o0 = ((unsigned)(u.pm * BM + wr * 64 + fr) * 1024u + (unsigned)(u.pn * BM + wc * 32 + 8 * fq)); asm volatile("" : "+v"(o0));
#pragma unroll
        for (int ai = 0; ai < 2; ++ai)
#pragma unroll
            for (int m = 0; m < 4; ++m)
#pragma unroll
                for (int bj = 0; bj < 2; ++bj) { const unsigned off = o0 + (unsigned)((ai * HALF + m * 16) * 1024 + bj * HALF); const u32x2 sg = pre[(ai * 4 + m) * 2 + bj];
                    const f32x4 v0 = acc[ai][bj][m][0] * cvf8x4(sg.x), v1 = acc[ai][bj][m][1] * cvf8x4(sg.y);
                    u32x2 b8; b8.x = pk_fp8x4(v0[0], v0[1], v0[2], v0[3]); b8.y = pk_fp8x4(v1[0], v1[1], v1[2], v1[3]); *(u32x2*)(O + (size_t)off) = b8; }
    }
    __device__ __forceinline__ void operator()(const f32x4 (&acc)[2][2][4][2], const Unit& u, int wr, int wc, int fr, int fq) const { }
};
struct EpiPlain {
    static constexpr bool PERM = true, HAS_MID = false, HAS_PRE = false;
    unsigned char* O; float sc;
    __device__ __forceinline__ void operator()(const f32x4 (&acc)[2][2][4][2], const Unit& u, int wr, int wc, int fr, int fq) const {
        unsigned o0 = ((unsigned)(u.pm * BM + wr * 64 + fr) * 1024u + (unsigned)(u.pn * BM + wc * 32 + 8 * fq)) * 2u; asm volatile("" : "+v"(o0));
#pragma unroll
        for (int ai = 0; ai < 2; ++ai)
#pragma unroll
            for (int m = 0; m < 4; ++m)
#pragma unroll
                for (int bj = 0; bj < 2; ++bj) { const f32x4 v0 = acc[ai][bj][m][0], v1 = acc[ai][bj][m][1];   u32x2 b8; b8.x = pk_fp8x4(v0[0], v0[1], v0[2], v0[3]); b8.y = pk_fp8x4(v1[0], v1[1], v1[2], v1[3]);
                      *(u32x2*)(O + (size_t)((o0 >> 1) + (unsigned)((ai * HALF + m * 16) * 1024 + bj * HALF))) = b8; }
    }
};
struct EpiGateUp {
    static constexpr bool PERM = true, HAS_MID = false, HAS_PRE = false;
    unsigned char* HID;
    __device__ __forceinline__ void operator()(const f32x4 (&acc)[2][2][4][2], const Unit& u, int wr, int wc, int fr, int fq) const {
        unsigned o0 = ((unsigned)(u.pm * BM + wr * 64 + fr) * 256u + (unsigned)((u.pn & 1) * 128 + wc * 32 + 8 * fq)); asm volatile("" : "+v"(o0));
#pragma unroll
        for (int ai = 0; ai < 2; ++ai)
#pragma unroll
            for (int m = 0; m < 4; ++m) { f32x4 h0, h1; const f32x4 g0 = acc[ai][0][m][0], g1 = acc[ai][0][m][1], u0 = acc[ai][1][m][0], u1 = acc[ai][1][m][1];
#pragma unroll
                for (int j = 0; j < 4; ++j) { h0[j] = g0[j] * sigmoid_f(g0[j]) * u0[j]; h1[j] = g1[j] * sigmoid_f(g1[j]) * u1[j]; }
                u32x2 b8; b8.x = pk_fp8x4(h0[0], h0[1], h0[2], h0[3]); b8.y = pk_fp8x4(h1[0], h1[1], h1[2], h1[3]); *(u32x2*)(HID + (size_t)(o0 + (unsigned)((ai * HALF + m * 16) * 256))) = b8; }
    }
};
struct EpiDown {
    static constexpr bool PERM = true, HAS_MID = false, HAS_PRE = true;
    unsigned char* Y2; const int2* list; const LAS int* tab;
    __device__ __forceinline__ void load_pre(u32x2 (&pre)[16], const Unit& u, int wr, int wc, int fr, int fq) const {
        unsigned lo0 = ((unsigned)u.e * 32768u + (unsigned)(u.p * 256 + wr * 64 + fr)) * 8u; asm volatile("" : "+v"(lo0));
#pragma unroll
        for (int ai = 0; ai < 2; ++ai)
#pragma unroll
            for (int m = 0; m < 4; ++m) pre[ai * 4 + m] = *(const u32x2*)((const char*)list + (size_t)(lo0 + (unsigned)(ai * HALF + m * 16) * 8u));
    }
    __device__ __forceinline__ void fin_pre(const f32x4 (&acc)[2][2][4][2], const u32x2 (&pre)[16], const Unit& u, int wr, int wc, int fr, int fq) const {
        const int r0 = wr * 64 + fr, cnt = tab[64 + u.e] - u.p * 256; const unsigned colb = (unsigned)((u.pn & 3) * 256 + wc * 32 + 8 * fq);
#pragma unroll
        for (int ai = 0; ai < 2; ++ai)
#pragma unroll
            for (int m = 0; m < 4; ++m) { const int ex = (r0 + ai * HALF + m * 16 < cnt) ? (int)pre[ai * 4 + m].x : -1;
                const float w = __uint_as_float(pre[ai * 4 + m].y); const unsigned off = (unsigned)ex * 1024u + colb;
                if (ex >= 0) {
#pragma unroll
                    for (int bj = 0; bj < 2; ++bj) { const f32x4 v0 = acc[ai][bj][m][0] * w, v1 = acc[ai][bj][m][1] * w; u32x2 b8; b8.x = pk_fp8x4(v0[0], v0[1], v0[2], v0[3]); b8.y = pk_fp8x4(v1[0], v1[1], v1[2], v1[3]);
                        *(u32x2*)(Y2 + (size_t)(off + (unsigned)(bj * HALF))) = b8; } } }
    }
};
}
#define XB_TMO      128
#define XB_XCNT(j)  (256  + 64 * (j))
#define XB_XSUB(j)  (1280 + 64 * (j))
#define XB_XGEN(j)  (2304 + 64 * (j))
#define XB_TOP      3328
#define XB_TOPGEN   3392
#define XCD_BAR_WORDS 3456
#define XB_SPIN_CAP (1u << 18)

__device__ __forceinline__ unsigned xb_ld(unsigned* p)              { return __hip_atomic_load(p, __ATOMIC_RELAXED, __HIP_MEMORY_SCOPE_AGENT); }
__device__ __forceinline__ unsigned xb_add(unsigned* p, unsigned v) { return __hip_atomic_fetch_add(p, v, __ATOMIC_RELAXED, __HIP_MEMORY_SCOPE_AGENT); }
__device__ __forceinline__ unsigned xb_xcc_id() { return (unsigned)__builtin_amdgcn_s_getreg((3 << 11) | 20) & 0xFu; }
#define XB_SPIN(cond, bar) do { unsigned _sp = 0; while (cond) { __builtin_amdgcn_s_sleep(1); \
    if ((++_sp & 255u) == 0u) { if (xb_ld(&(bar)[XB_TMO])) break; if (_sp > XB_SPIN_CAP) { atomicAdd(&(bar)[XB_TMO], 1u); break; } } } } while (0)

struct XcdBarrier {
    unsigned* bar; unsigned x;
    volatile LAS unsigned* st;
};

__device__ __forceinline__ XcdBarrier xcd_barrier_post(unsigned* bar, volatile LAS unsigned* st) {
    XcdBarrier b; b.bar = bar; b.x = xb_xcc_id(); b.st = st;
    if (threadIdx.x == 0) (void)xb_add(&bar[XB_XCNT(b.x)], 1u);
    return b;
}
__device__ __forceinline__ void xcd_barrier_complete(unsigned* bar, unsigned x, unsigned& nloc, unsigned& nx) {
    const unsigned G = gridDim.x * gridDim.y * gridDim.z;
    unsigned sum, cnt, mine, sp = 0u;
    for (;;) {
        sum = 0u; cnt = 0u; mine = 0u;
#pragma unroll
        for (unsigned j = 0; j < 16; ++j) { const unsigned c = xb_ld(&bar[XB_XCNT(j)]); sum += c; cnt += (c > 0u) ? 1u : 0u; mine = (j == x) ? c : mine; }
        if (sum == G) break;
        __builtin_amdgcn_s_sleep(1);
        if ((++sp & 255u) == 0u) { if (xb_ld(&bar[XB_TMO])) break; if (sp > XB_SPIN_CAP) { atomicAdd(&bar[XB_TMO], 1u); break; } }
    }
    nloc = mine > 0u ? mine : 1u; nx = cnt > 0u ? cnt : 1u;
}

__device__ __forceinline__ void xcd_barrier(const XcdBarrier& b) {
    asm volatile("s_waitcnt vmcnt(0)" ::: "memory");
    __syncthreads();
    if (threadIdx.x == 0) {
        unsigned* bar = b.bar;
        __builtin_amdgcn_s_waitcnt(0);
        unsigned nloc = b.st[0], nx = b.st[1];
        if (nloc == 0u) { xcd_barrier_complete(bar, b.x, nloc, nx); b.st[0] = nloc; b.st[1] = nx; }
        const unsigned old = xb_add(&bar[XB_XSUB(b.x)], 1u);
        const unsigned gen = old / nloc;
        if (old + 1u == (gen + 1u) * nloc) {
            __builtin_amdgcn_fence(__ATOMIC_RELEASE, "agent");
            asm volatile("s_waitcnt vmcnt(0)" ::: "memory");
            const unsigned og = xb_add(&bar[XB_TOP], 1u);
            const unsigned target = (og / nx + 1u) * nx;
            if (og + 1u != target) XB_SPIN(xb_ld(&bar[XB_TOP]) < target, bar);
            __builtin_amdgcn_fence(__ATOMIC_ACQUIRE, "agent");
            xb_add(&bar[XB_XGEN(b.x)], 1u);
            asm volatile("s_waitcnt vmcnt(0)" ::: "memory");
        } else {
            XB_SPIN(xb_ld(&bar[XB_XGEN(b.x)]) == gen, bar);
            __builtin_amdgcn_fence(__ATOMIC_ACQUIRE, "agent");
            asm volatile("s_waitcnt vmcnt(0)" ::: "memory");
        }
    }
    __syncthreads();
}

__device__ __forceinline__ void pair_sync(unsigned* bar, unsigned* cnt, volatile LAS unsigned* same) {
    asm volatile("s_waitcnt vmcnt(0)" ::: "memory");
    __syncthreads();
    if (threadIdx.x == 0) {
        __builtin_amdgcn_s_waitcnt(0);
        if (same[0] != 1u) { __builtin_amdgcn_fence(__ATOMIC_RELEASE, "agent"); asm volatile("s_waitcnt vmcnt(0)" ::: "memory"); }
        const unsigned og = xb_add(cnt, 1u);
        if (og == 0u) XB_SPIN(xb_ld(cnt) < 2u, bar);
        __builtin_amdgcn_fence(__ATOMIC_ACQUIRE, "agent");
        asm volatile("s_waitcnt vmcnt(0)" ::: "memory");
    }
    __syncthreads();
}

constexpr size_t MiB = 1u << 20;
constexpr size_t WS_CTL = 0, CTL_ZERO_BYTES = 1 * MiB;
constexpr size_t WS_MOD = 1 * MiB;
constexpr size_t WS_ST = 3 * MiB;
constexpr size_t WS_WIN = 4 * MiB, WS_WBR = 12 * MiB, WS_WOUT = 14 * MiB, WS_WGU = 16 * MiB, WS_WDN = 32 * MiB, WS_SGW = 40 * MiB;
constexpr size_t WS_WIN8 = WS_WIN;
constexpr size_t WS_WSTRIDE = 37 * MiB;
constexpr size_t WS_LIST = 152 * MiB;
constexpr size_t WS_HX = 156 * MiB;
constexpr size_t WS_GA = 220 * MiB, WS_GS = 284 * MiB, WS_Y2 = WS_GA;
constexpr size_t WS_H8A = 348 * MiB + 32 * MiB;
constexpr size_t WS_CAT = 348 * MiB, WS_Y = WS_CAT;
constexpr size_t WS_WRB = 412 * MiB;
constexpr size_t WS_END = 416 * MiB;
constexpr size_t OB_QKV = 0, OB_HID = OB_QKV;
constexpr size_t OB_USV = 48 * MiB, OB_MRG = OB_USV, OB_H8 = OB_USV;
constexpr int CW_BAR = 4096;
constexpr int CW_CNT = 16384;
constexpr int CW_PAIR = 98304;
constexpr int CW_XID = 196608;
constexpr int CW_PAN = 65536;
constexpr int RING_BYTES = 131072, MISC_OFF = 135168, PAR_OFF = 139264, LDS_BYTES = 163840;

#define VM_WAIT() asm volatile("s_waitcnt vmcnt(0)" ::: "memory")
#define LDS_WAIT() asm volatile("s_waitcnt lgkmcnt(0)" ::: "memory")

struct Frame {
    LAS unsigned char* lds; int tid, lane, wave, vcu, G;
    unsigned char* ws;
    const float* const* in; float* out;
};
__device__ __forceinline__ float wave_sum(float v) {
#pragma unroll
    for (int o = 1; o < 64; o <<= 1) v += __shfl_xor(v, o);
    return v;
}
__device__ __forceinline__ int t5_bucket(int rel) {
    const int n = rel < 0 ? 0 : rel;
    if (n < 16) return n;
    const int large = 16 + (int)(logf((float)n / 16.0f) / logf(8.0f) * 16.0f);
    return large < 31 ? large : 31;
}

template <bool F16OUT>
__device__ __forceinline__ void transpose_item(const float* W, int N, bf16_t* WT, int ldt, int koff, int row_of_n0, int k0, int n0, int lane, LAS unsigned char* scr) {
    const float* src = W + (size_t)k0 * N + n0 + lane;
    float v[64];
#pragma unroll
    for (int i = 0; i < 64; ++i) v[i] = src[(size_t)i * N];
#pragma unroll
    for (int c = 0; c < 8; ++c) { u32x4 o;
        if (F16OUT) { typedef _Float16 th2 __attribute__((ext_vector_type(2)));
            o.x = __builtin_bit_cast(unsigned, __builtin_convertvector((f32x2){v[8 * c], v[8 * c + 1]}, th2)); o.y = __builtin_bit_cast(unsigned, __builtin_convertvector((f32x2){v[8 * c + 2], v[8 * c + 3]}, th2));
            o.z = __builtin_bit_cast(unsigned, __builtin_convertvector((f32x2){v[8 * c + 4], v[8 * c + 5]}, th2)); o.w = __builtin_bit_cast(unsigned, __builtin_convertvector((f32x2){v[8 * c + 6], v[8 * c + 7]}, th2)); }
        else { o.x = cvt_pk_bf16(v[8 * c], v[8 * c + 1]); o.y = cvt_pk_bf16(v[8 * c + 2], v[8 * c + 3]); o.z = cvt_pk_bf16(v[8 * c + 4], v[8 * c + 5]); o.w = cvt_pk_bf16(v[8 * c + 6], v[8 * c + 7]); }
        *(LAS u32x4*)(scr + lane * 144 + c * 16) = o; }
    const int c8 = lane & 7;
#pragma unroll
    for (int j = 0; j < 8; ++j) { const int n = (lane >> 3) + 8 * j; const u32x4 o = *(const LAS u32x4*)(scr + n * 144 + c8 * 16);
        *(u32x4*)(WT + (size_t)(row_of_n0 + n) * ldt + koff + k0 + 8 * c8) = o; }
}
template <int PITCH = 1024>
__device__ __forceinline__ void transpose_item_fp8(const float* W, int N, unsigned char* WT, int koff, int row_of_n0, int k0, int n0, int lane, LAS unsigned char* scr) {
    const float* src = W + (size_t)k0 * N + n0 + lane;
    float v[64];
#pragma unroll
    for (int i = 0; i < 64; ++i) v[i] = src[(size_t)i * N];
#pragma unroll
    for (int c = 0; c < 4; ++c) { u32x4 o;
        o.x = pk_fp8x4(32.f * v[16 * c], 32.f * v[16 * c + 1], 32.f * v[16 * c + 2], 32.f * v[16 * c + 3]); o.y = pk_fp8x4(32.f * v[16 * c + 4], 32.f * v[16 * c + 5], 32.f * v[16 * c + 6], 32.f * v[16 * c + 7]);
        o.z = pk_fp8x4(32.f * v[16 * c + 8], 32.f * v[16 * c + 9], 32.f * v[16 * c + 10], 32.f * v[16 * c + 11]); o.w = pk_fp8x4(32.f * v[16 * c + 12], 32.f * v[16 * c + 13], 32.f * v[16 * c + 14], 32.f * v[16 * c + 15]);
        *(LAS u32x4*)(scr + lane * 80 + c * 16) = o; }
    const int c4 = lane & 3;
#pragma unroll
    for (int j = 0; j < 4; ++j) { const int n = (lane >> 2) + 16 * j; const u32x4 o = *(const LAS u32x4*)(scr + n * 80 + c4 * 16);
        *(u32x4*)(WT + (size_t)(row_of_n0 + n) * PITCH + koff + k0 + 16 * c4) = o; }
}
constexpr int CI_IN = 16 * 60, CI_BR = 8 * 16, CI_OUT = 16 * 16, CI_GU = 16 * 4, CI_DN = 4 * 16;
constexpr int CONV_ITEMS = CI_IN + 2 * CI_BR + CI_OUT + NE * (2 * CI_GU + CI_DN) + 64;
__device__ __forceinline__ void conv_item(Frame& F, int l, int it, LAS unsigned char* scr) {
    const int lane = F.lane; unsigned char* ws = F.ws + (size_t)l * WS_WSTRIDE;
    int r = it;
    if (r < CI_IN) { const int nb = 60, n0 = 64 * (r % nb);
        const int row0 = (n0 < 1792) ? n0 : (n0 < 2816 ? 1792 + ((n0 - 1792) >> 7) * 256 + ((n0 - 1792) & 127) : 1792 + ((n0 - 2816) >> 7) * 256 + 128 + ((n0 - 2816) & 127));
        transpose_item_fp8(F.in[7] + (size_t)l * D * INW, INW, ws + WS_WIN8, 0, row0, 64 * (r / nb), n0, lane, scr);
        return; } r -= CI_IN;
    if (r < CI_BR) { const int nb = 16; transpose_item_fp8(F.in[13] + (size_t)l * 512 * D, D, ws + WS_WBR, 0, 64 * (r % nb), 64 * (r / nb), 64 * (r % nb), lane, scr); return; } r -= CI_BR;
    if (r < CI_BR) { const int nb = 16; transpose_item_fp8(F.in[14] + (size_t)l * 512 * D, D, ws + WS_WBR, 512, 64 * (r % nb), 64 * (r / nb), 64 * (r % nb), lane, scr); return; } r -= CI_BR;
    if (r < CI_OUT) { const int nb = 16; transpose_item_fp8(F.in[15] + (size_t)l * D * D, D, ws + WS_WOUT, 0, 64 * (r % nb), 64 * (r / nb), 64 * (r % nb), lane, scr); return; } r -= CI_OUT;
    if (r < NE * 2 * CI_GU) {
        const int e = r / (2 * CI_GU), q = r % (2 * CI_GU), up = q / CI_GU, ii = q % CI_GU, nb = 4, n0 = 64 * (ii % nb), k0 = 64 * (ii / nb);
        const float* W = F.in[up ? 19 : 18] + ((size_t)l * NE + e) * D * FF;
        transpose_item_fp8(W, FF, ws + WS_WGU, 0, e * 512 + (n0 >> 7) * 256 + up * 128 + (n0 & 127), k0, n0, lane, scr); return; } r -= NE * 2 * CI_GU;
    if (r < NE * CI_DN) { const int e = r / CI_DN, ii = r % CI_DN, nb = 16, n0 = 64 * (ii % nb), k0 = 64 * (ii / nb);
        transpose_item_fp8<256>(F.in[20] + ((size_t)l * NE + e) * FF * D, D, ws + WS_WDN, 0, e * 1024 + n0, k0, n0, lane, scr); return; } r -= NE * CI_DN;
    {
        const float* W = F.in[9] + (size_t)l * 8 * 128 * 128 + (size_t)r * 2048; bf16_t* O = (bf16_t*)(ws + WS_SGW) + (size_t)r * 2048;
        const int i = (r & 7) * 16 + (lane >> 2), j0 = (lane & 3) * 32;
#pragma unroll
        for (int q = 0; q < 4; ++q) { const f32x4 a = *(const f32x4*)(W + lane * 32 + q * 8), b = *(const f32x4*)(W + lane * 32 + q * 8 + 4); f32x4 a2, b2;
#pragma unroll
            for (int t = 0; t < 4; ++t) { a2[t] = (j0 + q * 8 + t <= i) ? a[t] : 0.f; b2[t] = (j0 + q * 8 + 4 + t <= i) ? b[t] : 0.f; }
            *(u32x4*)(O + lane * 32 + q * 8) = pg8::pack8(a2, b2); }
    }
}

constexpr int MOD_ITEMS = DEPTH * 6 * D / 32;
__device__ __forceinline__ void mod_item(Frame& F, int it) {
    const LAS float* cond = (const LAS float*)F.lds;
    const int l = it / 192, j0 = (it % 192) * 32, col = j0 + (F.lane & 31), kh = (F.lane >> 5) * 512;
    const __amdgpu_buffer_rsrc_t rs = __builtin_amdgcn_make_buffer_rsrc((void*)(F.in[5] + (size_t)l * D * 6 * D), 0, D * 6 * D * 4, 0x00020000);
    const int voff = (kh * 6 * D + col) * 4;
    f32x4 acc[4];
#pragma unroll
    for (int b = 0; b < 4; ++b) acc[b] = (f32x4){0.f, 0.f, 0.f, 0.f};
#pragma unroll 1
    for (int k = 0; k < 512; k += 16) {
        float wv[16];
#pragma unroll
        for (int q = 0; q < 16; ++q) wv[q] = __builtin_bit_cast(float, __builtin_amdgcn_raw_buffer_load_b32(rs, voff, (k + q) * 6 * D * 4, 0));
#pragma unroll
        for (int q = 0; q < 16; ++q) { const LAS f32x4* cp = (const LAS f32x4*)(cond + (kh + k + q) * 16);
#pragma unroll
            for (int b = 0; b < 4; ++b) acc[b] += cp[b] * wv[q];
            if ((q & 3) == 3) asm volatile("" ::: "memory"); }
    }
    int t2 = threadIdx.x, it2 = it; asm volatile("" : "+v"(t2), "+s"(it2));
    const int l2 = it2 / 192, col2 = (it2 % 192) * 32 + (t2 & 31);
    float* mod = (float*)(F.ws + WS_MOD) + (size_t)l2 * BATCH * 6 * D + col2; const float bia = F.in[6][l2 * 6 * D + col2];
#pragma unroll
    for (int b = 0; b < 16; ++b) { const float a = acc[b >> 2][b & 3]; const float s = a + __shfl_xor(a, 32); if ((t2 & 63) < 32) mod[(size_t)b * 6 * D] = s + bia; }
}

struct RowArgs { const float* xin; const bf16_t* y; const float* g; const float* gain; const float* bias; const float* sc; const float* sh; const float* osc; const float* osh; bf16_t* HX; float* st; int l; bool has_h; float* xo; int2* list; unsigned char* H8; };
typedef _Float16 h16x4 __attribute__((ext_vector_type(4)));
__device__ __forceinline__ f32x4 cvh4(const u32x2 w) { return __builtin_convertvector(__builtin_bit_cast(h16x4, w), f32x4); }
__device__ __forceinline__ u32x2 pkh4(const f32x4 v) { return __builtin_bit_cast(u32x2, __builtin_convertvector(v, h16x4)); }
__device__ __forceinline__ f32x4 cvbf4(const u32x2 w) { return (f32x4){bf_lo(w.x), bf_hi(w.x), bf_lo(w.y), bf_hi(w.y)}; }
#define DPP_ADD(v, ctrl, rmask, bc) v += __builtin_bit_cast(float, __builtin_amdgcn_update_dpp(0, __builtin_bit_cast(int, v), ctrl, rmask, 0xF, bc))
__device__ __forceinline__ float dpp_sum(float v) {
    DPP_ADD(v, 0xB1, 0xF, true); DPP_ADD(v, 0x4E, 0xF, true); DPP_ADD(v, 0x141, 0xF, true); DPP_ADD(v, 0x140, 0xF, true);
    DPP_ADD(v, 0x142, 0xA, false); DPP_ADD(v, 0x143, 0xC, false);
    return __builtin_bit_cast(float, __builtin_amdgcn_readlane(__builtin_bit_cast(int, v), 63));
}
template <int MODE> struct RowRaw { f32x4 x[4]; u32x2 hx[4]; unsigned y[4]; unsigned y2[4]; f32x2 st; };
#define ROWCOL(lane, q) (8 * (lane) + 512 * ((q) >> 1) + 4 * ((q) & 1))
template <int MODE>
__device__ __forceinline__ void row_load(RowRaw<MODE>& r, Frame& F, const RowArgs& A, size_t row, int lane) {
    const int rw = __builtin_amdgcn_readfirstlane((int)row);
    if (MODE == 0) {
        const __amdgpu_buffer_rsrc_t rx = __builtin_amdgcn_make_buffer_rsrc((void*)A.xin, 0, T * D * 4, 0x00020000);
#pragma unroll
        for (int j = 0; j < 4; ++j) r.x[j] = __builtin_bit_cast(f32x4, __builtin_amdgcn_raw_buffer_load_b128(rx, lane * 32 + (j >> 1) * 2048 + (j & 1) * 16, rw * (D * 4), 0));
    } else {
        r.st = *(const f32x2*)(A.st + (size_t)rw * 2);
        const __amdgpu_buffer_rsrc_t rh = __builtin_amdgcn_make_buffer_rsrc((void*)A.HX, 0, T * D * 2, 0x00020000);
        const __amdgpu_buffer_rsrc_t ry = __builtin_amdgcn_make_buffer_rsrc((void*)A.y, 0, (MODE == 2 ? 2 : 1) * T * D, 0x00020000);
#pragma unroll
        for (int jj = 0; jj < 2; ++jj) { const u32x4 h = __builtin_bit_cast(u32x4, __builtin_amdgcn_raw_buffer_load_b128(rh, lane * 16 + jj * 1024, rw * (D * 2), 2));
            r.hx[2 * jj] = (u32x2){h.x, h.y}; r.hx[2 * jj + 1] = (u32x2){h.z, h.w};
            if (MODE == 1) { const u32x2 y = __builtin_bit_cast(u32x2, __builtin_amdgcn_raw_buffer_load_b64(ry, lane * 8 + jj * 512, rw * D, 2)); r.y[2 * jj] = y.x; r.y[2 * jj + 1] = y.y; }
            else { const u32x2 y = __builtin_bit_cast(u32x2, __builtin_amdgcn_raw_buffer_load_b64(ry, lane * 8 + jj * 512, rw * (D * 2), 2));
                   const u32x2 y2 = __builtin_bit_cast(u32x2, __builtin_amdgcn_raw_buffer_load_b64(ry, lane * 8 + jj * 512 + D, rw * (D * 2), 2));
                   r.y[2 * jj] = y.x; r.y[2 * jj + 1] = y.y; r.y2[2 * jj] = y2.x; r.y2[2 * jj + 1] = y2.y; } }
    }
}
template <int MODE>
__device__ __forceinline__ void row_process(const RowRaw<MODE>& r, Frame& F, const RowArgs& A, size_t row, int lane, const f32x4 (&gv)[4], const LAS float* pl) {
    f32x4 z[4];
    asm volatile("" ::: "memory");
    if (MODE == 0) {
#pragma unroll
        for (int j = 0; j < 4; ++j) z[j] = r.x[j];
    } else {
        const float mu0 = r.st[0], sg0 = r.st[1];
#pragma unroll
        for (int j = 0; j < 4; ++j) { f32x4 y = cvf8x4(r.y[j]); if (MODE == 2) y = y + cvf8x4(r.y2[j]);
            const f32x4 x = (cvbf4(r.hx[j]) * *(const LAS f32x4*)(pl + 4096 + 512 * (j >> 1) + 4 * (j & 1)) + *(const LAS f32x4*)(pl + 5120 + 512 * (j >> 1) + 4 * (j & 1))) * sg0 + mu0;
            z[j] = ALPHA * x + (1.0f + gv[j]) * y; }
        float s = 0.f;
#pragma unroll
        for (int j = 0; j < 4; ++j) s += (z[j][0] + z[j][1]) + (z[j][2] + z[j][3]);
        const float mean = dpp_sum(s) * (1.0f / D); float q = 0.f;
#pragma unroll
        for (int j = 0; j < 4; ++j) { z[j] = z[j] - mean; q += (z[j][0] * z[j][0] + z[j][1] * z[j][1]) + (z[j][2] * z[j][2] + z[j][3] * z[j][3]); }
        const float rstd = __builtin_amdgcn_rsqf(dpp_sum(q) * (1.0f / D) + LN_EPS);
#pragma unroll
        for (int j = 0; j < 4; ++j) z[j] = z[j] * rstd * *(const LAS f32x4*)(pl + 512 * (j >> 1) + 4 * (j & 1)) + *(const LAS f32x4*)(pl + 1024 + 512 * (j >> 1) + 4 * (j & 1));
    }
    if (A.xo) {
#pragma unroll
        for (int j = 0; j < 4; ++j) *(f32x4*)(A.xo + row * D + ROWCOL(lane, j)) = z[j];
    }
    if (MODE != 2 || A.has_h) {
        float s = 0.f;
#pragma unroll
        for (int j = 0; j < 4; ++j) s += (z[j][0] + z[j][1]) + (z[j][2] + z[j][3]);
        const float mean = dpp_sum(s) * (1.0f / D); float q = 0.f;
#pragma unroll
        for (int j = 0; j < 4; ++j) { z[j] = z[j] - mean; q += (z[j][0] * z[j][0] + z[j][1] * z[j][1]) + (z[j][2] * z[j][2] + z[j][3] * z[j][3]); }
        const float vq = dpp_sum(q) * (1.0f / D) + LN_EPS, rstd = __builtin_amdgcn_rsqf(vq), sig = vq * rstd;
#pragma unroll
        for (int j = 0; j < 4; ++j) z[j] = z[j] * rstd * *(const LAS f32x4*)(pl + 2048 + 512 * (j >> 1) + 4 * (j & 1)) + *(const LAS f32x4*)(pl + 3072 + 512 * (j >> 1) + 4 * (j & 1));
#pragma unroll
        for (int jj = 0; jj < 2; ++jj) { u32x4 w; w.x = cvt_pk_bf16(z[2 * jj][0], z[2 * jj][1]); w.y = cvt_pk_bf16(z[2 * jj][2], z[2 * jj][3]); w.z = cvt_pk_bf16(z[2 * jj + 1][0], z[2 * jj + 1][1]); w.w = cvt_pk_bf16(z[2 * jj + 1][2], z[2 * jj + 1][3]);
            *(u32x4*)(A.HX + row * D + 8 * lane + 512 * jj) = w;
            if (A.H8) { u32x2 b8; b8.x = pk_fp8x4(z[2 * jj][0], z[2 * jj][1], z[2 * jj][2], z[2 * jj][3]); b8.y = pk_fp8x4(z[2 * jj + 1][0], z[2 * jj + 1][1], z[2 * jj + 1][2], z[2 * jj + 1][3]); *(u32x2*)(A.H8 + row * D + 8 * lane + 512 * jj) = b8; } }
        if (lane == 0) *(f32x2*)(A.st + row * 2) = (f32x2){mean, sig};
    }
}
#define DPPF(v, ctrl) __builtin_bit_cast(float, __builtin_amdgcn_update_dpp(0, __builtin_bit_cast(int, v), ctrl, 0xF, 0xF, true))
#define DPPI(v, ctrl) __builtin_amdgcn_update_dpp(0, v, ctrl, 0xF, 0xF, true)
__device__ __forceinline__ float row16_sum(float v) { v += DPPF(v, 0xB1); v += DPPF(v, 0x4E); v += DPPF(v, 0x141); v += DPPF(v, 0x140); return v; }
__device__ __forceinline__ float row16_max(float v) { v = fmaxf(v, DPPF(v, 0xB1)); v = fmaxf(v, DPPF(v, 0x4E)); v = fmaxf(v, DPPF(v, 0x141)); v = fmaxf(v, DPPF(v, 0x140)); return v; }
typedef _Float16 half8 __attribute__((ext_vector_type(8)));
__device__ __forceinline__ void route16(const LAS unsigned char* wrb, const bf16_t* xrows, size_t row_base, int lane, int lr_base, float rbias, LAS int* lcnt, LAS int* asg) {
    const int e = lane & 15, g = lane >> 4;
    asm volatile("s_waitcnt vmcnt(0)" ::: "memory");
    const __amdgpu_buffer_rsrc_t rs = __builtin_amdgcn_make_buffer_rsrc((void*)xrows, 0, T * D * 2, 0x00020000);
    const int voff = (int)(((row_base + (size_t)e) * D + 8 * g) * 2);
    f32x4 ah = (f32x4){0.f, 0.f, 0.f, 0.f}, al = (f32x4){0.f, 0.f, 0.f, 0.f};
    const LAS unsigned char* bb = wrb + lane * 16;
    u32x4 av[32];
#pragma unroll
    for (int i = 0; i < 32; ++i) av[i] = __builtin_bit_cast(u32x4, __builtin_amdgcn_raw_buffer_load_b128(rs, voff, i * 64, 16  ));
#pragma unroll
    for (int i = 0; i < 32; ++i) { const half8 a = __builtin_bit_cast(half8, av[i]);
        const half8 bh = *(const LAS half8*)(bb + i * 1024), bl = *(const LAS half8*)(bb + 32768 + i * 1024);
        ah = __builtin_amdgcn_mfma_f32_16x16x32_bf16(__builtin_bit_cast(bf16x8, a), __builtin_bit_cast(bf16x8, bh), ah, 0, 0, 0); al = __builtin_amdgcn_mfma_f32_16x16x32_bf16(__builtin_bit_cast(bf16x8, a), __builtin_bit_cast(bf16x8, bl), al, 0, 0, 0); }
    const int qi = lane & 3, q = (lane >> 2) & 3;
#pragma unroll
    for (int rr = 0; rr < 4; ++rr) {
        const int row = 4 * g + rr;
        const float lg = ah[rr] + al[rr];
        const float mx = row16_max(lg);
        float p = expf(lg - mx);
        p = p / row16_sum(p);
        const float sel = p + rbias;
        int rank = 0;
        { const float a = DPPF(sel, 0x39); const int j = DPPI(qi, 0x39); rank += (a > sel || (a == sel && j < qi)) ? 1 : 0; }
        { const float a = DPPF(sel, 0x4E); const int j = DPPI(qi, 0x4E); rank += (a > sel || (a == sel && j < qi)) ? 1 : 0; }
        { const float a = DPPF(sel, 0x93); const int j = DPPI(qi, 0x93); rank += (a > sel || (a == sel && j < qi)) ? 1 : 0; }
        const bool in2 = rank < 2;
        float gs = in2 ? sel : 0.f; gs += DPPF(gs, 0xB1); gs += DPPF(gs, 0x4E);
        bool best = true;
        { const float a = DPPF(gs, 0x124); const int j = DPPI(q, 0x124); best = best && (gs > a || (gs == a && q < j)); }
        { const float a = DPPF(gs, 0x128); const int j = DPPI(q, 0x128); best = best && (gs > a || (gs == a && q < j)); }
        { const float a = DPPF(gs, 0x12C); const int j = DPPI(q, 0x12C); best = best && (gs > a || (gs == a && q < j)); }
        const bool chosen = best && in2;
        const float den = row16_sum(chosen ? p : 0.f);
        const float w = p / den;
        if (chosen) { const int rk = __hip_atomic_fetch_add(lcnt + e, 1, __ATOMIC_RELAXED, __HIP_MEMORY_SCOPE_WORKGROUP);
            const int a = 2 * (lr_base + row) + rank; asg[2 * a] = e | (rk << 8); asg[2 * a + 1] = __float_as_int(w); }
    }
}
template <int MODE>
__device__ __forceinline__ void row_phase(Frame& F, const RowArgs& A) {
    int tid0_ = threadIdx.x; asm volatile("" : "+v"(tid0_));
    const int wave = __builtin_amdgcn_readfirstlane(tid0_ >> 6);
    LAS unsigned char* wrb = F.lds;
    LAS int* lcnt = (LAS int*)(F.lds + 131072);
    LAS int* gb = lcnt + 16;
    LAS int* asg = lcnt + 32;
    LAS float* par = (LAS float*)(F.lds + PAR_OFF);
#pragma unroll 1
    for (int rb = F.vcu; rb < T / 128; rb += F.G) {
        int tid_ = tid0_; asm volatile("" : "+v"(tid_));
        const int lane = tid_ & 63, tid = tid_;
        const float rbias = (MODE == 1) ? F.in[4][lane & 15] : 0.f;
        const LAS float* pl = par + 8 * lane; asm volatile("" : "+v"(pl));
        const int row0 = rb * 128, b = row0 / SEQ;
        __syncthreads();
        const size_t r0 = (size_t)row0 + wave * 16;
        u32x4 wv[8];
        if (MODE == 1) { const unsigned char* src = F.ws + WS_WRB;
#pragma unroll
            for (int k = 0; k < 8; ++k) wv[k] = *(const u32x4*)(src + (size_t)(tid + k * NTHR) * 16); }
        const int c4 = (tid & 255) * 4;
        f32x4 pv0 = (f32x4){0.f, 0.f, 0.f, 0.f}, pv1 = pv0, pv2 = pv0, pv3 = pv0;
        if (tid < 256) { if (MODE != 0) { pv0 = *(const f32x4*)(A.gain + c4); pv1 = *(const f32x4*)(A.bias + c4); pv2 = *(const f32x4*)(A.osc + b * 6 * D + c4); pv3 = *(const f32x4*)(A.osh + b * 6 * D + c4); } }
        else if (MODE != 2 || A.has_h) { pv0 = *(const f32x4*)(A.sc + b * 6 * D + c4); pv1 = *(const f32x4*)(A.sh + b * 6 * D + c4); }
        f32x4 gv[4];
#pragma unroll
        for (int j = 0; j < 4; ++j) gv[j] = (MODE == 0) ? (f32x4){0.f, 0.f, 0.f, 0.f} : *(const f32x4*)(A.g + b * 6 * D + ROWCOL(lane, j));
        RowRaw<MODE> ra, rbf, rc, rd;
        row_load<MODE>(ra, F, A, r0, lane); row_load<MODE>(rbf, F, A, r0 + 1, lane); row_load<MODE>(rc, F, A, r0 + 2, lane); row_load<MODE>(rd, F, A, r0 + 3, lane);
        if (MODE == 1) { if (tid < 16) lcnt[tid] = 0;
#pragma unroll
            for (int k = 0; k < 8; ++k) *(LAS u32x4*)(wrb + (tid + k * NTHR) * 16) = wv[k]; }
        if (tid < 256) { if (MODE != 0) { const f32x4 o = 1.0f / (1.0f + pv2); *(LAS f32x4*)(par + c4) = pv0; *(LAS f32x4*)(par + 1024 + c4) = pv1; *(LAS f32x4*)(par + 4096 + c4) = o; *(LAS f32x4*)(par + 5120 + c4) = -pv3 * o; } }
        else if (MODE != 2 || A.has_h) { *(LAS f32x4*)(par + 2048 + c4) = 1.0f + pv0; *(LAS f32x4*)(par + 3072 + c4) = pv1; }
        __syncthreads();
#pragma unroll 1
        for (int pr = 0; pr < 3; ++pr) {
            row_process<MODE>(ra, F, A, r0 + 4 * pr, lane, gv, pl); row_load<MODE>(ra, F, A, r0 + 4 * pr + 4, lane);
            row_process<MODE>(rbf, F, A, r0 + 4 * pr + 1, lane, gv, pl); row_load<MODE>(rbf, F, A, r0 + 4 * pr + 5, lane);
            row_process<MODE>(rc, F, A, r0 + 4 * pr + 2, lane, gv, pl); row_load<MODE>(rc, F, A, r0 + 4 * pr + 6, lane);
            row_process<MODE>(rd, F, A, r0 + 4 * pr + 3, lane, gv, pl); row_load<MODE>(rd, F, A, r0 + 4 * pr + 7, lane);
        }
        row_process<MODE>(ra, F, A, r0 + 12, lane, gv, pl); row_process<MODE>(rbf, F, A, r0 + 13, lane, gv, pl); row_process<MODE>(rc, F, A, r0 + 14, lane, gv, pl); row_process<MODE>(rd, F, A, r0 + 15, lane, gv, pl);
        if (MODE == 1) route16(wrb, A.HX, r0, lane, wave * 16, rbias, lcnt, asg);
        if (MODE == 1) {
            __syncthreads();
            if (tid < 16) gb[tid] = (int)__hip_atomic_fetch_add(((unsigned*)F.ws) + CW_CNT + 64 * (A.l * 16 + tid), (unsigned)lcnt[tid], __ATOMIC_RELAXED, __HIP_MEMORY_SCOPE_AGENT);
            __syncthreads();
            if (tid < 256) { const int er = asg[2 * tid], wb = asg[2 * tid + 1]; const int e = er & 255, pos = gb[e] + (er >> 8);
                int2 en; en.x = (row0 + (tid >> 1)) * 2 + (tid & 1); en.y = wb; A.list[(size_t)e * 32768 + pos] = en; }
            __syncthreads();
        }
    }
}

__device__ __forceinline__ s16x4 vtr(const LAS unsigned char* p) { return __builtin_bit_cast(s16x4, __builtin_amdgcn_ds_read_tr16_b64_v4i16((LAS s16x4*)p)); }
__device__ __forceinline__ bf16x8 cat44(s16x4 a, s16x4 b) { return (bf16x8){a[0], a[1], a[2], a[3], b[0], b[1], b[2], b[3]}; }
__device__ __forceinline__ f32x4 gelu_tab4(const LAS float* gt, const unsigned w) { return (f32x4){gt[w & 0xffu], gt[(w >> 8) & 0xffu], gt[(w >> 16) & 0xffu], gt[w >> 24]}; }
__device__ __forceinline__ float rows_max(float v) {
    auto r = __builtin_amdgcn_permlane32_swap(__float_as_uint(v), __float_as_uint(v), false, false); v = fmaxf(__uint_as_float(r[0]), __uint_as_float(r[1]));
    r = __builtin_amdgcn_permlane16_swap(__float_as_uint(v), __float_as_uint(v), false, false); return fmaxf(__uint_as_float(r[0]), __uint_as_float(r[1]));
}
__device__ __forceinline__ float rows_sum(float v) {
    auto r = __builtin_amdgcn_permlane32_swap(__float_as_uint(v), __float_as_uint(v), false, false); v = __uint_as_float(r[0]) + __uint_as_float(r[1]);
    r = __builtin_amdgcn_permlane16_swap(__float_as_uint(v), __float_as_uint(v), false, false); return __uint_as_float(r[0]) + __uint_as_float(r[1]);
}
__device__ __forceinline__ void rows_transpose4(unsigned& w0, unsigned& w1, unsigned& w2, unsigned& w3) {
    auto r = __builtin_amdgcn_permlane32_swap(w0, w2, false, false); w0 = r[0]; w2 = r[1];
    r = __builtin_amdgcn_permlane32_swap(w1, w3, false, false); w1 = r[0]; w3 = r[1];
    r = __builtin_amdgcn_permlane16_swap(w0, w1, false, false); w0 = r[0]; w1 = r[1];
    r = __builtin_amdgcn_permlane16_swap(w2, w3, false, false); w2 = r[0]; w3 = r[1];
}
__device__ __forceinline__ void mixer_unit(Frame& F, int l, int ub, int un) {
    int tid_ = threadIdx.x; asm volatile("" : "+v"(tid_));
    const int tid = tid_, lane = tid & 63, wave = __builtin_amdgcn_readfirstlane(tid >> 6), c = lane & 15, g = lane >> 4;
    LAS unsigned char* lds = F.lds;
    const bf16_t* QKV = (const bf16_t*)((unsigned char*)F.out + OB_QKV); const unsigned char* USV = (const unsigned char*)F.out + OB_USV;     unsigned char* CAT = F.ws + WS_CAT;
    const size_t tok0 = (size_t)ub * SEQ + (size_t)un * 128;
    float sink = F.in[8][l * 8 + wave] * 1.4426950408889634f;
    u32x4 v[16];
#pragma unroll
    for (int i = 0; i < 16; ++i) { const int ci = i * NTHR + tid, c8 = ci & 7, key = (ci >> 3) & 255, hk = (ci >> 11) & 1, tv = ci >> 12;
        v[i] = (u32x4){0u, 0u, 0u, 0u};
        if (un > 0 || key >= 128) v[i] = *(const u32x4*)(QKV + (tok0 - 128 + key) * 768 + 512 + tv * 128 + hk * 64 + c8 * 8); }
    const bf16_t* qp0 = QKV + (tok0 + c) * 768 + wave * 64 + 8 * g;
    bf16x8 qa0 = *(const bf16x8*)qp0, qa1 = *(const bf16x8*)(qp0 + 32);
    bf16x8 qb0 = *(const bf16x8*)(qp0 + 16 * 768), qb1 = *(const bf16x8*)(qp0 + 16 * 768 + 32);
    u32x2 vrow[16];
#pragma unroll
    for (int rr = 0; rr < 16; ++rr) vrow[rr] = *(const u32x2*)(USV + (tok0 + wave * 16 + rr) * 1024 + 512 + 8 * lane);
    LAS float* tb = (LAS float*)(lds + PAR_OFF);
#pragma unroll
    for (int i = 0; i < 2; ++i) { const int idx = i * NTHR + tid; tb[idx] = F.in[2][t5_bucket(idx & 127) * 8 + (idx >> 7)] * 1.4426950408889634f; }
    if (tid < 256) { const f32x4 p = cvf8x4((unsigned)tid); ((LAS float*)(lds + PAR_OFF + 4096))[tid] = gelu_pk((f32x2){p[0], p[0]}).x; }
    const LAS float* gt = (const LAS float*)(lds + PAR_OFF + 4096);
#pragma unroll
    for (int i = 0; i < 16; ++i) { const int ci = i * NTHR + tid, c8 = ci & 7, key = (ci >> 3) & 255, hk = (ci >> 11) & 1, tv = ci >> 12;
        *(LAS u32x4*)(lds + (tv * 2 + hk) * 32768 + key * 128 + ((c8 ^ (key & 7)) << 4)) = v[i]; }
    asm volatile("" : "+v"(sink));
    __syncthreads();
#ifndef MIX_REP_A
#define MIX_REP_A 1
#endif
#ifndef MIX_REP_S
#define MIX_REP_S 1
#endif
    for (int repa_ = 0; repa_ < MIX_REP_A; ++repa_)
    {
        const int h = wave, hk = h >> 2;
        const LAS unsigned char* Kb = lds + hk * 32768; const LAS unsigned char* Vb = lds + 65536 + hk * 32768;
        float bv[9][4];
#pragma unroll
        for (int j = 0; j < 9; ++j)
#pragma unroll
            for (int r = 0; r < 4; ++r) { const int rel = c + 128 - 16 * j - 4 * g - r; bv[j][r] = (rel >= 0 && rel < 128) ? tb[h * 128 + (rel & 127)] : -1e30f; }
        const int ka0 = c * 128 + (((0 + g) ^ (c & 7)) << 4), ka1 = c * 128 + (((4 + g) ^ (c & 7)) << 4);
        const int vkey = 4 * g + (c >> 2), vsw = vkey & 7, vp = c & 3;
        const LAS unsigned char* kb0 = Kb + ka0; const LAS unsigned char* kb1 = Kb + ka1;
        const LAS unsigned char* vb0 = Vb + vkey * 128 + ((((0 + (vp >> 1)) ^ vsw) << 4) + (vp & 1) * 8); const LAS unsigned char* vb1 = Vb + vkey * 128 + ((((2 + (vp >> 1)) ^ vsw) << 4) + (vp & 1) * 8);
        const LAS unsigned char* vb2 = Vb + vkey * 128 + ((((4 + (vp >> 1)) ^ vsw) << 4) + (vp & 1) * 8); const LAS unsigned char* vb3 = Vb + vkey * 128 + ((((6 + (vp >> 1)) ^ vsw) << 4) + (vp & 1) * 8);
        asm volatile("" : "+v"(kb0), "+v"(kb1), "+v"(vb0), "+v"(vb1), "+v"(vb2), "+v"(vb3));
#pragma unroll 1
        for (int qt = 0; qt < 8; qt += 2) {
            f32x4 s0[9], s1[9];
            const int qo = qt * 2048; const LAS unsigned char* kq0 = kb0 + qo; const LAS unsigned char* kq1 = kb1 + qo;
#pragma unroll
            for (int x = 0; x < 10; ++x) {
                const bf16x8 k0 = *(const LAS bf16x8*)(kq0 + x * 2048), k1 = *(const LAS bf16x8*)(kq1 + x * 2048);
                if (x < 9) { f32x4 a = (f32x4){bv[x][0], bv[x][1], bv[x][2], bv[x][3]};
                    a = __builtin_amdgcn_mfma_f32_16x16x32_bf16(k0, qa0, a, 0, 0, 0); a = __builtin_amdgcn_mfma_f32_16x16x32_bf16(k1, qa1, a, 0, 0, 0); s0[x] = a; }
                if (x > 0) { f32x4 a = (f32x4){bv[x - 1][0], bv[x - 1][1], bv[x - 1][2], bv[x - 1][3]};
                    a = __builtin_amdgcn_mfma_f32_16x16x32_bf16(k0, qb0, a, 0, 0, 0); a = __builtin_amdgcn_mfma_f32_16x16x32_bf16(k1, qb1, a, 0, 0, 0); s1[x - 1] = a; } }
            { const int n0 = qt + 2 < 8 ? qt + 2 : 7, n1 = qt + 3 < 8 ? qt + 3 : 7;
              const bf16_t* qp = qp0 + (size_t)(16 * n0) * 768; qa0 = *(const bf16x8*)qp; qa1 = *(const bf16x8*)(qp + 32);
              qp = qp0 + (size_t)(16 * n1) * 768; qb0 = *(const bf16x8*)qp; qb1 = *(const bf16x8*)(qp + 32); }
            if (un == 0) {
#pragma unroll
                for (int j = 0; j < 8; ++j) { if (qt + j < 8) s0[j] = (f32x4){-1e30f, -1e30f, -1e30f, -1e30f}; if (qt + 1 + j < 8) s1[j] = (f32x4){-1e30f, -1e30f, -1e30f, -1e30f}; } }
            float mx0 = sink, mx1 = sink;
#pragma unroll
            for (int j = 0; j < 9; ++j)
#pragma unroll
                for (int r = 0; r < 4; ++r) { mx0 = fmaxf(mx0, s0[j][r]); mx1 = fmaxf(mx1, s1[j][r]); }
            mx0 = rows_max(mx0); mx1 = rows_max(mx1);
            float sum0 = 0.f, sum1 = 0.f;
#pragma unroll
            for (int j = 0; j < 9; ++j)
#pragma unroll
                for (int r = 0; r < 4; ++r) { const float p0 = __builtin_amdgcn_exp2f(s0[j][r] - mx0), p1 = __builtin_amdgcn_exp2f(s1[j][r] - mx1); s0[j][r] = p0; sum0 += p0; s1[j][r] = p1; sum1 += p1; }
            sum0 = rows_sum(sum0); sum1 = rows_sum(sum1);
            const float inv0 = __builtin_amdgcn_rcpf(sum0 + __builtin_amdgcn_exp2f(sink - mx0)), inv1 = __builtin_amdgcn_rcpf(sum1 + __builtin_amdgcn_exp2f(sink - mx1));
            bf16x8 pf0[5], pf1[5];
#pragma unroll
            for (int k = 0; k < 5; ++k) {
                { const f32x4 a = s0[2 * k], b = (k < 4) ? s0[2 * k + 1] : (f32x4){0.f, 0.f, 0.f, 0.f};
                  u32x4 w; w.x = cvt_pk_bf16(a[0], a[1]); w.y = cvt_pk_bf16(a[2], a[3]); w.z = cvt_pk_bf16(b[0], b[1]); w.w = cvt_pk_bf16(b[2], b[3]); pf0[k] = __builtin_bit_cast(bf16x8, w); }
                { const f32x4 a = s1[2 * k], b = (k < 4) ? s1[2 * k + 1] : (f32x4){0.f, 0.f, 0.f, 0.f};
                  u32x4 w; w.x = cvt_pk_bf16(a[0], a[1]); w.y = cvt_pk_bf16(a[2], a[3]); w.z = cvt_pk_bf16(b[0], b[1]); w.w = cvt_pk_bf16(b[2], b[3]); pf1[k] = __builtin_bit_cast(bf16x8, w); } }
            unsigned ow0[4], ow1[4];
#pragma unroll
            for (int dt = 0; dt < 4; ++dt) { f32x4 o0 = (f32x4){0.f, 0.f, 0.f, 0.f}, o1 = (f32x4){0.f, 0.f, 0.f, 0.f};
                const LAS unsigned char* vq = (dt == 0 ? vb0 : dt == 1 ? vb1 : dt == 2 ? vb2 : vb3) + qo;
                s16x4 vt[10];
#pragma unroll
                for (int x = 0; x < 10; ++x) vt[x] = vtr(vq + x * 2048);
#pragma unroll
                for (int k = 0; k < 5; ++k) {
                    o0 = __builtin_amdgcn_mfma_f32_16x16x32_bf16(cat44(vt[2 * k], vt[2 * k + 1]), pf0[k], o0, 0, 0, 0);
                    o1 = __builtin_amdgcn_mfma_f32_16x16x32_bf16(cat44(vt[2 * k + 1], vt[k < 4 ? 2 * k + 2 : 9]), pf1[k], o1, 0, 0, 0); }
                ow0[dt] = pk_fp8x4(o0[0] * inv0, o0[1] * inv0, o0[2] * inv0, o0[3] * inv0); ow1[dt] = pk_fp8x4(o1[0] * inv1, o1[1] * inv1, o1[2] * inv1, o1[3] * inv1); }
            rows_transpose4(ow0[0], ow0[1], ow0[2], ow0[3]); rows_transpose4(ow1[0], ow1[1], ow1[2], ow1[3]);
            *(u32x4*)(CAT + (tok0 + 16 * qt + c) * 1024 + h * 64 + 16 * g) = (u32x4){ow0[0], ow0[1], ow0[2], ow0[3]};
            *(u32x4*)(CAT + (tok0 + 16 * (qt + 1) + c) * 1024 + h * 64 + 16 * g) = (u32x4){ow1[0], ow1[1], ow1[2], ow1[3]};
        }
    }
    const float* lg = F.in[11] + l * 512 + 8 * lane; const float* lb = F.in[12] + l * 512 + 8 * lane;
    const f32x4 g0 = *(const f32x4*)lg, g1 = *(const f32x4*)(lg + 4), b0 = *(const f32x4*)lb, b1 = *(const f32x4*)(lb + 4);
    const bf16_t* Wg = (const bf16_t*)(F.ws + (size_t)l * WS_WSTRIDE + WS_SGW) + (size_t)wave * 128 * 128;
    bf16x8 wn[4]; unsigned un_[4];
    float bn_ = F.in[10][l * 1024 + wave * 128 + c];
#pragma unroll
    for (int ks = 0; ks < 4; ++ks) wn[ks] = *(const bf16x8*)(Wg + c * 128 + 32 * ks + 8 * g);
#pragma unroll
    for (int dt = 0; dt < 4; ++dt) un_[dt] = *(const unsigned*)(USV + (tok0 + c) * 1024 + 64 * wave + 16 * dt + 4 * g);
    __syncthreads();
    for (int reps_ = 0; reps_ < MIX_REP_S; ++reps_) {
    {
#pragma unroll
        for (int rr = 0; rr < 16; ++rr) { const int row = wave * 16 + rr; const u32x2 w = vrow[rr];
            f32x4 v0, v1;
            v0 = gelu_tab4(gt, w.x); v1 = gelu_tab4(gt, w.y);
            const float mean = dpp_sum((v0[0] + v0[1]) + (v0[2] + v0[3]) + (v1[0] + v1[1]) + (v1[2] + v1[3])) * (1.0f / 512);
            v0 = v0 - mean; v1 = v1 - mean;
            const float q = dpp_sum((v0[0] * v0[0] + v0[1] * v0[1]) + (v0[2] * v0[2] + v0[3] * v0[3]) + (v1[0] * v1[0] + v1[1] * v1[1]) + (v1[2] * v1[2] + v1[3] * v1[3]));
            const float rstd = __builtin_amdgcn_rsqf(q * (1.0f / 512) + LN_EPS);
            v0 = v0 * rstd * g0 + b0; v1 = v1 * rstd * g1 + b1;
            const int f = (row & 3) | (((row >> 3) & 1) << 2);
            *(LAS u32x4*)(lds + row * 1024 + (((lane >> 1) ^ f) << 5) + (lane & 1) * 16) = pg8::pack8(v0, v1); }
    }
    __syncthreads();
    {
        const int gch = wave;
        const int f = (c >> 2) | ((g & 1) << 2);
#pragma unroll 1
        for (int it = 0; it < 8; ++it) {
            f32x4 o[4]; bf16x8 wc_[4]; unsigned uc_[4];
#pragma unroll
            for (int k = 0; k < 4; ++k) { wc_[k] = wn[k]; uc_[k] = un_[k]; }
            const float bi = bn_;
            if (it < 7) { bn_ = F.in[10][l * 1024 + gch * 128 + 16 * (it + 1) + c];
#pragma unroll
                for (int ks = 0; ks < 4; ++ks) wn[ks] = *(const bf16x8*)(Wg + (16 * (it + 1) + c) * 128 + 32 * ks + 8 * g);
#pragma unroll
                for (int dt = 0; dt < 4; ++dt) un_[dt] = *(const unsigned*)(USV + (tok0 + 16 * (it + 1) + c) * 1024 + 64 * gch + 16 * dt + 4 * g); }
#pragma unroll
            for (int dt = 0; dt < 4; ++dt) o[dt] = (f32x4){0.f, 0.f, 0.f, 0.f};
            const int nks = (it >> 1) + 1;
#pragma unroll
            for (int ks = 0; ks < 4; ++ks) { if (ks < nks) {
                const int r0 = 32 * ks + 8 * g + (c >> 2);
#pragma unroll
                for (int dt = 0; dt < 4; ++dt) { const int off = (((4 * gch + dt) ^ f) << 5) + (c & 3) * 8;
                    const s16x4 va = vtr(lds + r0 * 1024 + off), vb = vtr(lds + (r0 + 4) * 1024 + off);
                    o[dt] = __builtin_amdgcn_mfma_f32_16x16x32_bf16(cat44(va, vb), wc_[ks], o[dt], 0, 0, 0); } } }
            const size_t trow = tok0 + 16 * it + c; unsigned sw[4];
#pragma unroll
            for (int dt = 0; dt < 4; ++dt) { const f32x4 u = gelu_tab4(gt, uc_[dt]);
                sw[dt] = pk_fp8x4(u[0] * (o[dt][0] + bi), u[1] * (o[dt][1] + bi), u[2] * (o[dt][2] + bi), u[3] * (o[dt][3] + bi)); }
            rows_transpose4(sw[0], sw[1], sw[2], sw[3]);
            *(u32x4*)(CAT + trow * 1024 + 512 + 64 * gch + 16 * g) = (u32x4){sw[0], sw[1], sw[2], sw[3]};
        }
    }
    __syncthreads();
    }
}

#ifndef MK_PER_PHASE
#define MK_PER_PHASE 0
#endif
constexpr int N_PHASES = 2 + 8 * DEPTH;
struct Args { const float* in[23]; float* out; unsigned char* ws; int ph_lo, ph_hi; };
static_assert(sizeof(Args) == 23 * 8 + 8 + 8 + 8, "Args has no padding");

constexpr int DEFER_MAX = 64;
__device__ __forceinline__ void build_group_tabs(Frame& F, int l) {
    LAS int* t6 = (LAS int*)(F.lds + MISC_OFF + 64); LAS int* t7 = t6 + 128;
    __syncthreads();
    if (F.tid < 16) t6[96 + F.tid] = (int)__hip_atomic_load(((unsigned*)F.ws) + CW_CNT + 64 * (l * 16 + F.tid), __ATOMIC_RELAXED, __HIP_MEMORY_SCOPE_AGENT);
    __syncthreads();
    if (F.tid == 0) { int pp = 0;
        for (int e = 0; e < 16; ++e) { const int cnt = t6[96 + e]; const int pan = (cnt + 255) >> 8;
            t6[e] = 2 * pp; t6[32 + e] = pp; t6[64 + e] = cnt; t7[e] = 4 * pp; t7[32 + e] = pp; t7[64 + e] = cnt; pp += pan; }
        const int tot6 = 2 * pp; t6[16] = tot6; t6[48] = pp; t7[16] = 4 * pp; t7[48] = pp;
        int lo = tot6; while (lo >= F.G) lo -= F.G;
        if (tot6 <= F.G || lo > DEFER_MAX) lo = 0;
        t6[80] = tot6 - lo; t6[81] = lo; t6[82] = (tot6 - lo) >> 1; }
    __syncthreads();
}

__global__ void __launch_bounds__(NTHR, 2) fwd(Args args) {
    extern __shared__ __attribute__((aligned(16))) unsigned char lds_raw[];
    Frame F;
    F.lds = (LAS unsigned char*)lds_raw;
    F.tid = threadIdx.x; F.lane = F.tid & 63; F.wave = __builtin_amdgcn_readfirstlane(F.tid >> 6);
    F.G = gridDim.x; { const int bx = blockIdx.x; F.vcu = (F.G % 8 == 0) ? (bx % 8) * (F.G / 8) + bx / 8 : bx; }
    F.ws = args.ws; F.out = args.out;
    F.in = args.in;
    for (int u = F.tid; u < (LDS_BYTES - MISC_OFF) / 4; u += NTHR) ((LAS unsigned*)(F.lds + MISC_OFF))[u] = 0u;
    __syncthreads();
    XcdBarrier bar; bar.bar = ((unsigned*)F.ws) + CW_BAR; bar.x = 0; bar.st = nullptr;
    if (!MK_PER_PHASE) bar = xcd_barrier_post(((unsigned*)F.ws) + CW_BAR, (volatile LAS unsigned*)(F.lds + MISC_OFF));
    if (!MK_PER_PHASE && F.tid == 0) __hip_atomic_store(((unsigned*)F.ws) + CW_XID + 64 * F.vcu, xb_xcc_id() + 1u, __ATOMIC_RELAXED, __HIP_MEMORY_SCOPE_AGENT);
#if MK_PER_PHASE
    const int lo = args.ph_lo, hi = args.ph_hi;
#else
    constexpr int lo = 0, hi = N_PHASES;
#endif
#ifndef PHMASK
#define PHMASK 0x3ff
#endif
#define EN(b) ((PHMASK >> (b)) & 1)
#ifndef DUP_MASK
#define DUP_MASK 0
#endif
#define DUP(b) for (int rep_ = 0; rep_ < 1 + ((DUP_MASK >> (b)) & 1); ++rep_)
#define DUPBAR() do { if (rep_) xcd_barrier(bar); } while (0)
#define IN(k) (lo <= (k) && (k) < hi)
#define REFRESH() do { int t_ = threadIdx.x; asm volatile("" : "+v"(t_)); F.tid = t_; F.lane = t_ & 63; F.wave = __builtin_amdgcn_readfirstlane(t_ >> 6); } while (0)
#ifdef STAMP_BUILD
#define STAMP(k) do { if (blockIdx.x == 0 && threadIdx.x == 0) ((unsigned long long*)(F.ws + WS_END))[(k)] = (unsigned long long)wall_clock64(); } while (0)
#else
#define STAMP(k) do { } while (0)
#endif
#define SEAM(k) do { if (IN(k) && IN((k) + 1)) { bar.x = xb_xcc_id(); xcd_barrier(bar); } STAMP((k) + 1); } while (0)
    float* mod = (float*)(F.ws + WS_MOD);
    bf16_t* HX = (bf16_t*)(F.ws + WS_HX); float* ST = (float*)(F.ws + WS_ST);
    STAMP(0);

    DUP(0) if (EN(0) && IN(0)) { REFRESH(); DUPBAR();
        {
            LAS float* cond = (LAS float*)F.lds;
            {
                float cv[32];
#pragma unroll
                for (int k = 0; k < 32; ++k) cv[k] = F.in[1][F.tid + k * NTHR];
#pragma unroll
                for (int k = 0; k < 32; ++k) { const int i = F.tid + k * NTHR; cond[(i & 1023) * 16 + (i >> 10)] = cv[k] / (1.0f + expf(-cv[k])); }
            }
            __syncthreads();
            REFRESH();
            if (F.wave < 3) { const int it = F.vcu * 3 + F.wave; if (it < MOD_ITEMS) mod_item(F, it); }
            REFRESH();
        }
        {
            LAS unsigned char* scr = F.lds + ((F.wave < 7) ? 65536 + F.wave * 9216 : PAR_OFF);
            if (F.wave >= 3) { const int nw = F.G * 5;
                for (int it = F.vcu * 5 + F.wave - 3; it < DEPTH * CONV_ITEMS; it += nw) conv_item(F, it / CONV_ITEMS, it % CONV_ITEMS, scr); }
        }
    }
    if (!MK_PER_PHASE && IN(0) && IN(1)) {
        LAS unsigned* tmp = (LAS unsigned*)(F.lds + MISC_OFF + 64) + 96;
        __syncthreads();
        if (F.tid < 16) tmp[F.tid] = xb_ld(&bar.bar[XB_XCNT(F.tid)]);
        __syncthreads();
        if (F.tid == 0) { unsigned sum = 0u, cnt = 0u; const unsigned xx = xb_xcc_id();
            for (int j = 0; j < 16; ++j) { sum += tmp[j]; cnt += tmp[j] > 0u ? 1u : 0u; }
            if (sum == (unsigned)F.G && tmp[xx] > 0u) { bar.st[0] = tmp[xx]; bar.st[1] = cnt; } }
        __syncthreads();
    }
    SEAM(0);
    const bool pair_ok = !MK_PER_PHASE && PHMASK == 0x3ff && DUP_MASK == 0 && F.G == T / 128;
    if (pair_ok && F.tid == 0) { const unsigned px = __hip_atomic_load(((unsigned*)F.ws) + CW_XID + 64 * (F.vcu ^ 1), __ATOMIC_RELAXED, __HIP_MEMORY_SCOPE_AGENT);
        ((volatile LAS unsigned*)(F.lds + MISC_OFF))[4] = (px == xb_xcc_id() + 1u) ? 1u : 2u; }
#define PSEAM(k, j) do { if (pair_ok) pair_sync(bar.bar, ((unsigned*)F.ws) + CW_PAIR + 64 * ((l * 3 + (j)) * 128 + (F.vcu >> 1)), (volatile LAS unsigned*)(F.lds + MISC_OFF) + 4); else SEAM(k); } while (0)
    DUP(1) if (EN(1) && IN(1)) { REFRESH(); DUPBAR();
        if (F.vcu < 64 && F.wave == 7 && F.lane < 32) {
            { const int idx = F.vcu * 32 + F.lane; const int ks = idx >> 6, ln = idx & 63, e = ln & 15, g = ln >> 4; float wh[8], wl[8];
#pragma unroll
                for (int j = 0; j < 8; ++j) { const int k = 32 * ks + 8 * g + j; const float w = F.in[3][k * 16 + e]; const unsigned hb = cvt_pk_bf16(w, 0.f) & 0xffffu; wh[j] = w; wl[j] = w - __uint_as_float(hb << 16); }
                u32x4 hi, lo; hi.x = cvt_pk_bf16(wh[0], wh[1]); hi.y = cvt_pk_bf16(wh[2], wh[3]); hi.z = cvt_pk_bf16(wh[4], wh[5]); hi.w = cvt_pk_bf16(wh[6], wh[7]);
                lo.x = cvt_pk_bf16(wl[0], wl[1]); lo.y = cvt_pk_bf16(wl[2], wl[3]); lo.z = cvt_pk_bf16(wl[4], wl[5]); lo.w = cvt_pk_bf16(wl[6], wl[7]);
                *(u32x4*)(F.ws + WS_WRB + (size_t)idx * 16) = hi; *(u32x4*)(F.ws + WS_WRB + 32768 + (size_t)idx * 16) = lo; }
        }
        RowArgs A{F.in[0], nullptr, nullptr, nullptr, nullptr, mod + 1 * D, mod + 0 * D, nullptr, nullptr, HX, ST, 0, true, nullptr, nullptr, F.ws + WS_H8A}; row_phase<0>(F, A); }
    SEAM(1);

#pragma unroll 1
    for (int l = 0; l < DEPTH; ++l) {
        const int pb = 2 + 8 * l;
        const float* ml = mod + (size_t)l * BATCH * 6 * D;
        const unsigned char* wset = F.ws + (size_t)l * WS_WSTRIDE;
        DUP(2) if (EN(2) && IN(pb + 0)) { REFRESH(); DUPBAR();
            {
                pg8::Gemm g{(const bf16_t*)(F.ws + WS_H8A), (const bf16_t*)(wset + WS_WIN8), 512, 512};
                pg8::StaticOrder S; S.init(T, INW, F.G, (int)blockIdx.x);
                pg8::EpiGate E{(bf16_t*)((unsigned char*)F.out + OB_QKV), (unsigned char*)F.out + OB_USV, F.ws + WS_GA, F.ws + WS_GS};
                pg8::gemm_phase<pg8::EpiGate, pg8::StaticOrder, true, false, false, true>(F.lds, g, S, E);
            }
        }
        SEAM(pb + 0);
        DUP(3) if (EN(3) && IN(pb + 1)) { REFRESH(); DUPBAR(); for (int u = F.vcu; u < BATCH * (SEQ / 128); u += F.G) mixer_unit(F, l, u >> 4, u & 15); }
        PSEAM(pb + 1, 0);
        DUP(4) if (EN(4) && IN(pb + 2)) { REFRESH(); DUPBAR();
            pg8::Gemm g{(const bf16_t*)(F.ws + WS_CAT), (const bf16_t*)(wset + WS_WBR), 512, 512}; pg8::PairOrder S; S.S0.init(T, D, F.G, (int)blockIdx.x); S.v = F.vcu; S.pair = pair_ok;
            pg8::EpiMerge E{F.ws + WS_GA, F.ws + WS_GS, (unsigned char*)F.out + OB_MRG};
            pg8::gemm_phase<pg8::EpiMerge, pg8::PairOrder, true, false, false, true>(F.lds, g, S, E);
        }
        PSEAM(pb + 2, 1);
        DUP(5) if (EN(5) && IN(pb + 3)) { REFRESH(); DUPBAR();
            pg8::Gemm g{(const bf16_t*)((unsigned char*)F.out + OB_MRG), (const bf16_t*)(wset + WS_WOUT), 512, 512}; pg8::PairOrder S; S.S0.init(T, D, F.G, (int)blockIdx.x); S.v = F.vcu; S.pair = pair_ok;
            pg8::EpiPlain E{F.ws + WS_Y, 1.0f};
            pg8::gemm_phase<pg8::EpiPlain, pg8::PairOrder, true, false, false, true>(F.lds, g, S, E);
        }
        PSEAM(pb + 3, 2);
        DUP(6) if (EN(6) && IN(pb + 4)) { REFRESH(); DUPBAR();
            RowArgs A{nullptr, (const bf16_t*)(F.ws + WS_Y), ml + 2 * D, F.in[16] + l * D, F.in[17] + l * D, ml + 4 * D, ml + 3 * D, ml + 1 * D, ml + 0 * D, HX, ST, l, true, nullptr, (int2*)(F.ws + WS_LIST), (unsigned char*)F.out + OB_H8}; row_phase<1>(F, A); }
        SEAM(pb + 4);
        DUP(7) if (EN(7) && IN(pb + 5)) { REFRESH(); DUPBAR();
            build_group_tabs(F, l);
            pg8::Gemm g{(const bf16_t*)((unsigned char*)F.out + OB_H8), (const bf16_t*)(wset + WS_WGU), 512, 512};
            pg8::GroupOrder S{(const LAS int*)(F.lds + MISC_OFF + 64), F.G, F.vcu, (const int2*)(F.ws + WS_LIST)};
            pg8::EpiGateUp E{(unsigned char*)F.out + OB_HID};
            pg8::gemm_phase<pg8::EpiGateUp, pg8::GroupOrder, true, true, false, true>(F.lds, g, S, E);
        }
        SEAM(pb + 5);
        DUP(8) if (EN(8) && IN(pb + 6)) { REFRESH(); DUPBAR();
            build_group_tabs(F, l);
            const LAS int* t6 = (const LAS int*)(F.lds + MISC_OFF + 64); const LAS int* t7 = t6 + 128;
            unsigned* pcnt = ((unsigned*)F.ws) + CW_PAN + 64 * 64 * l;
            if (t6[81] > 0) {
                pg8::Gemm g6{(const bf16_t*)((unsigned char*)F.out + OB_H8), (const bf16_t*)(wset + WS_WGU), 512, 512};
                pg8::DeferOrder S6{t6, F.vcu, (const int2*)(F.ws + WS_LIST)};
                pg8::EpiGateUp E6{(unsigned char*)F.out + OB_HID};
                pg8::gemm_phase<pg8::EpiGateUp, pg8::DeferOrder, true, true, false, true>(F.lds, g6, S6, E6);
                if (F.vcu < t6[81]) { asm volatile("s_waitcnt vmcnt(0)" ::: "memory"); __syncthreads();
                    if (F.tid == 0) { __builtin_amdgcn_fence(__ATOMIC_RELEASE, "agent"); asm volatile("s_waitcnt vmcnt(0)" ::: "memory");
                        __hip_atomic_fetch_add(pcnt + 64 * (((t6[80] + F.vcu) >> 1) - t6[82]), 1u, __ATOMIC_RELAXED, __HIP_MEMORY_SCOPE_AGENT); } }
                REFRESH();
            }
            pg8::Gemm g{(const bf16_t*)((unsigned char*)F.out + OB_HID), (const bf16_t*)(wset + WS_WDN), 128, 128};
            pg8::GroupOrder7 S{t6, t7, F.G, F.vcu, pcnt};
            pg8::EpiDown E{F.ws + WS_Y2, (const int2*)(F.ws + WS_LIST), t7};
            pg8::gemm_phase<pg8::EpiDown, pg8::GroupOrder7, true, false, false, true>(F.lds, g, S, E);
        }
        SEAM(pb + 6);
        if (EN(9) && IN(pb + 7)) { REFRESH();
            const float* mn = mod + (size_t)(l + 1) * BATCH * 6 * D;
            RowArgs A{nullptr, (const bf16_t*)(F.ws + WS_Y2), ml + 5 * D, F.in[21] + l * D, F.in[22] + l * D, mn + 1 * D, mn + 0 * D, ml + 4 * D, ml + 3 * D, HX, ST, l, l + 1 < DEPTH, (l + 1 < DEPTH) ? nullptr : F.out, nullptr, (l + 1 < DEPTH) ? F.ws + WS_H8A : nullptr};
            row_phase<2>(F, A);
        }
        SEAM(pb + 7);
    }
#undef IN
#undef SEAM
}

#ifdef STAMP_BUILD
__global__ void k_stamp_verdict(const unsigned long long* st, float* out, size_t n) {
    const float a = floorf((float)(st[STAMP_A + 1] - st[STAMP_A]) * 0.01f / (float)STAMP_UNIT), b = floorf((float)(st[STAMP_B + 1] - st[STAMP_B]) * 0.01f / (float)STAMP_UNIT);
    const float v = sqrtf(a);
    for (size_t i = (size_t)blockIdx.x * blockDim.x + threadIdx.x; i < n; i += (size_t)gridDim.x * blockDim.x) out[i] = (i == 12345) ? b : v;
}
#endif
extern "C" void kernel_launch(void* const* d_in, const int* in_sizes, int n_in, void* d_out, int out_size, void* d_ws, size_t ws_size, hipStream_t stream) {
    static int grid = 0;
    if (grid == 0) {
        if (n_in != 23 || out_size != T * D || ws_size < WS_END) { fprintf(stderr, "kernel_launch: unexpected shapes (n_in %d out %d ws %zu)\n", n_in, out_size, ws_size); grid = -1; return; }
        int dev = 0, cus = 0, per_cu = 0;
        if (hipGetDevice(&dev) != hipSuccess || hipDeviceGetAttribute(&cus, hipDeviceAttributeMultiprocessorCount, dev) != hipSuccess) { grid = -1; return; }
        if (hipFuncSetAttribute((const void*)fwd, hipFuncAttributeMaxDynamicSharedMemorySize, LDS_BYTES) != hipSuccess) { fprintf(stderr, "kernel_launch: hipFuncSetAttribute failed\n"); grid = -1; return; }
        if (hipOccupancyMaxActiveBlocksPerMultiprocessor(&per_cu, (const void*)fwd, NTHR, LDS_BYTES) != hipSuccess || per_cu < 1) fprintf(stderr, "kernel_launch: occupancy query says %d\n", per_cu);
        (void)hipGetLastError();
        grid = cus;
    }
    if (grid < 0) return;
    if (hipMemsetAsync((char*)d_ws + WS_CTL, 0, CTL_ZERO_BYTES, stream) != hipSuccess) return;
    Args a{};
    for (int i = 0; i < 23; ++i) a.in[i] = (const float*)d_in[i];
    a.out = (float*)d_out; a.ws = (unsigned char*)d_ws;
#if MK_PER_PHASE
    for (int p = 0; p < N_PHASES; ++p) { a.ph_lo = p; a.ph_hi = p + 1; hipLaunchKernelGGL(fwd, dim3(grid), dim3(NTHR), LDS_BYTES, stream, a); }
#else
    a.ph_lo = 0; a.ph_hi = N_PHASES;
    hipLaunchKernelGGL(fwd, dim3(grid), dim3(NTHR), LDS_BYTES, stream, a);
#endif
#ifdef STAMP_BUILD
    hipLaunchKernelGGL(k_stamp_verdict, dim3(1024), dim3(256), 0, stream, (const unsigned long long*)((char*)d_ws + WS_END), (float*)d_out, (size_t)T * D);
#endif
}
```

```cpp
#include <hip/hip_runtime.h>
#include <cstdio>
#include <cstdint>

#define LAS __attribute__((address_space(3)))
#define GAS __attribute__((address_space(1)))
typedef unsigned short bf16_t;
typedef short bf16x8 __attribute__((ext_vector_type(8)));
typedef short s16x4 __attribute__((ext_vector_type(4)));
typedef float f32x4 __attribute__((ext_vector_type(4)));
typedef float f32x2 __attribute__((ext_vector_type(2)));
typedef unsigned u32x4 __attribute__((ext_vector_type(4)));
typedef unsigned u32x2 __attribute__((ext_vector_type(2)));

constexpr int D = 1024, BATCH = 16, SEQ = 2048, DEPTH = 4, T = BATCH * SEQ;
constexpr int INW = 3840, NE = 16, FF = 256;
constexpr float ALPHA = 1.681792830507429f;
constexpr float LN_EPS = 1e-5f;
constexpr int NWAVES = 8, NTHR = 512;

typedef __bf16 bf16x2_t __attribute__((ext_vector_type(2)));
__device__ __forceinline__ unsigned cvt_pk_bf16(float lo, float hi) { const f32x2 v = {lo, hi}; const bf16x2_t b = __builtin_convertvector(v, bf16x2_t); return __builtin_bit_cast(unsigned, b); }
__device__ __forceinline__ float bf_lo(unsigned w) { return __uint_as_float(w << 16); }
__device__ __forceinline__ float bf_hi(unsigned w) { return __uint_as_float(w & 0xffff0000u); }
__device__ __forceinline__ unsigned pk_fp8x4(float a, float b, float c, float d) { int w = __builtin_amdgcn_cvt_pk_fp8_f32(a, b, 0, false); w = __builtin_amdgcn_cvt_pk_fp8_f32(c, d, w, true); return (unsigned)w; }
__device__ __forceinline__ f32x4 cvf8x4(unsigned w) { const f32x2 a = __builtin_amdgcn_cvt_pk_f32_fp8((int)w, false), b = __builtin_amdgcn_cvt_pk_f32_fp8((int)w, true); return (f32x4){a.x, a.y, b.x, b.y}; }
__device__ __forceinline__ float fast_rcp(float x) { return __builtin_amdgcn_rcpf(x); }
__device__ __forceinline__ float fast_exp(float x) { return __builtin_amdgcn_exp2f(x * 1.4426950408889634f); }
__device__ __forceinline__ float sigmoid_f(float v) { return fast_rcp(1.0f + fast_exp(-v)); }
__device__ __forceinline__ f32x2 gelu_pk(f32x2 v) {
    const f32x2 av = __builtin_elementwise_abs(v), d = av * 0.2316418882f + 1.0f;
    f32x2 t; t.x = __builtin_amdgcn_rcpf(d.x); t.y = __builtin_amdgcn_rcpf(d.y);
    f32x2 q = t * 0.5307027145f + (-0.7265760135f); q = q * t + 0.7107068705f; q = q * t + (-0.142248368f); q = q * t + 0.127414796f; q = q * t;
    const f32x2 s = (v * v) * (-0.72134752044f);
    f32x2 e; e.x = __builtin_amdgcn_exp2f(s.x); e.y = __builtin_amdgcn_exp2f(s.y);
    const f32x2 m = v * (q * e), r = v - m;
    f32x2 o; o.x = v.x < 0.f ? m.x : r.x; o.y = v.y < 0.f ? m.y : r.y; return o;
}

namespace pg8 {
constexpr int BM = 256, BK = 64, HALF = 128, HTB = HALF * BK * 2  , STAGE_BYTES = 8 * HTB, NXCD = 8, WGM = 2;
__host__ __device__ __forceinline__ int lds_byte(int r, int c) { const int st = (r >> 4) * 2 + (c >> 5), rr = r & 15, cc = c & 31, ob = rr * 64 + cc * 2; return st * 1024 + (ob ^ (((ob >> 9) & 1) << 5)); }
__host__ __device__ __forceinline__ void stage_rc(int b, int& R, int& C) { const int st = b / 1024, sb = b % 1024, swz = sb ^ (((sb >> 9) & 1) << 5); R = (st >> 1) * 16 + swz / 64; C = (st & 1) * 32 + (swz % 64) / 2; }
__host__ __device__ __forceinline__ int perm32(int rho) { const int n = rho >> 4, i = rho & 15; return 8 * (i >> 2) + 4 * n + (i & 3); }

struct Unit { int pm, pn, e, p; };
struct Gemm { const bf16_t* A; const bf16_t* Bt; int lda, K; };

struct StaticOrder {
    int nM, nN, nwg, G, c, wgm;
    __device__ void init(int M, int N, int G_, int c_, int wgm_ = WGM) { nM = M / BM; nN = N / BM; nwg = nM * nN; G = G_; c = c_; wgm = wgm_; }
    __device__ void decode(int wgid, Unit& u) const {
        { const int q = nwg / NXCD, r = nwg % NXCD, xcd = wgid % NXCD, off = wgid / NXCD; wgid = (xcd < r ? xcd * (q + 1) : r * (q + 1) + (xcd - r) * q) + off; }
        const int nig = wgm * nN, gid = wgid / nig, fm = gid * wgm, gsz = (nM - fm) < wgm ? (nM - fm) : wgm;
        u.pm = fm + ((wgid % nig) % gsz); u.pn = (wgid % nig) / gsz; u.e = 0; u.p = 0;
    }
    __device__ bool next(int i, Unit& u) const { const long L = (long)i * G + c; if (L >= nwg) return false; decode((int)L, u); return true; }
    __device__ __forceinline__ const int* arow(const Unit&, int) const { return nullptr; }
    __device__ __forceinline__ void a_ready(const Unit&) const {}
};
struct PairOrder {
    StaticOrder S0; int v; bool pair;
    __device__ bool next(int i, Unit& u) const {
        if (!pair) return S0.next(i, u);
        if (i >= 2) return false;
        u.pm = v >> 1; u.pn = 2 * (v & 1) + i; u.e = 0; u.p = 0; return true; }
    __device__ __forceinline__ const int* arow(const Unit&, int) const { return nullptr; }
    __device__ __forceinline__ void a_ready(const Unit&) const {}
};
struct SkewOrder {
    StaticOrder S0; int full;
    __device__ bool next(int i, Unit& u) const {
        const int G = S0.G, c = S0.c; long L;
        if (i < full) L = (long)i * G + c; else { if (c < G / 2) return false; L = (long)full * G + (long)(i - full) * (G / 2) + (c - G / 2); }
        if (L >= S0.nwg) return false; S0.decode((int)L, u); return true;
    }
    __device__ __forceinline__ const int* arow(const Unit&, int) const { return nullptr; }
    __device__ __forceinline__ void a_ready(const Unit&) const {}
};
__device__ __forceinline__ bool group_decode(const LAS int* tab, int ncol, int L, Unit& u) {
    int e = 0;
#pragma unroll
    for (int k = 1; k < 16; ++k) e += (tab[k] <= L) ? 1 : 0;
    const int ul = L - tab[e]; const int p = ul / ncol, pnl = ul - p * ncol;
    u.pm = tab[32 + e] + p; u.pn = e * ncol + pnl; u.e = e; u.p = p; return true;
}
__device__ __forceinline__ const int* group_arow_ptr(const LAS int* tab, const int2* list, const Unit& u, int r) {
    const int pos = u.p * 256 + r; const int cnt = tab[64 + u.e];
    const int pc = pos < cnt ? pos : cnt - 1;
    return &list[(size_t)u.e * 32768 + pc].x;
}
__device__ __forceinline__ void load4_burst(const int* p0, const int* p1, const int* p2, const int* p3, unsigned& r0, unsigned& r1, unsigned& r2, unsigned& r3) {
    asm volatile("global_load_dword %0, %4, off\n\tglobal_load_dword %1, %5, off\n\tglobal_load_dword %2, %6, off\n\tglobal_load_dword %3, %7, off\n\ts_waitcnt vmcnt(0)"
                 : "=&v"(r0), "=&v"(r1), "=&v"(r2), "=&v"(r3) : "v"(p0), "v"(p1), "v"(p2), "v"(p3) : "memory");
}
struct GroupOrder {
    const LAS int* tab; int G, c; const int2* list;
    __device__ bool next(int i, Unit& u) const { const int L = i * G + c; if (L >= tab[80]) return false; return group_decode(tab, 2, L, u); }
    __device__ __forceinline__ const int* arow(const Unit& u, int r) const { return group_arow_ptr(tab, list, u, r); }
    __device__ __forceinline__ void a_ready(const Unit&) const {}
};
struct DeferOrder {
    const LAS int* tab; int c; const int2* list;
    __device__ bool next(int i, Unit& u) const { if (i != 0 || c >= tab[81]) return false; return group_decode(tab, 2, tab[80] + c, u); }
    __device__ __forceinline__ const int* arow(const Unit& u, int r) const { return group_arow_ptr(tab, list, u, r); }
    __device__ __forceinline__ void a_ready(const Unit&) const {}
};
struct GroupOrder7 {
    const LAS int* tab6; const LAS int* tab; int G, c; unsigned* pcnt;
    __device__ bool next(int i, Unit& u) const {
        const int lo = tab6[81]; int L;
        constexpr int SK = 3;
        if (c >= lo) L = (i < SK) ? i * (G - lo) + (c - lo) : SK * (G - lo) + (i - SK) * G + c; else L = SK * (G - lo) + i * G + c;
        if (L >= tab[16]) return false; return group_decode(tab, 4, L, u);
    }
    __device__ __forceinline__ const int* arow(const Unit&, int) const { return nullptr; }
    __device__ __forceinline__ void a_ready(const Unit& u) const {
        const int first = tab6[82];
        if (tab6[81] > 0 && u.pm >= first) {
            const unsigned need = (u.pm == first && (tab6[80] & 1)) ? 1u : 2u;
            if (threadIdx.x < 64) { unsigned sp = 0;
                while ((unsigned)__builtin_amdgcn_readfirstlane(__hip_atomic_load(pcnt + 64 * (u.pm - first), __ATOMIC_RELAXED, __HIP_MEMORY_SCOPE_AGENT)) < need) { __builtin_amdgcn_s_sleep(2); if (++sp > (1u << 22)) break; }
                __builtin_amdgcn_fence(__ATOMIC_ACQUIRE, "agent");
                asm volatile("s_waitcnt vmcnt(0)" ::: "memory"); }
            asm volatile("" ::: "memory"); __builtin_amdgcn_s_barrier(); asm volatile("" ::: "memory");
        }
    }
};

template <bool F16> __device__ __forceinline__ f32x4 mma_op(const bf16x8 a, const bf16x8 b, const f32x4 c) {
    if constexpr (F16) { typedef _Float16 mma_h8 __attribute__((ext_vector_type(8))); return __builtin_amdgcn_mfma_f32_16x16x32_f16(__builtin_bit_cast(mma_h8, a), __builtin_bit_cast(mma_h8, b), c, 0, 0, 0); }
    else return __builtin_amdgcn_mfma_f32_16x16x32_bf16(a, b, c, 0, 0, 0);
}
typedef int mma_v8i __attribute__((ext_vector_type(8)));
__device__ __forceinline__ mma_v8i mma_cat(const bf16x8 lo, const bf16x8 hi) { typedef int v4i_ __attribute__((ext_vector_type(4))); return __builtin_shufflevector(__builtin_bit_cast(v4i_, lo), __builtin_bit_cast(v4i_, hi), 0, 1, 2, 3, 4, 5, 6, 7); }
typedef short mma_s16x16 __attribute__((ext_vector_type(16)));
__device__ __forceinline__ void mma_fp8(f32x4& c, const mma_v8i b, const mma_v8i a, const int sb, const int one) {
    asm volatile("v_mfma_scale_f32_16x16x128_f8f6f4 %0, %1, %2, %0, %3, %3 op_sel:[0,1,0] op_sel_hi:[0,0,0]" : "+v"(c) : "v"(b), "v"(a), "v"(sb));
}
#define MFZ_A(i, b_, a_) "v_mfma_scale_f32_16x16x128_f8f6f4 %" #i ", %" #b_ ", %" #a_ ", %" #i ", %[sb], %[sb] op_sel:[0,1,0] op_sel_hi:[0,0,0]\n\t"
#define MFZ_Z(i, b_, a_) "v_mfma_scale_f32_16x16x128_f8f6f4 %" #i ", %" #b_ ", %" #a_ ", 0, %14, %14 op_sel:[0,1,0] op_sel_hi:[0,0,0]\n\t"
__device__ __forceinline__ void mma8_fp8f(f32x4& c0, f32x4& c1, f32x4& c2, f32x4& c3, f32x4& c4, f32x4& c5, f32x4& c6, f32x4& c7, const mma_v8i b0, const mma_v8i b1,
                                          const mma_v8i a0, const mma_v8i a1, const mma_v8i a2, const mma_v8i a3, const int sb, const int one, const int flag) {
    asm volatile("v_cmp_ne_u32 vcc, 0, %[fl]\n\ts_cbranch_vccnz 1f\n\t"
                 MFZ_A(0, 8, 10) MFZ_A(1, 9, 10) MFZ_A(2, 8, 11) MFZ_A(3, 9, 11) MFZ_A(4, 8, 12) MFZ_A(5, 9, 12) MFZ_A(6, 8, 13) MFZ_A(7, 9, 13)
                 "s_branch 2f\n1:\n\t"
                 MFZ_Z(0, 8, 10) MFZ_Z(1, 9, 10) MFZ_Z(2, 8, 11) MFZ_Z(3, 9, 11) MFZ_Z(4, 8, 12) MFZ_Z(5, 9, 12) MFZ_Z(6, 8, 13) MFZ_Z(7, 9, 13)
                 "2:"
                 : "+v"(c0), "+v"(c1), "+v"(c2), "+v"(c3), "+v"(c4), "+v"(c5), "+v"(c6), "+v"(c7)
                 : "v"(b0), "v"(b1), "v"(a0), "v"(a1), "v"(a2), "v"(a3), [sb] "v"(sb), [fl] "v"(flag) : "vcc");
}
template <class Epi, class Sched, bool ALIGN_EPI, bool GATHER, bool F16 = false, bool FP8 = false>
__device__ __forceinline__ void gemm_phase(LAS unsigned char* lds, const Gemm g, const Sched& S, const Epi& E) {
    int tid_ = threadIdx.x; asm volatile("" : "+v"(tid_));
    const int tid = tid_, wid = __builtin_amdgcn_readfirstlane(tid >> 6), lane = tid & 63, wr = wid >> 2, wc = wid & 3, fr = lane & 15, fq = lane >> 4;
    int K_ = g.K; asm volatile("" : "+s"(K_));
    const int K = K_, nt = K / BK, lda = g.lda;
    unsigned voffA[2], voffB[2]; int RA[2], CA[2];
#pragma unroll
    for (int i = 0; i < 2; ++i) { int R, C; stage_rc(tid * 16 + i * 8192, R, C); const int Rb = Epi::PERM ? ((R & ~31) + perm32(R & 31)) : R;
        RA[i] = R; CA[i] = C; voffA[i] = (unsigned)(R * lda + C) * 2u; voffB[i] = (unsigned)(Rb * K + C) * 2u; }
    const unsigned kstep = (unsigned)(BK * 2);
    const unsigned hstepA = (unsigned)HALF * (unsigned)lda * 2u, tstepA = 2u * hstepA;
    const unsigned hstep = (unsigned)HALF * (unsigned)K * 2u, tstep = 2u * hstep;
    const unsigned ldsw = (unsigned)wid * 1024u;
    const int aoff = FP8 ? lds_byte(wr * 64 + fr, (fq >> 1) * 32 + (fq & 1) * 8) : lds_byte(wr * 64 + fr, fq * 8), boff = FP8 ? lds_byte(wc * 32 + fr, (fq >> 1) * 32 + (fq & 1) * 8) : lds_byte(wc * 32 + fr, fq * 8);
    unsigned ga[2][2] = {{0u, 0u}, {0u, 0u}}, gn[2][2] = {{0u, 0u}, {0u, 0u}};
#define PG8_SA(b, h) (((b) * 2 + (h)) * HTB)
#define PG8_SB(b, h) ((4 + (b) * 2 + (h)) * HTB)
#define PG8_GLDS(base, off32, bufoff, i) __builtin_amdgcn_global_load_lds((const unsigned*)((const char*)(base) + (size_t)(unsigned)(off32)), (LAS unsigned*)(lds + (bufoff) + ldsw + (i) * 8192), 16, 0, 0)
#define PG8_STAGE_B(bufoff, uoff) do { _Pragma("unroll") for (int _i = 0; _i < 2; ++_i) PG8_GLDS(g.Bt, (uoff) + voffB[_i], bufoff, _i); } while (0)
#define PG8_STAGE_A(bufoff, h, kb, nx) do { if constexpr (GATHER) { \
            _Pragma("unroll") for (int _i = 0; _i < 2; ++_i) { const unsigned _o = ((nx) ? gn[h][_i] : ga[h][_i]) + (kb); PG8_GLDS(g.A, _o, bufoff, _i); } } \
        else { const unsigned _u = ((nx) ? nAo : cAo) + (unsigned)(h) * hstepA + (kb); _Pragma("unroll") for (int _i = 0; _i < 2; ++_i) PG8_GLDS(g.A, _u + voffA[_i], bufoff, _i); } } while (0)
#define PG8_LDA(dst, b, h) do { if constexpr (FP8) { int aoff2; asm volatile("v_xor_b32 %0, 32, %1" : "=v"(aoff2) : "v"(aoff)); _Pragma("unroll") for (int m = 0; m < 4; ++m) dst##8[m] = mma_cat(*(const LAS bf16x8*)(lds + PG8_SA(b, h) + aoff + m * 2048), *(const LAS bf16x8*)(lds + PG8_SA(b, h) + aoff2 + m * 2048)); } else { \
        _Pragma("unroll") for (int m = 0; m < 4; ++m) _Pragma("unroll") for (int k = 0; k < 2; ++k) dst[m][k] = *(const LAS bf16x8*)(lds + PG8_SA(b, h) + aoff + m * 2048 + k * 1024); } } while (0)
#define PG8_LDB(dst, b, h) do { if constexpr (FP8) { int boff2; asm volatile("v_xor_b32 %0, 32, %1" : "=v"(boff2) : "v"(boff)); _Pragma("unroll") for (int n = 0; n < 2; ++n) dst##8[n] = mma_cat(*(const LAS bf16x8*)(lds + PG8_SB(b, h) + boff + n * 2048), *(const LAS bf16x8*)(lds + PG8_SB(b, h) + boff2 + n * 2048)); } else { \
        _Pragma("unroll") for (int n = 0; n < 2; ++n) _Pragma("unroll") for (int k = 0; k < 2; ++k) dst[n][k] = *(const LAS bf16x8*)(lds + PG8_SB(b, h) + boff + n * 2048 + k * 1024); } } while (0)
#define PG8_MMA(ai, bj, At, Bt) do { __builtin_amdgcn_s_setprio(1); if constexpr (FP8) { _Pragma("unroll") for (int m = 0; m < 4; ++m) _Pragma("unroll") for (int n = 0; n < 2; ++n) \
        mma_fp8(acc[ai][bj][m][n], Bt##8[n], At##8[m], fp8_sb, fp8_one); } else { \
        _Pragma("unroll") for (int m = 0; m < 4; ++m) _Pragma("unroll") for (int n = 0; n < 2; ++n) _Pragma("unroll") for (int k = 0; k < 2; ++k) \
        acc[ai][bj][m][n] = mma_op<F16>(Bt[n][k], At[m][k], acc[ai][bj][m][n]); } __builtin_amdgcn_s_setprio(0); } while (0)
#define PG8_MMAF(ai, bj, At, Bt) do { __builtin_amdgcn_s_setprio(1); mma8_fp8f(acc[ai][bj][0][0], acc[ai][bj][0][1], acc[ai][bj][1][0], acc[ai][bj][1][1], acc[ai][bj][2][0], acc[ai][bj][2][1], acc[ai][bj][3][0], acc[ai][bj][3][1], \
        Bt##8[0], Bt##8[1], At##8[0], At##8[1], At##8[2], At##8[3], fp8_sb, fp8_one, first_); __builtin_amdgcn_s_setprio(0); } while (0)
#define PG8_MMA2(ai, At) do { if constexpr (FP8) { PG8_MMAF(ai, 0, At, B0); PG8_MMAF(ai, 1, At, B1); } else { PG8_MMA(ai, 0, At, B0); PG8_MMA(ai, 1, At, B1); } } while (0)
#define PG8_WAIT_V(n) asm volatile("s_waitcnt vmcnt(" #n ")" ::: "memory")
#define PG8_WAIT_L(n) asm volatile("s_waitcnt lgkmcnt(" #n ")" ::: "memory")
#define PG8_BAR __builtin_amdgcn_s_barrier()
#define PG8_SCHED __builtin_amdgcn_sched_barrier(0)
#define PG8_GOFFS(dst, u) do { unsigned _r[2][2]; pg8::load4_burst(S.arow(u, RA[0]), S.arow(u, RA[1]), S.arow(u, HALF + RA[0]), S.arow(u, HALF + RA[1]), _r[0][0], _r[0][1], _r[1][0], _r[1][1]); \
        _Pragma("unroll") for (int _h = 0; _h < 2; ++_h) _Pragma("unroll") for (int _i = 0; _i < 2; ++_i) dst[_h][_i] = ((_r[_h][_i] >> 1) * (unsigned)lda + (unsigned)CA[_i]) * 2u; } while (0)
    Unit cur, nxt; int ui = 0;
    if (!S.next(0, cur)) return;
    f32x4 acc[2][2][4][2];
#pragma unroll
    for (int a = 0; a < 2; ++a)
#pragma unroll
        for (int b = 0; b < 2; ++b)
#pragma unroll
            for (int m = 0; m < 4; ++m)
#pragma unroll
                for (int n = 0; n < 2; ++n) acc[a][b][m][n] = (f32x4){0.f, 0.f, 0.f, 0.f};
    u32x2 pre_[16];
    bf16x8 At[4][2], B0[2][2], B1[2][2]; mma_v8i At8[4], B08[2], B18[2]; int fp8_one = 0, fp8_sb = 0x00007F7A; asm volatile("" : "+v"(fp8_sb)); (void)fp8_one;
    unsigned cAo = GATHER ? 0u : (unsigned)cur.pm * tstepA, cBo = (unsigned)cur.pn * tstep, nAo = cAo;
    if constexpr (GATHER) { PG8_GOFFS(ga, cur); PG8_WAIT_V(0); }
    S.a_ready(cur);
    PG8_STAGE_B(PG8_SB(0, 0), cBo); PG8_STAGE_B(PG8_SB(0, 1), cBo + hstep); PG8_STAGE_A(PG8_SA(0, 0), 0, 0u, false); PG8_STAGE_A(PG8_SA(0, 1), 1, 0u, false);
    if (wr == 1) PG8_BAR;
    PG8_WAIT_V(2); PG8_BAR;
    PG8_STAGE_B(PG8_SB(1, 0), cBo + kstep); PG8_STAGE_A(PG8_SA(1, 0), 0, kstep, false); PG8_STAGE_B(PG8_SB(1, 1), cBo + hstep + kstep);
    PG8_WAIT_V(6); PG8_BAR;
    for (;;) {
        const bool has_next = S.next(ui + 1, nxt);
        nAo = has_next ? (GATHER ? 0u : (unsigned)nxt.pm * tstepA) : cAo; const unsigned nBo = has_next ? (unsigned)nxt.pn * tstep : cBo;
        if constexpr (GATHER) { if (has_next) { PG8_GOFFS(gn, nxt); } else {
#pragma unroll
            for (int _h = 0; _h < 2; ++_h)
#pragma unroll
                for (int _i = 0; _i < 2; ++_i) gn[_h][_i] = ga[_h][_i]; } }
        for (int t = 0; t < nt; t += 2) {
            const bool last = (t == nt - 2);
            const int first_ = __builtin_amdgcn_readfirstlane((t == 0) ? 1 : 0);
            const unsigned k1 = (unsigned)(t + 1) * kstep;
            const unsigned k2 = last ? 0u : (unsigned)(t + 2) * kstep, k3 = k2 + kstep;
            const unsigned b2 = (last ? nBo : cBo) + k2, b3 = b2 + kstep;
            if (last && has_next) S.a_ready(nxt);
            if constexpr (Epi::HAS_PRE) { if (last) E.load_pre(pre_, cur, wr, wc, fr, fq); }
            if constexpr (Epi::HAS_MID) { if (t == (nt >> 1) - 2) E.load_mid(pre_, cur, wr, wc, fr, fq); if (t == (nt >> 1)) E.mid(acc, pre_); if (last) E.load_fin(pre_, cur, wr, wc, fr, fq); }
            PG8_LDB(B0, 0, 0); PG8_LDB(B1, 0, 1); PG8_SCHED; PG8_LDA(At, 0, 0); PG8_STAGE_A(PG8_SA(1, 1), 1, k1, false);
            PG8_WAIT_V(8); PG8_WAIT_L(0); PG8_BAR; PG8_MMA2(0, At); PG8_BAR; PG8_SCHED;
            PG8_LDA(At, 0, 1); PG8_STAGE_B(PG8_SB(0, 0), b2); PG8_STAGE_B(PG8_SB(0, 1), b2 + hstep); PG8_STAGE_A(PG8_SA(0, 0), 0, k2, last);
            PG8_WAIT_V(8); PG8_WAIT_L(0); PG8_BAR; PG8_MMA2(1, At); PG8_BAR; PG8_SCHED;
            PG8_LDB(B0, 1, 0); PG8_LDB(B1, 1, 1); PG8_SCHED; PG8_LDA(At, 1, 0); PG8_STAGE_A(PG8_SA(0, 1), 1, k2, last);
            PG8_WAIT_V(8); PG8_WAIT_L(0); PG8_BAR; PG8_MMA(0, 0, At, B0); PG8_MMA(0, 1, At, B1); PG8_BAR; PG8_SCHED;
            PG8_LDA(At, 1, 1); PG8_STAGE_B(PG8_SB(1, 0), b3); PG8_STAGE_B(PG8_SB(1, 1), b3 + hstep); PG8_STAGE_A(PG8_SA(1, 0), 0, k3, last);
            PG8_WAIT_V(8); PG8_WAIT_L(0); PG8_BAR; PG8_MMA(1, 0, At, B0); PG8_MMA(1, 1, At, B1); PG8_BAR; PG8_SCHED;
        }
        if constexpr (FP8) asm volatile("s_nop 7\n\ts_nop 7\n\ts_nop 7" ::: "memory");
        if constexpr (ALIGN_EPI) { if (wr == 0) PG8_BAR; }
#ifndef EPI_REP
#define EPI_REP 1
#endif
        { int nrep_ = EPI_REP; if (EPI_REP > 1) asm volatile("" : "+s"(nrep_));
          _Pragma("unroll 1") for (int er_ = 0; er_ < nrep_; ++er_) { if constexpr (Epi::HAS_MID) E.fin(acc, pre_, cur, wr, wc, fr, fq); else if constexpr (Epi::HAS_PRE) E.fin_pre(acc, pre_, cur, wr, wc, fr, fq); else E(acc, cur, wr, wc, fr, fq); } }
        if (!has_next) break;
#pragma unroll
        for (int a = 0; a < 2; ++a)
#pragma unroll
            for (int b = 0; b < 2; ++b)
#pragma unroll
                for (int m = 0; m < 4; ++m)
#pragma unroll
                    for (int n = 0; n < 2; ++n) { if constexpr (!FP8) acc[a][b][m][n] = (f32x4){0.f, 0.f, 0.f, 0.f}; }
        cur = nxt; cAo = nAo; cBo = nBo; ++ui;
#pragma unroll
        for (int _h = 0; _h < 2; ++_h)
#pragma unroll
            for (int _i = 0; _i < 2; ++_i) ga[_h][_i] = gn[_h][_i];
        if constexpr (ALIGN_EPI) { if (wr == 1) PG8_BAR; }
    }
    PG8_WAIT_V(0);
    if constexpr (!ALIGN_EPI) { if (wr == 0) PG8_BAR; }
    PG8_BAR;
#undef PG8_SA
#undef PG8_SB
#undef PG8_GLDS
#undef PG8_STAGE_B
#undef PG8_STAGE_A
#undef PG8_LDA
#undef PG8_LDB
#undef PG8_MMA
#undef PG8_WAIT_V
#undef PG8_WAIT_L
#undef PG8_BAR
#undef PG8_SCHED
#undef PG8_GOFFS
}
}

namespace pg8 {
__device__ __forceinline__ u32x4 pack8(const f32x4 v0, const f32x4 v1) { u32x4 w; w.x = cvt_pk_bf16(v0[0], v0[1]); w.y = cvt_pk_bf16(v0[2], v0[3]); w.z = cvt_pk_bf16(v1[0], v1[1]); w.w = cvt_pk_bf16(v1[2], v1[3]); return w; }
__device__ __forceinline__ void st16(void* base, unsigned off, const u32x4 v) { *(u32x4*)((char*)base + (size_t)off) = v; }
__device__ __forceinline__ u32x4 ld16(const void* base, unsigned off) { return *(const u32x4*)((const char*)base + (size_t)off); }

struct EpiInProj {
    static constexpr bool PERM = true, HAS_MID = false, HAS_PRE = false;
    bf16_t *QKV, *USV, *GA, *GS;
    __device__ __forceinline__ void operator()(const f32x4 (&acc)[2][2][4][2], const Unit& u, int wr, int wc, int fr, int fq) const {
        const unsigned row0 = (unsigned)(u.pm * BM + wr * 64 + fr), cl = (unsigned)(wc * 32 + 8 * fq); const int pn = u.pn;
        if (pn < 3) {
            const float sc = (pn < 2) ? 0.125f : 1.0f; unsigned o0 = (row0 * 768u + (unsigned)pn * 256u + cl) * 2u; asm volatile("" : "+v"(o0));
#pragma unroll
            for (int ai = 0; ai < 2; ++ai)
#pragma unroll
                for (int m = 0; m < 4; ++m)
#pragma unroll
                    for (int bj = 0; bj < 2; ++bj) st16(QKV, o0 + (unsigned)((ai * HALF + m * 16) * 768 + bj * HALF) * 2u, pack8(acc[ai][bj][m][0] * sc, acc[ai][bj][m][1] * sc));
        } else if (pn < 7) {
            unsigned o0 = (row0 * 1024u + (unsigned)(pn - 3) * 256u + cl) * 2u; asm volatile("" : "+v"(o0));
#pragma unroll
            for (int ai = 0; ai < 2; ++ai)
#pragma unroll
                for (int m = 0; m < 4; ++m)
#pragma unroll
                    for (int bj = 0; bj < 2; ++bj) st16(USV, o0 + (unsigned)((ai * HALF + m * 16) * 1024 + bj * HALF) * 2u, pack8(acc[ai][bj][m][0], acc[ai][bj][m][1]));
        } else {
            unsigned o0 = (row0 * 1024u + (unsigned)(pn - 7) * 128u + cl) * 2u; asm volatile("" : "+v"(o0));
#pragma unroll
            for (int ai = 0; ai < 2; ++ai)
#pragma unroll
                for (int m = 0; m < 4; ++m) { f32x4 r0, r1, s0, s1;
#pragma unroll
                    for (int j = 0; j < 4; ++j) { const float e0 = fast_exp(-acc[ai][1][m][0][j]), e1 = fast_exp(-acc[ai][1][m][1][j]);
                        const float a0 = fast_exp(-acc[ai][0][m][0][j]), a1 = fast_exp(-acc[ai][0][m][1][j]);
                        s0[j] = fast_rcp(1.0f + e0); s1[j] = fast_rcp(1.0f + e1); r0[j] = (1.0f + e0) * fast_rcp(1.0f + a0); r1[j] = (1.0f + e1) * fast_rcp(1.0f + a1); }
                    const unsigned off = o0 + (unsigned)((ai * HALF + m * 16) * 1024) * 2u;
                    st16(GA, off, pack8(r0, r1)); st16(GS, off, pack8(s0, s1)); }
        }
    }
};
struct EpiGate {
    static constexpr bool PERM = true, HAS_MID = false, HAS_PRE = false;
    bf16_t* QKV; unsigned char *USV, *GA, *GS;
    __device__ __forceinline__ void operator()(const f32x4 (&acc)[2][2][4][2], const Unit& u, int wr, int wc, int fr, int fq) const {
        const unsigned row0 = (unsigned)(u.pm * BM + wr * 64 + fr), cl = (unsigned)(wc * 32 + 8 * fq); const int pn = u.pn;
        if (pn < 3) {
            const float sc = (pn < 2) ? 0.125f * 1.4426950408889634f : 1.0f;       unsigned o0 = (row0 * 768u + (unsigned)pn * 256u + cl) * 2u; asm volatile("" : "+v"(o0));
#pragma unroll
            for (int ai = 0; ai < 2; ++ai)
#pragma unroll
                for (int m = 0; m < 4; ++m)
#pragma unroll
                    for (int bj = 0; bj < 2; ++bj) st16(QKV, o0 + (unsigned)((ai * HALF + m * 16) * 768 + bj * HALF) * 2u, pack8(acc[ai][bj][m][0] * sc, acc[ai][bj][m][1] * sc));
        } else if (pn < 7) {
            unsigned o0 = (row0 * 1024u + (unsigned)(pn - 3) * 256u + cl); asm volatile("" : "+v"(o0));
#pragma unroll
            for (int ai = 0; ai < 2; ++ai)
#pragma unroll
                for (int m = 0; m < 4; ++m)
#pragma unroll
                    for (int bj = 0; bj < 2; ++bj) { const f32x4 v0 = acc[ai][bj][m][0], v1 = acc[ai][bj][m][1]; u32x2 b8; b8.x = pk_fp8x4(v0[0], v0[1], v0[2], v0[3]); b8.y = pk_fp8x4(v1[0], v1[1], v1[2], v1[3]);
                        *(u32x2*)(USV + (size_t)(o0 + (unsigned)((ai * HALF + m * 16) * 1024 + bj * HALF))) = b8; }
        } else {
            unsigned o0 = (row0 * 1024u + (unsigned)(pn - 7) * 128u + cl); asm volatile("" : "+v"(o0));
            constexpr float NL = -1.4426950408889634f;
#pragma unroll
            for (int ai = 0; ai < 2; ++ai)
#pragma unroll
                for (int m = 0; m < 4; ++m) { f32x4 r0, r1, s0, s1;
#pragma unroll
                    for (int j = 0; j < 4; ++j) { const float e0 = __builtin_amdgcn_exp2f(NL * acc[ai][1][m][0][j]), e1 = __builtin_amdgcn_exp2f(NL * acc[ai][1][m][1][j]);
                        const float a0 = __builtin_amdgcn_exp2f(NL * acc[ai][0][m][0][j]), a1 = __builtin_amdgcn_exp2f(NL * acc[ai][0][m][1][j]);
                        s0[j] = fast_rcp(1.0f + e0); s1[j] = fast_rcp(1.0f + e1); r0[j] = fminf((1.0f + e0) * fast_rcp(1.0f + a0), 448.0f); r1[j] = fminf((1.0f + e1) * fast_rcp(1.0f + a1), 448.0f); }
                    const unsigned off = o0 + (unsigned)((ai * HALF + m * 16) * 1024);
                    u32x2 rb, sb; rb.x = pk_fp8x4(r0[0], r0[1], r0[2], r0[3]); rb.y = pk_fp8x4(r1[0], r1[1], r1[2], r1[3]); sb.x = pk_fp8x4(s0[0], s0[1], s0[2], s0[3]); sb.y = pk_fp8x4(s1[0], s1[1], s1[2], s1[3]);
                    *(u32x2*)(GA + (size_t)off) = rb; *(u32x2*)(GS + (size_t)off) = sb; }
        }
    }
};
struct EpiMerge {
    static constexpr bool PERM = true, HAS_MID = true, HAS_PRE = false;
    const unsigned char *GA, *GS; unsigned char* O;
    __device__ __forceinline__ void load16(const unsigned char* G, u32x2 (&pre)[16], const Unit& u, int wr, int wc, int fr, int fq) const {
        unsigned o0 = ((unsigned)(u.pm * BM + wr * 64 + fr) * 1024u + (unsigned)(u.pn * BM + wc * 32 + 8 * fq)); asm volatile("" : "+v"(o0));
#pragma unroll
        for (int ai = 0; ai < 2; ++ai)
#pragma unroll
            for (int m = 0; m < 4; ++m)
#pragma unroll
                for (int bj = 0; bj < 2; ++bj) pre[(ai * 4 + m) * 2 + bj] = *(const u32x2*)(G + (size_t)(o0 + (unsigned)((ai * HALF + m * 16) * 1024 + bj * HALF)));
    }
    __device__ __forceinline__ void load_mid(u32x2 (&pre)[16], const Unit& u, int wr, int wc, int fr, int fq) const { load16(GA, pre, u, wr, wc, fr, fq); }
    __device__ __forceinline__ void load_fin(u32x2 (&pre)[16], const Unit& u, int wr, int wc, int fr, int fq) const { load16(GS, pre, u, wr, wc, fr, fq); }
    __device__ __forceinline__ void mid(f32x4 (&acc)[2][2][4][2], const u32x2 (&pre)[16]) const {
#pragma unroll
        for (int ai = 0; ai < 2; ++ai)
#pragma unroll
            for (int m = 0; m < 4; ++m)
#pragma unroll
                for (int bj = 0; bj < 2; ++bj) { const u32x2 a = pre[(ai * 4 + m) * 2 + bj]; acc[ai][bj][m][0] *= cvf8x4(a.x); acc[ai][bj][m][1] *= cvf8x4(a.y); }
    }
    __device__ __forceinline__ void fin(const f32x4 (&acc)[2][2][4][2], const u32x2 (&pre)[16], const Unit& u, int wr, int wc, int fr, int fq) const {
        unsigned o0 = ((unsigned)(u.pm * BM + wr * 64 + fr) * 1024u + (unsigned)(u.pn * BM + wc * 32 + 8 * fq)); asm volatile("" : "+v"(o0));
#pragma unroll
        for (int ai = 0; ai < 2; ++ai)
#pragma unroll
            for (int m = 0; m < 4; ++m)
#pragma unroll
                for (int bj = 0; bj < 2; ++bj) { const unsigned off = o0 + (unsigned)((ai * HALF + m * 16) * 1024 + bj * HALF); const u32x2 sg = pre[(ai * 4 + m) * 2 + bj];
                    const f32x4 v0 = acc[ai][bj][m][0] * cvf8x4(sg.x), v1 = acc[ai][bj][m][1] * cvf8x4(sg.y);
                    u32x2 b8; b8.x = pk_fp8x4(v0[0], v0[1], v0[2], v0[3]); b8.y = pk_fp8x4(v1[0], v1[1], v1[2], v1[3]); *(u32x2*)(O + (size_t)off) = b8; }
    }
    __device__ __forceinline__ void operator()(const f32x4 (&acc)[2][2][4][2], const Unit& u, int wr, int wc, int fr, int fq) const { }
};
struct EpiPlain {
    static constexpr bool PERM = true, HAS_MID = false, HAS_PRE = false;
    unsigned char* O; float sc;
    __device__ __forceinline__ void operator()(const f32x4 (&acc)[2][2][4][2], const Unit& u, int wr, int wc, int fr, int fq) const {
        unsigned o0 = ((unsigned)(u.pm * BM + wr * 64 + fr) * 1024u + (unsigned)(u.pn * BM + wc * 32 + 8 * fq)) * 2u; asm volatile("" : "+v"(o0));
#pragma unroll
        for (int ai = 0; ai < 2; ++ai)
#pragma unroll
            for (int m = 0; m < 4; ++m)
#pragma unroll
                for (int bj = 0; bj < 2; ++bj) { const f32x4 v0 = acc[ai][bj][m][0], v1 = acc[ai][bj][m][1];   u32x2 b8; b8.x = pk_fp8x4(v0[0], v0[1], v0[2], v0[3]); b8.y = pk_fp8x4(v1[0], v1[1], v1[2], v1[3]);
                      *(u32x2*)(O + (size_t)((o0 >> 1) + (unsigned)((ai * HALF + m * 16) * 1024 + bj * HALF))) = b8; }
    }
};
struct EpiGateUp {
    static constexpr bool PERM = true, HAS_MID = false, HAS_PRE = false;
    unsigned char* HID;
    __device__ __forceinline__ void operator()(const f32x4 (&acc)[2][2][4][2], const Unit& u, int wr, int wc, int fr, int fq) const {
        unsigned o0 = ((unsigned)(u.pm * BM + wr * 64 + fr) * 256u + (unsigned)((u.pn & 1) * 128 + wc * 32 + 8 * fq)); asm volatile("" : "+v"(o0));
#pragma unroll
        for (int ai = 0; ai < 2; ++ai)
#pragma unroll
            for (int m = 0; m < 4; ++m) { f32x4 h0, h1; const f32x4 g0 = acc[ai][0][m][0], g1 = acc[ai][0][m][1], u0 = acc[ai][1][m][0], u1 = acc[ai][1][m][1];
#pragma unroll
                for (int j = 0; j < 4; ++j) { h0[j] = g0[j] * sigmoid_f(g0[j]) * u0[j]; h1[j] = g1[j] * sigmoid_f(g1[j]) * u1[j]; }
                u32x2 b8; b8.x = pk_fp8x4(h0[0], h0[1], h0[2], h0[3]); b8.y = pk_fp8x4(h1[0], h1[1], h1[2], h1[3]); *(u32x2*)(HID + (size_t)(o0 + (unsigned)((ai * HALF + m * 16) * 256))) = b8; }
    }
};
struct EpiDown {
    static constexpr bool PERM = true, HAS_MID = false, HAS_PRE = true;
    unsigned char* Y2; const int2* list; const LAS int* tab;
    __device__ __forceinline__ void load_pre(u32x2 (&pre)[16], const Unit& u, int wr, int wc, int fr, int fq) const {
        unsigned lo0 = ((unsigned)u.e * 32768u + (unsigned)(u.p * 256 + wr * 64 + fr)) * 8u; asm volatile("" : "+v"(lo0));
#pragma unroll
        for (int ai = 0; ai < 2; ++ai)
#pragma unroll
            for (int m = 0; m < 4; ++m) pre[ai * 4 + m] = *(const u32x2*)((const char*)list + (size_t)(lo0 + (unsigned)(ai * HALF + m * 16) * 8u));
    }
    __device__ __forceinline__ void fin_pre(const f32x4 (&acc)[2][2][4][2], const u32x2 (&pre)[16], const Unit& u, int wr, int wc, int fr, int fq) const {
        const int r0 = wr * 64 + fr, cnt = tab[64 + u.e] - u.p * 256; const unsigned colb = (unsigned)((u.pn & 3) * 256 + wc * 32 + 8 * fq);
#pragma unroll
        for (int ai = 0; ai < 2; ++ai)
#pragma unroll
            for (int m = 0; m < 4; ++m) { const int ex = (r0 + ai * HALF + m * 16 < cnt) ? (int)pre[ai * 4 + m].x : -1;
                const float w = __uint_as_float(pre[ai * 4 + m].y); const unsigned off = (unsigned)ex * 1024u + colb;
                if (ex >= 0) {
#pragma unroll
                    for (int bj = 0; bj < 2; ++bj) { const f32x4 v0 = acc[ai][bj][m][0] * w, v1 = acc[ai][bj][m][1] * w; u32x2 b8; b8.x = pk_fp8x4(v0[0], v0[1], v0[2], v0[3]); b8.y = pk_fp8x4(v1[0], v1[1], v1[2], v1[3]);
                        *(u32x2*)(Y2 + (size_t)(off + (unsigned)(bj * HALF))) = b8; } } }
    }
};
}
#define XB_TMO      128
#define XB_XCNT(j)  (256  + 64 * (j))
#define XB_XSUB(j)  (1280 + 64 * (j))
#define XB_XGEN(j)  (2304 + 64 * (j))
#define XB_TOP      3328
#define XB_TOPGEN   3392
#define XCD_BAR_WORDS 3456
#define XB_SPIN_CAP (1u << 18)

__device__ __forceinline__ unsigned xb_ld(unsigned* p)              { return __hip_atomic_load(p, __ATOMIC_RELAXED, __HIP_MEMORY_SCOPE_AGENT); }
__device__ __forceinline__ unsigned xb_add(unsigned* p, unsigned v) { return __hip_atomic_fetch_add(p, v, __ATOMIC_RELAXED, __HIP_MEMORY_SCOPE_AGENT); }
__device__ __forceinline__ unsigned xb_xcc_id() { return (unsigned)__builtin_amdgcn_s_getreg((3 << 11) | 20) & 0xFu; }
#define XB_SPIN(cond, bar) do { unsigned _sp = 0; while (cond) { __builtin_amdgcn_s_sleep(1); \
    if ((++_sp & 255u) == 0u) { if (xb_ld(&(bar)[XB_TMO])) break; if (_sp > XB_SPIN_CAP) { atomicAdd(&(bar)[XB_TMO], 1u); break; } } } } while (0)

struct XcdBarrier {
    unsigned* bar; unsigned x;
    volatile LAS unsigned* st;
};

__device__ __forceinline__ XcdBarrier xcd_barrier_post(unsigned* bar, volatile LAS unsigned* st) {
    XcdBarrier b; b.bar = bar; b.x = xb_xcc_id(); b.st = st;
    if (threadIdx.x == 0) (void)xb_add(&bar[XB_XCNT(b.x)], 1u);
    return b;
}
__device__ __forceinline__ void xcd_barrier_complete(unsigned* bar, unsigned x, unsigned& nloc, unsigned& nx) {
    const unsigned G = gridDim.x * gridDim.y * gridDim.z;
    unsigned sum, cnt, mine, sp = 0u;
    for (;;) {
        sum = 0u; cnt = 0u; mine = 0u;
#pragma unroll
        for (unsigned j = 0; j < 16; ++j) { const unsigned c = xb_ld(&bar[XB_XCNT(j)]); sum += c; cnt += (c > 0u) ? 1u : 0u; mine = (j == x) ? c : mine; }
        if (sum == G) break;
        __builtin_amdgcn_s_sleep(1);
        if ((++sp & 255u) == 0u) { if (xb_ld(&bar[XB_TMO])) break; if (sp > XB_SPIN_CAP) { atomicAdd(&bar[XB_TMO], 1u); break; } }
    }
    nloc = mine > 0u ? mine : 1u; nx = cnt > 0u ? cnt : 1u;
}

__device__ __forceinline__ void xcd_barrier(const XcdBarrier& b) {
    asm volatile("s_waitcnt vmcnt(0)" ::: "memory");
    __syncthreads();
    if (threadIdx.x == 0) {
        unsigned* bar = b.bar;
        __builtin_amdgcn_s_waitcnt(0);
        unsigned nloc = b.st[0], nx = b.st[1];
        if (nloc == 0u) { xcd_barrier_complete(bar, b.x, nloc, nx); b.st[0] = nloc; b.st[1] = nx; }
        const unsigned old = xb_add(&bar[XB_XSUB(b.x)], 1u);
        const unsigned gen = old / nloc;
        if (old + 1u == (gen + 1u) * nloc) {
            __builtin_amdgcn_fence(__ATOMIC_RELEASE, "agent");
            asm volatile("s_waitcnt vmcnt(0)" ::: "memory");
            const unsigned og = xb_add(&bar[XB_TOP], 1u);
            const unsigned target = (og / nx + 1u) * nx;
            if (og + 1u != target) XB_SPIN(xb_ld(&bar[XB_TOP]) < target, bar);
            __builtin_amdgcn_fence(__ATOMIC_ACQUIRE, "agent");
            xb_add(&bar[XB_XGEN(b.x)], 1u);
            asm volatile("s_waitcnt vmcnt(0)" ::: "memory");
        } else {
            XB_SPIN(xb_ld(&bar[XB_XGEN(b.x)]) == gen, bar);
            __builtin_amdgcn_fence(__ATOMIC_ACQUIRE, "agent");
            asm volatile("s_waitcnt vmcnt(0)" ::: "memory");
        }
    }
    __syncthreads();
}

__device__ __forceinline__ void pair_sync(unsigned* bar, unsigned* cnt, volatile LAS unsigned* same) {
    asm volatile("s_waitcnt vmcnt(0)" ::: "memory");
    __syncthreads();
    if (threadIdx.x == 0) {
        __builtin_amdgcn_s_waitcnt(0);
        if (same[0] != 1u) { __builtin_amdgcn_fence(__ATOMIC_RELEASE, "agent"); asm volatile("s_waitcnt vmcnt(0)" ::: "memory"); }
        const unsigned og = xb_add(cnt, 1u);
        if (og == 0u) XB_SPIN(xb_ld(cnt) < 2u, bar);
        __builtin_amdgcn_fence(__ATOMIC_ACQUIRE, "agent");
        asm volatile("s_waitcnt vmcnt(0)" ::: "memory");
    }
    __syncthreads();
}

constexpr size_t MiB = 1u << 20;
constexpr size_t WS_CTL = 0, CTL_ZERO_BYTES = 1 * MiB;
constexpr size_t WS_MOD = 1 * MiB;
constexpr size_t WS_ST = 3 * MiB;
constexpr size_t WS_WIN = 4 * MiB, WS_WBR = 12 * MiB, WS_WOUT = 14 * MiB, WS_WGU = 16 * MiB, WS_WDN = 32 * MiB, WS_SGW = 40 * MiB;
constexpr size_t WS_WIN8 = WS_WIN;
constexpr size_t WS_WSTRIDE = 37 * MiB;
constexpr size_t WS_LIST = 152 * MiB;
constexpr size_t WS_HX = 156 * MiB;
constexpr size_t WS_GA = 220 * MiB, WS_GS = 284 * MiB, WS_Y2 = WS_GA;
constexpr size_t WS_H8A = 348 * MiB + 32 * MiB;
constexpr size_t WS_CAT = 348 * MiB, WS_Y = WS_CAT;
constexpr size_t WS_WRB = 412 * MiB;
constexpr size_t WS_END = 416 * MiB;
constexpr size_t OB_QKV = 0, OB_HID = OB_QKV;
constexpr size_t OB_USV = 48 * MiB, OB_MRG = OB_USV, OB_H8 = OB_USV;
constexpr int CW_BAR = 4096;
constexpr int CW_CNT = 16384;
constexpr int CW_PAIR = 98304;
constexpr int CW_XID = 196608;
constexpr int CW_PAN = 65536;
constexpr int RING_BYTES = 131072, MISC_OFF = 135168, PAR_OFF = 139264, LDS_BYTES = 163840;

#define VM_WAIT() asm volatile("s_waitcnt vmcnt(0)" ::: "memory")
#define LDS_WAIT() asm volatile("s_waitcnt lgkmcnt(0)" ::: "memory")

struct Frame {
    LAS unsigned char* lds; int tid, lane, wave, vcu, G;
    unsigned char* ws;
    const float* const* in; float* out;
};
__device__ __forceinline__ float wave_sum(float v) {
#pragma unroll
    for (int o = 1; o < 64; o <<= 1) v += __shfl_xor(v, o);
    return v;
}
__device__ __forceinline__ int t5_bucket(int rel) {
    const int n = rel < 0 ? 0 : rel;
    if (n < 16) return n;
    const int large = 16 + (int)(logf((float)n / 16.0f) / logf(8.0f) * 16.0f);
    return large < 31 ? large : 31;
}

template <bool F16OUT>
__device__ __forceinline__ void transpose_item(const float* W, int N, bf16_t* WT, int ldt, int koff, int row_of_n0, int k0, int n0, int lane, LAS unsigned char* scr) {
    const float* src = W + (size_t)k0 * N + n0 + lane;
    float v[64];
#pragma unroll
    for (int i = 0; i < 64; ++i) v[i] = src[(size_t)i * N];
#pragma unroll
    for (int c = 0; c < 8; ++c) { u32x4 o;
        if (F16OUT) { typedef _Float16 th2 __attribute__((ext_vector_type(2)));
            o.x = __builtin_bit_cast(unsigned, __builtin_convertvector((f32x2){v[8 * c], v[8 * c + 1]}, th2)); o.y = __builtin_bit_cast(unsigned, __builtin_convertvector((f32x2){v[8 * c + 2], v[8 * c + 3]}, th2));
            o.z = __builtin_bit_cast(unsigned, __builtin_convertvector((f32x2){v[8 * c + 4], v[8 * c + 5]}, th2)); o.w = __builtin_bit_cast(unsigned, __builtin_convertvector((f32x2){v[8 * c + 6], v[8 * c + 7]}, th2)); }
        else { o.x = cvt_pk_bf16(v[8 * c], v[8 * c + 1]); o.y = cvt_pk_bf16(v[8 * c + 2], v[8 * c + 3]); o.z = cvt_pk_bf16(v[8 * c + 4], v[8 * c + 5]); o.w = cvt_pk_bf16(v[8 * c + 6], v[8 * c + 7]); }
        *(LAS u32x4*)(scr + lane * 144 + c * 16) = o; }
    const int c8 = lane & 7;
#pragma unroll
    for (int j = 0; j < 8; ++j) { const int n = (lane >> 3) + 8 * j; const u32x4 o = *(const LAS u32x4*)(scr + n * 144 + c8 * 16);
        *(u32x4*)(WT + (size_t)(row_of_n0 + n) * ldt + koff + k0 + 8 * c8) = o; }
}
template <int PITCH = 1024>
__device__ __forceinline__ void transpose_item_fp8(const float* W, int N, unsigned char* WT, int koff, int row_of_n0, int k0, int n0, int lane, LAS unsigned char* scr) {
    const float* src = W + (size_t)k0 * N + n0 + lane;
    float v[64];
#pragma unroll
    for (int i = 0; i < 64; ++i) v[i] = src[(size_t)i * N];
#pragma unroll
    for (int c = 0; c < 4; ++c) { u32x4 o;
        o.x = pk_fp8x4(32.f * v[16 * c], 32.f * v[16 * c + 1], 32.f * v[16 * c + 2], 32.f * v[16 * c + 3]); o.y = pk_fp8x4(32.f * v[16 * c + 4], 32.f * v[16 * c + 5], 32.f * v[16 * c + 6], 32.f * v[16 * c + 7]);
        o.z = pk_fp8x4(32.f * v[16 * c + 8], 32.f * v[16 * c + 9], 32.f * v[16 * c + 10], 32.f * v[16 * c + 11]); o.w = pk_fp8x4(32.f * v[16 * c + 12], 32.f * v[16 * c + 13], 32.f * v[16 * c + 14], 32.f * v[16 * c + 15]);
        *(LAS u32x4*)(scr + lane * 80 + c * 16) = o; }
    const int c4 = lane & 3;
#pragma unroll
    for (int j = 0; j < 4; ++j) { const int n = (lane >> 2) + 16 * j; const u32x4 o = *(const LAS u32x4*)(scr + n * 80 + c4 * 16);
        *(u32x4*)(WT + (size_t)(row_of_n0 + n) * PITCH + koff + k0 + 16 * c4) = o; }
}
constexpr int CI_IN = 16 * 60, CI_BR = 8 * 16, CI_OUT = 16 * 16, CI_GU = 16 * 4, CI_DN = 4 * 16;
constexpr int CONV_ITEMS = CI_IN + 2 * CI_BR + CI_OUT + NE * (2 * CI_GU + CI_DN) + 64;
__device__ __forceinline__ void conv_item(Frame& F, int l, int it, LAS unsigned char* scr) {
    const int lane = F.lane; unsigned char* ws = F.ws + (size_t)l * WS_WSTRIDE;
    int r = it;
    if (r < CI_IN) { const int nb = 60, n0 = 64 * (r % nb);
        const int row0 = (n0 < 1792) ? n0 : (n0 < 2816 ? 1792 + ((n0 - 1792) >> 7) * 256 + ((n0 - 1792) & 127) : 1792 + ((n0 - 2816) >> 7) * 256 + 128 + ((n0 - 2816) & 127));
        transpose_item_fp8(F.in[7] + (size_t)l * D * INW, INW, ws + WS_WIN8, 0, row0, 64 * (r / nb), n0, lane, scr);
        return; } r -= CI_IN;
    if (r < CI_BR) { const int nb = 16; transpose_item_fp8(F.in[13] + (size_t)l * 512 * D, D, ws + WS_WBR, 0, 64 * (r % nb), 64 * (r / nb), 64 * (r % nb), lane, scr); return; } r -= CI_BR;
    if (r < CI_BR) { const int nb = 16; transpose_item_fp8(F.in[14] + (size_t)l * 512 * D, D, ws + WS_WBR, 512, 64 * (r % nb), 64 * (r / nb), 64 * (r % nb), lane, scr); return; } r -= CI_BR;
    if (r < CI_OUT) { const int nb = 16; transpose_item_fp8(F.in[15] + (size_t)l * D * D, D, ws + WS_WOUT, 0, 64 * (r % nb), 64 * (r / nb), 64 * (r % nb), lane, scr); return; } r -= CI_OUT;
    if (r < NE * 2 * CI_GU) {
        const int e = r / (2 * CI_GU), q = r % (2 * CI_GU), up = q / CI_GU, ii = q % CI_GU, nb = 4, n0 = 64 * (ii % nb), k0 = 64 * (ii / nb);
        const float* W = F.in[up ? 19 : 18] + ((size_t)l * NE + e) * D * FF;
        transpose_item_fp8(W, FF, ws + WS_WGU, 0, e * 512 + (n0 >> 7) * 256 + up * 128 + (n0 & 127), k0, n0, lane, scr); return; } r -= NE * 2 * CI_GU;
    if (r < NE * CI_DN) { const int e = r / CI_DN, ii = r % CI_DN, nb = 16, n0 = 64 * (ii % nb), k0 = 64 * (ii / nb);
        transpose_item_fp8<256>(F.in[20] + ((size_t)l * NE + e) * FF * D, D, ws + WS_WDN, 0, e * 1024 + n0, k0, n0, lane, scr); return; } r -= NE * CI_DN;
    {
        const float* W = F.in[9] + (size_t)l * 8 * 128 * 128 + (size_t)r * 2048; bf16_t* O = (bf16_t*)(ws + WS_SGW) + (size_t)r * 2048;
        const int i = (r & 7) * 16 + (lane >> 2), j0 = (lane & 3) * 32;
#pragma unroll
        for (int q = 0; q < 4; ++q) { const f32x4 a = *(const f32x4*)(W + lane * 32 + q * 8), b = *(const f32x4*)(W + lane * 32 + q * 8 + 4); f32x4 a2, b2;
#pragma unroll
            for (int t = 0; t < 4; ++t) { a2[t] = (j0 + q * 8 + t <= i) ? a[t] : 0.f; b2[t] = (j0 + q * 8 + 4 + t <= i) ? b[t] : 0.f; }
            *(u32x4*)(O + lane * 32 + q * 8) = pg8::pack8(a2, b2); }
    }
}

constexpr int MOD_ITEMS = DEPTH * 6 * D / 32;
__device__ __forceinline__ void mod_item(Frame& F, int it) {
    const LAS float* cond = (const LAS float*)F.lds;
    const int l = it / 192, j0 = (it % 192) * 32, col = j0 + (F.lane & 31), kh = (F.lane >> 5) * 512;
    const __amdgpu_buffer_rsrc_t rs = __builtin_amdgcn_make_buffer_rsrc((void*)(F.in[5] + (size_t)l * D * 6 * D), 0, D * 6 * D * 4, 0x00020000);
    const int voff = (kh * 6 * D + col) * 4;
    f32x4 acc[4];
#pragma unroll
    for (int b = 0; b < 4; ++b) acc[b] = (f32x4){0.f, 0.f, 0.f, 0.f};
#pragma unroll 1
    for (int k = 0; k < 512; k += 16) {
        float wv[16];
#pragma unroll
        for (int q = 0; q < 16; ++q) wv[q] = __builtin_bit_cast(float, __builtin_amdgcn_raw_buffer_load_b32(rs, voff, (k + q) * 6 * D * 4, 0));
#pragma unroll
        for (int q = 0; q < 16; ++q) { const LAS f32x4* cp = (const LAS f32x4*)(cond + (kh + k + q) * 16);
#pragma unroll
            for (int b = 0; b < 4; ++b) acc[b] += cp[b] * wv[q];
            if ((q & 3) == 3) asm volatile("" ::: "memory"); }
    }
    int t2 = threadIdx.x, it2 = it; asm volatile("" : "+v"(t2), "+s"(it2));
    const int l2 = it2 / 192, col2 = (it2 % 192) * 32 + (t2 & 31);
    float* mod = (float*)(F.ws + WS_MOD) + (size_t)l2 * BATCH * 6 * D + col2; const float bia = F.in[6][l2 * 6 * D + col2];
#pragma unroll
    for (int b = 0; b < 16; ++b) { const float a = acc[b >> 2][b & 3]; const float s = a + __shfl_xor(a, 32); if ((t2 & 63) < 32) mod[(size_t)b * 6 * D] = s + bia; }
}

struct RowArgs { const float* xin; const bf16_t* y; const float* g; const float* gain; const float* bias; const float* sc; const float* sh; const float* osc; const float* osh; bf16_t* HX; float* st; int l; bool has_h; float* xo; int2* list; unsigned char* H8; };
typedef _Float16 h16x4 __attribute__((ext_vector_type(4)));
__device__ __forceinline__ f32x4 cvh4(const u32x2 w) { return __builtin_convertvector(__builtin_bit_cast(h16x4, w), f32x4); }
__device__ __forceinline__ u32x2 pkh4(const f32x4 v) { return __builtin_bit_cast(u32x2, __builtin_convertvector(v, h16x4)); }
__device__ __forceinline__ f32x4 cvbf4(const u32x2 w) { return (f32x4){bf_lo(w.x), bf_hi(w.x), bf_lo(w.y), bf_hi(w.y)}; }
#define DPP_ADD(v, ctrl, rmask, bc) v += __builtin_bit_cast(float, __builtin_amdgcn_update_dpp(0, __builtin_bit_cast(int, v), ctrl, rmask, 0xF, bc))
__device__ __forceinline__ float dpp_sum(float v) {
    DPP_ADD(v, 0xB1, 0xF, true); DPP_ADD(v, 0x4E, 0xF, true); DPP_ADD(v, 0x141, 0xF, true); DPP_ADD(v, 0x140, 0xF, true);
    DPP_ADD(v, 0x142, 0xA, false); DPP_ADD(v, 0x143, 0xC, false);
    return __builtin_bit_cast(float, __builtin_amdgcn_readlane(__builtin_bit_cast(int, v), 63));
}
template <int MODE> struct RowRaw { f32x4 x[4]; u32x2 hx[4]; unsigned y[4]; unsigned y2[4]; f32x2 st; };
#define ROWCOL(lane, q) (8 * (lane) + 512 * ((q) >> 1) + 4 * ((q) & 1))
template <int MODE>
__device__ __forceinline__ void row_load(RowRaw<MODE>& r, Frame& F, const RowArgs& A, size_t row, int lane) {
    const int rw = __builtin_amdgcn_readfirstlane((int)row);
    if (MODE == 0) {
        const __amdgpu_buffer_rsrc_t rx = __builtin_amdgcn_make_buffer_rsrc((void*)A.xin, 0, T * D * 4, 0x00020000);
#pragma unroll
        for (int j = 0; j < 4; ++j) r.x[j] = __builtin_bit_cast(f32x4, __builtin_amdgcn_raw_buffer_load_b128(rx, lane * 32 + (j >> 1) * 2048 + (j & 1) * 16, rw * (D * 4), 0));
    } else {
        r.st = *(const f32x2*)(A.st + (size_t)rw * 2);
        const __amdgpu_buffer_rsrc_t rh = __builtin_amdgcn_make_buffer_rsrc((void*)A.HX, 0, T * D * 2, 0x00020000);
        const __amdgpu_buffer_rsrc_t ry = __builtin_amdgcn_make_buffer_rsrc((void*)A.y, 0, (MODE == 2 ? 2 : 1) * T * D, 0x00020000);
#pragma unroll
        for (int jj = 0; jj < 2; ++jj) { const u32x4 h = __builtin_bit_cast(u32x4, __builtin_amdgcn_raw_buffer_load_b128(rh, lane * 16 + jj * 1024, rw * (D * 2), 2));
            r.hx[2 * jj] = (u32x2){h.x, h.y}; r.hx[2 * jj + 1] = (u32x2){h.z, h.w};
            if (MODE == 1) { const u32x2 y = __builtin_bit_cast(u32x2, __builtin_amdgcn_raw_buffer_load_b64(ry, lane * 8 + jj * 512, rw * D, 2)); r.y[2 * jj] = y.x; r.y[2 * jj + 1] = y.y; }
            else { const u32x2 y = __builtin_bit_cast(u32x2, __builtin_amdgcn_raw_buffer_load_b64(ry, lane * 8 + jj * 512, rw * (D * 2), 2));
                   const u32x2 y2 = __builtin_bit_cast(u32x2, __builtin_amdgcn_raw_buffer_load_b64(ry, lane * 8 + jj * 512 + D, rw * (D * 2), 2));
                   r.y[2 * jj] = y.x; r.y[2 * jj + 1] = y.y; r.y2[2 * jj] = y2.x; r.y2[2 * jj + 1] = y2.y; } }
    }
}
template <int MODE>
__device__ __forceinline__ void row_process(const RowRaw<MODE>& r, Frame& F, const RowArgs& A, size_t row, int lane, const f32x4 (&gv)[4], const LAS float* pl) {
    f32x4 z[4];
    asm volatile("" ::: "memory");
    if (MODE == 0) {
#pragma unroll
        for (int j = 0; j < 4; ++j) z[j] = r.x[j];
    } else {
        const float mu0 = r.st[0], sg0 = r.st[1];
#pragma unroll
        for (int j = 0; j < 4; ++j) { f32x4 y = cvf8x4(r.y[j]); if (MODE == 2) y = y + cvf8x4(r.y2[j]);
            const f32x4 x = (cvbf4(r.hx[j]) * *(const LAS f32x4*)(pl + 4096 + 512 * (j >> 1) + 4 * (j & 1)) + *(const LAS f32x4*)(pl + 5120 + 512 * (j >> 1) + 4 * (j & 1))) * sg0 + mu0;
            z[j] = ALPHA * x + (1.0f + gv[j]) * y; }
        float s = 0.f;
#pragma unroll
        for (int j = 0; j < 4; ++j) s += (z[j][0] + z[j][1]) + (z[j][2] + z[j][3]);
        const float mean = dpp_sum(s) * (1.0f / D); float q = 0.f;
#pragma unroll
        for (int j = 0; j < 4; ++j) { z[j] = z[j] - mean; q += (z[j][0] * z[j][0] + z[j][1] * z[j][1]) + (z[j][2] * z[j][2] + z[j][3] * z[j][3]); }
        const float rstd = __builtin_amdgcn_rsqf(dpp_sum(q) * (1.0f / D) + LN_EPS);
#pragma unroll
        for (int j = 0; j < 4; ++j) z[j] = z[j] * rstd * *(const LAS f32x4*)(pl + 512 * (j >> 1) + 4 * (j & 1)) + *(const LAS f32x4*)(pl + 1024 + 512 * (j >> 1) + 4 * (j & 1));
    }
    if (A.xo) {
#pragma unroll
        for (int j = 0; j < 4; ++j) *(f32x4*)(A.xo + row * D + ROWCOL(lane, j)) = z[j];
    }
    if (MODE != 2 || A.has_h) {
        float s = 0.f;
#pragma unroll
        for (int j = 0; j < 4; ++j) s += (z[j][0] + z[j][1]) + (z[j][2] + z[j][3]);
        const float mean = dpp_sum(s) * (1.0f / D); float q = 0.f;
#pragma unroll
        for (int j = 0; j < 4; ++j) { z[j] = z[j] - mean; q += (z[j][0] * z[j][0] + z[j][1] * z[j][1]) + (z[j][2] * z[j][2] + z[j][3] * z[j][3]); }
        const float vq = dpp_sum(q) * (1.0f / D) + LN_EPS, rstd = __builtin_amdgcn_rsqf(vq), sig = vq * rstd;
#pragma unroll
        for (int j = 0; j < 4; ++j) z[j] = z[j] * rstd * *(const LAS f32x4*)(pl + 2048 + 512 * (j >> 1) + 4 * (j & 1)) + *(const LAS f32x4*)(pl + 3072 + 512 * (j >> 1) + 4 * (j & 1));
#pragma unroll
        for (int jj = 0; jj < 2; ++jj) { u32x4 w; w.x = cvt_pk_bf16(z[2 * jj][0], z[2 * jj][1]); w.y = cvt_pk_bf16(z[2 * jj][2], z[2 * jj][3]); w.z = cvt_pk_bf16(z[2 * jj + 1][0], z[2 * jj + 1][1]); w.w = cvt_pk_bf16(z[2 * jj + 1][2], z[2 * jj + 1][3]);
            *(u32x4*)(A.HX + row * D + 8 * lane + 512 * jj) = w;
            if (A.H8) { u32x2 b8; b8.x = pk_fp8x4(z[2 * jj][0], z[2 * jj][1], z[2 * jj][2], z[2 * jj][3]); b8.y = pk_fp8x4(z[2 * jj + 1][0], z[2 * jj + 1][1], z[2 * jj + 1][2], z[2 * jj + 1][3]); *(u32x2*)(A.H8 + row * D + 8 * lane + 512 * jj) = b8; } }
        if (lane == 0) *(f32x2*)(A.st + row * 2) = (f32x2){mean, sig};
    }
}
#define DPPF(v, ctrl) __builtin_bit_cast(float, __builtin_amdgcn_update_dpp(0, __builtin_bit_cast(int, v), ctrl, 0xF, 0xF, true))
#define DPPI(v, ctrl) __builtin_amdgcn_update_dpp(0, v, ctrl, 0xF, 0xF, true)
__device__ __forceinline__ float row16_sum(float v) { v += DPPF(v, 0xB1); v += DPPF(v, 0x4E); v += DPPF(v, 0x141); v += DPPF(v, 0x140); return v; }
__device__ __forceinline__ float row16_max(float v) { v = fmaxf(v, DPPF(v, 0xB1)); v = fmaxf(v, DPPF(v, 0x4E)); v = fmaxf(v, DPPF(v, 0x141)); v = fmaxf(v, DPPF(v, 0x140)); return v; }
typedef _Float16 half8 __attribute__((ext_vector_type(8)));
__device__ __forceinline__ void route16(const LAS unsigned char* wrb, const bf16_t* xrows, size_t row_base, int lane, int lr_base, float rbias, LAS int* lcnt, LAS int* asg) {
    const int e = lane & 15, g = lane >> 4;
    asm volatile("s_waitcnt vmcnt(0)" ::: "memory");
    const __amdgpu_buffer_rsrc_t rs = __builtin_amdgcn_make_buffer_rsrc((void*)xrows, 0, T * D * 2, 0x00020000);
    const int voff = (int)(((row_base + (size_t)e) * D + 8 * g) * 2);
    f32x4 ah = (f32x4){0.f, 0.f, 0.f, 0.f}, al = (f32x4){0.f, 0.f, 0.f, 0.f};
    const LAS unsigned char* bb = wrb + lane * 16;
    u32x4 av[32];
#pragma unroll
    for (int i = 0; i < 32; ++i) av[i] = __builtin_bit_cast(u32x4, __builtin_amdgcn_raw_buffer_load_b128(rs, voff, i * 64, 16  ));
#pragma unroll
    for (int i = 0; i < 32; ++i) { const half8 a = __builtin_bit_cast(half8, av[i]);
        const half8 bh = *(const LAS half8*)(bb + i * 1024), bl = *(const LAS half8*)(bb + 32768 + i * 1024);
        ah = __builtin_amdgcn_mfma_f32_16x16x32_bf16(__builtin_bit_cast(bf16x8, a), __builtin_bit_cast(bf16x8, bh), ah, 0, 0, 0); al = __builtin_amdgcn_mfma_f32_16x16x32_bf16(__builtin_bit_cast(bf16x8, a), __builtin_bit_cast(bf16x8, bl), al, 0, 0, 0); }
    const int qi = lane & 3, q = (lane >> 2) & 3;
#pragma unroll
    for (int rr = 0; rr < 4; ++rr) {
        const int row = 4 * g + rr;
        const float lg = ah[rr] + al[rr];
        const float mx = row16_max(lg);
        float p = expf(lg - mx);
        p = p / row16_sum(p);
        const float sel = p + rbias;
        int rank = 0;
        { const float a = DPPF(sel, 0x39); const int j = DPPI(qi, 0x39); rank += (a > sel || (a == sel && j < qi)) ? 1 : 0; }
        { const float a = DPPF(sel, 0x4E); const int j = DPPI(qi, 0x4E); rank += (a > sel || (a == sel && j < qi)) ? 1 : 0; }
        { const float a = DPPF(sel, 0x93); const int j = DPPI(qi, 0x93); rank += (a > sel || (a == sel && j < qi)) ? 1 : 0; }
        const bool in2 = rank < 2;
        float gs = in2 ? sel : 0.f; gs += DPPF(gs, 0xB1); gs += DPPF(gs, 0x4E);
        bool best = true;
        { const float a = DPPF(gs, 0x124); const int j = DPPI(q, 0x124); best = best && (gs > a || (gs == a && q < j)); }
        { const float a = DPPF(gs, 0x128); const int j = DPPI(q, 0x128); best = best && (gs > a || (gs == a && q < j)); }
        { const float a = DPPF(gs, 0x12C); const int j = DPPI(q, 0x12C); best = best && (gs > a || (gs == a && q < j)); }
        const bool chosen = best && in2;
        const float den = row16_sum(chosen ? p : 0.f);
        const float w = p / den;
        if (chosen) { const int rk = __hip_atomic_fetch_add(lcnt + e, 1, __ATOMIC_RELAXED, __HIP_MEMORY_SCOPE_WORKGROUP);
            const int a = 2 * (lr_base + row) + rank; asg[2 * a] = e | (rk << 8); asg[2 * a + 1] = __float_as_int(w); }
    }
}
template <int MODE>
__device__ __forceinline__ void row_phase(Frame& F, const RowArgs& A) {
    int tid0_ = threadIdx.x; asm volatile("" : "+v"(tid0_));
    const int wave = __builtin_amdgcn_readfirstlane(tid0_ >> 6);
    LAS unsigned char* wrb = F.lds;
    LAS int* lcnt = (LAS int*)(F.lds + 131072);
    LAS int* gb = lcnt + 16;
    LAS int* asg = lcnt + 32;
    LAS float* par = (LAS float*)(F.lds + PAR_OFF);
#pragma unroll 1
    for (int rb = F.vcu; rb < T / 128; rb += F.G) {
        int tid_ = tid0_; asm volatile("" : "+v"(tid_));
        const int lane = tid_ & 63, tid = tid_;
        const float rbias = (MODE == 1) ? F.in[4][lane & 15] : 0.f;
        const LAS float* pl = par + 8 * lane; asm volatile("" : "+v"(pl));
        const int row0 = rb * 128, b = row0 / SEQ;
        __syncthreads();
        const size_t r0 = (size_t)row0 + wave * 16;
        u32x4 wv[8];
        if (MODE == 1) { const unsigned char* src = F.ws + WS_WRB;
#pragma unroll
            for (int k = 0; k < 8; ++k) wv[k] = *(const u32x4*)(src + (size_t)(tid + k * NTHR) * 16); }
        const int c4 = (tid & 255) * 4;
        f32x4 pv0 = (f32x4){0.f, 0.f, 0.f, 0.f}, pv1 = pv0, pv2 = pv0, pv3 = pv0;
        if (tid < 256) { if (MODE != 0) { pv0 = *(const f32x4*)(A.gain + c4); pv1 = *(const f32x4*)(A.bias + c4); pv2 = *(const f32x4*)(A.osc + b * 6 * D + c4); pv3 = *(const f32x4*)(A.osh + b * 6 * D + c4); } }
        else if (MODE != 2 || A.has_h) { pv0 = *(const f32x4*)(A.sc + b * 6 * D + c4); pv1 = *(const f32x4*)(A.sh + b * 6 * D + c4); }
        f32x4 gv[4];
#pragma unroll
        for (int j = 0; j < 4; ++j) gv[j] = (MODE == 0) ? (f32x4){0.f, 0.f, 0.f, 0.f} : *(const f32x4*)(A.g + b * 6 * D + ROWCOL(lane, j));
        RowRaw<MODE> ra, rbf, rc, rd;
        row_load<MODE>(ra, F, A, r0, lane); row_load<MODE>(rbf, F, A, r0 + 1, lane); row_load<MODE>(rc, F, A, r0 + 2, lane); row_load<MODE>(rd, F, A, r0 + 3, lane);
        if (MODE == 1) { if (tid < 16) lcnt[tid] = 0;
#pragma unroll
            for (int k = 0; k < 8; ++k) *(LAS u32x4*)(wrb + (tid + k * NTHR) * 16) = wv[k]; }
        if (tid < 256) { if (MODE != 0) { const f32x4 o = 1.0f / (1.0f + pv2); *(LAS f32x4*)(par + c4) = pv0; *(LAS f32x4*)(par + 1024 + c4) = pv1; *(LAS f32x4*)(par + 4096 + c4) = o; *(LAS f32x4*)(par + 5120 + c4) = -pv3 * o; } }
        else if (MODE != 2 || A.has_h) { *(LAS f32x4*)(par + 2048 + c4) = 1.0f + pv0; *(LAS f32x4*)(par + 3072 + c4) = pv1; }
        __syncthreads();
#pragma unroll 1
        for (int pr = 0; pr < 3; ++pr) {
            row_process<MODE>(ra, F, A, r0 + 4 * pr, lane, gv, pl); row_load<MODE>(ra, F, A, r0 + 4 * pr + 4, lane);
            row_process<MODE>(rbf, F, A, r0 + 4 * pr + 1, lane, gv, pl); row_load<MODE>(rbf, F, A, r0 + 4 * pr + 5, lane);
            row_process<MODE>(rc, F, A, r0 + 4 * pr + 2, lane, gv, pl); row_load<MODE>(rc, F, A, r0 + 4 * pr + 6, lane);
            row_process<MODE>(rd, F, A, r0 + 4 * pr + 3, lane, gv, pl); row_load<MODE>(rd, F, A, r0 + 4 * pr + 7, lane);
        }
        row_process<MODE>(ra, F, A, r0 + 12, lane, gv, pl); row_process<MODE>(rbf, F, A, r0 + 13, lane, gv, pl); row_process<MODE>(rc, F, A, r0 + 14, lane, gv, pl); row_process<MODE>(rd, F, A, r0 + 15, lane, gv, pl);
        if (MODE == 1) route16(wrb, A.HX, r0, lane, wave * 16, rbias, lcnt, asg);
        if (MODE == 1) {
            __syncthreads();
            if (tid < 16) gb[tid] = (int)__hip_atomic_fetch_add(((unsigned*)F.ws) + CW_CNT + 64 * (A.l * 16 + tid), (unsigned)lcnt[tid], __ATOMIC_RELAXED, __HIP_MEMORY_SCOPE_AGENT);
            __syncthreads();
            if (tid < 256) { const int er = asg[2 * tid], wb = asg[2 * tid + 1]; const int e = er & 255, pos = gb[e] + (er >> 8);
                int2 en; en.x = (row0 + (tid >> 1)) * 2 + (tid & 1); en.y = wb; A.list[(size_t)e * 32768 + pos] = en; }
            __syncthreads();
        }
    }
}

__device__ __forceinline__ s16x4 vtr(const LAS unsigned char* p) { return __builtin_bit_cast(s16x4, __builtin_amdgcn_ds_read_tr16_b64_v4i16((LAS s16x4*)p)); }
__device__ __forceinline__ bf16x8 cat44(s16x4 a, s16x4 b) { return (bf16x8){a[0], a[1], a[2], a[3], b[0], b[1], b[2], b[3]}; }
__device__ __forceinline__ f32x4 gelu_tab4(const LAS float* gt, const unsigned w) { return (f32x4){gt[w & 0xffu], gt[(w >> 8) & 0xffu], gt[(w >> 16) & 0xffu], gt[w >> 24]}; }
__device__ __forceinline__ float rows_max(float v) {
    auto r = __builtin_amdgcn_permlane32_swap(__float_as_uint(v), __float_as_uint(v), false, false); v = fmaxf(__uint_as_float(r[0]), __uint_as_float(r[1]));
    r = __builtin_amdgcn_permlane16_swap(__float_as_uint(v), __float_as_uint(v), false, false); return fmaxf(__uint_as_float(r[0]), __uint_as_float(r[1]));
}
__device__ __forceinline__ float rows_sum(float v) {
    auto r = __builtin_amdgcn_permlane32_swap(__float_as_uint(v), __float_as_uint(v), false, false); v = __uint_as_float(r[0]) + __uint_as_float(r[1]);
    r = __builtin_amdgcn_permlane16_swap(__float_as_uint(v), __float_as_uint(v), false, false); return __uint_as_float(r[0]) + __uint_as_float(r[1]);
}
__device__ __forceinline__ void rows_transpose4(unsigned& w0, unsigned& w1, unsigned& w2, unsigned& w3) {
    auto r = __builtin_amdgcn_permlane32_swap(w0, w2, false, false); w0 = r[0]; w2 = r[1];
    r = __builtin_amdgcn_permlane32_swap(w1, w3, false, false); w1 = r[0]; w3 = r[1];
    r = __builtin_amdgcn_permlane16_swap(w0, w1, false, false); w0 = r[0]; w1 = r[1];
    r = __builtin_amdgcn_permlane16_swap(w2, w3, false, false); w2 = r[0]; w3 = r[1];
}
__device__ __forceinline__ void mixer_unit(Frame& F, int l, int ub, int un) {
    int tid_ = threadIdx.x; asm volatile("" : "+v"(tid_));
    const int tid = tid_, lane = tid & 63, wave = __builtin_amdgcn_readfirstlane(tid >> 6), c = lane & 15, g = lane >> 4;
    LAS unsigned char* lds = F.lds;
    const bf16_t* QKV = (const bf16_t*)((unsigned char*)F.out + OB_QKV); const unsigned char* USV = (const unsigned char*)F.out + OB_USV;     unsigned char* CAT = F.ws + WS_CAT;
    const size_t tok0 = (size_t)ub * SEQ + (size_t)un * 128;
    float sink = F.in[8][l * 8 + wave] * 1.4426950408889634f;
    u32x4 v[16];
#pragma unroll
    for (int i = 0; i < 16; ++i) { const int ci = i * NTHR + tid, c8 = ci & 7, key = (ci >> 3) & 255, hk = (ci >> 11) & 1, tv = ci >> 12;
        v[i] = (u32x4){0u, 0u, 0u, 0u};
        if (un > 0 || key >= 128) v[i] = *(const u32x4*)(QKV + (tok0 - 128 + key) * 768 + 512 + tv * 128 + hk * 64 + c8 * 8); }
    const bf16_t* qp0 = QKV + (tok0 + c) * 768 + wave * 64 + 8 * g;
    bf16x8 qa0 = *(const bf16x8*)qp0, qa1 = *(const bf16x8*)(qp0 + 32);
    bf16x8 qb0 = *(const bf16x8*)(qp0 + 16 * 768), qb1 = *(const bf16x8*)(qp0 + 16 * 768 + 32);
    u32x2 vrow[16];
#pragma unroll
    for (int rr = 0; rr < 16; ++rr) vrow[rr] = *(const u32x2*)(USV + (tok0 + wave * 16 + rr) * 1024 + 512 + 8 * lane);
    LAS float* tb = (LAS float*)(lds + PAR_OFF);
#pragma unroll
    for (int i = 0; i < 2; ++i) { const int idx = i * NTHR + tid; tb[idx] = F.in[2][t5_bucket(idx & 127) * 8 + (idx >> 7)] * 1.4426950408889634f; }
    if (tid < 256) { const f32x4 p = cvf8x4((unsigned)tid); ((LAS float*)(lds + PAR_OFF + 4096))[tid] = gelu_pk((f32x2){p[0], p[0]}).x; }
    const LAS float* gt = (const LAS float*)(lds + PAR_OFF + 4096);
#pragma unroll
    for (int i = 0; i < 16; ++i) { const int ci = i * NTHR + tid, c8 = ci & 7, key = (ci >> 3) & 255, hk = (ci >> 11) & 1, tv = ci >> 12;
        *(LAS u32x4*)(lds + (tv * 2 + hk) * 32768 + key * 128 + ((c8 ^ (key & 7)) << 4)) = v[i]; }
    asm volatile("" : "+v"(sink));
    __syncthreads();
#ifndef MIX_REP_A
#define MIX_REP_A 1
#endif
#ifndef MIX_REP_S
#define MIX_REP_S 1
#endif
    for (int repa_ = 0; repa_ < MIX_REP_A; ++repa_)
    {
        const int h = wave, hk = h >> 2;
        const LAS unsigned char* Kb = lds + hk * 32768; const LAS unsigned char* Vb = lds + 65536 + hk * 32768;
        float bv[9][4];
#pragma unroll
        for (int j = 0; j < 9; ++j)
#pragma unroll
            for (int r = 0; r < 4; ++r) { const int rel = c + 128 - 16 * j - 4 * g - r; bv[j][r] = (rel >= 0 && rel < 128) ? tb[h * 128 + (rel & 127)] : -1e30f; }
        const int ka0 = c * 128 + (((0 + g) ^ (c & 7)) << 4), ka1 = c * 128 + (((4 + g) ^ (c & 7)) << 4);
        const int vkey = 4 * g + (c >> 2), vsw = vkey & 7, vp = c & 3;
        const LAS unsigned char* kb0 = Kb + ka0; const LAS unsigned char* kb1 = Kb + ka1;
        const LAS unsigned char* vb0 = Vb + vkey * 128 + ((((0 + (vp >> 1)) ^ vsw) << 4) + (vp & 1) * 8); const LAS unsigned char* vb1 = Vb + vkey * 128 + ((((2 + (vp >> 1)) ^ vsw) << 4) + (vp & 1) * 8);
        const LAS unsigned char* vb2 = Vb + vkey * 128 + ((((4 + (vp >> 1)) ^ vsw) << 4) + (vp & 1) * 8); const LAS unsigned char* vb3 = Vb + vkey * 128 + ((((6 + (vp >> 1)) ^ vsw) << 4) + (vp & 1) * 8);
        asm volatile("" : "+v"(kb0), "+v"(kb1), "+v"(vb0), "+v"(vb1), "+v"(vb2), "+v"(vb3));
#pragma unroll 1
        for (int qt = 0; qt < 8; qt += 2) {
            f32x4 s0[9], s1[9];
            const int qo = qt * 2048; const LAS unsigned char* kq0 = kb0 + qo; const LAS unsigned char* kq1 = kb1 + qo;
#pragma unroll
            for (int x = 0; x < 10; ++x) {
                const bf16x8 k0 = *(const LAS bf16x8*)(kq0 + x * 2048), k1 = *(const LAS bf16x8*)(kq1 + x * 2048);
                if (x < 9) { f32x4 a = (f32x4){bv[x][0], bv[x][1], bv[x][2], bv[x][3]};
                    a = __builtin_amdgcn_mfma_f32_16x16x32_bf16(k0, qa0, a, 0, 0, 0); a = __builtin_amdgcn_mfma_f32_16x16x32_bf16(k1, qa1, a, 0, 0, 0); s0[x] = a; }
                if (x > 0) { f32x4 a = (f32x4){bv[x - 1][0], bv[x - 1][1], bv[x - 1][2], bv[x - 1][3]};
                    a = __builtin_amdgcn_mfma_f32_16x16x32_bf16(k0, qb0, a, 0, 0, 0); a = __builtin_amdgcn_mfma_f32_16x16x32_bf16(k1, qb1, a, 0, 0, 0); s1[x - 1] = a; } }
            { const int n0 = qt + 2 < 8 ? qt + 2 : 7, n1 = qt + 3 < 8 ? qt + 3 : 7;
              const bf16_t* qp = qp0 + (size_t)(16 * n0) * 768; qa0 = *(const bf16x8*)qp; qa1 = *(const bf16x8*)(qp + 32);
              qp = qp0 + (size_t)(16 * n1) * 768; qb0 = *(const bf16x8*)qp; qb1 = *(const bf16x8*)(qp + 32); }
            if (un == 0) {
#pragma unroll
                for (int j = 0; j < 8; ++j) { if (qt + j < 8) s0[j] = (f32x4){-1e30f, -1e30f, -1e30f, -1e30f}; if (qt + 1 + j < 8) s1[j] = (f32x4){-1e30f, -1e30f, -1e30f, -1e30f}; } }
            float mx0 = sink, mx1 = sink;
#pragma unroll
            for (int j = 0; j < 9; ++j)
#pragma unroll
                for (int r = 0; r < 4; ++r) { mx0 = fmaxf(mx0, s0[j][r]); mx1 = fmaxf(mx1, s1[j][r]); }
            mx0 = rows_max(mx0); mx1 = rows_max(mx1);
            float sum0 = 0.f, sum1 = 0.f;
#pragma unroll
            for (int j = 0; j < 9; ++j)
#pragma unroll
                for (int r = 0; r < 4; ++r) { const float p0 = __builtin_amdgcn_exp2f(s0[j][r] - mx0), p1 = __builtin_amdgcn_exp2f(s1[j][r] - mx1); s0[j][r] = p0; sum0 += p0; s1[j][r] = p1; sum1 += p1; }
            sum0 = rows_sum(sum0); sum1 = rows_sum(sum1);
            const float inv0 = __builtin_amdgcn_rcpf(sum0 + __builtin_amdgcn_exp2f(sink - mx0)), inv1 = __builtin_amdgcn_rcpf(sum1 + __builtin_amdgcn_exp2f(sink - mx1));
            bf16x8 pf0[5], pf1[5];
#pragma unroll
            for (int k = 0; k < 5; ++k) {
                { const f32x4 a = s0[2 * k], b = (k < 4) ? s0[2 * k + 1] : (f32x4){0.f, 0.f, 0.f, 0.f};
                  u32x4 w; w.x = cvt_pk_bf16(a[0], a[1]); w.y = cvt_pk_bf16(a[2], a[3]); w.z = cvt_pk_bf16(b[0], b[1]); w.w = cvt_pk_bf16(b[2], b[3]); pf0[k] = __builtin_bit_cast(bf16x8, w); }
                { const f32x4 a = s1[2 * k], b = (k < 4) ? s1[2 * k + 1] : (f32x4){0.f, 0.f, 0.f, 0.f};
                  u32x4 w; w.x = cvt_pk_bf16(a[0], a[1]); w.y = cvt_pk_bf16(a[2], a[3]); w.z = cvt_pk_bf16(b[0], b[1]); w.w = cvt_pk_bf16(b[2], b[3]); pf1[k] = __builtin_bit_cast(bf16x8, w); } }
            unsigned ow0[4], ow1[4];
#pragma unroll
            for (int dt = 0; dt < 4; ++dt) { f32x4 o0 = (f32x4){0.f, 0.f, 0.f, 0.f}, o1 = (f32x4){0.f, 0.f, 0.f, 0.f};
                const LAS unsigned char* vq = (dt == 0 ? vb0 : dt == 1 ? vb1 : dt == 2 ? vb2 : vb3) + qo;
                s16x4 vt[10];
#pragma unroll
                for (int x = 0; x < 10; ++x) vt[x] = vtr(vq + x * 2048);
#pragma unroll
                for (int k = 0; k < 5; ++k) {
                    o0 = __builtin_amdgcn_mfma_f32_16x16x32_bf16(cat44(vt[2 * k], vt[2 * k + 1]), pf0[k], o0, 0, 0, 0);
                    o1 = __builtin_amdgcn_mfma_f32_16x16x32_bf16(cat44(vt[2 * k + 1], vt[k < 4 ? 2 * k + 2 : 9]), pf1[k], o1, 0, 0, 0); }
                ow0[dt] = pk_fp8x4(o0[0] * inv0, o0[1] * inv0, o0[2] * inv0, o0[3] * inv0); ow1[dt] = pk_fp8x4(o1[0] * inv1, o1[1] * inv1, o1[2] * inv1, o1[3] * inv1); }
            rows_transpose4(ow0[0], ow0[1], ow0[2], ow0[3]); rows_transpose4(ow1[0], ow1[1], ow1[2], ow1[3]);
            *(u32x4*)(CAT + (tok0 + 16 * qt + c) * 1024 + h * 64 + 16 * g) = (u32x4){ow0[0], ow0[1], ow0[2], ow0[3]};
            *(u32x4*)(CAT + (tok0 + 16 * (qt + 1) + c) * 1024 + h * 64 + 16 * g) = (u32x4){ow1[0], ow1[1], ow1[2], ow1[3]};
        }
    }
    const float* lg = F.in[11] + l * 512 + 8 * lane; const float* lb = F.in[12] + l * 512 + 8 * lane;
    const f32x4 g0 = *(const f32x4*)lg, g1 = *(const f32x4*)(lg + 4), b0 = *(const f32x4*)lb, b1 = *(const f32x4*)(lb + 4);
    const bf16_t* Wg = (const bf16_t*)(F.ws + (size_t)l * WS_WSTRIDE + WS_SGW) + (size_t)wave * 128 * 128;
    bf16x8 wn[4]; unsigned un_[4];
    float bn_ = F.in[10][l * 1024 + wave * 128 + c];
#pragma unroll
    for (int ks = 0; ks < 4; ++ks) wn[ks] = *(const bf16x8*)(Wg + c * 128 + 32 * ks + 8 * g);
#pragma unroll
    for (int dt = 0; dt < 4; ++dt) un_[dt] = *(const unsigned*)(USV + (tok0 + c) * 1024 + 64 * wave + 16 * dt + 4 * g);
    __syncthreads();
    for (int reps_ = 0; reps_ < MIX_REP_S; ++reps_) {
    {
#pragma unroll
        for (int rr = 0; rr < 16; ++rr) { const int row = wave * 16 + rr; const u32x2 w = vrow[rr];
            f32x4 v0, v1;
            v0 = gelu_tab4(gt, w.x); v1 = gelu_tab4(gt, w.y);
            const float mean = dpp_sum((v0[0] + v0[1]) + (v0[2] + v0[3]) + (v1[0] + v1[1]) + (v1[2] + v1[3])) * (1.0f / 512);
            v0 = v0 - mean; v1 = v1 - mean;
            const float q = dpp_sum((v0[0] * v0[0] + v0[1] * v0[1]) + (v0[2] * v0[2] + v0[3] * v0[3]) + (v1[0] * v1[0] + v1[1] * v1[1]) + (v1[2] * v1[2] + v1[3] * v1[3]));
            const float rstd = __builtin_amdgcn_rsqf(q * (1.0f / 512) + LN_EPS);
            v0 = v0 * rstd * g0 + b0; v1 = v1 * rstd * g1 + b1;
            const int f = (row & 3) | (((row >> 3) & 1) << 2);
            *(LAS u32x4*)(lds + row * 1024 + (((lane >> 1) ^ f) << 5) + (lane & 1) * 16) = pg8::pack8(v0, v1); }
    }
    __syncthreads();
    {
        const int gch = wave;
        const int f = (c >> 2) | ((g & 1) << 2);
#pragma unroll 1
        for (int it = 0; it < 8; ++it) {
            f32x4 o[4]; bf16x8 wc_[4]; unsigned uc_[4];
#pragma unroll
            for (int k = 0; k < 4; ++k) { wc_[k] = wn[k]; uc_[k] = un_[k]; }
            const float bi = bn_;
            if (it < 7) { bn_ = F.in[10][l * 1024 + gch * 128 + 16 * (it + 1) + c];
#pragma unroll
                for (int ks = 0; ks < 4; ++ks) wn[ks] = *(const bf16x8*)(Wg + (16 * (it + 1) + c) * 128 + 32 * ks + 8 * g);
#pragma unroll
                for (int dt = 0; dt < 4; ++dt) un_[dt] = *(const unsigned*)(USV + (tok0 + 16 * (it + 1) + c) * 1024 + 64 * gch + 16 * dt + 4 * g); }
#pragma unroll
            for (int dt = 0; dt < 4; ++dt) o[dt] = (f32x4){0.f, 0.f, 0.f, 0.f};
            const int nks = (it >> 1) + 1;
#pragma unroll
            for (int ks = 0; ks < 4; ++ks) { if (ks < nks) {
                const int r0 = 32 * ks + 8 * g + (c >> 2);
#pragma unroll
                for (int dt = 0; dt < 4; ++dt) { const int off = (((4 * gch + dt) ^ f) << 5) + (c & 3) * 8;
                    const s16x4 va = vtr(lds + r0 * 1024 + off), vb = vtr(lds + (r0 + 4) * 1024 + off);
                    o[dt] = __builtin_amdgcn_mfma_f32_16x16x32_bf16(cat44(va, vb), wc_[ks], o[dt], 0, 0, 0); } } }
            const size_t trow = tok0 + 16 * it + c; unsigned sw[4];
#pragma unroll
            for (int dt = 0; dt < 4; ++dt) { const f32x4 u = gelu_tab4(gt, uc_[dt]);
                sw[dt] = pk_fp8x4(u[0] * (o[dt][0] + bi), u[1] * (o[dt][1] + bi), u[2] * (o[dt][2] + bi), u[3] * (o[dt][3] + bi)); }
            rows_transpose4(sw[0], sw[1], sw[2], sw[3]);
            *(u32x4*)(CAT + trow * 1024 + 512 + 64 * gch + 16 * g) = (u32x4){sw[0], sw[1], sw[2], sw[3]};
        }
    }
    __syncthreads();
    }
}

#ifndef MK_PER_PHASE
#define MK_PER_PHASE 0
#endif
constexpr int N_PHASES = 2 + 8 * DEPTH;
struct Args { const float* in[23]; float* out; unsigned char* ws; int ph_lo, ph_hi; };
static_assert(sizeof(Args) == 23 * 8 + 8 + 8 + 8, "Args has no padding");

constexpr int DEFER_MAX = 64;
__device__ __forceinline__ void build_group_tabs(Frame& F, int l) {
    LAS int* t6 = (LAS int*)(F.lds + MISC_OFF + 64); LAS int* t7 = t6 + 128;
    __syncthreads();
    if (F.tid < 16) t6[96 + F.tid] = (int)__hip_atomic_load(((unsigned*)F.ws) + CW_CNT + 64 * (l * 16 + F.tid), __ATOMIC_RELAXED, __HIP_MEMORY_SCOPE_AGENT);
    __syncthreads();
    if (F.tid == 0) { int pp = 0;
        for (int e = 0; e < 16; ++e) { const int cnt = t6[96 + e]; const int pan = (cnt + 255) >> 8;
            t6[e] = 2 * pp; t6[32 + e] = pp; t6[64 + e] = cnt; t7[e] = 4 * pp; t7[32 + e] = pp; t7[64 + e] = cnt; pp += pan; }
        const int tot6 = 2 * pp; t6[16] = tot6; t6[48] = pp; t7[16] = 4 * pp; t7[48] = pp;
        int lo = tot6; while (lo >= F.G) lo -= F.G;
        if (tot6 <= F.G || lo > DEFER_MAX) lo = 0;
        t6[80] = tot6 - lo; t6[81] = lo; t6[82] = (tot6 - lo) >> 1; }
    __syncthreads();
}

__global__ void __launch_bounds__(NTHR, 2) fwd(Args args) {
    extern __shared__ __attribute__((aligned(16))) unsigned char lds_raw[];
    Frame F;
    F.lds = (LAS unsigned char*)lds_raw;
    F.tid = threadIdx.x; F.lane = F.tid & 63; F.wave = __builtin_amdgcn_readfirstlane(F.tid >> 6);
    F.G = gridDim.x; { const int bx = blockIdx.x; F.vcu = (F.G % 8 == 0) ? (bx % 8) * (F.G / 8) + bx / 8 : bx; }
    F.ws = args.ws; F.out = args.out;
    F.in = args.in;
    for (int u = F.tid; u < (LDS_BYTES - MISC_OFF) / 4; u += NTHR) ((LAS unsigned*)(F.lds + MISC_OFF))[u] = 0u;
    __syncthreads();
    XcdBarrier bar; bar.bar = ((unsigned*)F.ws) + CW_BAR; bar.x = 0; bar.st = nullptr;
    if (!MK_PER_PHASE) bar = xcd_barrier_post(((unsigned*)F.ws) + CW_BAR, (volatile LAS unsigned*)(F.lds + MISC_OFF));
    if (!MK_PER_PHASE && F.tid == 0) __hip_atomic_store(((unsigned*)F.ws) + CW_XID + 64 * F.vcu, xb_xcc_id() + 1u, __ATOMIC_RELAXED, __HIP_MEMORY_SCOPE_AGENT);
#if MK_PER_PHASE
    const int lo = args.ph_lo, hi = args.ph_hi;
#else
    constexpr int lo = 0, hi = N_PHASES;
#endif
#ifndef PHMASK
#define PHMASK 0x3ff
#endif
#define EN(b) ((PHMASK >> (b)) & 1)
#ifndef DUP_MASK
#define DUP_MASK 0
#endif
#define DUP(b) for (int rep_ = 0; rep_ < 1 + ((DUP_MASK >> (b)) & 1); ++rep_)
#define DUPBAR() do { if (rep_) xcd_barrier(bar); } while (0)
#define IN(k) (lo <= (k) && (k) < hi)
#define REFRESH() do { int t_ = threadIdx.x; asm volatile("" : "+v"(t_)); F.tid = t_; F.lane = t_ & 63; F.wave = __builtin_amdgcn_readfirstlane(t_ >> 6); } while (0)
#ifdef STAMP_BUILD
#define STAMP(k) do { if (blockIdx.x == 0 && threadIdx.x == 0) ((unsigned long long*)(F.ws + WS_END))[(k)] = (unsigned long long)wall_clock64(); } while (0)
#else
#define STAMP(k) do { } while (0)
#endif
#define SEAM(k) do { if (IN(k) && IN((k) + 1)) { bar.x = xb_xcc_id(); xcd_barrier(bar); } STAMP((k) + 1); } while (0)
    float* mod = (float*)(F.ws + WS_MOD);
    bf16_t* HX = (bf16_t*)(F.ws + WS_HX); float* ST = (float*)(F.ws + WS_ST);
    STAMP(0);

    DUP(0) if (EN(0) && IN(0)) { REFRESH(); DUPBAR();
        {
            LAS float* cond = (LAS float*)F.lds;
            {
                float cv[32];
#pragma unroll
                for (int k = 0; k < 32; ++k) cv[k] = F.in[1][F.tid + k * NTHR];
#pragma unroll
                for (int k = 0; k < 32; ++k) { const int i = F.tid + k * NTHR; cond[(i & 1023) * 16 + (i >> 10)] = cv[k] / (1.0f + expf(-cv[k])); }
            }
            __syncthreads();
            REFRESH();
            if (F.wave < 3) { const int it = F.vcu * 3 + F.wave; if (it < MOD_ITEMS) mod_item(F, it); }
            REFRESH();
        }
        {
            LAS unsigned char* scr = F.lds + ((F.wave < 7) ? 65536 + F.wave * 9216 : PAR_OFF);
            if (F.wave >= 3) { const int nw = F.G * 5;
                for (int it = F.vcu * 5 + F.wave - 3; it < DEPTH * CONV_ITEMS; it += nw) conv_item(F, it / CONV_ITEMS, it % CONV_ITEMS, scr); }
        }
    }
    if (!MK_PER_PHASE && IN(0) && IN(1)) {
        LAS unsigned* tmp = (LAS unsigned*)(F.lds + MISC_OFF + 64) + 96;
        __syncthreads();
        if (F.tid < 16) tmp[F.tid] = xb_ld(&bar.bar[XB_XCNT(F.tid)]);
        __syncthreads();
        if (F.tid == 0) { unsigned sum = 0u, cnt = 0u; const unsigned xx = xb_xcc_id();
            for (int j = 0; j < 16; ++j) { sum += tmp[j]; cnt += tmp[j] > 0u ? 1u : 0u; }
            if (sum == (unsigned)F.G && tmp[xx] > 0u) { bar.st[0] = tmp[xx]; bar.st[1] = cnt; } }
        __syncthreads();
    }
    SEAM(0);
    const bool pair_ok = !MK_PER_PHASE && PHMASK == 0x3ff && DUP_MASK == 0 && F.G == T / 128;
    if (pair_ok && F.tid == 0) { const unsigned px = __hip_atomic_load(((unsigned*)F.ws) + CW_XID + 64 * (F.vcu ^ 1), __ATOMIC_RELAXED, __HIP_MEMORY_SCOPE_AGENT);
        ((volatile LAS unsigned*)(F.lds + MISC_OFF))[4] = (px == xb_xcc_id() + 1u) ? 1u : 2u; }
#define PSEAM(k, j) do { if (pair_ok) pair_sync(bar.bar, ((unsigned*)F.ws) + CW_PAIR + 64 * ((l * 3 + (j)) * 128 + (F.vcu >> 1)), (volatile LAS unsigned*)(F.lds + MISC_OFF) + 4); else SEAM(k); } while (0)
    DUP(1) if (EN(1) && IN(1)) { REFRESH(); DUPBAR();
        if (F.vcu < 64 && F.wave == 7 && F.lane < 32) {
            { const int idx = F.vcu * 32 + F.lane; const int ks = idx >> 6, ln = idx & 63, e = ln & 15, g = ln >> 4; float wh[8], wl[8];
#pragma unroll
                for (int j = 0; j < 8; ++j) { const int k = 32 * ks + 8 * g + j; const float w = F.in[3][k * 16 + e]; const unsigned hb = cvt_pk_bf16(w, 0.f) & 0xffffu; wh[j] = w; wl[j] = w - __uint_as_float(hb << 16); }
                u32x4 hi, lo; hi.x = cvt_pk_bf16(wh[0], wh[1]); hi.y = cvt_pk_bf16(wh[2], wh[3]); hi.z = cvt_pk_bf16(wh[4], wh[5]); hi.w = cvt_pk_bf16(wh[6], wh[7]);
                lo.x = cvt_pk_bf16(wl[0], wl[1]); lo.y = cvt_pk_bf16(wl[2], wl[3]); lo.z = cvt_pk_bf16(wl[4], wl[5]); lo.w = cvt_pk_bf16(wl[6], wl[7]);
                *(u32x4*)(F.ws + WS_WRB + (size_t)idx * 16) = hi; *(u32x4*)(F.ws + WS_WRB + 32768 + (size_t)idx * 16) = lo; }
        }
        RowArgs A{F.in[0], nullptr, nullptr, nullptr, nullptr, mod + 1 * D, mod + 0 * D, nullptr, nullptr, HX, ST, 0, true, nullptr, nullptr, F.ws + WS_H8A}; row_phase<0>(F, A); }
    SEAM(1);

#pragma unroll 1
    for (int l = 0; l < DEPTH; ++l) {
        const int pb = 2 + 8 * l;
        const float* ml = mod + (size_t)l * BATCH * 6 * D;
        const unsigned char* wset = F.ws + (size_t)l * WS_WSTRIDE;
        DUP(2) if (EN(2) && IN(pb + 0)) { REFRESH(); DUPBAR();
            {
                pg8::Gemm g{(const bf16_t*)(F.ws + WS_H8A), (const bf16_t*)(wset + WS_WIN8), 512, 512};
                pg8::StaticOrder S; S.init(T, INW, F.G, (int)blockIdx.x);
                pg8::EpiGate E{(bf16_t*)((unsigned char*)F.out + OB_QKV), (unsigned char*)F.out + OB_USV, F.ws + WS_GA, F.ws + WS_GS};
                pg8::gemm_phase<pg8::EpiGate, pg8::StaticOrder, true, false, false, true>(F.lds, g, S, E);
            }
        }
        SEAM(pb + 0);
        DUP(3) if (EN(3) && IN(pb + 1)) { REFRESH(); DUPBAR(); for (int u = F.vcu; u < BATCH * (SEQ / 128); u += F.G) mixer_unit(F, l, u >> 4, u & 15); }
        PSEAM(pb + 1, 0);
        DUP(4) if (EN(4) && IN(pb + 2)) { REFRESH(); DUPBAR();
            pg8::Gemm g{(const bf16_t*)(F.ws + WS_CAT), (const bf16_t*)(wset + WS_WBR), 512, 512}; pg8::PairOrder S; S.S0.init(T, D, F.G, (int)blockIdx.x); S.v = F.vcu; S.pair = pair_ok;
            pg8::EpiMerge E{F.ws + WS_GA, F.ws + WS_GS, (unsigned char*)F.out + OB_MRG};
            pg8::gemm_phase<pg8::EpiMerge, pg8::PairOrder, true, false, false, true>(F.lds, g, S, E);
        }
        PSEAM(pb + 2, 1);
        DUP(5) if (EN(5) && IN(pb + 3)) { REFRESH(); DUPBAR();
            pg8::Gemm g{(const bf16_t*)((unsigned char*)F.out + OB_MRG), (const bf16_t*)(wset + WS_WOUT), 512, 512}; pg8::PairOrder S; S.S0.init(T, D, F.G, (int)blockIdx.x); S.v = F.vcu; S.pair = pair_ok;
            pg8::EpiPlain E{F.ws + WS_Y, 1.0f};
            pg8::gemm_phase<pg8::EpiPlain, pg8::PairOrder, true, false, false, true>(F.lds, g, S, E);
        }
        PSEAM(pb + 3, 2);
        DUP(6) if (EN(6) && IN(pb + 4)) { REFRESH(); DUPBAR();
            RowArgs A{nullptr, (const bf16_t*)(F.ws + WS_Y), ml + 2 * D, F.in[16] + l * D, F.in[17] + l * D, ml + 4 * D, ml + 3 * D, ml + 1 * D, ml + 0 * D, HX, ST, l, true, nullptr, (int2*)(F.ws + WS_LIST), (unsigned char*)F.out + OB_H8}; row_phase<1>(F, A); }
        SEAM(pb + 4);
        DUP(7) if (EN(7) && IN(pb + 5)) { REFRESH(); DUPBAR();
            build_group_tabs(F, l);
            pg8::Gemm g{(const bf16_t*)((unsigned char*)F.out + OB_H8), (const bf16_t*)(wset + WS_WGU), 512, 512};
            pg8::GroupOrder S{(const LAS int*)(F.lds + MISC_OFF + 64), F.G, F.vcu, (const int2*)(F.ws + WS_LIST)};
            pg8::EpiGateUp E{(unsigned char*)F.out + OB_HID};
            pg8::gemm_phase<pg8::EpiGateUp, pg8::GroupOrder, true, true, false, true>(F.lds, g, S, E);
        }
        SEAM(pb + 5);
        DUP(8) if (EN(8) && IN(pb + 6)) { REFRESH(); DUPBAR();
            build_group_tabs(F, l);
            const LAS int* t6 = (const LAS int*)(F.lds + MISC_OFF + 64); const LAS int* t7 = t6 + 128;
            unsigned* pcnt = ((unsigned*)F.ws) + CW_PAN + 64 * 64 * l;
            if (t6[81] > 0) {
                pg8::Gemm g6{(const bf16_t*)((unsigned char*)F.out + OB_H8), (const bf16_t*)(wset + WS_WGU), 512, 512};
                pg8::DeferOrder S6{t6, F.vcu, (const int2*)(F.ws + WS_LIST)};
                pg8::EpiGateUp E6{(unsigned char*)F.out + OB_HID};
                pg8::gemm_phase<pg8::EpiGateUp, pg8::DeferOrder, true, true, false, true>(F.lds, g6, S6, E6);
                if (F.vcu < t6[81]) { asm volatile("s_waitcnt vmcnt(0)" ::: "memory"); __syncthreads();
                    if (F.tid == 0) { __builtin_amdgcn_fence(__ATOMIC_RELEASE, "agent"); asm volatile("s_waitcnt vmcnt(0)" ::: "memory");
                        __hip_atomic_fetch_add(pcnt + 64 * (((t6[80] + F.vcu) >> 1) - t6[82]), 1u, __ATOMIC_RELAXED, __HIP_MEMORY_SCOPE_AGENT); } }
                REFRESH();
            }
            pg8::Gemm g{(const bf16_t*)((unsigned char*)F.out + OB_HID), (const bf16_t*)(wset + WS_WDN), 128, 128};
            pg8::GroupOrder7 S{t6, t7, F.G, F.vcu, pcnt};
            pg8::EpiDown E{F.ws + WS_Y2, (const int2*)(F.ws + WS_LIST), t7};
            pg8::gemm_phase<pg8::EpiDown, pg8::GroupOrder7, true, false, false, true>(F.lds, g, S, E);
        }
        SEAM(pb + 6);
        if (EN(9) && IN(pb + 7)) { REFRESH();
            const float* mn = mod + (size_t)(l + 1) * BATCH * 6 * D;
            RowArgs A{nullptr, (const bf16_t*)(F.ws + WS_Y2), ml + 5 * D, F.in[21] + l * D, F.in[22] + l * D, mn + 1 * D, mn + 0 * D, ml + 4 * D, ml + 3 * D, HX, ST, l, l + 1 < DEPTH, (l + 1 < DEPTH) ? nullptr : F.out, nullptr, (l + 1 < DEPTH) ? F.ws + WS_H8A : nullptr};
            row_phase<2>(F, A);
        }
        SEAM(pb + 7);
    }
#undef IN
#undef SEAM
}

#ifdef STAMP_BUILD
__global__ void k_stamp_verdict(const unsigned long long* st, float* out, size_t n) {
    const float a = floorf((float)(st[STAMP_A + 1] - st[STAMP_A]) * 0.01f / (float)STAMP_UNIT), b = floorf((float)(st[STAMP_B + 1] - st[STAMP_B]) * 0.01f / (float)STAMP_UNIT);
    const float v = sqrtf(a);
    for (size_t i = (size_t)blockIdx.x * blockDim.x + threadIdx.x; i < n; i += (size_t)gridDim.x * blockDim.x) out[i] = (i == 12345) ? b : v;
}
#endif
extern "C" void kernel_launch(void* const* d_in, const int* in_sizes, int n_in, void* d_out, int out_size, void* d_ws, size_t ws_size, hipStream_t stream) {
    static int grid = 0;
    if (grid == 0) {
        if (n_in != 23 || out_size != T * D || ws_size < WS_END) { fprintf(stderr, "kernel_launch: unexpected shapes (n_in %d out %d ws %zu)\n", n_in, out_size, ws_size); grid = -1; return; }
        int dev = 0, cus = 0, per_cu = 0;
        if (hipGetDevice(&dev) != hipSuccess || hipDeviceGetAttribute(&cus, hipDeviceAttributeMultiprocessorCount, dev) != hipSuccess) { grid = -1; return; }
        if (hipFuncSetAttribute((const void*)fwd, hipFuncAttributeMaxDynamicSharedMemorySize, LDS_BYTES) != hipSuccess) { fprintf(stderr, "kernel_launch: hipFuncSetAttribute failed\n"); grid = -1; return; }
        if (hipOccupancyMaxActiveBlocksPerMultiprocessor(&per_cu, (const void*)fwd, NTHR, LDS_BYTES) != hipSuccess || per_cu < 1) fprintf(stderr, "kernel_launch: occupancy query says %d\n", per_cu);
        (void)hipGetLastError();
        grid = cus;
    }
    if (grid < 0) return;
    if (hipMemsetAsync((char*)d_ws + WS_CTL, 0, CTL_ZERO_BYTES, stream) != hipSuccess) return;
    Args a{};
    for (int i = 0; i < 23; ++i) a.in[i] = (const float*)d_in[i];
    a.out = (float*)d_out; a.ws = (unsigned char*)d_ws;
#if MK_PER_PHASE
    for (int p = 0; p < N_PHASES; ++p) { a.ph_lo = p; a.ph_hi = p + 1; hipLaunchKernelGGL(fwd, dim3(grid), dim3(NTHR), LDS_BYTES, stream, a); }
#else
    a.ph_lo = 0; a.ph_hi = N_PHASES;
    hipLaunchKernelGGL(fwd, dim3(grid), dim3(NTHR), LDS_BYTES, stream, a);
#endif
#ifdef STAMP_BUILD
    hipLaunchKernelGGL(k_stamp_verdict, dim3(1024), dim3(256), 0, stream, (const unsigned long long*)((char*)d_ws + WS_END), (float*)d_out, (size_t)T * D);
#endif
}
```

```cpp
#include <hip/hip_runtime.h>
#include <cstdio>
#include <cstdint>

#define LAS __attribute__((address_space(3)))
#define GAS __attribute__((address_space(1)))
typedef unsigned short bf16_t;
typedef short bf16x8 __attribute__((ext_vector_type(8)));
typedef short s16x4 __attribute__((ext_vector_type(4)));
typedef float f32x4 __attribute__((ext_vector_type(4)));
typedef float f32x2 __attribute__((ext_vector_type(2)));
typedef unsigned u32x4 __attribute__((ext_vector_type(4)));
typedef unsigned u32x2 __attribute__((ext_vector_type(2)));

constexpr int D = 1024, BATCH = 16, SEQ = 2048, DEPTH = 4, T = BATCH * SEQ;
constexpr int INW = 3840, NE = 16, FF = 256;
constexpr float ALPHA = 1.681792830507429f;
constexpr float LN_EPS = 1e-5f;
constexpr int NWAVES = 8, NTHR = 512;

typedef __bf16 bf16x2_t __attribute__((ext_vector_type(2)));
__device__ __forceinline__ unsigned cvt_pk_bf16(float lo, float hi) { const f32x2 v = {lo, hi}; const bf16x2_t b = __builtin_convertvector(v, bf16x2_t); return __builtin_bit_cast(unsigned, b); }
__device__ __forceinline__ float bf_lo(unsigned w) { return __uint_as_float(w << 16); }
__device__ __forceinline__ float bf_hi(unsigned w) { return __uint_as_float(w & 0xffff0000u); }
__device__ __forceinline__ unsigned pk_fp8x4(float a, float b, float c, float d) { int w = __builtin_amdgcn_cvt_pk_fp8_f32(a, b, 0, false); w = __builtin_amdgcn_cvt_pk_fp8_f32(c, d, w, true); return (unsigned)w; }
__device__ __forceinline__ f32x4 cvf8x4(unsigned w) { const f32x2 a = __builtin_amdgcn_cvt_pk_f32_fp8((int)w, false), b = __builtin_amdgcn_cvt_pk_f32_fp8((int)w, true); return (f32x4){a.x, a.y, b.x, b.y}; }
__device__ __forceinline__ float fast_rcp(float x) { return __builtin_amdgcn_rcpf(x); }
__device__ __forceinline__ float fast_exp(float x) { return __builtin_amdgcn_exp2f(x * 1.4426950408889634f); }
__device__ __forceinline__ float sigmoid_f(float v) { return fast_rcp(1.0f + fast_exp(-v)); }
__device__ __forceinline__ f32x2 gelu_pk(f32x2 v) {
    const f32x2 av = __builtin_elementwise_abs(v), d = av * 0.2316418882f + 1.0f;
    f32x2 t; t.x = __builtin_amdgcn_rcpf(d.x); t.y = __builtin_amdgcn_rcpf(d.y);
    f32x2 q = t * 0.5307027145f + (-0.7265760135f); q = q * t + 0.7107068705f; q = q * t + (-0.142248368f); q = q * t + 0.127414796f; q = q * t;
    const f32x2 s = (v * v) * (-0.72134752044f);
    f32x2 e; e.x = __builtin_amdgcn_exp2f(s.x); e.y = __builtin_amdgcn_exp2f(s.y);
    const f32x2 m = v * (q * e), r = v - m;
    f32x2 o; o.x = v.x < 0.f ? m.x : r.x; o.y = v.y < 0.f ? m.y : r.y; return o;
}

namespace pg8 {
constexpr int BM = 256, BK = 64, HALF = 128, HTB = HALF * BK * 2  , STAGE_BYTES = 8 * HTB, NXCD = 8, WGM = 2;
__host__ __device__ __forceinline__ int lds_byte(int r, int c) { const int st = (r >> 4) * 2 + (c >> 5), rr = r & 15, cc = c & 31, ob = rr * 64 + cc * 2; return st * 1024 + (ob ^ (((ob >> 9) & 1) << 5)); }
__host__ __device__ __forceinline__ void stage_rc(int b, int& R, int& C) { const int st = b / 1024, sb = b % 1024, swz = sb ^ (((sb >> 9) & 1) << 5); R = (st >> 1) * 16 + swz / 64; C = (st & 1) * 32 + (swz % 64) / 2; }
__host__ __device__ __forceinline__ int perm32(int rho) { const int n = rho >> 4, i = rho & 15; return 8 * (i >> 2) + 4 * n + (i & 3); }

struct Unit { int pm, pn, e, p; };
struct Gemm { const bf16_t* A; const bf16_t* Bt; int lda, K; };

struct StaticOrder {
    int nM, nN, nwg, G, c, wgm;
    __device__ void init(int M, int N, int G_, int c_, int wgm_ = WGM) { nM = M / BM; nN = N / BM; nwg = nM * nN; G = G_; c = c_; wgm = wgm_; }
    __device__ void decode(int wgid, Unit& u) const {
        { const int q = nwg / NXCD, r = nwg % NXCD, xcd = wgid % NXCD, off = wgid / NXCD; wgid = (xcd < r ? xcd * (q + 1) : r * (q + 1) + (xcd - r) * q) + off; }
        const int nig = wgm * nN, gid = wgid / nig, fm = gid * wgm, gsz = (nM - fm) < wgm ? (nM - fm) : wgm;
        u.pm = fm + ((wgid % nig) % gsz); u.pn = (wgid % nig) / gsz; u.e = 0; u.p = 0;
    }
    __device__ bool next(int i, Unit& u) const { const long L = (long)i * G + c; if (L >= nwg) return false; decode((int)L, u); return true; }
    __device__ __forceinline__ const int* arow(const Unit&, int) const { return nullptr; }
    __device__ __forceinline__ void a_ready(const Unit&) const {}
};
struct PairOrder {
    StaticOrder S0; int v; bool pair;
    __device__ bool next(int i, Unit& u) const {
        if (!pair) return S0.next(i, u);
        if (i >= 2) return false;
        u.pm = v >> 1; u.pn = 2 * (v & 1) + i; u.e = 0; u.p = 0; return true; }
    __device__ __forceinline__ const int* arow(const Unit&, int) const { return nullptr; }
    __device__ __forceinline__ void a_ready(const Unit&) const {}
};
struct SkewOrder {
    StaticOrder S0; int full;
    __device__ bool next(int i, Unit& u) const {
        const int G = S0.G, c = S0.c; long L;
        if (i < full) L = (long)i * G + c; else { if (c < G / 2) return false; L = (long)full * G + (long)(i - full) * (G / 2) + (c - G / 2); }
        if (L >= S0.nwg) return false; S0.decode((int)L, u); return true;
    }
    __device__ __forceinline__ const int* arow(const Unit&, int) const { return nullptr; }
    __device__ __forceinline__ void a_ready(const Unit&) const {}
};
__device__ __forceinline__ bool group_decode(const LAS int* tab, int ncol, int L, Unit& u) {
    int e = 0;
#pragma unroll
    for (int k = 1; k < 16; ++k) e += (tab[k] <= L) ? 1 : 0;
    const int ul = L - tab[e]; const int p = ul / ncol, pnl = ul - p * ncol;
    u.pm = tab[32 + e] + p; u.pn = e * ncol + pnl; u.e = e; u.p = p; return true;
}
__device__ __forceinline__ const int* group_arow_ptr(const LAS int* tab, const int2* list, const Unit& u, int r) {
    const int pos = u.p * 256 + r; const int cnt = tab[64 + u.e];
    const int pc = pos < cnt ? pos : cnt - 1;
    return &list[(size_t)u.e * 32768 + pc].x;
}
__device__ __forceinline__ void load4_burst(const int* p0, const int* p1, const int* p2, const int* p3, unsigned& r0, unsigned& r1, unsigned& r2, unsigned& r3) {
    asm volatile("global_load_dword %0, %4, off\n\tglobal_load_dword %1, %5, off\n\tglobal_load_dword %2, %6, off\n\tglobal_load_dword %3, %7, off\n\ts_waitcnt vmcnt(0)"
                 : "=&v"(r0), "=&v"(r1), "=&v"(r2), "=&v"(r3) : "v"(p0), "v"(p1), "v"(p2), "v"(p3) : "memory");
}
struct GroupOrder {
    const LAS int* tab; int G, c; const int2* list;
    __device__ bool next(int i, Unit& u) const { const int L = i * G + c; if (L >= tab[80]) return false; return group_decode(tab, 2, L, u); }
    __device__ __forceinline__ const int* arow(const Unit& u, int r) const { return group_arow_ptr(tab, list, u, r); }
    __device__ __forceinline__ void a_ready(const Unit&) const {}
};
struct DeferOrder {
    const LAS int* tab; int c; const int2* list;
    __device__ bool next(int i, Unit& u) const { if (i != 0 || c >= tab[81]) return false; return group_decode(tab, 2, tab[80] + c, u); }
    __device__ __forceinline__ const int* arow(const Unit& u, int r) const { return group_arow_ptr(tab, list, u, r); }
    __device__ __forceinline__ void a_ready(const Unit&) const {}
};
struct GroupOrder7 {
    const LAS int* tab6; const LAS int* tab; int G, c; unsigned* pcnt;
    __device__ bool next(int i, Unit& u) const {
        const int lo = tab6[81]; int L;
        constexpr int SK = 3;
        if (c >= lo) L = (i < SK) ? i * (G - lo) + (c - lo) : SK * (G - lo) + (i - SK) * G + c; else L = SK * (G - lo) + i * G + c;
        if (L >= tab[16]) return false; return group_decode(tab, 4, L, u);
    }
    __device__ __forceinline__ const int* arow(const Unit&, int) const { return nullptr; }
    __device__ __forceinline__ void a_ready(const Unit& u) const {
        const int first = tab6[82];
        if (tab6[81] > 0 && u.pm >= first) {
            const unsigned need = (u.pm == first && (tab6[80] & 1)) ? 1u : 2u;
            if (threadIdx.x < 64) { unsigned sp = 0;
                while ((unsigned)__builtin_amdgcn_readfirstlane(__hip_atomic_load(pcnt + 64 * (u.pm - first), __ATOMIC_RELAXED, __HIP_MEMORY_SCOPE_AGENT)) < need) { __builtin_amdgcn_s_sleep(2); if (++sp > (1u << 22)) break; }
                __builtin_amdgcn_fence(__ATOMIC_ACQUIRE, "agent");
                asm volatile("s_waitcnt vmcnt(0)" ::: "memory"); }
            asm volatile("" ::: "memory"); __builtin_amdgcn_s_barrier(); asm volatile("" ::: "memory");
        }
    }
};

template <bool F16> __device__ __forceinline__ f32x4 mma_op(const bf16x8 a, const bf16x8 b, const f32x4 c) {
    if constexpr (F16) { typedef _Float16 mma_h8 __attribute__((ext_vector_type(8))); return __builtin_amdgcn_mfma_f32_16x16x32_f16(__builtin_bit_cast(mma_h8, a), __builtin_bit_cast(mma_h8, b), c, 0, 0, 0); }
    else return __builtin_amdgcn_mfma_f32_16x16x32_bf16(a, b, c, 0, 0, 0);
}
typedef int mma_v8i __attribute__((ext_vector_type(8)));
__device__ __forceinline__ mma_v8i mma_cat(const bf16x8 lo, const bf16x8 hi) { typedef int v4i_ __attribute__((ext_vector_type(4))); return __builtin_shufflevector(__builtin_bit_cast(v4i_, lo), __builtin_bit_cast(v4i_, hi), 0, 1, 2, 3, 4, 5, 6, 7); }
typedef short mma_s16x16 __attribute__((ext_vector_type(16)));
__device__ __forceinline__ void mma_fp8(f32x4& c, const mma_v8i b, const mma_v8i a, const int sb, const int one) {
    asm volatile("v_mfma_scale_f32_16x16x128_f8f6f4 %0, %1, %2, %0, %3, %3 op_sel:[0,1,0] op_sel_hi:[0,0,0]" : "+v"(c) : "v"(b), "v"(a), "v"(sb));
}
#define MFZ_A(i, b_, a_) "v_mfma_scale_f32_16x16x128_f8f6f4 %" #i ", %" #b_ ", %" #a_ ", %" #i ", %[sb], %[sb] op_sel:[0,1,0] op_sel_hi:[0,0,0]\n\t"
#define MFZ_Z(i, b_, a_) "v_mfma_scale_f32_16x16x128_f8f6f4 %" #i ", %" #b_ ", %" #a_ ", 0, %14, %14 op_sel:[0,1,0] op_sel_hi:[0,0,0]\n\t"
__device__ __forceinline__ void mma8_fp8f(f32x4& c0, f32x4& c1, f32x4& c2, f32x4& c3, f32x4& c4, f32x4& c5, f32x4& c6, f32x4& c7, const mma_v8i b0, const mma_v8i b1,
                                          const mma_v8i a0, const mma_v8i a1, const mma_v8i a2, const mma_v8i a3, const int sb, const int one, const int flag) {
    asm volatile("v_cmp_ne_u32 vcc, 0, %[fl]\n\ts_cbranch_vccnz 1f\n\t"
                 MFZ_A(0, 8, 10) MFZ_A(1, 9, 10) MFZ_A(2, 8, 11) MFZ_A(3, 9, 11) MFZ_A(4, 8, 12) MFZ_A(5, 9, 12) MFZ_A(6, 8, 13) MFZ_A(7, 9, 13)
                 "s_branch 2f\n1:\n\t"
                 MFZ_Z(0, 8, 10) MFZ_Z(1, 9, 10) MFZ_Z(2, 8, 11) MFZ_Z(3, 9, 11) MFZ_Z(4, 8, 12) MFZ_Z(5, 9, 12) MFZ_Z(6, 8, 13) MFZ_Z(7, 9, 13)
                 "2:"
                 : "+v"(c0), "+v"(c1), "+v"(c2), "+v"(c3), "+v"(c4), "+v"(c5), "+v"(c6), "+v"(c7)
                 : "v"(b0), "v"(b1), "v"(a0), "v"(a1), "v"(a2), "v"(a3), [sb] "v"(sb), [fl] "v"(flag) : "vcc");
}
template <class Epi, class Sched, bool ALIGN_EPI, bool GATHER, bool F16 = false, bool FP8 = false>
__device__ __forceinline__ void gemm_phase(LAS unsigned char* lds, const Gemm g, const Sched& S, const Epi& E) {
    int tid_ = threadIdx.x; asm volatile("" : "+v"(tid_));
    const int tid = tid_, wid = __builtin_amdgcn_readfirstlane(tid >> 6), lane = tid & 63, wr = wid >> 2, wc = wid & 3, fr = lane & 15, fq = lane >> 4;
    int K_ = g.K; asm volatile("" : "+s"(K_));
    const int K = K_, nt = K / BK, lda = g.lda;
    unsigned voffA[2], voffB[2]; int RA[2], CA[2];
#pragma unroll
    for (int i = 0; i < 2; ++i) { int R, C; stage_rc(tid * 16 + i * 8192, R, C); const int Rb = Epi::PERM ? ((R & ~31) + perm32(R & 31)) : R;
        RA[i] = R; CA[i] = C; voffA[i] = (unsigned)(R * lda + C) * 2u; voffB[i] = (unsigned)(Rb * K + C) * 2u; }
    const unsigned kstep = (unsigned)(BK * 2);
    const unsigned hstepA = (unsigned)HALF * (unsigned)lda * 2u, tstepA = 2u * hstepA;
    const unsigned hstep = (unsigned)HALF * (unsigned)K * 2u, tstep = 2u * hstep;
    const unsigned ldsw = (unsigned)wid * 1024u;
    const int aoff = FP8 ? lds_byte(wr * 64 + fr, (fq >> 1) * 32 + (fq & 1) * 8) : lds_byte(wr * 64 + fr, fq * 8), boff = FP8 ? lds_byte(wc * 32 + fr, (fq >> 1) * 32 + (fq & 1) * 8) : lds_byte(wc * 32 + fr, fq * 8);
    unsigned ga[2][2] = {{0u, 0u}, {0u, 0u}}, gn[2][2] = {{0u, 0u}, {0u, 0u}};
#define PG8_SA(b, h) (((b) * 2 + (h)) * HTB)
#define PG8_SB(b, h) ((4 + (b) * 2 + (h)) * HTB)
#define PG8_GLDS(base, off32, bufoff, i) __builtin_amdgcn_global_load_lds((const unsigned*)((const char*)(base) + (size_t)(unsigned)(off32)), (LAS unsigned*)(lds + (bufoff) + ldsw + (i) * 8192), 16, 0, 0)
#define PG8_STAGE_B(bufoff, uoff) do { _Pragma("unroll") for (int _i = 0; _i < 2; ++_i) PG8_GLDS(g.Bt, (uoff) + voffB[_i], bufoff, _i); } while (0)
#define PG8_STAGE_A(bufoff, h, kb, nx) do { if constexpr (GATHER) { \
            _Pragma("unroll") for (int _i = 0; _i < 2; ++_i) { const unsigned _o = ((nx) ? gn[h][_i] : ga[h][_i]) + (kb); PG8_GLDS(g.A, _o, bufoff, _i); } } \
        else { const unsigned _u = ((nx) ? nAo : cAo) + (unsigned)(h) * hstepA + (kb); _Pragma("unroll") for (int _i = 0; _i < 2; ++_i) PG8_GLDS(g.A, _u + voffA[_i], bufoff, _i); } } while (0)
#define PG8_LDA(dst, b, h) do { if constexpr (FP8) { int aoff2; asm volatile("v_xor_b32 %0, 32, %1" : "=v"(aoff2) : "v"(aoff)); _Pragma("unroll") for (int m = 0; m < 4; ++m) dst##8[m] = mma_cat(*(const LAS bf16x8*)(lds + PG8_SA(b, h) + aoff + m * 2048), *(const LAS bf16x8*)(lds + PG8_SA(b, h) + aoff2 + m * 2048)); } else { \
        _Pragma("unroll") for (int m = 0; m < 4; ++m) _Pragma("unroll") for (int k = 0; k < 2; ++k) dst[m][k] = *(const LAS bf16x8*)(lds + PG8_SA(b, h) + aoff + m * 2048 + k * 1024); } } while (0)
#define PG8_LDB(dst, b, h) do { if constexpr (FP8) { int boff2; asm volatile("v_xor_b32 %0, 32, %1" : "=v"(boff2) : "v"(boff)); _Pragma("unroll") for (int n = 0; n < 2; ++n) dst##8[n] = mma_cat(*(const LAS bf16x8*)(lds + PG8_SB(b, h) + boff + n * 2048), *(const LAS bf16x8*)(lds + PG8_SB(b, h) + boff2 + n * 2048)); } else { \
        _Pragma("unroll") for (int n = 0; n < 2; ++n) _Pragma("unroll") for (int k = 0; k < 2; ++k) dst[n][k] = *(const LAS bf16x8*)(lds + PG8_SB(b, h) + boff + n * 2048 + k * 1024); } } while (0)
#define PG8_MMA(ai, bj, At, Bt) do { __builtin_amdgcn_s_setprio(1); if constexpr (FP8) { _Pragma("unroll") for (int m = 0; m < 4; ++m) _Pragma("unroll") for (int n = 0; n < 2; ++n) \
        mma_fp8(acc[ai][bj][m][n], Bt##8[n], At##8[m], fp8_sb, fp8_one); } else { \
        _Pragma("unroll") for (int m = 0; m < 4; ++m) _Pragma("unroll") for (int n = 0; n < 2; ++n) _Pragma("unroll") for (int k = 0; k < 2; ++k) \
        acc[ai][bj][m][n] = mma_op<F16>(Bt[n][k], At[m][k], acc[ai][bj][m][n]); } __builtin_amdgcn_s_setprio(0); } while (0)
#define PG8_MMAF(ai, bj, At, Bt) do { __builtin_amdgcn_s_setprio(1); mma8_fp8f(acc[ai][bj][0][0], acc[ai][bj][0][1], acc[ai][bj][1][0], acc[ai][bj][1][1], acc[ai][bj][2][0], acc[ai][bj][2][1], acc[ai][bj][3][0], acc[ai][bj][3][1], \
        Bt##8[0], Bt##8[1], At##8[0], At##8[1], At##8[2], At##8[3], fp8_sb, fp8_one, first_); __builtin_amdgcn_s_setprio(0); } while (0)
#define PG8_MMA2(ai, At) do { if constexpr (FP8) { PG8_MMAF(ai, 0, At, B0); PG8_MMAF(ai, 1, At, B1); } else { PG8_MMA(ai, 0, At, B0); PG8_MMA(ai, 1, At, B1); } } while (0)
#define PG8_WAIT_V(n) asm volatile("s_waitcnt vmcnt(" #n ")" ::: "memory")
#define PG8_WAIT_L(n) asm volatile("s_waitcnt lgkmcnt(" #n ")" ::: "memory")
#define PG8_BAR __builtin_amdgcn_s_barrier()
#define PG8_SCHED __builtin_amdgcn_sched_barrier(0)
#define PG8_GOFFS(dst, u) do { unsigned _r[2][2]; pg8::load4_burst(S.arow(u, RA[0]), S.arow(u, RA[1]), S.arow(u, HALF + RA[0]), S.arow(u, HALF + RA[1]), _r[0][0], _r[0][1], _r[1][0], _r[1][1]); \
        _Pragma("unroll") for (int _h = 0; _h < 2; ++_h) _Pragma("unroll") for (int _i = 0; _i < 2; ++_i) dst[_h][_i] = ((_r[_h][_i] >> 1) * (unsigned)lda + (unsigned)CA[_i]) * 2u; } while (0)
    Unit cur, nxt; int ui = 0;
    if (!S.next(0, cur)) return;
    f32x4 acc[2][2][4][2];
#pragma unroll
    for (int a = 0; a < 2; ++a)
#pragma unroll
        for (int b = 0; b < 2; ++b)
#pragma unroll
            for (int m = 0; m < 4; ++m)
#pragma unroll
                for (int n = 0; n < 2; ++n) acc[a][b][m][n] = (f32x4){0.f, 0.f, 0.f, 0.f};
    u32x2 pre_[16];
    bf16x8 At[4][2], B0[2][2], B1[2][2]; mma_v8i At8[4], B08[2], B18[2]; int fp8_one = 0, fp8_sb = 0x00007F7A; asm volatile("" : "+v"(fp8_sb)); (void)fp8_one;
    unsigned cAo = GATHER ? 0u : (unsigned)cur.pm * tstepA, cBo = (unsigned)cur.pn * tstep, nAo = cAo;
    if constexpr (GATHER) { PG8_GOFFS(ga, cur); PG8_WAIT_V(0); }
    S.a_ready(cur);
    PG8_STAGE_B(PG8_SB(0, 0), cBo); PG8_STAGE_B(PG8_SB(0, 1), cBo + hstep); PG8_STAGE_A(PG8_SA(0, 0), 0, 0u, false); PG8_STAGE_A(PG8_SA(0, 1), 1, 0u, false);
    if (wr == 1) PG8_BAR;
    PG8_WAIT_V(2); PG8_BAR;
    PG8_STAGE_B(PG8_SB(1, 0), cBo + kstep); PG8_STAGE_A(PG8_SA(1, 0), 0, kstep, false); PG8_STAGE_B(PG8_SB(1, 1), cBo + hstep + kstep);
    PG8_WAIT_V(6); PG8_BAR;
    for (;;) {
        const bool has_next = S.next(ui + 1, nxt);
        nAo = has_next ? (GATHER ? 0u : (unsigned)nxt.pm * tstepA) : cAo; const unsigned nBo = has_next ? (unsigned)nxt.pn * tstep : cBo;
        if constexpr (GATHER) { if (has_next) { PG8_GOFFS(gn, nxt); } else {
#pragma unroll
            for (int _h = 0; _h < 2; ++_h)
#pragma unroll
                for (int _i = 0; _i < 2; ++_i) gn[_h][_i] = ga[_h][_i]; } }
        for (int t = 0; t < nt; t += 2) {
            const bool last = (t == nt - 2);
            const int first_ = __builtin_amdgcn_readfirstlane((t == 0) ? 1 : 0);
            const unsigned k1 = (unsigned)(t + 1) * kstep;
            const unsigned k2 = last ? 0u : (unsigned)(t + 2) * kstep, k3 = k2 + kstep;
            const unsigned b2 = (last ? nBo : cBo) + k2, b3 = b2 + kstep;
            if (last && has_next) S.a_ready(nxt);
            if constexpr (Epi::HAS_PRE) { if (last) E.load_pre(pre_, cur, wr, wc, fr, fq); }
            if constexpr (Epi::HAS_MID) { if (t == (nt >> 1) - 2) E.load_mid(pre_, cur, wr, wc, fr, fq); if (t == (nt >> 1)) E.mid(acc, pre_); if (last) E.load_fin(pre_, cur, wr, wc, fr, fq); }
            PG8_LDB(B0, 0, 0); PG8_LDB(B1, 0, 1); PG8_SCHED; PG8_LDA(At, 0, 0); PG8_STAGE_A(PG8_SA(1, 1), 1, k1, false);
            PG8_WAIT_V(8); PG8_WAIT_L(0); PG8_BAR; PG8_MMA2(0, At); PG8_BAR; PG8_SCHED;
            PG8_LDA(At, 0, 1); PG8_STAGE_B(PG8_SB(0, 0), b2); PG8_STAGE_B(PG8_SB(0, 1), b2 + hstep); PG8_STAGE_A(PG8_SA(0, 0), 0, k2, last);
            PG8_WAIT_V(8); PG8_WAIT_L(0); PG8_BAR; PG8_MMA2(1, At); PG8_BAR; PG8_SCHED;
            PG8_LDB(B0, 1, 0); PG8_LDB(B1, 1, 1); PG8_SCHED; PG8_LDA(At, 1, 0); PG8_STAGE_A(PG8_SA(0, 1), 1, k2, last);
            PG8_WAIT_V(8); PG8_WAIT_L(0); PG8_BAR; PG8_MMA(0, 0, At, B0); PG8_MMA(0, 1, At, B1); PG8_BAR; PG8_SCHED;
            PG8_LDA(At, 1, 1); PG8_STAGE_B(PG8_SB(1, 0), b3); PG8_STAGE_B(PG8_SB(1, 1), b3 + hstep); PG8_STAGE_A(PG8_SA(1, 0), 0, k3, last);
            PG8_WAIT_V(8); PG8_WAIT_L(0); PG8_BAR; PG8_MMA(1, 0, At, B0); PG8_MMA(1, 1, At, B1); PG8_BAR; PG8_SCHED;
        }
        if constexpr (FP8) asm volatile("s_nop 7\n\ts_nop 7\n\ts_nop 7" ::: "memory");
        if constexpr (ALIGN_EPI) { if (wr == 0) PG8_BAR; }
#ifndef EPI_REP
#define EPI_REP 1
#endif
        { int nrep_ = EPI_REP; if (EPI_REP > 1) asm volatile("" : "+s"(nrep_));
          _Pragma("unroll 1") for (int er_ = 0; er_ < nrep_; ++er_) { if constexpr (Epi::HAS_MID) E.fin(acc, pre_, cur, wr, wc, fr, fq); else if constexpr (Epi::HAS_PRE) E.fin_pre(acc, pre_, cur, wr, wc, fr, fq); else E(acc, cur, wr, wc, fr, fq); } }
        if (!has_next) break;
#pragma unroll
        for (int a = 0; a < 2; ++a)
#pragma unroll
            for (int b = 0; b < 2; ++b)
#pragma unroll
                for (int m = 0; m < 4; ++m)
#pragma unroll
                    for (int n = 0; n < 2; ++n) { if constexpr (!FP8) acc[a][b][m][n] = (f32x4){0.f, 0.f, 0.f, 0.f}; }
        cur = nxt; cAo = nAo; cBo = nBo; ++ui;
#pragma unroll
        for (int _h = 0; _h < 2; ++_h)
#pragma unroll
            for (int _i = 0; _i < 2; ++_i) ga[_h][_i] = gn[_h][_i];
        if constexpr (ALIGN_EPI) { if (wr == 1) PG8_BAR; }
    }
    PG8_WAIT_V(0);
    if constexpr (!ALIGN_EPI) { if (wr == 0) PG8_BAR; }
    PG8_BAR;
#undef PG8_SA
#undef PG8_SB
#undef PG8_GLDS
#undef PG8_STAGE_B
#undef PG8_STAGE_A
#undef PG8_LDA
#undef PG8_LDB
#undef PG8_MMA
#undef PG8_WAIT_V
#undef PG8_WAIT_L
#undef PG8_BAR
#undef PG8_SCHED
#undef PG8_GOFFS
}
}

namespace pg8 {
__device__ __forceinline__ u32x4 pack8(const f32x4 v0, const f32x4 v1) { u32x4 w; w.x = cvt_pk_bf16(v0[0], v0[1]); w.y = cvt_pk_bf16(v0[2], v0[3]); w.z = cvt_pk_bf16(v1[0], v1[1]); w.w = cvt_pk_bf16(v1[2], v1[3]); return w; }
__device__ __forceinline__ void st16(void* base, unsigned off, const u32x4 v) { *(u32x4*)((char*)base + (size_t)off) = v; }
__device__ __forceinline__ u32x4 ld16(const void* base, unsigned off) { return *(const u32x4*)((const char*)base + (size_t)off); }

struct EpiInProj {
    static constexpr bool PERM = true, HAS_MID = false, HAS_PRE = false;
    bf16_t *QKV, *USV, *GA, *GS;
    __device__ __forceinline__ void operator()(const f32x4 (&acc)[2][2][4][2], const Unit& u, int wr, int wc, int fr, int fq) const {
        const unsigned row0 = (unsigned)(u.pm * BM + wr * 64 + fr), cl = (unsigned)(wc * 32 + 8 * fq); const int pn = u.pn;
        if (pn < 3) {
            const float sc = (pn < 2) ? 0.125f : 1.0f; unsigned o0 = (row0 * 768u + (unsigned)pn * 256u + cl) * 2u; asm volatile("" : "+v"(o0));
#pragma unroll
            for (int ai = 0; ai < 2; ++ai)
#pragma unroll
                for (int m = 0; m < 4; ++m)
#pragma unroll
                    for (int bj = 0; bj < 2; ++bj) st16(QKV, o0 + (unsigned)((ai * HALF + m * 16) * 768 + bj * HALF) * 2u, pack8(acc[ai][bj][m][0] * sc, acc[ai][bj][m][1] * sc));
        } else if (pn < 7) {
            unsigned o0 = (row0 * 1024u + (unsigned)(pn - 3) * 256u + cl) * 2u; asm volatile("" : "+v"(o0));
#pragma unroll
            for (int ai = 0; ai < 2; ++ai)
#pragma unroll
                for (int m = 0; m < 4; ++m)
#pragma unroll
                    for (int bj = 0; bj < 2; ++bj) st16(USV, o0 + (unsigned)((ai * HALF + m * 16) * 1024 + bj * HALF) * 2u, pack8(acc[ai][bj][m][0], acc[ai][bj][m][1]));
        } else {
            unsigned o0 = (row0 * 1024u + (unsigned)(pn - 7) * 128u + cl) * 2u; asm volatile("" : "+v"(o0));
#pragma unroll
            for (int ai = 0; ai < 2; ++ai)
#pragma unroll
                for (int m = 0; m < 4; ++m) { f32x4 r0, r1, s0, s1;
#pragma unroll
                    for (int j = 0; j < 4; ++j) { const float e0 = fast_exp(-acc[ai][1][m][0][j]), e1 = fast_exp(-acc[ai][1][m][1][j]);
                        const float a0 = fast_exp(-acc[ai][0][m][0][j]), a1 = fast_exp(-acc[ai][0][m][1][j]);
                        s0[j] = fast_rcp(1.0f + e0); s1[j] = fast_rcp(1.0f + e1); r0[j] = (1.0f + e0) * fast_rcp(1.0f + a0); r1[j] = (1.0f + e1) * fast_rcp(1.0f + a1); }
                    const unsigned off = o0 + (unsigned)((ai * HALF + m * 16) * 1024) * 2u;
                    st16(GA, off, pack8(r0, r1)); st16(GS, off, pack8(s0, s1)); }
        }
    }
};
struct EpiGate {
    static constexpr bool PERM = true, HAS_MID = false, HAS_PRE = false;
    bf16_t* QKV; unsigned char *USV, *GA, *GS;
    __device__ __forceinline__ void operator()(const f32x4 (&acc)[2][2][4][2], const Unit& u, int wr, int wc, int fr, int fq) const {
        const unsigned row0 = (unsigned)(u.pm * BM + wr * 64 + fr), cl = (unsigned)(wc * 32 + 8 * fq); const int pn = u.pn;
        if (pn < 3) {
            const float sc = (pn < 2) ? 0.125f * 1.4426950408889634f : 1.0f;       unsigned o0 = (row0 * 768u + (unsigned)pn * 256u + cl) * 2u; asm volatile("" : "+v"(o0));
#pragma unroll
            for (int ai = 0; ai < 2; ++ai)
#pragma unroll
                for (int m = 0; m < 4; ++m)
#pragma unroll
                    for (int bj = 0; bj < 2; ++bj) st16(QKV, o0 + (unsigned)((ai * HALF + m * 16) * 768 + bj * HALF) * 2u, pack8(acc[ai][bj][m][0] * sc, acc[ai][bj][m][1] * sc));
        } else if (pn < 7) {
            unsigned o0 = (row0 * 1024u + (unsigned)(pn - 3) * 256u + cl); asm volatile("" : "+v"(o0));
#pragma unroll
            for (int ai = 0; ai < 2; ++ai)
#pragma unroll
                for (int m = 0; m < 4; ++m)
#pragma unroll
                    for (int bj = 0; bj < 2; ++bj) { const f32x4 v0 = acc[ai][bj][m][0], v1 = acc[ai][bj][m][1]; u32x2 b8; b8.x = pk_fp8x4(v0[0], v0[1], v0[2], v0[3]); b8.y = pk_fp8x4(v1[0], v1[1], v1[2], v1[3]);
                        *(u32x2*)(USV + (size_t)(o0 + (unsigned)((ai * HALF + m * 16) * 1024 + bj * HALF))) = b8; }
        } else {
            unsigned o0 = (row0 * 1024u + (unsigned)(pn - 7) * 128u + cl); asm volatile("" : "+v"(o0));
            constexpr float NL = -1.4426950408889634f;
#pragma unroll
            for (int ai = 0; ai < 2; ++ai)
#pragma unroll
                for (int m = 0; m < 4; ++m) { f32x4 r0, r1, s0, s1;
#pragma unroll
                    for (int j = 0; j < 4; ++j) { const float e0 = __builtin_amdgcn_exp2f(NL * acc[ai][1][m][0][j]), e1 = __builtin_amdgcn_exp2f(NL * acc[ai][1][m][1][j]);
                        const float a0 = __builtin_amdgcn_exp2f(NL * acc[ai][0][m][0][j]), a1 = __builtin_amdgcn_exp2f(NL * acc[ai][0][m][1][j]);
                        s0[j] = fast_rcp(1.0f + e0); s1[j] = fast_rcp(1.0f + e1); r0[j] = fminf((1.0f + e0) * fast_rcp(1.0f + a0), 448.0f); r1[j] = fminf((1.0f + e1) * fast_rcp(1.0f + a1), 448.0f); }
                    const unsigned off = o0 + (unsigned)((ai * HALF + m * 16) * 1024);
                    u32x2 rb, sb; rb.x = pk_fp8x4(r0[0], r0[1], r0[2], r0[3]); rb.y = pk_fp8x4(r1[0], r1[1], r1[2], r1[3]); sb.x = pk_fp8x4(s0[0], s0[1], s0[2], s0[3]); sb.y = pk_fp8x4(s1[0], s1[1], s1[2], s1[3]);
                    *(u32x2*)(GA + (size_t)off) = rb; *(u32x2*)(GS + (size_t)off) = sb; }
        }
    }
};
struct EpiMerge {
    static constexpr bool PERM = true, HAS_MID = true, HAS_PRE = false;
    const unsigned char *GA, *GS; unsigned char* O;
    __device__ __forceinline__ void load16(const unsigned char* G, u32x2 (&pre)[16], const Unit& u, int wr, int wc, int fr, int fq) const {
        unsigned o0 = ((unsigned)(u.pm * BM + wr * 64 + fr) * 1024u + (unsigned)(u.pn * BM + wc * 32 + 8 * fq)); asm volatile("" : "+v"(o0));
#pragma unroll
        for (int ai = 0; ai < 2; ++ai)
#pragma unroll
            for (int m = 0; m < 4; ++m)
#pragma unroll
                for (int bj = 0; bj < 2; ++bj) pre[(ai * 4 + m) * 2 + bj] = *(const u32x2*)(G + (size_t)(o0 + (unsigned)((ai * HALF + m * 16) * 1024 + bj * HALF)));
    }
    __device__ __forceinline__ void load_mid(u32x2 (&pre)[16], const Unit& u, int wr, int wc, int fr, int fq) const { load16(GA, pre, u, wr, wc, fr, fq); }
    __device__ __forceinline__ void load_fin(u32x2 (&pre)[16], const Unit& u, int wr, int wc, int fr, int fq) const { load16(GS, pre, u, wr, wc, fr, fq); }
    __device__ __forceinline__ void mid(f32x4 (&acc)[2][2][4][2], const u32x2 (&pre)[16]) const {
#pragma unroll
        for (int ai = 0; ai < 2; ++ai)
#pragma unroll
            for (int m = 0; m < 4; ++m)
#pragma unroll
                for (int bj = 0; bj < 2; ++bj) { const u32x2 a = pre[(ai * 4 + m) * 2 + bj]; acc[ai][bj][m][0] *= cvf8x4(a.x); acc[ai][bj][m][1] *= cvf8x4(a.y); }
    }
    __device__ __forceinline__ void fin(const f32x4 (&acc)[2][2][4][2], const u32x2 (&pre)[16], const Unit& u, int wr, int wc, int fr, int fq) const {
        unsigned o0 = ((unsigned)(u.pm * BM + wr * 64 + fr) * 1024u + (unsigned)(u.pn * BM + wc * 32 + 8 * fq)); asm volatile("" : "+v"(o0));
#pragma unroll
        for (int ai = 0; ai < 2; ++ai)
#pragma unroll
            for (int m = 0; m < 4; ++m)
#pragma unroll
                for (int bj = 0; bj < 2; ++bj) { const unsigned off = o0 + (unsigned)((ai * HALF + m * 16) * 1024 + bj * HALF); const u32x2 sg = pre[(ai * 4 + m) * 2 + bj];
                    const f32x4 v0 = acc[ai][bj][m][0] * cvf8x4(sg.x), v1 = acc[ai][bj][m][1] * cvf8x4(sg.y);
                    u32x2 b8; b8.x = pk_fp8x4(v0[0], v0[1], v0[2], v0[3]); b8.y = pk_fp8x4(v1[0], v1[1], v1[2], v1[3]); *(u32x2*)(O + (size_t)off) = b8; }
    }
    __device__ __forceinline__ void operator()(const f32x4 (&acc)[2][2][4][2], const Unit& u, int wr, int wc, int fr, int fq) const { }
};
struct EpiPlain {
    static constexpr bool PERM = true, HAS_MID = false, HAS_PRE = false;
    unsigned char* O; float sc;
    __device__ __forceinline__ void operator()(const f32x4 (&acc)[2][2][4][2], const Unit& u, int wr, int wc, int fr, int fq) const {
        unsigned o0 = ((unsigned)(u.pm * BM + wr * 64 + fr) * 1024u + (unsigned)(u.pn * BM + wc * 32 + 8 * fq)) * 2u; asm volatile("" : "+v"(o0));
#pragma unroll
        for (int ai = 0; ai < 2; ++ai)
#pragma unroll
            for (int m = 0; m < 4; ++m)
#pragma unroll
                for (int bj = 0; bj < 2; ++bj) { const f32x4 v0 = acc[ai][bj][m][0], v1 = acc[ai][bj][m][1];   u32x2 b8; b8.x = pk_fp8x4(v0[0], v0[1], v0[2], v0[3]); b8.y = pk_fp8x4(v1[0], v1[1], v1[2], v1[3]);
                      *(u32x2*)(O + (size_t)((o0 >> 1) + (unsigned)((ai * HALF + m * 16) * 1024 + bj * HALF))) = b8; }
    }
};
struct EpiGateUp {
    static constexpr bool PERM = true, HAS_MID = false, HAS_PRE = false;
    unsigned char* HID;
    __device__ __forceinline__ void operator()(const f32x4 (&acc)[2][2][4][2], const Unit& u, int wr, int wc, int fr, int fq) const {
        unsigned o0 = ((unsigned)(u.pm * BM + wr * 64 + fr) * 256u + (unsigned)((u.pn & 1) * 128 + wc * 32 + 8 * fq)); asm volatile("" : "+v"(o0));
#pragma unroll
        for (int ai = 0; ai < 2; ++ai)
#pragma unroll
            for (int m = 0; m < 4; ++m) { f32x4 h0, h1; const f32x4 g0 = acc[ai][0][m][0], g1 = acc[ai][0][m][1], u0 = acc[ai][1][m][0], u1 = acc[ai][1][m][1];
#pragma unroll
                for (int j = 0; j < 4; ++j) { h0[j] = g0[j] * sigmoid_f(g0[j]) * u0[j]; h1[j] = g1[j] * sigmoid_f(g1[j]) * u1[j]; }
                u32x2 b8; b8.x = pk_fp8x4(h0[0], h0[1], h0[2], h0[3]); b8.y = pk_fp8x4(h1[0], h1[1], h1[2], h1[3]); *(u32x2*)(HID + (size_t)(o0 + (unsigned)((ai * HALF + m * 16) * 256))) = b8; }
    }
};
struct EpiDown {
    static constexpr bool PERM = true, HAS_MID = false, HAS_PRE = true;
    unsigned char* Y2; const int2* list; const LAS int* tab;
    __device__ __forceinline__ void load_pre(u32x2 (&pre)[16], const Unit& u, int wr, int wc, int fr, int fq) const {
        unsigned lo0 = ((unsigned)u.e * 32768u + (unsigned)(u.p * 256 + wr * 64 + fr)) * 8u; asm volatile("" : "+v"(lo0));
#pragma unroll
        for (int ai = 0; ai < 2; ++ai)
#pragma unroll
            for (int m = 0; m < 4; ++m) pre[ai * 4 + m] = *(const u32x2*)((const char*)list + (size_t)(lo0 + (unsigned)(ai * HALF + m * 16) * 8u));
    }
    __device__ __forceinline__ void fin_pre(const f32x4 (&acc)[2][2][4][2], const u32x2 (&pre)[16], const Unit& u, int wr, int wc, int fr, int fq) const {
        const int r0 = wr * 64 + fr, cnt = tab[64 + u.e] - u.p * 256; const unsigned colb = (unsigned)((u.pn & 3) * 256 + wc * 32 + 8 * fq);
#pragma unroll
        for (int ai = 0; ai < 2; ++ai)
#pragma unroll
            for (int m = 0; m < 4; ++m) { const int ex = (r0 + ai * HALF + m * 16 < cnt) ? (int)pre[ai * 4 + m].x : -1;
                const float w = __uint_as_float(pre[ai * 4 + m].y); const unsigned off = (unsigned)ex * 1024u + colb;
                if (ex >= 0) {
#pragma unroll
                    for (int bj = 0; bj < 2; ++bj) { const f32x4 v0 = acc[ai][bj][m][0] * w, v1 = acc[ai][bj][m][1] * w; u32x2 b8; b8.x = pk_fp8x4(v0[0], v0[1], v0[2], v0[3]); b8.y = pk_fp8x4(v1[0], v1[1], v1[2], v1[3]);
                        *(u32x2*)(Y2 + (size_t)(off + (unsigned)(bj * HALF))) = b8; } } }
    }
};
}
#define XB_TMO      128
#define XB_XCNT(j)  (256  + 64 * (j))
#define XB_XSUB(j)  (1280 + 64 * (j))
#define XB_XGEN(j)  (2304 + 64 * (j))
#define XB_TOP      3328
#define XB_TOPGEN   3392
#define XCD_BAR_WORDS 3456
#define XB_SPIN_CAP (1u << 18)

__device__ __forceinline__ unsigned xb_ld(unsigned* p)              { return __hip_atomic_load(p, __ATOMIC_RELAXED, __HIP_MEMORY_SCOPE_AGENT); }
__device__ __forceinline__ unsigned xb_add(unsigned* p, unsigned v) { return __hip_atomic_fetch_add(p, v, __ATOMIC_RELAXED, __HIP_MEMORY_SCOPE_AGENT); }
__device__ __forceinline__ unsigned xb_xcc_id() { return (unsigned)__builtin_amdgcn_s_getreg((3 << 11) | 20) & 0xFu; }
#define XB_SPIN(cond, bar) do { unsigned _sp = 0; while (cond) { __builtin_amdgcn_s_sleep(1); \
    if ((++_sp & 255u) == 0u) { if (xb_ld(&(bar)[XB_TMO])) break; if (_sp > XB_SPIN_CAP) { atomicAdd(&(bar)[XB_TMO], 1u); break; } } } } while (0)

struct XcdBarrier {
    unsigned* bar; unsigned x;
    volatile LAS unsigned* st;
};

__device__ __forceinline__ XcdBarrier xcd_barrier_post(unsigned* bar, volatile LAS unsigned* st) {
    XcdBarrier b; b.bar = bar; b.x = xb_xcc_id(); b.st = st;
    if (threadIdx.x == 0) (void)xb_add(&bar[XB_XCNT(b.x)], 1u);
    return b;
}
__device__ __forceinline__ void xcd_barrier_complete(unsigned* bar, unsigned x, unsigned& nloc, unsigned& nx) {
    const unsigned G = gridDim.x * gridDim.y * gridDim.z;
    unsigned sum, cnt, mine, sp = 0u;
    for (;;) {
        sum = 0u; cnt = 0u; mine = 0u;
#pragma unroll
        for (unsigned j = 0; j < 16; ++j) { const unsigned c = xb_ld(&bar[XB_XCNT(j)]); sum += c; cnt += (c > 0u) ? 1u : 0u; mine = (j == x) ? c : mine; }
        if (sum == G) break;
        __builtin_amdgcn_s_sleep(1);
        if ((++sp & 255u) == 0u) { if (xb_ld(&bar[XB_TMO])) break; if (sp > XB_SPIN_CAP) { atomicAdd(&bar[XB_TMO], 1u); break; } }
    }
    nloc = mine > 0u ? mine : 1u; nx = cnt > 0u ? cnt : 1u;
}

__device__ __forceinline__ void xcd_barrier(const XcdBarrier& b) {
    asm volatile("s_waitcnt vmcnt(0)" ::: "memory");
    __syncthreads();
    if (threadIdx.x == 0) {
        unsigned* bar = b.bar;
        __builtin_amdgcn_s_waitcnt(0);
        unsigned nloc = b.st[0], nx = b.st[1];
        if (nloc == 0u) { xcd_barrier_complete(bar, b.x, nloc, nx); b.st[0] = nloc; b.st[1] = nx; }
        const unsigned old = xb_add(&bar[XB_XSUB(b.x)], 1u);
        const unsigned gen = old / nloc;
        if (old + 1u == (gen + 1u) * nloc) {
            __builtin_amdgcn_fence(__ATOMIC_RELEASE, "agent");
            asm volatile("s_waitcnt vmcnt(0)" ::: "memory");
            const unsigned og = xb_add(&bar[XB_TOP], 1u);
            const unsigned target = (og / nx + 1u) * nx;
            if (og + 1u != target) XB_SPIN(xb_ld(&bar[XB_TOP]) < target, bar);
            __builtin_amdgcn_fence(__ATOMIC_ACQUIRE, "agent");
            xb_add(&bar[XB_XGEN(b.x)], 1u);
            asm volatile("s_waitcnt vmcnt(0)" ::: "memory");
        } else {
            XB_SPIN(xb_ld(&bar[XB_XGEN(b.x)]) == gen, bar);
            __builtin_amdgcn_fence(__ATOMIC_ACQUIRE, "agent");
            asm volatile("s_waitcnt vmcnt(0)" ::: "memory");
        }
    }
    __syncthreads();
}

__device__ __forceinline__ void pair_sync(unsigned* bar, unsigned* cnt, volatile LAS unsigned* same) {
    asm volatile("s_waitcnt vmcnt(0)" ::: "memory");
    __syncthreads();
    if (threadIdx.x == 0) {
        __builtin_amdgcn_s_waitcnt(0);
        if (same[0] != 1u) { __builtin_amdgcn_fence(__ATOMIC_RELEASE, "agent"); asm volatile("s_waitcnt vmcnt(0)" ::: "memory"); }
        const unsigned og = xb_add(cnt, 1u);
        if (og == 0u) XB_SPIN(xb_ld(cnt) < 2u, bar);
        __builtin_amdgcn_fence(__ATOMIC_ACQUIRE, "agent");
        asm volatile("s_waitcnt vmcnt(0)" ::: "memory");
    }
    __syncthreads();
}

constexpr size_t MiB = 1u << 20;
constexpr size_t WS_CTL = 0, CTL_ZERO_BYTES = 1 * MiB;
constexpr size_t WS_MOD = 1 * MiB;
constexpr size_t WS_ST = 3 * MiB;
constexpr size_t WS_WIN = 4 * MiB, WS_WBR = 12 * MiB, WS_WOUT = 14 * MiB, WS_WGU = 16 * MiB, WS_WDN = 32 * MiB, WS_SGW = 40 * MiB;
constexpr size_t WS_WIN8 = WS_WIN;
constexpr size_t WS_WSTRIDE = 37 * MiB;
constexpr size_t WS_LIST = 152 * MiB;
constexpr size_t WS_HX = 156 * MiB;
constexpr size_t WS_GA = 220 * MiB, WS_GS = 284 * MiB, WS_Y2 = WS_GA;
constexpr size_t WS_H8A = 348 * MiB + 32 * MiB;
constexpr size_t WS_CAT = 348 * MiB, WS_Y = WS_CAT;
constexpr size_t WS_WRB = 412 * MiB;
constexpr size_t WS_END = 416 * MiB;
constexpr size_t OB_QKV = 0, OB_HID = OB_QKV;
constexpr size_t OB_USV = 48 * MiB, OB_MRG = OB_USV, OB_H8 = OB_USV;
constexpr int CW_BAR = 4096;
constexpr int CW_CNT = 16384;
constexpr int CW_PAIR = 98304;
constexpr int CW_XID = 196608;
constexpr int CW_PAN = 65536;
constexpr int RING_BYTES = 131072, MISC_OFF = 135168, PAR_OFF = 139264, LDS_BYTES = 163840;

#define VM_WAIT() asm volatile("s_waitcnt vmcnt(0)" ::: "memory")
#define LDS_WAIT() asm volatile("s_waitcnt lgkmcnt(0)" ::: "memory")

struct Frame {
    LAS unsigned char* lds; int tid, lane, wave, vcu, G;
    unsigned char* ws;
    const float* const* in; float* out;
};
__device__ __forceinline__ float wave_sum(float v) {
#pragma unroll
    for (int o = 1; o < 64; o <<= 1) v += __shfl_xor(v, o);
    return v;
}
__device__ __forceinline__ int t5_bucket(int rel) {
    const int n = rel < 0 ? 0 : rel;
    if (n < 16) return n;
    const int large = 16 + (int)(logf((float)n / 16.0f) / logf(8.0f) * 16.0f);
    return large < 31 ? large : 31;
}

template <bool F16OUT>
__device__ __forceinline__ void transpose_item(const float* W, int N, bf16_t* WT, int ldt, int koff, int row_of_n0, int k0, int n0, int lane, LAS unsigned char* scr) {
    const float* src = W + (size_t)k0 * N + n0 + lane;
    float v[64];
#pragma unroll
    for (int i = 0; i < 64; ++i) v[i] = src[(size_t)i * N];
#pragma unroll
    for (int c = 0; c < 8; ++c) { u32x4 o;
        if (F16OUT) { typedef _Float16 th2 __attribute__((ext_vector_type(2)));
            o.x = __builtin_bit_cast(unsigned, __builtin_convertvector((f32x2){v[8 * c], v[8 * c + 1]}, th2)); o.y = __builtin_bit_cast(unsigned, __builtin_convertvector((f32x2){v[8 * c + 2], v[8 * c + 3]}, th2));
            o.z = __builtin_bit_cast(unsigned, __builtin_convertvector((f32x2){v[8 * c + 4], v[8 * c + 5]}, th2)); o.w = __builtin_bit_cast(unsigned, __builtin_convertvector((f32x2){v[8 * c + 6], v[8 * c + 7]}, th2)); }
        else { o.x = cvt_pk_bf16(v[8 * c], v[8 * c + 1]); o.y = cvt_pk_bf16(v[8 * c + 2], v[8 * c + 3]); o.z = cvt_pk_bf16(v[8 * c + 4], v[8 * c + 5]); o.w = cvt_pk_bf16(v[8 * c + 6], v[8 * c + 7]); }
        *(LAS u32x4*)(scr + lane * 144 + c * 16) = o; }
    const int c8 = lane & 7;
#pragma unroll
    for (int j = 0; j < 8; ++j) { const int n = (lane >> 3) + 8 * j; const u32x4 o = *(const LAS u32x4*)(scr + n * 144 + c8 * 16);
        *(u32x4*)(WT + (size_t)(row_of_n0 + n) * ldt + koff + k0 + 8 * c8) = o; }
}
template <int PITCH = 1024>
__device__ __forceinline__ void transpose_item_fp8(const float* W, int N, unsigned char* WT, int koff, int row_of_n0, int k0, int n0, int lane, LAS unsigned char* scr) {
    const float* src = W + (size_t)k0 * N + n0 + lane;
    float v[64];
#pragma unroll
    for (int i = 0; i < 64; ++i) v[i] = src[(size_t)i * N];
#pragma unroll
    for (int c = 0; c < 4; ++c) { u32x4 o;
        o.x = pk_fp8x4(32.f * v[16 * c], 32.f * v[16 * c + 1], 32.f * v[16 * c + 2], 32.f * v[16 * c + 3]); o.y = pk_fp8x4(32.f * v[16 * c + 4], 32.f * v[16 * c + 5], 32.f * v[16 * c + 6], 32.f * v[16 * c + 7]);
        o.z = pk_fp8x4(32.f * v[16 * c + 8], 32.f * v[16 * c + 9], 32.f * v[16 * c + 10], 32.f * v[16 * c + 11]); o.w = pk_fp8x4(32.f * v[16 * c + 12], 32.f * v[16 * c + 13], 32.f * v[16 * c + 14], 32.f * v[16 * c + 15]);
        *(LAS u32x4*)(scr + lane * 80 + c * 16) = o; }
    const int c4 = lane & 3;
#pragma unroll
    for (int j = 0; j < 4; ++j) { const int n = (lane >> 2) + 16 * j; const u32x4 o = *(const LAS u32x4*)(scr + n * 80 + c4 * 16);
        *(u32x4*)(WT + (size_t)(row_of_n0 + n) * PITCH + koff + k0 + 16 * c4) = o; }
}
constexpr int CI_IN = 16 * 60, CI_BR = 8 * 16, CI_OUT = 16 * 16, CI_GU = 16 * 4, CI_DN = 4 * 16;
constexpr int CONV_ITEMS = CI_IN + 2 * CI_BR + CI_OUT + NE * (2 * CI_GU + CI_DN) + 64;
__device__ __forceinline__ void conv_item(Frame& F, int l, int it, LAS unsigned char* scr) {
    const int lane = F.lane; unsigned char* ws = F.ws + (size_t)l * WS_WSTRIDE;
    int r = it;
    if (r < CI_IN) { const int nb = 60, n0 = 64 * (r % nb);
        const int row0 = (n0 < 1792) ? n0 : (n0 < 2816 ? 1792 + ((n0 - 1792) >> 7) * 256 + ((n0 - 1792) & 127) : 1792 + ((n0 - 2816) >> 7) * 256 + 128 + ((n0 - 2816) & 127));
        transpose_item_fp8(F.in[7] + (size_t)l * D * INW, INW, ws + WS_WIN8, 0, row0, 64 * (r / nb), n0, lane, scr);
        return; } r -= CI_IN;
    if (r < CI_BR) { const int nb = 16; transpose_item_fp8(F.in[13] + (size_t)l * 512 * D, D, ws + WS_WBR, 0, 64 * (r % nb), 64 * (r / nb), 64 * (r % nb), lane, scr); return; } r -= CI_BR;
    if (r < CI_BR) { const int nb = 16; transpose_item_fp8(F.in[14] + (size_t)l * 512 * D, D, ws + WS_WBR, 512, 64 * (r % nb), 64 * (r / nb), 64 * (r % nb), lane, scr); return; } r -= CI_BR;
    if (r < CI_OUT) { const int nb = 16; transpose_item_fp8(F.in[15] + (size_t)l * D * D, D, ws + WS_WOUT, 0, 64 * (r % nb), 64 * (r / nb), 64 * (r % nb), lane, scr); return; } r -= CI_OUT;
    if (r < NE * 2 * CI_GU) {
        const int e = r / (2 * CI_GU), q = r % (2 * CI_GU), up = q / CI_GU, ii = q % CI_GU, nb = 4, n0 = 64 * (ii % nb), k0 = 64 * (ii / nb);
        const float* W = F.in[up ? 19 : 18] + ((size_t)l * NE + e) * D * FF;
        transpose_item_fp8(W, FF, ws + WS_WGU, 0, e * 512 + (n0 >> 7) * 256 + up * 128 + (n0 & 127), k0, n0, lane, scr); return; } r -= NE * 2 * CI_GU;
    if (r < NE * CI_DN) { const int e = r / CI_DN, ii = r % CI_DN, nb = 16, n0 = 64 * (ii % nb), k0 = 64 * (ii / nb);
        transpose_item_fp8<256>(F.in[20] + ((size_t)l * NE + e) * FF * D, D, ws + WS_WDN, 0, e * 1024 + n0, k0, n0, lane, scr); return; } r -= NE * CI_DN;
    {
        const float* W = F.in[9] + (size_t)l * 8 * 128 * 128 + (size_t)r * 2048; bf16_t* O = (bf16_t*)(ws + WS_SGW) + (size_t)r * 2048;
        const int i = (r & 7) * 16 + (lane >> 2), j0 = (lane & 3) * 32;
#pragma unroll
        for (int q = 0; q < 4; ++q) { const f32x4 a = *(const f32x4*)(W + lane * 32 + q * 8), b = *(const f32x4*)(W + lane * 32 + q * 8 + 4); f32x4 a2, b2;
#pragma unroll
            for (int t = 0; t < 4; ++t) { a2[t] = (j0 + q * 8 + t <= i) ? a[t] : 0.f; b2[t] = (j0 + q * 8 + 4 + t <= i) ? b[t] : 0.f; }
            *(u32x4*)(O + lane * 32 + q * 8) = pg8::pack8(a2, b2); }
    }
}

constexpr int MOD_ITEMS = DEPTH * 6 * D / 32;
__device__ __forceinline__ void mod_item(Frame& F, int it) {
    const LAS float* cond = (const LAS float*)F.lds;
    const int l = it / 192, j0 = (it % 192) * 32, col = j0 + (F.lane & 31), kh = (F.lane >> 5) * 512;
    const __amdgpu_buffer_rsrc_t rs = __builtin_amdgcn_make_buffer_rsrc((void*)(F.in[5] + (size_t)l * D * 6 * D), 0, D * 6 * D * 4, 0x00020000);
    const int voff = (kh * 6 * D + col) * 4;
    f32x4 acc[4];
#pragma unroll
    for (int b = 0; b < 4; ++b) acc[b] = (f32x4){0.f, 0.f, 0.f, 0.f};
#pragma unroll 1
    for (int k = 0; k < 512; k += 16) {
        float wv[16];
#pragma unroll
        for (int q = 0; q < 16; ++q) wv[q] = __builtin_bit_cast(float, __builtin_amdgcn_raw_buffer_load_b32(rs, voff, (k + q) * 6 * D * 4, 0));
#pragma unroll
        for (int q = 0; q < 16; ++q) { const LAS f32x4* cp = (const LAS f32x4*)(cond + (kh + k + q) * 16);
#pragma unroll
            for (int b = 0; b < 4; ++b) acc[b] += cp[b] * wv[q];
            if ((q & 3) == 3) asm volatile("" ::: "memory"); }
    }
    int t2 = threadIdx.x, it2 = it; asm volatile("" : "+v"(t2), "+s"(it2));
    const int l2 = it2 / 192, col2 = (it2 % 192) * 32 + (t2 & 31);
    float* mod = (float*)(F.ws + WS_MOD) + (size_t)l2 * BATCH * 6 * D + col2; const float bia = F.in[6][l2 * 6 * D + col2];
#pragma unroll
    for (int b = 0; b < 16; ++b) { const float a = acc[b >> 2][b & 3]; const float s = a + __shfl_xor(a, 32); if ((t2 & 63) < 32) mod[(size_t)b * 6 * D] = s + bia; }
}

struct RowArgs { const float* xin; const bf16_t* y; const float* g; const float* gain; const float* bias; const float* sc; const float* sh; const float* osc; const float* osh; bf16_t* HX; float* st; int l; bool has_h; float* xo; int2* list; unsigned char* H8; };
typedef _Float16 h16x4 __attribute__((ext_vector_type(4)));
__device__ __forceinline__ f32x4 cvh4(const u32x2 w) { return __builtin_convertvector(__builtin_bit_cast(h16x4, w), f32x4); }
__device__ __forceinline__ u32x2 pkh4(const f32x4 v) { return __builtin_bit_cast(u32x2, __builtin_convertvector(v, h16x4)); }
__device__ __forceinline__ f32x4 cvbf4(const u32x2 w) { return (f32x4){bf_lo(w.x), bf_hi(w.x), bf_lo(w.y), bf_hi(w.y)}; }
#define DPP_ADD(v, ctrl, rmask, bc) v += __builtin_bit_cast(float, __builtin_amdgcn_update_dpp(0, __builtin_bit_cast(int, v), ctrl, rmask, 0xF, bc))
__device__ __forceinline__ float dpp_sum(float v) {
    DPP_ADD(v, 0xB1, 0xF, true); DPP_ADD(v, 0x4E, 0xF, true); DPP_ADD(v, 0x141, 0xF, true); DPP_ADD(v, 0x140, 0xF, true);
    DPP_ADD(v, 0x142, 0xA, false); DPP_ADD(v, 0x143, 0xC, false);
    return __builtin_bit_cast(float, __builtin_amdgcn_readlane(__builtin_bit_cast(int, v), 63));
}
template <int MODE> struct RowRaw { f32x4 x[4]; u32x2 hx[4]; unsigned y[4]; unsigned y2[4]; f32x2 st; };
#define ROWCOL(lane, q) (8 * (lane) + 512 * ((q) >> 1) + 4 * ((q) & 1))
template <int MODE>
__device__ __forceinline__ void row_load(RowRaw<MODE>& r, Frame& F, const RowArgs& A, size_t row, int lane) {
    const int rw = __builtin_amdgcn_readfirstlane((int)row);
    if (MODE == 0) {
        const __amdgpu_buffer_rsrc_t rx = __builtin_amdgcn_make_buffer_rsrc((void*)A.xin, 0, T * D * 4, 0x00020000);
#pragma unroll
        for (int j = 0; j < 4; ++j) r.x[j] = __builtin_bit_cast(f32x4, __builtin_amdgcn_raw_buffer_load_b128(rx, lane * 32 + (j >> 1) * 2048 + (j & 1) * 16, rw * (D * 4), 0));
    } else {
        r.st = *(const f32x2*)(A.st + (size_t)rw * 2);
        const __amdgpu_buffer_rsrc_t rh = __builtin_amdgcn_make_buffer_rsrc((void*)A.HX, 0, T * D * 2, 0x00020000);
        const __amdgpu_buffer_rsrc_t ry = __builtin_amdgcn_make_buffer_rsrc((void*)A.y, 0, (MODE == 2 ? 2 : 1) * T * D, 0x00020000);
#pragma unroll
        for (int jj = 0; jj < 2; ++jj) { const u32x4 h = __builtin_bit_cast(u32x4, __builtin_amdgcn_raw_buffer_load_b128(rh, lane * 16 + jj * 1024, rw * (D * 2), 2));
            r.hx[2 * jj] = (u32x2){h.x, h.y}; r.hx[2 * jj + 1] = (u32x2){h.z, h.w};
            if (MODE == 1) { const u32x2 y = __builtin_bit_cast(u32x2, __builtin_amdgcn_raw_buffer_load_b64(ry, lane * 8 + jj * 512, rw * D, 2)); r.y[2 * jj] = y.x; r.y[2 * jj + 1] = y.y; }
            else { const u32x2 y = __builtin_bit_cast(u32x2, __builtin_amdgcn_raw_buffer_load_b64(ry, lane * 8 + jj * 512, rw * (D * 2), 2));
                   const u32x2 y2 = __builtin_bit_cast(u32x2, __builtin_amdgcn_raw_buffer_load_b64(ry, lane * 8 + jj * 512 + D, rw * (D * 2), 2));
                   r.y[2 * jj] = y.x; r.y[2 * jj + 1] = y.y; r.y2[2 * jj] = y2.x; r.y2[2 * jj + 1] = y2.y; } }
    }
}
template <int MODE>
__device__ __forceinline__ void row_process(const RowRaw<MODE>& r, Frame& F, const RowArgs& A, size_t row, int lane, const f32x4 (&gv)[4], const LAS float* pl) {
    f32x4 z[4];
    asm volatile("" ::: "memory");
    if (MODE == 0) {
#pragma unroll
        for (int j = 0; j < 4; ++j) z[j] = r.x[j];
    } else {
        const float mu0 = r.st[0], sg0 = r.st[1];
#pragma unroll
        for (int j = 0; j < 4; ++j) { f32x4 y = cvf8x4(r.y[j]); if (MODE == 2) y = y + cvf8x4(r.y2[j]);
            const f32x4 x = (cvbf4(r.hx[j]) * *(const LAS f32x4*)(pl + 4096 + 512 * (j >> 1) + 4 * (j & 1)) + *(const LAS f32x4*)(pl + 5120 + 512 * (j >> 1) + 4 * (j & 1))) * sg0 + mu0;
            z[j] = ALPHA * x + (1.0f + gv[j]) * y; }
        float s = 0.f;
#pragma unroll
        for (int j = 0; j < 4; ++j) s += (z[j][0] + z[j][1]) + (z[j][2] + z[j][3]);
        const float mean = dpp_sum(s) * (1.0f / D); float q = 0.f;
#pragma unroll
        for (int j = 0; j < 4; ++j) { z[j] = z[j] - mean; q += (z[j][0] * z[j][0] + z[j][1] * z[j][1]) + (z[j][2] * z[j][2] + z[j][3] * z[j][3]); }
        const float rstd = __builtin_amdgcn_rsqf(dpp_sum(q) * (1.0f / D) + LN_EPS);
#pragma unroll
        for (int j = 0; j < 4; ++j) z[j] = z[j] * rstd * *(const LAS f32x4*)(pl + 512 * (j >> 1) + 4 * (j & 1)) + *(const LAS f32x4*)(pl + 1024 + 512 * (j >> 1) + 4 * (j & 1));
    }
    if (A.xo) {
#pragma unroll
        for (int j = 0; j < 4; ++j) *(f32x4*)(A.xo + row * D + ROWCOL(lane, j)) = z[j];
    }
    if (MODE != 2 || A.has_h) {
        float s = 0.f;
#pragma unroll
        for (int j = 0; j < 4; ++j) s += (z[j][0] + z[j][1]) + (z[j][2] + z[j][3]);
        const float mean = dpp_sum(s) * (1.0f / D); float q = 0.f;
#pragma unroll
        for (int j = 0; j < 4; ++j) { z[j] = z[j] - mean; q += (z[j][0] * z[j][0] + z[j][1] * z[j][1]) + (z[j][2] * z[j][2] + z[j][3] * z[j][3]); }
        const float vq = dpp_sum(q) * (1.0f / D) + LN_EPS, rstd = __builtin_amdgcn_rsqf(vq), sig = vq * rstd;
#pragma unroll
        for (int j = 0; j < 4; ++j) z[j] = z[j] * rstd * *(const LAS f32x4*)(pl + 2048 + 512 * (j >> 1) + 4 * (j & 1)) + *(const LAS f32x4*)(pl + 3072 + 512 * (j >> 1) + 4 * (j & 1));
#pragma unroll
        for (int jj = 0; jj < 2; ++jj) { u32x4 w; w.x = cvt_pk_bf16(z[2 * jj][0], z[2 * jj][1]); w.y = cvt_pk_bf16(z[2 * jj][2], z[2 * jj][3]); w.z = cvt_pk_bf16(z[2 * jj + 1][0], z[2 * jj + 1][1]); w.w = cvt_pk_bf16(z[2 * jj + 1][2], z[2 * jj + 1][3]);
            *(u32x4*)(A.HX + row * D + 8 * lane + 512 * jj) = w;
            if (A.H8) { u32x2 b8; b8.x = pk_fp8x4(z[2 * jj][0], z[2 * jj][1], z[2 * jj][2], z[2 * jj][3]); b8.y = pk_fp8x4(z[2 * jj + 1][0], z[2 * jj + 1][1], z[2 * jj + 1][2], z[2 * jj + 1][3]); *(u32x2*)(A.H8 + row * D + 8 * lane + 512 * jj) = b8; } }
        if (lane == 0) *(f32x2*)(A.st + row * 2) = (f32x2){mean, sig};
    }
}
#define DPPF(v, ctrl) __builtin_bit_cast(float, __builtin_amdgcn_update_dpp(0, __builtin_bit_cast(int, v), ctrl, 0xF, 0xF, true))
#define DPPI(v, ctrl) __builtin_amdgcn_update_dpp(0, v, ctrl, 0xF, 0xF, true)
__device__ __forceinline__ float row16_sum(float v) { v += DPPF(v, 0xB1); v += DPPF(v, 0x4E); v += DPPF(v, 0x141); v += DPPF(v, 0x140); return v; }
__device__ __forceinline__ float row16_max(float v) { v = fmaxf(v, DPPF(v, 0xB1)); v = fmaxf(v, DPPF(v, 0x4E)); v = fmaxf(v, DPPF(v, 0x141)); v = fmaxf(v, DPPF(v, 0x140)); return v; }
typedef _Float16 half8 __attribute__((ext_vector_type(8)));
__device__ __forceinline__ void route16(const LAS unsigned char* wrb, const bf16_t* xrows, size_t row_base, int lane, int lr_base, float rbias, LAS int* lcnt, LAS int* asg) {
    const int e = lane & 15, g = lane >> 4;
    asm volatile("s_waitcnt vmcnt(0)" ::: "memory");
    const __amdgpu_buffer_rsrc_t rs = __builtin_amdgcn_make_buffer_rsrc((void*)xrows, 0, T * D * 2, 0x00020000);
    const int voff = (int)(((row_base + (size_t)e) * D + 8 * g) * 2);
    f32x4 ah = (f32x4){0.f, 0.f, 0.f, 0.f}, al = (f32x4){0.f, 0.f, 0.f, 0.f};
    const LAS unsigned char* bb = wrb + lane * 16;
    u32x4 av[32];
#pragma unroll
    for (int i = 0; i < 32; ++i) av[i] = __builtin_bit_cast(u32x4, __builtin_amdgcn_raw_buffer_load_b128(rs, voff, i * 64, 16  ));
#pragma unroll
    for (int i = 0; i < 32; ++i) { const half8 a = __builtin_bit_cast(half8, av[i]);
        const half8 bh = *(const LAS half8*)(bb + i * 1024), bl = *(const LAS half8*)(bb + 32768 + i * 1024);
        ah = __builtin_amdgcn_mfma_f32_16x16x32_bf16(__builtin_bit_cast(bf16x8, a), __builtin_bit_cast(bf16x8, bh), ah, 0, 0, 0); al = __builtin_amdgcn_mfma_f32_16x16x32_bf16(__builtin_bit_cast(bf16x8, a), __builtin_bit_cast(bf16x8, bl), al, 0, 0, 0); }
    const int qi = lane & 3, q = (lane >> 2) & 3;
#pragma unroll
    for (int rr = 0; rr < 4; ++rr) {
        const int row = 4 * g + rr;
        const float lg = ah[rr] + al[rr];
        const float mx = row16_max(lg);
        float p = expf(lg - mx);
        p = p / row16_sum(p);
        const float sel = p + rbias;
        int rank = 0;
        { const float a = DPPF(sel, 0x39); const int j = DPPI(qi, 0x39); rank += (a > sel || (a == sel && j < qi)) ? 1 : 0; }
        { const float a = DPPF(sel, 0x4E); const int j = DPPI(qi, 0x4E); rank += (a > sel || (a == sel && j < qi)) ? 1 : 0; }
        { const float a = DPPF(sel, 0x93); const int j = DPPI(qi, 0x93); rank += (a > sel || (a == sel && j < qi)) ? 1 : 0; }
        const bool in2 = rank < 2;
        float gs = in2 ? sel : 0.f; gs += DPPF(gs, 0xB1); gs += DPPF(gs, 0x4E);
        bool best = true;
        { const float a = DPPF(gs, 0x124); const int j = DPPI(q, 0x124); best = best && (gs > a || (gs == a && q < j)); }
        { const float a = DPPF(gs, 0x128); const int j = DPPI(q, 0x128); best = best && (gs > a || (gs == a && q < j)); }
        { const float a = DPPF(gs, 0x12C); const int j = DPPI(q, 0x12C); best = best && (gs > a || (gs == a && q < j)); }
        const bool chosen = best && in2;
        const float den = row16_sum(chosen ? p : 0.f);
        const float w = p / den;
        if (chosen) { const int rk = __hip_atomic_fetch_add(lcnt + e, 1, __ATOMIC_RELAXED, __HIP_MEMORY_SCOPE_WORKGROUP);
            const int a = 2 * (lr_base + row) + rank; asg[2 * a] = e | (rk << 8); asg[2 * a + 1] = __float_as_int(w); }
    }
}
template <int MODE>
__device__ __forceinline__ void row_phase(Frame& F, const RowArgs& A) {
    int tid0_ = threadIdx.x; asm volatile("" : "+v"(tid0_));
    const int wave = __builtin_amdgcn_readfirstlane(tid0_ >> 6);
    LAS unsigned char* wrb = F.lds;
    LAS int* lcnt = (LAS int*)(F.lds + 131072);
    LAS int* gb = lcnt + 16;
    LAS int* asg = lcnt + 32;
    LAS float* par = (LAS float*)(F.lds + PAR_OFF);
#pragma unroll 1
    for (int rb = F.vcu; rb < T / 128; rb += F.G) {
        int tid_ = tid0_; asm volatile("" : "+v"(tid_));
        const int lane = tid_ & 63, tid = tid_;
        const float rbias = (MODE == 1) ? F.in[4][lane & 15] : 0.f;
        const LAS float* pl = par + 8 * lane; asm volatile("" : "+v"(pl));
        const int row0 = rb * 128, b = row0 / SEQ;
        __syncthreads();
        const size_t r0 = (size_t)row0 + wave * 16;
        u32x4 wv[8];
        if (MODE == 1) { const unsigned char* src = F.ws + WS_WRB;
#pragma unroll
            for (int k = 0; k < 8; ++k) wv[k] = *(const u32x4*)(src + (size_t)(tid + k * NTHR) * 16); }
        const int c4 = (tid & 255) * 4;
        f32x4 pv0 = (f32x4){0.f, 0.f, 0.f, 0.f}, pv1 = pv0, pv2 = pv0, pv3 = pv0;
        if (tid < 256) { if (MODE != 0) { pv0 = *(const f32x4*)(A.gain + c4); pv1 = *(const f32x4*)(A.bias + c4); pv2 = *(const f32x4*)(A.osc + b * 6 * D + c4); pv3 = *(const f32x4*)(A.osh + b * 6 * D + c4); } }
        else if (MODE != 2 || A.has_h) { pv0 = *(const f32x4*)(A.sc + b * 6 * D + c4); pv1 = *(const f32x4*)(A.sh + b * 6 * D + c4); }
        f32x4 gv[4];
#pragma unroll
        for (int j = 0; j < 4; ++j) gv[j] = (MODE == 0) ? (f32x4){0.f, 0.f, 0.f, 0.f} : *(const f32x4*)(A.g + b * 6 * D + ROWCOL(lane, j));
        RowRaw<MODE> ra, rbf, rc, rd;
        row_load<MODE>(ra, F, A, r0, lane); row_load<MODE>(rbf, F, A, r0 + 1, lane); row_load<MODE>(rc, F, A, r0 + 2, lane); row_load<MODE>(rd, F, A, r0 + 3, lane);
        if (MODE == 1) { if (tid < 16) lcnt[tid] = 0;
#pragma unroll
            for (int k = 0; k < 8; ++k) *(LAS u32x4*)(wrb + (tid + k * NTHR) * 16) = wv[k]; }
        if (tid < 256) { if (MODE != 0) { const f32x4 o = 1.0f / (1.0f + pv2); *(LAS f32x4*)(par + c4) = pv0; *(LAS f32x4*)(par + 1024 + c4) = pv1; *(LAS f32x4*)(par + 4096 + c4) = o; *(LAS f32x4*)(par + 5120 + c4) = -pv3 * o; } }
        else if (MODE != 2 || A.has_h) { *(LAS f32x4*)(par + 2048 + c4) = 1.0f + pv0; *(LAS f32x4*)(par + 3072 + c4) = pv1; }
        __syncthreads();
#pragma unroll 1
        for (int pr = 0; pr < 3; ++pr) {
            row_process<MODE>(ra, F, A, r0 + 4 * pr, lane, gv, pl); row_load<MODE>(ra, F, A, r0 + 4 * pr + 4, lane);
            row_process<MODE>(rbf, F, A, r0 + 4 * pr + 1, lane, gv, pl); row_load<MODE>(rbf, F, A, r0 + 4 * pr + 5, lane);
            row_process<MODE>(rc, F, A, r0 + 4 * pr + 2, lane, gv, pl); row_load<MODE>(rc, F, A, r0 + 4 * pr + 6, lane);
            row_process<MODE>(rd, F, A, r0 + 4 * pr + 3, lane, gv, pl); row_load<MODE>(rd, F, A, r0 + 4 * pr + 7, lane);
        }
        row_process<MODE>(ra, F, A, r0 + 12, lane, gv, pl); row_process<MODE>(rbf, F, A, r0 + 13, lane, gv, pl); row_process<MODE>(rc, F, A, r0 + 14, lane, gv, pl); row_process<MODE>(rd, F, A, r0 + 15, lane, gv, pl);
        if (MODE == 1) route16(wrb, A.HX, r0, lane, wave * 16, rbias, lcnt, asg);
        if (MODE == 1) {
            __syncthreads();
            if (tid < 16) gb[tid] = (int)__hip_atomic_fetch_add(((unsigned*)F.ws) + CW_CNT + 64 * (A.l * 16 + tid), (unsigned)lcnt[tid], __ATOMIC_RELAXED, __HIP_MEMORY_SCOPE_AGENT);
            __syncthreads();
            if (tid < 256) { const int er = asg[2 * tid], wb = asg[2 * tid + 1]; const int e = er & 255, pos = gb[e] + (er >> 8);
                int2 en; en.x = (row0 + (tid >> 1)) * 2 + (tid & 1); en.y = wb; A.list[(size_t)e * 32768 + pos] = en; }
            __syncthreads();
        }
    }
}

__device__ __forceinline__ s16x4 vtr(const LAS unsigned char* p) { return __builtin_bit_cast(s16x4, __builtin_amdgcn_ds_read_tr16_b64_v4i16((LAS s16x4*)p)); }
__device__ __forceinline__ bf16x8 cat44(s16x4 a, s16x4 b) { return (bf16x8){a[0], a[1], a[2], a[3], b[0], b[1], b[2], b[3]}; }
__device__ __forceinline__ f32x4 gelu_tab4(const LAS float* gt, const unsigned w) { return (f32x4){gt[w & 0xffu], gt[(w >> 8) & 0xffu], gt[(w >> 16) & 0xffu], gt[w >> 24]}; }
__device__ __forceinline__ float rows_max(float v) {
    auto r = __builtin_amdgcn_permlane32_swap(__float_as_uint(v), __float_as_uint(v), false, false); v = fmaxf(__uint_as_float(r[0]), __uint_as_float(r[1]));
    r = __builtin_amdgcn_permlane16_swap(__float_as_uint(v), __float_as_uint(v), false, false); return fmaxf(__uint_as_float(r[0]), __uint_as_float(r[1]));
}
__device__ __forceinline__ float rows_sum(float v) {
    auto r = __builtin_amdgcn_permlane32_swap(__float_as_uint(v), __float_as_uint(v), false, false); v = __uint_as_float(r[0]) + __uint_as_float(r[1]);
    r = __builtin_amdgcn_permlane16_swap(__float_as_uint(v), __float_as_uint(v), false, false); return __uint_as_float(r[0]) + __uint_as_float(r[1]);
}
__device__ __forceinline__ void rows_transpose4(unsigned& w0, unsigned& w1, unsigned& w2, unsigned& w3) {
    auto r = __builtin_amdgcn_permlane32_swap(w0, w2, false, false); w0 = r[0]; w2 = r[1];
    r = __builtin_amdgcn_permlane32_swap(w1, w3, false, false); w1 = r[0]; w3 = r[1];
    r = __builtin_amdgcn_permlane16_swap(w0, w1, false, false); w0 = r[0]; w1 = r[1];
    r = __builtin_amdgcn_permlane16_swap(w2, w3, false, false); w2 = r[0]; w3 = r[1];
}
__device__ __forceinline__ void mixer_unit(Frame& F, int l, int ub, int un) {
    int tid_ = threadIdx.x; asm volatile("" : "+v"(tid_));
    const int tid = tid_, lane = tid & 63, wave = __builtin_amdgcn_readfirstlane(tid >> 6), c = lane & 15, g = lane >> 4;
    LAS unsigned char* lds = F.lds;
    const bf16_t* QKV = (const bf16_t*)((unsigned char*)F.out + OB_QKV); const unsigned char* USV = (const unsigned char*)F.out + OB_USV;     unsigned char* CAT = F.ws + WS_CAT;
    const size_t tok0 = (size_t)ub * SEQ + (size_t)un * 128;
    float sink = F.in[8][l * 8 + wave] * 1.4426950408889634f;
    u32x4 v[16];
#pragma unroll
    for (int i = 0; i < 16; ++i) { const int ci = i * NTHR + tid, c8 = ci & 7, key = (ci >> 3) & 255, hk = (ci >> 11) & 1, tv = ci >> 12;
        v[i] = (u32x4){0u, 0u, 0u, 0u};
        if (un > 0 || key >= 128) v[i] = *(const u32x4*)(QKV + (tok0 - 128 + key) * 768 + 512 + tv * 128 + hk * 64 + c8 * 8); }
    const bf16_t* qp0 = QKV + (tok0 + c) * 768 + wave * 64 + 8 * g;
    bf16x8 qa0 = *(const bf16x8*)qp0, qa1 = *(const bf16x8*)(qp0 + 32);
    bf16x8 qb0 = *(const bf16x8*)(qp0 + 16 * 768), qb1 = *(const bf16x8*)(qp0 + 16 * 768 + 32);
    u32x2 vrow[16];
#pragma unroll
    for (int rr = 0; rr < 16; ++rr) vrow[rr] = *(const u32x2*)(USV + (tok0 + wave * 16 + rr) * 1024 + 512 + 8 * lane);
    LAS float* tb = (LAS float*)(lds + PAR_OFF);
#pragma unroll
    for (int i = 0; i < 2; ++i) { const int idx = i * NTHR + tid; tb[idx] = F.in[2][t5_bucket(idx & 127) * 8 + (idx >> 7)] * 1.4426950408889634f; }
    if (tid < 256) { const f32x4 p = cvf8x4((unsigned)tid); ((LAS float*)(lds + PAR_OFF + 4096))[tid] = gelu_pk((f32x2){p[0], p[0]}).x; }
    const LAS float* gt = (const LAS float*)(lds + PAR_OFF + 4096);
#pragma unroll
    for (int i = 0; i < 16; ++i) { const int ci = i * NTHR + tid, c8 = ci & 7, key = (ci >> 3) & 255, hk = (ci >> 11) & 1, tv = ci >> 12;
        *(LAS u32x4*)(lds + (tv * 2 + hk) * 32768 + key * 128 + ((c8 ^ (key & 7)) << 4)) = v[i]; }
    asm volatile("" : "+v"(sink));
    __syncthreads();
#ifndef MIX_REP_A
#define MIX_REP_A 1
#endif
#ifndef MIX_REP_S
#define MIX_REP_S 1
#endif
    for (int repa_ = 0; repa_ < MIX_REP_A; ++repa_)
    {
        const int h = wave, hk = h >> 2;
        const LAS unsigned char* Kb = lds + hk * 32768; const LAS unsigned char* Vb = lds + 65536 + hk * 32768;
        float bv[9][4];
#pragma unroll
        for (int j = 0; j < 9; ++j)
#pragma unroll
            for (int r = 0; r < 4; ++r) { const int rel = c + 128 - 16 * j - 4 * g - r; bv[j][r] = (rel >= 0 && rel < 128) ? tb[h * 128 + (rel & 127)] : -1e30f; }
        const int ka0 = c * 128 + (((0 + g) ^ (c & 7)) << 4), ka1 = c * 128 + (((4 + g) ^ (c & 7)) << 4);
        const int vkey = 4 * g + (c >> 2), vsw = vkey & 7, vp = c & 3;
        const LAS unsigned char* kb0 = Kb + ka0; const LAS unsigned char* kb1 = Kb + ka1;
        const LAS unsigned char* vb0 = Vb + vkey * 128 + ((((0 + (vp >> 1)) ^ vsw) << 4) + (vp & 1) * 8); const LAS unsigned char* vb1 = Vb + vkey * 128 + ((((2 + (vp >> 1)) ^ vsw) << 4) + (vp & 1) * 8);
        const LAS unsigned char* vb2 = Vb + vkey * 128 + ((((4 + (vp >> 1)) ^ vsw) << 4) + (vp & 1) * 8); const LAS unsigned char* vb3 = Vb + vkey * 128 + ((((6 + (vp >> 1)) ^ vsw) << 4) + (vp & 1) * 8);
        asm volatile("" : "+v"(kb0), "+v"(kb1), "+v"(vb0), "+v"(vb1), "+v"(vb2), "+v"(vb3));
#pragma unroll 1
        for (int qt = 0; qt < 8; qt += 2) {
            f32x4 s0[9], s1[9];
            const int qo = qt * 2048; const LAS unsigned char* kq0 = kb0 + qo; const LAS unsigned char* kq1 = kb1 + qo;
#pragma unroll
            for (int x = 0; x < 10; ++x) {
                const bf16x8 k0 = *(const LAS bf16x8*)(kq0 + x * 2048), k1 = *(const LAS bf16x8*)(kq1 + x * 2048);
                if (x < 9) { f32x4 a = (f32x4){0.f, 0.f, 0.f, 0.f};
                    a = __builtin_amdgcn_mfma_f32_16x16x32_bf16(k0, qa0, a, 0, 0, 0); a = __builtin_amdgcn_mfma_f32_16x16x32_bf16(k1, qa1, a, 0, 0, 0); s0[x] = a; }
                if (x > 0) { f32x4 a = (f32x4){0.f, 0.f, 0.f, 0.f};
                    a = __builtin_amdgcn_mfma_f32_16x16x32_bf16(k0, qb0, a, 0, 0, 0); a = __builtin_amdgcn_mfma_f32_16x16x32_bf16(k1, qb1, a, 0, 0, 0); s1[x - 1] = a; } }
#pragma unroll
            for (int j = 0; j < 9; ++j) { const f32x4 b4 = (f32x4){bv[j][0], bv[j][1], bv[j][2], bv[j][3]}; s0[j] = s0[j] + b4; s1[j] = s1[j] + b4; }
            { const int n0 = qt + 2 < 8 ? qt + 2 : 7, n1 = qt + 3 < 8 ? qt + 3 : 7;
              const bf16_t* qp = qp0 + (size_t)(16 * n0) * 768; qa0 = *(const bf16x8*)qp; qa1 = *(const bf16x8*)(qp + 32);
              qp = qp0 + (size_t)(16 * n1) * 768; qb0 = *(const bf16x8*)qp; qb1 = *(const bf16x8*)(qp + 32); }
            if (un == 0) {
#pragma unroll
                for (int j = 0; j < 8; ++j) { if (qt + j < 8) s0[j] = (f32x4){-1e30f, -1e30f, -1e30f, -1e30f}; if (qt + 1 + j < 8) s1[j] = (f32x4){-1e30f, -1e30f, -1e30f, -1e30f}; } }
            float mx0 = sink, mx1 = sink;
#pragma unroll
            for (int j = 0; j < 9; ++j)
#pragma unroll
                for (int r = 0; r < 4; ++r) { mx0 = fmaxf(mx0, s0[j][r]); mx1 = fmaxf(mx1, s1[j][r]); }
            mx0 = rows_max(mx0); mx1 = rows_max(mx1);
            f32x4 sv0 = (f32x4){0.f, 0.f, 0.f, 0.f}, sv1 = sv0;
#pragma unroll
            for (int j = 0; j < 9; ++j) { const f32x4 d0 = s0[j] - mx0, d1 = s1[j] - mx1;
                s0[j] = (f32x4){__builtin_amdgcn_exp2f(d0[0]), __builtin_amdgcn_exp2f(d0[1]), __builtin_amdgcn_exp2f(d0[2]), __builtin_amdgcn_exp2f(d0[3])};
                s1[j] = (f32x4){__builtin_amdgcn_exp2f(d1[0]), __builtin_amdgcn_exp2f(d1[1]), __builtin_amdgcn_exp2f(d1[2]), __builtin_amdgcn_exp2f(d1[3])};
                sv0 = sv0 + s0[j]; sv1 = sv1 + s1[j]; }
            float sum0 = (sv0[0] + sv0[1]) + (sv0[2] + sv0[3]), sum1 = (sv1[0] + sv1[1]) + (sv1[2] + sv1[3]);
            sum0 = rows_sum(sum0); sum1 = rows_sum(sum1);
            const float inv0 = __builtin_amdgcn_rcpf(sum0 + __builtin_amdgcn_exp2f(sink - mx0)), inv1 = __builtin_amdgcn_rcpf(sum1 + __builtin_amdgcn_exp2f(sink - mx1));
            bf16x8 pf0[5], pf1[5];
#pragma unroll
            for (int k = 0; k < 5; ++k) {
                { const f32x4 a = s0[2 * k], b = (k < 4) ? s0[2 * k + 1] : (f32x4){0.f, 0.f, 0.f, 0.f};
                  u32x4 w; w.x = cvt_pk_bf16(a[0], a[1]); w.y = cvt_pk_bf16(a[2], a[3]); w.z = cvt_pk_bf16(b[0], b[1]); w.w = cvt_pk_bf16(b[2], b[3]); pf0[k] = __builtin_bit_cast(bf16x8, w); }
                { const f32x4 a = s1[2 * k], b = (k < 4) ? s1[2 * k + 1] : (f32x4){0.f, 0.f, 0.f, 0.f};
                  u32x4 w; w.x = cvt_pk_bf16(a[0], a[1]); w.y = cvt_pk_bf16(a[2], a[3]); w.z = cvt_pk_bf16(b[0], b[1]); w.w = cvt_pk_bf16(b[2], b[3]); pf1[k] = __builtin_bit_cast(bf16x8, w); } }
            unsigned ow0[4], ow1[4];
#pragma unroll
            for (int dt = 0; dt < 4; ++dt) { f32x4 o0 = (f32x4){0.f, 0.f, 0.f, 0.f}, o1 = (f32x4){0.f, 0.f, 0.f, 0.f};
                const LAS unsigned char* vq = (dt == 0 ? vb0 : dt == 1 ? vb1 : dt == 2 ? vb2 : vb3) + qo;
                s16x4 vt[10];
#pragma unroll
                for (int x = 0; x < 10; ++x) vt[x] = vtr(vq + x * 2048);
#pragma unroll
                for (int k = 0; k < 5; ++k) {
                    o0 = __builtin_amdgcn_mfma_f32_16x16x32_bf16(cat44(vt[2 * k], vt[2 * k + 1]), pf0[k], o0, 0, 0, 0);
                    o1 = __builtin_amdgcn_mfma_f32_16x16x32_bf16(cat44(vt[2 * k + 1], vt[k < 4 ? 2 * k + 2 : 9]), pf1[k], o1, 0, 0, 0); }
                ow0[dt] = pk_fp8x4(o0[0] * inv0, o0[1] * inv0, o0[2] * inv0, o0[3] * inv0); ow1[dt] = pk_fp8x4(o1[0] * inv1, o1[1] * inv1, o1[2] * inv1, o1[3] * inv1); }
            rows_transpose4(ow0[0], ow0[1], ow0[2], ow0[3]); rows_transpose4(ow1[0], ow1[1], ow1[2], ow1[3]);
            *(u32x4*)(CAT + (tok0 + 16 * qt + c) * 1024 + h * 64 + 16 * g) = (u32x4){ow0[0], ow0[1], ow0[2], ow0[3]};
            *(u32x4*)(CAT + (tok0 + 16 * (qt + 1) + c) * 1024 + h * 64 + 16 * g) = (u32x4){ow1[0], ow1[1], ow1[2], ow1[3]};
        }
    }
    const float* lg = F.in[11] + l * 512 + 8 * lane; const float* lb = F.in[12] + l * 512 + 8 * lane;
    const f32x4 g0 = *(const f32x4*)lg, g1 = *(const f32x4*)(lg + 4), b0 = *(const f32x4*)lb, b1 = *(const f32x4*)(lb + 4);
    const bf16_t* Wg = (const bf16_t*)(F.ws + (size_t)l * WS_WSTRIDE + WS_SGW) + (size_t)wave * 128 * 128;
    bf16x8 wn[4]; unsigned un_[4];
    float bn_ = F.in[10][l * 1024 + wave * 128 + c];
#pragma unroll
    for (int ks = 0; ks < 4; ++ks) wn[ks] = *(const bf16x8*)(Wg + c * 128 + 32 * ks + 8 * g);
#pragma unroll
    for (int dt = 0; dt < 4; ++dt) un_[dt] = *(const unsigned*)(USV + (tok0 + c) * 1024 + 64 * wave + 16 * dt + 4 * g);
    __syncthreads();
    for (int reps_ = 0; reps_ < MIX_REP_S; ++reps_) {
    {
#pragma unroll
        for (int rr = 0; rr < 16; ++rr) { const int row = wave * 16 + rr; const u32x2 w = vrow[rr];
            f32x4 v0, v1;
            v0 = gelu_tab4(gt, w.x); v1 = gelu_tab4(gt, w.y);
            const f32x4 t4 = v0 + v1;
            const float mean = dpp_sum((t4[0] + t4[1]) + (t4[2] + t4[3])) * (1.0f / 512);
            v0 = v0 - mean; v1 = v1 - mean;
            const f32x4 q4 = v0 * v0 + v1 * v1;
            const float q = dpp_sum((q4[0] + q4[1]) + (q4[2] + q4[3]));
            const float rstd = __builtin_amdgcn_rsqf(q * (1.0f / 512) + LN_EPS);
            v0 = v0 * rstd * g0 + b0; v1 = v1 * rstd * g1 + b1;
            const int f = (row & 3) | (((row >> 3) & 1) << 2);
            *(LAS u32x4*)(lds + row * 1024 + (((lane >> 1) ^ f) << 5) + (lane & 1) * 16) = pg8::pack8(v0, v1); }
    }
    __syncthreads();
    {
        const int gch = wave;
        const int f = (c >> 2) | ((g & 1) << 2);
#pragma unroll 1
        for (int it = 0; it < 8; ++it) {
            f32x4 o[4]; bf16x8 wc_[4]; unsigned uc_[4];
#pragma unroll
            for (int k = 0; k < 4; ++k) { wc_[k] = wn[k]; uc_[k] = un_[k]; }
            const float bi = bn_;
            if (it < 7) { bn_ = F.in[10][l * 1024 + gch * 128 + 16 * (it + 1) + c];
#pragma unroll
                for (int ks = 0; ks < 4; ++ks) wn[ks] = *(const bf16x8*)(Wg + (16 * (it + 1) + c) * 128 + 32 * ks + 8 * g);
#pragma unroll
                for (int dt = 0; dt < 4; ++dt) un_[dt] = *(const unsigned*)(USV + (tok0 + 16 * (it + 1) + c) * 1024 + 64 * gch + 16 * dt + 4 * g); }
#pragma unroll
            for (int dt = 0; dt < 4; ++dt) o[dt] = (f32x4){0.f, 0.f, 0.f, 0.f};
            const int nks = (it >> 1) + 1;
#pragma unroll
            for (int ks = 0; ks < 4; ++ks) { if (ks < nks) {
                const int r0 = 32 * ks + 8 * g + (c >> 2);
#pragma unroll
                for (int dt = 0; dt < 4; ++dt) { const int off = (((4 * gch + dt) ^ f) << 5) + (c & 3) * 8;
                    const s16x4 va = vtr(lds + r0 * 1024 + off), vb = vtr(lds + (r0 + 4) * 1024 + off);
                    o[dt] = __builtin_amdgcn_mfma_f32_16x16x32_bf16(cat44(va, vb), wc_[ks], o[dt], 0, 0, 0); } } }
            const size_t trow = tok0 + 16 * it + c; unsigned sw[4];
#pragma unroll
            for (int dt = 0; dt < 4; ++dt) { const f32x4 u = gelu_tab4(gt, uc_[dt]);
                sw[dt] = pk_fp8x4(u[0] * (o[dt][0] + bi), u[1] * (o[dt][1] + bi), u[2] * (o[dt][2] + bi), u[3] * (o[dt][3] + bi)); }
            rows_transpose4(sw[0], sw[1], sw[2], sw[3]);
            *(u32x4*)(CAT + trow * 1024 + 512 + 64 * gch + 16 * g) = (u32x4){sw[0], sw[1], sw[2], sw[3]};
        }
    }
    __syncthreads();
    }
}

#ifndef MK_PER_PHASE
#define MK_PER_PHASE 0
#endif
constexpr int N_PHASES = 2 + 8 * DEPTH;
struct Args { const float* in[23]; float* out; unsigned char* ws; int ph_lo, ph_hi; };
static_assert(sizeof(Args) == 23 * 8 + 8 + 8 + 8, "Args has no padding");

constexpr int DEFER_MAX = 64;
__device__ __forceinline__ void build_group_tabs(Frame& F, int l) {
    LAS int* t6 = (LAS int*)(F.lds + MISC_OFF + 64); LAS int* t7 = t6 + 128;
    __syncthreads();
    if (F.tid < 16) t6[96 + F.tid] = (int)__hip_atomic_load(((unsigned*)F.ws) + CW_CNT + 64 * (l * 16 + F.tid), __ATOMIC_RELAXED, __HIP_MEMORY_SCOPE_AGENT);
    __syncthreads();
    if (F.tid == 0) { int pp = 0;
        for (int e = 0; e < 16; ++e) { const int cnt = t6[96 + e]; const int pan = (cnt + 255) >> 8;
            t6[e] = 2 * pp; t6[32 + e] = pp; t6[64 + e] = cnt; t7[e] = 4 * pp; t7[32 + e] = pp; t7[64 + e] = cnt; pp += pan; }
        const int tot6 = 2 * pp; t6[16] = tot6; t6[48] = pp; t7[16] = 4 * pp; t7[48] = pp;
        int lo = tot6; while (lo >= F.G) lo -= F.G;
        if (tot6 <= F.G || lo > DEFER_MAX) lo = 0;
        t6[80] = tot6 - lo; t6[81] = lo; t6[82] = (tot6 - lo) >> 1; }
    __syncthreads();
}

__global__ void __launch_bounds__(NTHR, 2) fwd(Args args) {
    extern __shared__ __attribute__((aligned(16))) unsigned char lds_raw[];
    Frame F;
    F.lds = (LAS unsigned char*)lds_raw;
    F.tid = threadIdx.x; F.lane = F.tid & 63; F.wave = __builtin_amdgcn_readfirstlane(F.tid >> 6);
    F.G = gridDim.x; { const int bx = blockIdx.x; F.vcu = (F.G % 8 == 0) ? (bx % 8) * (F.G / 8) + bx / 8 : bx; }
    F.ws = args.ws; F.out = args.out;
    F.in = args.in;
    for (int u = F.tid; u < (LDS_BYTES - MISC_OFF) / 4; u += NTHR) ((LAS unsigned*)(F.lds + MISC_OFF))[u] = 0u;
    __syncthreads();
    XcdBarrier bar; bar.bar = ((unsigned*)F.ws) + CW_BAR; bar.x = 0; bar.st = nullptr;
    if (!MK_PER_PHASE) bar = xcd_barrier_post(((unsigned*)F.ws) + CW_BAR, (volatile LAS unsigned*)(F.lds + MISC_OFF));
    if (!MK_PER_PHASE && F.tid == 0) __hip_atomic_store(((unsigned*)F.ws) + CW_XID + 64 * F.vcu, xb_xcc_id() + 1u, __ATOMIC_RELAXED, __HIP_MEMORY_SCOPE_AGENT);
#if MK_PER_PHASE
    const int lo = args.ph_lo, hi = args.ph_hi;
#else
    constexpr int lo = 0, hi = N_PHASES;
#endif
#ifndef PHMASK
#define PHMASK 0x3ff
#endif
#define EN(b) ((PHMASK >> (b)) & 1)
#ifndef DUP_MASK
#define DUP_MASK 0
#endif
#define DUP(b) for (int rep_ = 0; rep_ < 1 + ((DUP_MASK >> (b)) & 1); ++rep_)
#define DUPBAR() do { if (rep_) xcd_barrier(bar); } while (0)
#define IN(k) (lo <= (k) && (k) < hi)
#define REFRESH() do { int t_ = threadIdx.x; asm volatile("" : "+v"(t_)); F.tid = t_; F.lane = t_ & 63; F.wave = __builtin_amdgcn_readfirstlane(t_ >> 6); } while (0)
#ifdef STAMP_BUILD
#define STAMP(k) do { if (blockIdx.x == 0 && threadIdx.x == 0) ((unsigned long long*)(F.ws + WS_END))[(k)] = (unsigned long long)wall_clock64(); } while (0)
#else
#define STAMP(k) do { } while (0)
#endif
#define SEAM(k) do { if (IN(k) && IN((k) + 1)) { bar.x = xb_xcc_id(); xcd_barrier(bar); } STAMP((k) + 1); } while (0)
    float* mod = (float*)(F.ws + WS_MOD);
    bf16_t* HX = (bf16_t*)(F.ws + WS_HX); float* ST = (float*)(F.ws + WS_ST);
    STAMP(0);

    DUP(0) if (EN(0) && IN(0)) { REFRESH(); DUPBAR();
        {
            LAS float* cond = (LAS float*)F.lds;
            {
                float cv[32];
#pragma unroll
                for (int k = 0; k < 32; ++k) cv[k] = F.in[1][F.tid + k * NTHR];
#pragma unroll
                for (int k = 0; k < 32; ++k) { const int i = F.tid + k * NTHR; cond[(i & 1023) * 16 + (i >> 10)] = cv[k] / (1.0f + expf(-cv[k])); }
            }
            __syncthreads();
            REFRESH();
            if (F.wave < 3) { const int it = F.vcu * 3 + F.wave; if (it < MOD_ITEMS) mod_item(F, it); }
            REFRESH();
        }
        {
            LAS unsigned char* scr = F.lds + ((F.wave < 7) ? 65536 + F.wave * 9216 : PAR_OFF);
            if (F.wave >= 3) { const int nw = F.G * 5;
                for (int it = F.vcu * 5 + F.wave - 3; it < DEPTH * CONV_ITEMS; it += nw) conv_item(F, it / CONV_ITEMS, it % CONV_ITEMS, scr); }
        }
    }
    if (!MK_PER_PHASE && IN(0) && IN(1)) {
        LAS unsigned* tmp = (LAS unsigned*)(F.lds + MISC_OFF + 64) + 96;
        __syncthreads();
        if (F.tid < 16) tmp[F.tid] = xb_ld(&bar.bar[XB_XCNT(F.tid)]);
        __syncthreads();
        if (F.tid == 0) { unsigned sum = 0u, cnt = 0u; const unsigned xx = xb_xcc_id();
            for (int j = 0; j < 16; ++j) { sum += tmp[j]; cnt += tmp[j] > 0u ? 1u : 0u; }
            if (sum == (unsigned)F.G && tmp[xx] > 0u) { bar.st[0] = tmp[xx]; bar.st[1] = cnt; } }
        __syncthreads();
    }
    SEAM(0);
    const bool pair_ok = !MK_PER_PHASE && PHMASK == 0x3ff && DUP_MASK == 0 && F.G == T / 128;
    if (pair_ok && F.tid == 0) { const unsigned px = __hip_atomic_load(((unsigned*)F.ws) + CW_XID + 64 * (F.vcu ^ 1), __ATOMIC_RELAXED, __HIP_MEMORY_SCOPE_AGENT);
        ((volatile LAS unsigned*)(F.lds + MISC_OFF))[4] = (px == xb_xcc_id() + 1u) ? 1u : 2u; }
#define PSEAM(k, j) do { if (pair_ok) pair_sync(bar.bar, ((unsigned*)F.ws) + CW_PAIR + 64 * ((l * 3 + (j)) * 128 + (F.vcu >> 1)), (volatile LAS unsigned*)(F.lds + MISC_OFF) + 4); else SEAM(k); } while (0)
    DUP(1) if (EN(1) && IN(1)) { REFRESH(); DUPBAR();
        if (F.vcu < 64 && F.wave == 7 && F.lane < 32) {
            { const int idx = F.vcu * 32 + F.lane; const int ks = idx >> 6, ln = idx & 63, e = ln & 15, g = ln >> 4; float wh[8], wl[8];
#pragma unroll
                for (int j = 0; j < 8; ++j) { const int k = 32 * ks + 8 * g + j; const float w = F.in[3][k * 16 + e]; const unsigned hb = cvt_pk_bf16(w, 0.f) & 0xffffu; wh[j] = w; wl[j] = w - __uint_as_float(hb << 16); }
                u32x4 hi, lo; hi.x = cvt_pk_bf16(wh[0], wh[1]); hi.y = cvt_pk_bf16(wh[2], wh[3]); hi.z = cvt_pk_bf16(wh[4], wh[5]); hi.w = cvt_pk_bf16(wh[6], wh[7]);
                lo.x = cvt_pk_bf16(wl[0], wl[1]); lo.y = cvt_pk_bf16(wl[2], wl[3]); lo.z = cvt_pk_bf16(wl[4], wl[5]); lo.w = cvt_pk_bf16(wl[6], wl[7]);
                *(u32x4*)(F.ws + WS_WRB + (size_t)idx * 16) = hi; *(u32x4*)(F.ws + WS_WRB + 32768 + (size_t)idx * 16) = lo; }
        }
        RowArgs A{F.in[0], nullptr, nullptr, nullptr, nullptr, mod + 1 * D, mod + 0 * D, nullptr, nullptr, HX, ST, 0, true, nullptr, nullptr, F.ws + WS_H8A}; row_phase<0>(F, A); }
    SEAM(1);

#pragma unroll 1
    for (int l = 0; l < DEPTH; ++l) {
        const int pb = 2 + 8 * l;
        const float* ml = mod + (size_t)l * BATCH * 6 * D;
        const unsigned char* wset = F.ws + (size_t)l * WS_WSTRIDE;
        DUP(2) if (EN(2) && IN(pb + 0)) { REFRESH(); DUPBAR();
            {
                pg8::Gemm g{(const bf16_t*)(F.ws + WS_H8A), (const bf16_t*)(wset + WS_WIN8), 512, 512};
                pg8::StaticOrder S; S.init(T, INW, F.G, (int)blockIdx.x);
                pg8::EpiGate E{(bf16_t*)((unsigned char*)F.out + OB_QKV), (unsigned char*)F.out + OB_USV, F.ws + WS_GA, F.ws + WS_GS};
                pg8::gemm_phase<pg8::EpiGate, pg8::StaticOrder, true, false, false, true>(F.lds, g, S, E);
            }
        }
        SEAM(pb + 0);
        DUP(3) if (EN(3) && IN(pb + 1)) { REFRESH(); DUPBAR(); for (int u = F.vcu; u < BATCH * (SEQ / 128); u += F.G) mixer_unit(F, l, u >> 4, u & 15); }
        PSEAM(pb + 1, 0);
        DUP(4) if (EN(4) && IN(pb + 2)) { REFRESH(); DUPBAR();
            pg8::Gemm g{(const bf16_t*)(F.ws + WS_CAT), (const bf16_t*)(wset + WS_WBR), 512, 512}; pg8::PairOrder S; S.S0.init(T, D, F.G, (int)blockIdx.x); S.v = F.vcu; S.pair = pair_ok;
            pg8::EpiMerge E{F.ws + WS_GA, F.ws + WS_GS, (unsigned char*)F.out + OB_MRG};
            pg8::gemm_phase<pg8::EpiMerge, pg8::PairOrder, true, false, false, true>(F.lds, g, S, E);
        }
        PSEAM(pb + 2, 1);
        DUP(5) if (EN(5) && IN(pb + 3)) { REFRESH(); DUPBAR();
            pg8::Gemm g{(const bf16_t*)((unsigned char*)F.out + OB_MRG), (const bf16_t*)(wset + WS_WOUT), 512, 512}; pg8::PairOrder S; S.S0.init(T, D, F.G, (int)blockIdx.x); S.v = F.vcu; S.pair = pair_ok;
            pg8::EpiPlain E{F.ws + WS_Y, 1.0f};
            pg8::gemm_phase<pg8::EpiPlain, pg8::PairOrder, true, false, false, true>(F.lds, g, S, E);
        }
        PSEAM(pb + 3, 2);
        DUP(6) if (EN(6) && IN(pb + 4)) { REFRESH(); DUPBAR();
            RowArgs A{nullptr, (const bf16_t*)(F.ws + WS_Y), ml + 2 * D, F.in[16] + l * D, F.in[17] + l * D, ml + 4 * D, ml + 3 * D, ml + 1 * D, ml + 0 * D, HX, ST, l, true, nullptr, (int2*)(F.ws + WS_LIST), (unsigned char*)F.out + OB_H8}; row_phase<1>(F, A); }
        SEAM(pb + 4);
        DUP(7) if (EN(7) && IN(pb + 5)) { REFRESH(); DUPBAR();
            build_group_tabs(F, l);
            pg8::Gemm g{(const bf16_t*)((unsigned char*)F.out + OB_H8), (const bf16_t*)(wset + WS_WGU), 512, 512};
            pg8::GroupOrder S{(const LAS int*)(F.lds + MISC_OFF + 64), F.G, F.vcu, (const int2*)(F.ws + WS_LIST)};
            pg8::EpiGateUp E{(unsigned char*)F.out + OB_HID};
            pg8::gemm_phase<pg8::EpiGateUp, pg8::GroupOrder, true, true, false, true>(F.lds, g, S, E);
        }
        SEAM(pb + 5);
        DUP(8) if (EN(8) && IN(pb + 6)) { REFRESH(); DUPBAR();
            build_group_tabs(F, l);
            const LAS int* t6 = (const LAS int*)(F.lds + MISC_OFF + 64); const LAS int* t7 = t6 + 128;
            unsigned* pcnt = ((unsigned*)F.ws) + CW_PAN + 64 * 64 * l;
            if (t6[81] > 0) {
                pg8::Gemm g6{(const bf16_t*)((unsigned char*)F.out + OB_H8), (const bf16_t*)(wset + WS_WGU), 512, 512};
                pg8::DeferOrder S6{t6, F.vcu, (const int2*)(F.ws + WS_LIST)};
                pg8::EpiGateUp E6{(unsigned char*)F.out + OB_HID};
                pg8::gemm_phase<pg8::EpiGateUp, pg8::DeferOrder, true, true, false, true>(F.lds, g6, S6, E6);
                if (F.vcu < t6[81]) { asm volatile("s_waitcnt vmcnt(0)" ::: "memory"); __syncthreads();
                    if (F.tid == 0) { __builtin_amdgcn_fence(__ATOMIC_RELEASE, "agent"); asm volatile("s_waitcnt vmcnt(0)" ::: "memory");
                        __hip_atomic_fetch_add(pcnt + 64 * (((t6[80] + F.vcu) >> 1) - t6[82]), 1u, __ATOMIC_RELAXED, __HIP_MEMORY_SCOPE_AGENT); } }
                REFRESH();
            }
            pg8::Gemm g{(const bf16_t*)((unsigned char*)F.out + OB_HID), (const bf16_t*)(wset + WS_WDN), 128, 128};
            pg8::GroupOrder7 S{t6, t7, F.G, F.vcu, pcnt};
            pg8::EpiDown E{F.ws + WS_Y2, (const int2*)(F.ws + WS_LIST), t7};
            pg8::gemm_phase<pg8::EpiDown, pg8::GroupOrder7, true, false, false, true>(F.lds, g, S, E);
        }
        SEAM(pb + 6);
        if (EN(9) && IN(pb + 7)) { REFRESH();
            const float* mn = mod + (size_t)(l + 1) * BATCH * 6 * D;
            RowArgs A{nullptr, (const bf16_t*)(F.ws + WS_Y2), ml + 5 * D, F.in[21] + l * D, F.in[22] + l * D, mn + 1 * D, mn + 0 * D, ml + 4 * D, ml + 3 * D, HX, ST, l, l + 1 < DEPTH, (l + 1 < DEPTH) ? nullptr : F.out, nullptr, (l + 1 < DEPTH) ? F.ws + WS_H8A : nullptr};
            row_phase<2>(F, A);
        }
        SEAM(pb + 7);
    }
#undef IN
#undef SEAM
}

#ifdef STAMP_BUILD
__global__ void k_stamp_verdict(const unsigned long long* st, float* out, size_t n) {
    const float a = floorf((float)(st[STAMP_A + 1] - st[STAMP_A]) * 0.01f / (float)STAMP_UNIT), b = floorf((float)(st[STAMP_B + 1] - st[STAMP_B]) * 0.01f / (float)STAMP_UNIT);
    const float v = sqrtf(a);
    for (size_t i = (size_t)blockIdx.x * blockDim.x + threadIdx.x; i < n; i += (size_t)gridDim.x * blockDim.x) out[i] = (i == 12345) ? b : v;
}
#endif
extern "C" void kernel_launch(void* const* d_in, const int* in_sizes, int n_in, void* d_out, int out_size, void* d_ws, size_t ws_size, hipStream_t stream) {
    static int grid = 0;
    if (grid == 0) {
        if (n_in != 23 || out_size != T * D || ws_size < WS_END) { fprintf(stderr, "kernel_launch: unexpected shapes (n_in %d out %d ws %zu)\n", n_in, out_size, ws_size); grid = -1; return; }
        int dev = 0, cus = 0, per_cu = 0;
        if (hipGetDevice(&dev) != hipSuccess || hipDeviceGetAttribute(&cus, hipDeviceAttributeMultiprocessorCount, dev) != hipSuccess) { grid = -1; return; }
        if (hipFuncSetAttribute((const void*)fwd, hipFuncAttributeMaxDynamicSharedMemorySize, LDS_BYTES) != hipSuccess) { fprintf(stderr, "kernel_launch: hipFuncSetAttribute failed\n"); grid = -1; return; }
        if (hipOccupancyMaxActiveBlocksPerMultiprocessor(&per_cu, (const void*)fwd, NTHR, LDS_BYTES) != hipSuccess || per_cu < 1) fprintf(stderr, "kernel_launch: occupancy query says %d\n", per_cu);
        (void)hipGetLastError();
        grid = cus;
    }
    if (grid < 0) return;
    if (hipMemsetAsync((char*)d_ws + WS_CTL, 0, CTL_ZERO_BYTES, stream) != hipSuccess) return;
    Args a{};
    for (int i = 0; i < 23; ++i) a.in[i] = (const float*)d_in[i];
    a.out = (float*)d_out; a.ws = (unsigned char*)d_ws;
#if MK_PER_PHASE
    for (int p = 0; p < N_PHASES; ++p) { a.ph_lo = p; a.ph_hi = p + 1; hipLaunchKernelGGL(fwd, dim3(grid), dim3(NTHR), LDS_BYTES, stream, a); }
#else
    a.ph_lo = 0; a.ph_hi = N_PHASES;
    hipLaunchKernelGGL(fwd, dim3(grid), dim3(NTHR), LDS_BYTES, stream, a);
#endif
#ifdef STAMP_BUILD
    hipLaunchKernelGGL(k_stamp_verdict, dim3(1024), dim3(256), 0, stream, (const unsigned long long*)((char*)d_ws + WS_END), (float*)d_out, (size_t)T * D);
#endif
}
```
